# Optimizing an MI355X kernel written in HIP

```python
import jax, jax.numpy as jnp
from jax import lax
import numpy as np


D_MODEL = 1024
BATCH = 8
SEQ = 8192
DEPTH = 1
DEC_BATCH = 8
DEC_SEQ = 2048
PAST_LEN = 128

GRID_W = 64
PLE_DIM = 256
POOL_WIDTH = 1024
POOL_GROUPS = 4
POOL_GROUP_WIDTH = POOL_WIDTH // POOL_GROUPS
POOL_WINDOWS = (2, 4, 8, 16)
N_Q_HEADS = 16
N_KV_HEADS = 4
HEADS_PER_KV = N_Q_HEADS // N_KV_HEADS
HEAD_DIM = 64
Q_WIDTH = N_Q_HEADS * HEAD_DIM
KV_WIDTH = N_KV_HEADS * HEAD_DIM
ROPE_AXIS_DIM = HEAD_DIM // 2
ROPE_BASE = 10000.0
Q_BLOCK = 128
EPS = 1e-6
IN_SPLITS = (POOL_WIDTH, POOL_WIDTH, Q_WIDTH, KV_WIDTH, KV_WIDTH, Q_WIDTH, D_MODEL, D_MODEL)
IN_WIDTH = sum(IN_SPLITS)
SPLIT_POINTS = tuple(int(v) for v in np.cumsum(IN_SPLITS)[:-1])

kernel_name = 'hybrid_pool_gqa_encoder'


def rms_norm(x, g):
    xf = x.astype(jnp.float32)
    y = xf * lax.rsqrt(jnp.mean(xf * xf, axis=-1, keepdims=True) + EPS)
    return (y * g.astype(jnp.float32)).astype(x.dtype)


def rope_1d(x, pos):
    dim = x.shape[-1]
    freqs = ROPE_BASE ** (-jnp.arange(0, dim, 2, dtype=jnp.float32) / dim)
    ang = pos[:, None] * freqs[None, :]
    cos = jnp.cos(ang)[None, :, None, :]
    sin = jnp.sin(ang)[None, :, None, :]
    xf = x.astype(jnp.float32)
    x1, x2 = xf[..., : dim // 2], xf[..., dim // 2:]
    out = jnp.concatenate([x1 * cos - x2 * sin, x2 * cos + x1 * sin], axis=-1)
    return out.astype(x.dtype)


def axial_rope(x, pos_row, pos_col):
    return jnp.concatenate([rope_1d(x[..., :ROPE_AXIS_DIM], pos_row),
                            rope_1d(x[..., ROPE_AXIS_DIM:], pos_col)], axis=-1)


def pool_mixer(u, pool_w, pool_scale):
    B, T, _ = u.shape
    uf = u.astype(jnp.float32)
    c = jnp.concatenate([jnp.zeros((B, 1, POOL_WIDTH), jnp.float32), jnp.cumsum(uf, axis=1)], axis=1)
    t = jnp.arange(T)
    groups = []
    for gi, w in enumerate(POOL_WINDOWS):
        sl = slice(gi * POOL_GROUP_WIDTH, (gi + 1) * POOL_GROUP_WIDTH)
        lo = jnp.clip(t - w // 2, 0, T)
        hi = jnp.clip(t + w - w // 2, 0, T)
        cnt = (hi - lo).astype(jnp.float32)
        cg = c[:, :, sl]
        mean = (cg[:, hi] - cg[:, lo]) / cnt[None, :, None]
        groups.append(mean - uf[..., sl])
    pooled = jnp.stack(groups, axis=2).astype(u.dtype)
    mixed = jnp.einsum('btgc,gcd->btgd', pooled, pool_w).reshape(B, T, POOL_WIDTH)
    return mixed * pool_scale


def block_attention(q, k, v):
    B, T, _, _ = q.shape
    n_blk = T // Q_BLOCK
    scale = HEAD_DIM ** -0.5
    qb = q.reshape(B, n_blk, Q_BLOCK, N_KV_HEADS, HEADS_PER_KV, HEAD_DIM)
    qb = jnp.moveaxis(qb, 1, 0)

    def one_block(qi):
        s = jnp.einsum('bqkgd,bskd->bkgqs', qi, k, preferred_element_type=jnp.float32) * scale
        p = jax.nn.softmax(s, axis=-1)
        return jnp.einsum('bkgqs,bskd->bqkgd', p.astype(v.dtype), v)

    o = lax.map(one_block, qb)
    return jnp.moveaxis(o, 0, 1).reshape(B, T, Q_WIDTH)


def encoder_layer(x, p_i, norm_pre, w_in, pool_w, pool_scale, w_branch_a, q_norm, k_norm,
                  w_branch_b, w_out, norm_post, ple_norm, w_ple_gate, w_ple_in):
    B, T, _ = x.shape
    rows = T // GRID_W
    pos_row = jnp.repeat(jnp.arange(rows, dtype=jnp.float32), GRID_W)
    pos_col = jnp.tile(jnp.arange(GRID_W, dtype=jnp.float32), rows)

    h = rms_norm(x, norm_pre)
    u = h @ w_in
    ua, za, q, k, v, zb, ma, mb = jnp.split(u, SPLIT_POINTS, axis=-1)

    a = pool_mixer(ua, pool_w, pool_scale) * jax.nn.silu(za)
    a = a @ w_branch_a

    q = rms_norm(q.reshape(B, T, N_Q_HEADS, HEAD_DIM), q_norm)
    k = rms_norm(k.reshape(B, T, N_KV_HEADS, HEAD_DIM), k_norm)
    v = v.reshape(B, T, N_KV_HEADS, HEAD_DIM)
    q = axial_rope(q, pos_row, pos_col)
    k = axial_rope(k, pos_row, pos_col)
    b = block_attention(q, k, v) * jax.nn.silu(zb)
    b = b @ w_branch_b

    merged = jax.nn.sigmoid(ma) * a + jax.nn.sigmoid(mb) * b
    x = x + rms_norm(merged @ w_out, norm_post)

    gate = jax.nn.sigmoid(rms_norm(x, ple_norm) @ w_ple_gate)
    return x + gate * (p_i @ w_ple_in)


def trunk(x, p, norm_pre, w_in, pool_w, pool_scale, w_branch_a, q_norm, k_norm,
          w_branch_b, w_out, norm_post, ple_norm, w_ple_gate, w_ple_in):
    for i in range(DEPTH):
        x = encoder_layer(x, p[i], norm_pre[i], w_in[i], pool_w[i], pool_scale[i], w_branch_a[i],
                          q_norm[i], k_norm[i], w_branch_b[i], w_out[i], norm_post[i],
                          ple_norm[i], w_ple_gate[i], w_ple_in[i])
    return x


def setup_inputs(seed: int = 0) -> dict:
    key = jax.random.key(seed)
    ks = jax.random.split(key, 20)
    f32 = jnp.float32

    def nrm(k, shape, scale=1.0):
        return jax.random.normal(k, shape, f32) * scale

    return {
        'x_prompt': nrm(ks[0], (BATCH, SEQ, D_MODEL)),
        'x_sample': nrm(ks[1], (DEC_BATCH, DEC_SEQ, D_MODEL)),
        'p_prompt': nrm(ks[2], (DEPTH, BATCH, SEQ, PLE_DIM)),
        'p_sample': nrm(ks[3], (DEPTH, DEC_BATCH, DEC_SEQ, PLE_DIM)),
        'norm_pre': 1.0 + nrm(ks[4], (DEPTH, D_MODEL), 0.05),
        'w_in': nrm(ks[5], (DEPTH, D_MODEL, IN_WIDTH), D_MODEL ** -0.5),
        'pool_w': nrm(ks[6], (DEPTH, POOL_GROUPS, POOL_GROUP_WIDTH, POOL_GROUP_WIDTH), POOL_GROUP_WIDTH ** -0.5),
        'pool_scale': 1.0 + nrm(ks[7], (DEPTH, POOL_WIDTH), 0.05),
        'w_branch_a': nrm(ks[8], (DEPTH, POOL_WIDTH, D_MODEL), POOL_WIDTH ** -0.5),
        'q_norm': 1.0 + nrm(ks[9], (DEPTH, HEAD_DIM), 0.05),
        'k_norm': 1.0 + nrm(ks[10], (DEPTH, HEAD_DIM), 0.05),
        'w_branch_b': nrm(ks[11], (DEPTH, Q_WIDTH, D_MODEL), Q_WIDTH ** -0.5),
        'w_out': nrm(ks[12], (DEPTH, D_MODEL, D_MODEL), D_MODEL ** -0.5),
        'norm_post': 1.0 + nrm(ks[13], (DEPTH, D_MODEL), 0.05),
        'ple_norm': 1.0 + nrm(ks[14], (DEPTH, D_MODEL), 0.05),
        'w_ple_gate': nrm(ks[15], (DEPTH, D_MODEL, D_MODEL), D_MODEL ** -0.5),
        'w_ple_in': nrm(ks[16], (DEPTH, PLE_DIM, D_MODEL), PLE_DIM ** -0.5),
    }


def reference(x_prompt, x_sample, p_prompt, p_sample, norm_pre, w_in, pool_w, pool_scale, w_branch_a,
              q_norm, k_norm, w_branch_b, w_out, norm_post, ple_norm, w_ple_gate, w_ple_in):
    y_prompt = trunk(x_prompt, p_prompt, norm_pre, w_in, pool_w, pool_scale, w_branch_a, q_norm, k_norm,
                     w_branch_b, w_out, norm_post, ple_norm, w_ple_gate, w_ple_in)
    y_sample = trunk(x_sample, p_sample, norm_pre, w_in, pool_w, pool_scale, w_branch_a, q_norm, k_norm,
                     w_branch_b, w_out, norm_post, ple_norm, w_ple_gate, w_ple_in)
    return (y_prompt, y_sample)
```

```cpp
#include <hip/hip_runtime.h>
#include <hip/hip_cooperative_groups.h>
#include <hip/hip_bf16.h>
#include <cstdio>
#include <cstdint>
#include <cmath>
namespace cg = cooperative_groups;

namespace pg8 {
#define PG8_LAS __attribute__((address_space(3)))
typedef unsigned short bf16_t;
typedef short bf16x8 __attribute__((ext_vector_type(8)));
typedef float f32x4 __attribute__((ext_vector_type(4)));
typedef unsigned u32x4 __attribute__((ext_vector_type(4)));
constexpr int BM = 256, BK = 64, HALF = 128, HTB = HALF * BK * 2  , STAGE_BYTES = 8 * HTB, NXCD = 8, WGM = 8;

__host__ __device__ __forceinline__ int lds_byte(int r, int c) { const int st = (r >> 4) * 2 + (c >> 5), rr = r & 15, cc = c & 31, ob = rr * 64 + cc * 2; return st * 1024 + (ob ^ (((ob >> 9) & 1) << 5)); }
__host__ __device__ __forceinline__ void stage_rc(int b, int& R, int& C) { const int st = b / 1024, sb = b % 1024, swz = sb ^ (((sb >> 9) & 1) << 5); R = (st >> 1) * 16 + swz / 64; C = (st & 1) * 32 + (swz % 64) / 2; }
__host__ __device__ __forceinline__ int perm32(int rho) { const int n = rho >> 4, i = rho & 15; return 8 * (i >> 2) + 4 * n + (i & 3); }

struct Unit { int pm, pn; };
struct Gemm { const bf16_t* A; const bf16_t* A2; const bf16_t* Bt; int lda, ldb, K, K1; size_t a_pn_off; };

struct StaticOrder {
    int nM, nN, nwg, G, c;
    __host__ __device__ void init(int M, int N, int G_, int c_) { nM = M / BM; nN = N / BM; nwg = nM * nN; G = G_; c = c_; }
    __host__ __device__ bool next(int i, Unit& u) const {
        const long L = (long)i * G + c; if (L >= nwg) return false;
        int wgid = (int)L; { const int q = nwg / NXCD, r = nwg % NXCD, xcd = wgid % NXCD, off = wgid / NXCD; wgid = (xcd < r ? xcd * (q + 1) : r * (q + 1) + (xcd - r) * q) + off; }
        const int nig = WGM * nN, gid = wgid / nig, fm = gid * WGM, gsz = (nM - fm) < WGM ? (nM - fm) : WGM;
        u.pm = fm + ((wgid % nig) % gsz); u.pn = (wgid % nig) / gsz; return true;
    }
    __device__ __forceinline__ void a_ready(const Unit&) const {}
    __device__ __forceinline__ void done(const Unit&) const {}
};

__device__ __forceinline__ unsigned cvt_pk_bf16(float lo, float hi) { unsigned r; asm volatile("v_cvt_pk_bf16_f32 %0, %1, %2" : "=v"(r) : "v"(lo), "v"(hi)); return r; }
__device__ __forceinline__ float bf_lo(unsigned w) { return __uint_as_float(w << 16); }
__device__ __forceinline__ float bf_hi(unsigned w) { return __uint_as_float(w & 0xffff0000u); }
__device__ __forceinline__ float fsigmoid(float x) { return __builtin_amdgcn_rcpf(1.0f + __builtin_amdgcn_exp2f(-1.4426950408889634f * x)); }
__device__ __forceinline__ float fsilu(float x) { return x * fsigmoid(x); }
__device__ __forceinline__ u32x4 pack8(const f32x4& v0, const f32x4& v1) { u32x4 w; w.x = cvt_pk_bf16(v0[0], v0[1]); w.y = cvt_pk_bf16(v0[2], v0[3]); w.z = cvt_pk_bf16(v1[0], v1[1]); w.w = cvt_pk_bf16(v1[2], v1[3]); return w; }
__device__ __forceinline__ void unpack8(const u32x4& w, f32x4& v0, f32x4& v1) { v0 = (f32x4){bf_lo(w.x), bf_hi(w.x), bf_lo(w.y), bf_hi(w.y)}; v1 = (f32x4){bf_lo(w.z), bf_hi(w.z), bf_lo(w.w), bf_hi(w.w)}; }

struct EpiIn {
    static constexpr bool PERM = true, AFTER_DRAIN = false, MID = false;
    bf16_t *ua, *sza, *q, *k, *v, *szb, *ma, *mb;
    __device__ __forceinline__ void operator()(const f32x4 (&acc)[2][2][4][2], const Unit& u, int wr, int wc, int fr, int fq) const {
        const int pn = u.pn; bf16_t* base; int ldc = 1024, ct; bool act = false;
        if (pn < 4) { base = ua; ct = pn; }
        else if (pn < 8) { base = sza; ct = pn - 4; act = true; }
        else if (pn < 12) { base = q; ct = pn - 8; }
        else if (pn == 12) { base = k; ct = 0; ldc = 256; }
        else if (pn == 13) { base = v; ct = 0; ldc = 256; }
        else if (pn < 18) { base = szb; ct = pn - 14; act = true; }
        else if (pn < 22) { base = ma; ct = pn - 18; }
        else { base = mb; ct = pn - 22; }
        const int row0 = u.pm * BM + wr * 64 + fr, col0 = ct * BM + wc * 32 + 8 * fq;
#pragma unroll
        for (int ai = 0; ai < 2; ++ai)
#pragma unroll
            for (int m = 0; m < 4; ++m) { bf16_t* rowp = base + (size_t)(row0 + ai * HALF + m * 16) * ldc + col0;
#pragma unroll
                for (int bj = 0; bj < 2; ++bj) { f32x4 v0 = acc[ai][bj][m][0], v1 = acc[ai][bj][m][1];
                    if (act) {
#pragma unroll
                        for (int e = 0; e < 4; ++e) { v0[e] = fsilu(v0[e]); v1[e] = fsilu(v1[e]); } }
                    *(u32x4*)(rowp + bj * HALF) = pack8(v0, v1); } }
    }
};
struct EpiPlain {
    static constexpr bool PERM = true, AFTER_DRAIN = false, MID = false;
    bf16_t* O; int ldc;
    __device__ __forceinline__ void operator()(const f32x4 (&acc)[2][2][4][2], const Unit& u, int wr, int wc, int fr, int fq) const {
        const int row0 = u.pm * BM + wr * 64 + fr, col0 = u.pn * BM + wc * 32 + 8 * fq;
#pragma unroll
        for (int ai = 0; ai < 2; ++ai)
#pragma unroll
            for (int m = 0; m < 4; ++m) { bf16_t* rowp = O + (size_t)(row0 + ai * HALF + m * 16) * ldc + col0;
#pragma unroll
                for (int bj = 0; bj < 2; ++bj) *(u32x4*)(rowp + bj * HALF) = pack8(acc[ai][bj][m][0], acc[ai][bj][m][1]); }
    }
};
struct EpiPool {
    static constexpr bool PERM = true, AFTER_DRAIN = false, MID = false;
    bf16_t* O; const bf16_t* sza; const float* pscale;
    __device__ __forceinline__ void operator()(const f32x4 (&acc)[2][2][4][2], const Unit& u, int wr, int wc, int fr, int fq) const {
        const int row0 = u.pm * BM + wr * 64 + fr, col0 = u.pn * BM + wc * 32 + 8 * fq;
        f32x4 ps[2][2];
#pragma unroll
        for (int bj = 0; bj < 2; ++bj)
#pragma unroll
            for (int n = 0; n < 2; ++n) ps[bj][n] = *(const f32x4*)(pscale + col0 + bj * HALF + 4 * n);
#pragma unroll
        for (int ai = 0; ai < 2; ++ai)
#pragma unroll
            for (int m = 0; m < 4; ++m) { const size_t off = (size_t)(row0 + ai * HALF + m * 16) * 1024 + col0;
#pragma unroll
                for (int bj = 0; bj < 2; ++bj) { const u32x4 gw = *(const u32x4*)(sza + off + bj * HALF); f32x4 g0, g1; unpack8(gw, g0, g1);
                    const f32x4 v0 = acc[ai][bj][m][0] * ps[bj][0] * g0, v1 = acc[ai][bj][m][1] * ps[bj][1] * g1;
                    *(u32x4*)(O + off + bj * HALF) = pack8(v0, v1); } }
    }
};
struct EpiMerge {
    static constexpr bool PERM = true, AFTER_DRAIN = false, MID = true;
    bf16_t* O; const bf16_t* ma; const bf16_t* mb;
    __device__ __forceinline__ void mid(f32x4 (&acc)[2][2][4][2], const Unit& u, int wr, int wc, int fr, int fq) const {
        int row0 = u.pm * BM + wr * 64 + fr, col0 = u.pn * BM + wc * 32 + 8 * fq;
        asm volatile("" : "+v"(row0), "+v"(col0));
#pragma unroll
        for (int ai = 0; ai < 2; ++ai)
#pragma unroll
            for (int m = 0; m < 4; ++m) { const size_t off = (size_t)(row0 + ai * HALF + m * 16) * 1024 + col0;
#pragma unroll
                for (int bj = 0; bj < 2; ++bj) { const u32x4 aw = *(const u32x4*)(ma + off + bj * HALF), bw = *(const u32x4*)(mb + off + bj * HALF);
                    f32x4 a0, a1, b0, b1; unpack8(aw, a0, a1); unpack8(bw, b0, b1);
#pragma unroll
                    for (int e = 0; e < 4; ++e) {
                        const float ea0 = __builtin_amdgcn_exp2f(-1.4426950408889634f * a0[e]), ea1 = __builtin_amdgcn_exp2f(-1.4426950408889634f * a1[e]);
                        const float eb0 = __builtin_amdgcn_exp2f(-1.4426950408889634f * fmaxf(b0[e], -60.f)), eb1 = __builtin_amdgcn_exp2f(-1.4426950408889634f * fmaxf(b1[e], -60.f));
                        acc[ai][bj][m][0][e] *= (1.0f + eb0) * __builtin_amdgcn_rcpf(1.0f + ea0);
                        acc[ai][bj][m][1][e] *= (1.0f + eb1) * __builtin_amdgcn_rcpf(1.0f + ea1); } }
                asm volatile("" : "+v"(acc[ai][0][m][0]), "+v"(acc[ai][0][m][1]), "+v"(acc[ai][1][m][0]), "+v"(acc[ai][1][m][1]) :: "memory"); }
    }
    __device__ __forceinline__ void operator()(const f32x4 (&acc)[2][2][4][2], const Unit& u, int wr, int wc, int fr, int fq) const {
        const int row0 = u.pm * BM + wr * 64 + fr, col0 = u.pn * BM + wc * 32 + 8 * fq;
#pragma unroll
        for (int ai = 0; ai < 2; ++ai)
#pragma unroll
            for (int m = 0; m < 4; ++m) { const size_t off = (size_t)(row0 + ai * HALF + m * 16) * 1024 + col0;
#pragma unroll
                for (int bj = 0; bj < 2; ++bj) { const u32x4 bw = *(const u32x4*)(mb + off + bj * HALF); f32x4 b0, b1; unpack8(bw, b0, b1); f32x4 v0 = acc[ai][bj][m][0], v1 = acc[ai][bj][m][1];
#pragma unroll
                    for (int e = 0; e < 4; ++e) { v0[e] *= fsigmoid(fmaxf(b0[e], -60.f)); v1[e] *= fsigmoid(fmaxf(b1[e], -60.f)); }
                    *(u32x4*)(O + off + bj * HALF) = pack8(v0, v1); } }
    }
};
struct EpiFinal {
    static constexpr bool PERM = true, AFTER_DRAIN = false, MID = false;
    float* out; const bf16_t* pe;
    __device__ __forceinline__ void operator()(const f32x4 (&acc)[2][2][4][2], const Unit& u, int wr, int wc, int fr, int fq) const {
        const int row0 = u.pm * BM + wr * 64 + fr, col0 = u.pn * BM + wc * 32 + 8 * fq;
#pragma unroll
        for (int ai = 0; ai < 2; ++ai)
#pragma unroll
            for (int m = 0; m < 4; ++m) { const size_t off = (size_t)(row0 + ai * HALF + m * 16) * 1024 + col0;
#pragma unroll
                for (int bj = 0; bj < 2; ++bj) { const u32x4 pw = *(const u32x4*)(pe + off + bj * HALF); f32x4 p0, p1; unpack8(pw, p0, p1);
                    float* op = out + off + bj * HALF; const f32x4 x0 = *(const f32x4*)op, x1 = *(const f32x4*)(op + 4);
                    f32x4 g0 = acc[ai][bj][m][0], g1 = acc[ai][bj][m][1];
#pragma unroll
                    for (int e = 0; e < 4; ++e) { g0[e] = x0[e] + fsigmoid(g0[e]) * p0[e]; g1[e] = x1[e] + fsigmoid(g1[e]) * p1[e]; }
                    *(f32x4*)op = g0; *(f32x4*)(op + 4) = g1; } }
    }
};

template <class Epi, class Sched, bool ALIGN_EPI = false, bool SP2 = false>
__device__ __forceinline__ void gemm_phase(PG8_LAS unsigned char* lds, const Gemm g, const Sched& S, const Epi& E) {
    const int tid = threadIdx.x, wid = __builtin_amdgcn_readfirstlane(tid >> 6), lane = tid & 63, wr = wid >> 2, wc = wid & 3, fr = lane & 15, fq = lane >> 4;
    const int nt = g.K / BK, nth = g.K1 / BK;
    unsigned voffA[2], voffB[2];
#pragma unroll
    for (int i = 0; i < 2; ++i) { int R, C; stage_rc(tid * 16 + i * 8192, R, C); const int Rb = Epi::PERM ? ((R & ~31) + perm32(R & 31)) : R;
        voffA[i] = (unsigned)(R * g.lda + C) * 2u; voffB[i] = (unsigned)(Rb * g.ldb + C) * 2u; }
    const size_t kstep = (size_t)(BK * 2);
    const size_t hstepA = (size_t)HALF * g.lda * 2, hstepB = (size_t)HALF * g.ldb * 2;
    const size_t tstepA = 2 * hstepA, tstepB = 2 * hstepB;
    const unsigned ldsw = (unsigned)wid * 1024u;
    const int aoff = lds_byte(wr * 64 + fr, fq * 8), boff = lds_byte(wc * 32 + fr, fq * 8);
#define PG8_SA(b, h) (((b) * 2 + (h)) * HTB)
#define PG8_SB(b, h) ((4 + (b) * 2 + (h)) * HTB)
#define PG8_STAGE(bufoff, gbase, voff) do { _Pragma("unroll") for (int _i = 0; _i < 2; ++_i) \
        __builtin_amdgcn_global_load_lds((const unsigned*)((const char*)(gbase) + (voff)[_i]), (PG8_LAS unsigned*)(lds + (bufoff) + ldsw + _i * 8192), 16, 0, 0); } while (0)
#define PG8_LDA(dst, b, h) do { _Pragma("unroll") for (int m = 0; m < 4; ++m) _Pragma("unroll") for (int k = 0; k < 2; ++k) dst[m][k] = *(const PG8_LAS bf16x8*)(lds + PG8_SA(b, h) + aoff + m * 2048 + k * 1024); } while (0)
#define PG8_LDB(dst, b, h) do { _Pragma("unroll") for (int n = 0; n < 2; ++n) _Pragma("unroll") for (int k = 0; k < 2; ++k) dst[n][k] = *(const PG8_LAS bf16x8*)(lds + PG8_SB(b, h) + boff + n * 2048 + k * 1024); } while (0)
#define PG8_MMA(ai, bj, At, Bt) do { __builtin_amdgcn_s_setprio(1); _Pragma("unroll") for (int m = 0; m < 4; ++m) _Pragma("unroll") for (int n = 0; n < 2; ++n) _Pragma("unroll") for (int k = 0; k < 2; ++k) \
        acc[ai][bj][m][n] = __builtin_amdgcn_mfma_f32_16x16x32_bf16(Bt[n][k], At[m][k], acc[ai][bj][m][n], 0, 0, 0); __builtin_amdgcn_s_setprio(0); } while (0)
#define PG8_WAIT_V(n) asm volatile("s_waitcnt vmcnt(" #n ")" ::: "memory")
#define PG8_WAIT_L(n) asm volatile("s_waitcnt lgkmcnt(" #n ")" ::: "memory")
#define PG8_BAR __builtin_amdgcn_s_barrier()
#define PG8_SCHED __builtin_amdgcn_sched_barrier(0)
    Unit cur, nxt; int ui = 0;
    if (!S.next(0, cur)) return;
    f32x4 acc[2][2][4][2];
#pragma unroll
    for (int a = 0; a < 2; ++a)
#pragma unroll
        for (int b = 0; b < 2; ++b)
#pragma unroll
            for (int m = 0; m < 4; ++m)
#pragma unroll
                for (int n = 0; n < 2; ++n) acc[a][b][m][n] = (f32x4){0.f, 0.f, 0.f, 0.f};
    bf16x8 At[4][2], B0[2][2], B1[2][2];
    const char* cA = (const char*)g.A + (size_t)cur.pm * tstepA + (size_t)cur.pn * g.a_pn_off; const char* cA2 = (const char*)g.A2 + (size_t)cur.pm * tstepA; const char* cB = (const char*)g.Bt + (size_t)cur.pn * tstepB;
    S.a_ready(cur);
    if constexpr (SP2) {
        PG8_STAGE(PG8_SB(0, 0), cB, voffB); PG8_STAGE(PG8_SB(0, 1), cB + hstepB, voffB); PG8_STAGE(PG8_SA(0, 0), cA, voffA); PG8_STAGE(PG8_SA(0, 1), cA + hstepA, voffA);
        if (wr == 1) PG8_BAR;
        PG8_WAIT_V(2); PG8_BAR;
        PG8_STAGE(PG8_SB(1, 0), cB + kstep, voffB); PG8_STAGE(PG8_SA(1, 0), cA + kstep, voffA); PG8_STAGE(PG8_SB(1, 1), cB + hstepB + kstep, voffB);
        PG8_WAIT_V(6); PG8_BAR;
    } else {
        PG8_STAGE(PG8_SB(0, 0), cB, voffB); PG8_STAGE(PG8_SA(0, 0), cA, voffA); PG8_STAGE(PG8_SB(0, 1), cB + hstepB, voffB); PG8_STAGE(PG8_SA(0, 1), cA + hstepA, voffA);
        if (wr == 1) PG8_BAR;
        PG8_WAIT_V(4); PG8_BAR;
        PG8_STAGE(PG8_SB(1, 0), cB + kstep, voffB); PG8_STAGE(PG8_SA(1, 0), cA + kstep, voffA); PG8_STAGE(PG8_SB(1, 1), cB + hstepB + kstep, voffB);
        PG8_WAIT_V(6); PG8_BAR;
    }
    for (;;) {
        const bool has_next = S.next(ui + 1, nxt);
        const char* nA = has_next ? (const char*)g.A + (size_t)nxt.pm * tstepA + (size_t)nxt.pn * g.a_pn_off : cA; const char* nA2 = has_next ? (const char*)g.A2 + (size_t)nxt.pm * tstepA : cA2; const char* nB = has_next ? (const char*)g.Bt + (size_t)nxt.pn * tstepB : cB;
        for (int t = 0; t < nt; t += 2) {
            const bool last = (t == nt - 2);
            if constexpr (Epi::MID) { if (t == nth) E.mid(acc, cur, wr, wc, fr, fq); }
            const char* a1 = (t + 1 < nth) ? cA + (size_t)(t + 1) * kstep : cA2 + (size_t)(t + 1 - nth) * kstep;
            const char* a2 = last ? nA : ((t + 2 < nth) ? cA + (size_t)(t + 2) * kstep : cA2 + (size_t)(t + 2 - nth) * kstep); const char* b2 = last ? nB : cB + (size_t)(t + 2) * kstep;
            const char* a3 = a2 + kstep; const char* b3 = b2 + kstep;
            if (last && has_next) S.a_ready(nxt);
            if constexpr (SP2) {
            PG8_LDB(B0, 0, 0); PG8_LDB(B1, 0, 1); PG8_SCHED; PG8_LDA(At, 0, 0); PG8_STAGE(PG8_SA(1, 1), a1 + hstepA, voffA);
            PG8_WAIT_V(8); PG8_WAIT_L(0); PG8_BAR; PG8_MMA(0, 0, At, B0); PG8_MMA(0, 1, At, B1); PG8_BAR; PG8_SCHED;
            PG8_LDA(At, 0, 1); PG8_STAGE(PG8_SB(0, 0), b2, voffB); PG8_STAGE(PG8_SB(0, 1), b2 + hstepB, voffB); PG8_STAGE(PG8_SA(0, 0), a2, voffA);
            PG8_WAIT_V(8); PG8_WAIT_L(0); PG8_BAR; PG8_MMA(1, 0, At, B0); PG8_MMA(1, 1, At, B1); PG8_BAR; PG8_SCHED;
            PG8_LDB(B0, 1, 0); PG8_LDB(B1, 1, 1); PG8_SCHED; PG8_LDA(At, 1, 0); PG8_STAGE(PG8_SA(0, 1), a2 + hstepA, voffA);
            PG8_WAIT_V(8); PG8_WAIT_L(0); PG8_BAR; PG8_MMA(0, 0, At, B0); PG8_MMA(0, 1, At, B1); PG8_BAR; PG8_SCHED;
            PG8_LDA(At, 1, 1); PG8_STAGE(PG8_SB(1, 0), b3, voffB); PG8_STAGE(PG8_SB(1, 1), b3 + hstepB, voffB); PG8_STAGE(PG8_SA(1, 0), a3, voffA);
            PG8_WAIT_V(8); PG8_WAIT_L(0); PG8_BAR; PG8_MMA(1, 0, At, B0); PG8_MMA(1, 1, At, B1); PG8_BAR; PG8_SCHED;
            } else {
            PG8_LDB(B0, 0, 0); PG8_SCHED; PG8_LDA(At, 0, 0); PG8_STAGE(PG8_SA(1, 1), a1 + hstepA, voffA);
            PG8_WAIT_L(8); PG8_BAR; PG8_WAIT_L(0); PG8_MMA(0, 0, At, B0); PG8_BAR; PG8_SCHED;
            PG8_LDB(B1, 0, 1); PG8_STAGE(PG8_SB(0, 0), b2, voffB);
            PG8_BAR; PG8_WAIT_L(0); PG8_MMA(0, 1, At, B1); PG8_BAR;
            PG8_LDA(At, 0, 1); PG8_STAGE(PG8_SA(0, 0), a2, voffA);
            PG8_BAR; PG8_WAIT_L(0); PG8_MMA(1, 0, At, B0); PG8_BAR; PG8_SCHED;
            PG8_STAGE(PG8_SB(0, 1), b2 + hstepB, voffB);
            PG8_WAIT_V(6); PG8_BAR; PG8_MMA(1, 1, At, B1); PG8_BAR;
            PG8_LDB(B0, 1, 0); PG8_SCHED; PG8_LDA(At, 1, 0); PG8_STAGE(PG8_SA(0, 1), a2 + hstepA, voffA);
            PG8_WAIT_L(8); PG8_BAR; PG8_WAIT_L(0); PG8_MMA(0, 0, At, B0); PG8_BAR; PG8_SCHED;
            PG8_LDB(B1, 1, 1); PG8_STAGE(PG8_SB(1, 0), b3, voffB);
            PG8_BAR; PG8_WAIT_L(0); PG8_MMA(0, 1, At, B1); PG8_BAR;
            PG8_LDA(At, 1, 1); PG8_STAGE(PG8_SA(1, 0), a3, voffA);
            PG8_BAR; PG8_WAIT_L(0); PG8_MMA(1, 0, At, B0); PG8_BAR; PG8_SCHED;
            PG8_STAGE(PG8_SB(1, 1), b3 + hstepB, voffB);
            PG8_WAIT_V(6); PG8_BAR; PG8_MMA(1, 1, At, B1); PG8_BAR;
            }
        }
        if constexpr (ALIGN_EPI) { if (wr == 0) PG8_BAR; }
        if constexpr (!Epi::AFTER_DRAIN) { E(acc, cur, wr, wc, fr, fq); S.done(cur); }
        if (!has_next) break;
#pragma unroll
        for (int a = 0; a < 2; ++a)
#pragma unroll
            for (int b = 0; b < 2; ++b)
#pragma unroll
                for (int m = 0; m < 4; ++m)
#pragma unroll
                    for (int n = 0; n < 2; ++n) acc[a][b][m][n] = (f32x4){0.f, 0.f, 0.f, 0.f};
        cur = nxt; cA = nA; cA2 = nA2; cB = nB; ++ui;
        if constexpr (ALIGN_EPI) { if (wr == 1) PG8_BAR; }
    }
    PG8_WAIT_V(0);
    if constexpr (!ALIGN_EPI) { if (wr == 0) PG8_BAR; }
    PG8_BAR;
    if constexpr (Epi::AFTER_DRAIN) { E.fused(acc, cur, wr, wc, fr, fq, lds, wid, lane); S.done(cur); }
#undef PG8_SA
#undef PG8_SB
#undef PG8_STAGE
#undef PG8_LDA
#undef PG8_LDB
#undef PG8_MMA
#undef PG8_WAIT_V
#undef PG8_WAIT_L
#undef PG8_BAR
#undef PG8_SCHED
}
}

namespace attn_body {
using bf16=__hip_bfloat16;
using bf16x8=__attribute__((ext_vector_type(8)))short;
using s16x4=__attribute__((ext_vector_type(4)))short;
using f32x16=__attribute__((ext_vector_type(16)))float;
using u32x4=__attribute__((ext_vector_type(4)))unsigned;
constexpr int D=64,QP=1024,KP=256;
constexpr int NW=8,QBLK=32,QB=QBLK*NW,KVBLK=64;

__device__ __forceinline__ int crow(int r,int hi){return (r&3)+8*(r>>2)+4*hi;}
#define SBAR() __builtin_amdgcn_sched_barrier(0)
__device__ __forceinline__ void cmask(f32x16&p0,f32x16&p1,int jb,int qrel,int hi){
  const float NEG=-INFINITY; int kb=64*jb+4*hi;
  #pragma unroll
  for(int r=0;r<16;++r){int kv=kb+(r&3)+8*(r>>2); if(kv>qrel)p0[r]=NEG; if(kv+32>qrel)p1[r]=NEG;}
}

constexpr int NSLOT=3, SLOTB=8192;
constexpr int LDS_K=0, LDS_V=NSLOT*SLOTB, LDS_WS=2*NSLOT*SLOTB, LDS_OST=LDS_WS+NW*64*4, LDS_BYTES=LDS_OST+NW*4096;
constexpr float C2=0.125f*1.4426950408889634f;
__device__ __forceinline__ void glds16(const void*gsrc,unsigned lds_dst){unsigned keep;
  asm volatile("s_mov_b32 %0, m0\n\ts_mov_b32 m0, %2\n\ts_nop 0\n\tglobal_load_lds_dwordx4 %1, off\n\ts_mov_b32 m0, %0":"=&s"(keep):"v"(gsrc),"s"(lds_dst):"memory");}
__device__ __forceinline__ float max3f(float a,float b,float c){float r;asm("v_max3_f32 %0, %1, %2, %3":"=v"(r):"v"(a),"v"(b),"v"(c));return r;}
__device__ __forceinline__ float max2f(float a,float b){float r;asm("v_max_f32_e32 %0, %1, %2":"=v"(r):"v"(a),"v"(b));return r;}
__device__ __forceinline__ float fadd_s(float a,float b){float r;asm("v_add_f32_e32 %0, %1, %2":"=v"(r):"v"(a),"v"(b));return r;}
__device__ __forceinline__ float fsub_s(float a,float b){float r;asm("v_sub_f32_e32 %0, %1, %2":"=v"(r):"v"(a),"v"(b));return r;}
typedef float f32x2_t __attribute__((ext_vector_type(2))); typedef __bf16 bf16x2_t __attribute__((ext_vector_type(2)));
__device__ __forceinline__ unsigned cvtpk_s(float lo,float hi){f32x2_t v={lo,hi};bf16x2_t b=__builtin_convertvector(v,bf16x2_t);return __builtin_bit_cast(unsigned,b);}
#define WAIT_BAR(N) asm volatile("s_waitcnt vmcnt(" #N ") lgkmcnt(0)\n\ts_barrier":::"memory")

__device__ __forceinline__ void qkt(f32x16&p0,f32x16&p1,const char*Kslot,const bf16x8*qr,const f32x16&negm,int r32,int hi){
  const char*kb=Kslot+hi*1024+r32*16;
  #pragma unroll
  for(int d0=0;d0<4;++d0){
    const bf16x8 b0=*reinterpret_cast<const bf16x8*>(kb+d0*2048);
    const bf16x8 b1=*reinterpret_cast<const bf16x8*>(kb+d0*2048+512);
    if(d0==0){p0=__builtin_amdgcn_mfma_f32_32x32x16_bf16(b0,qr[0],negm,0,0,0);p1=__builtin_amdgcn_mfma_f32_32x32x16_bf16(b1,qr[0],negm,0,0,0);}
    else{p0=__builtin_amdgcn_mfma_f32_32x32x16_bf16(b0,qr[d0],p0,0,0,0);p1=__builtin_amdgcn_mfma_f32_32x32x16_bf16(b1,qr[d0],p1,0,0,0);}}
}
typedef __attribute__((address_space(3))) const char* lds_cptr;
typedef short v4i16_t __attribute__((ext_vector_type(4)));
__device__ __forceinline__ void kload8(bf16x8*kf,lds_cptr kp){
  kf[0]=*(const __attribute__((address_space(3))) bf16x8*)(kp);      kf[1]=*(const __attribute__((address_space(3))) bf16x8*)(kp+512);
  kf[2]=*(const __attribute__((address_space(3))) bf16x8*)(kp+2048); kf[3]=*(const __attribute__((address_space(3))) bf16x8*)(kp+2560);
  kf[4]=*(const __attribute__((address_space(3))) bf16x8*)(kp+4096); kf[5]=*(const __attribute__((address_space(3))) bf16x8*)(kp+4608);
  kf[6]=*(const __attribute__((address_space(3))) bf16x8*)(kp+6144); kf[7]=*(const __attribute__((address_space(3))) bf16x8*)(kp+6656);
}
__device__ __forceinline__ void kload2(bf16x8*kf,lds_cptr kp,int j){ kf[2*j]=*(const __attribute__((address_space(3))) bf16x8*)(kp+j*2048); kf[2*j+1]=*(const __attribute__((address_space(3))) bf16x8*)(kp+j*2048+512); }
__device__ __forceinline__ s16x4 vtr(lds_cptr p){ return __builtin_bit_cast(s16x4,__builtin_amdgcn_ds_read_tr16_b64_v4i16((__attribute__((address_space(3))) v4i16_t*)p)); }
__device__ __forceinline__ float rowmax(const f32x16&p0,const f32x16&p1){
  float a=max3f(p0[0],p0[1],p1[0]),b=max3f(p0[2],p0[3],p1[1]);a=max3f(a,p1[2],p1[3]);
  #pragma unroll
  for(int r=4;r<16;r+=4){a=max3f(a,p0[r],p0[r+1]);b=max3f(b,p0[r+2],p0[r+3]);a=max3f(a,p1[r],p1[r+1]);b=max3f(b,p1[r+2],p1[r+3]);}
  const float m=max2f(a,b);
  auto rr=__builtin_amdgcn_permlane32_swap(__float_as_uint(m),__float_as_uint(m),false,false);
  return max2f(__uint_as_float(rr[0]),__uint_as_float(rr[1]));
}
__device__ __forceinline__ void pv(f32x16*o,int vb,bf16x8 pa0,bf16x8 pa1,bf16x8 pa2,bf16x8 pa3){
  #pragma unroll
  for(int d0=0;d0<2;++d0){s16x4 lo[4],hi[4];
    #pragma unroll
    for(int ks=0;ks<4;++ks){
      asm volatile("ds_read_b64_tr_b16 %0,%1 offset:%c2":"=&v"(lo[ks]):"v"(vb),"i"(d0*4096+ks*1024):"memory");
      asm volatile("ds_read_b64_tr_b16 %0,%1 offset:%c2":"=&v"(hi[ks]):"v"(vb),"i"(d0*4096+ks*1024+512):"memory");}
    asm volatile("s_waitcnt lgkmcnt(0)":::"memory");SBAR();
    #define PK(k) (bf16x8){lo[k][0],lo[k][1],lo[k][2],lo[k][3],hi[k][0],hi[k][1],hi[k][2],hi[k][3]}
    o[d0]=__builtin_amdgcn_mfma_f32_32x32x16_bf16(pa0,PK(0),o[d0],0,0,0);
    o[d0]=__builtin_amdgcn_mfma_f32_32x32x16_bf16(pa1,PK(1),o[d0],0,0,0);
    o[d0]=__builtin_amdgcn_mfma_f32_32x32x16_bf16(pa2,PK(2),o[d0],0,0,0);
    o[d0]=__builtin_amdgcn_mfma_f32_32x32x16_bf16(pa3,PK(3),o[d0],0,0,0);
    #undef PK
  }
}
#define ATTN_STORE16(p,v) (*(u32x4*)(p)=(v))
__device__ __forceinline__ float abf_lo(unsigned w){return __uint_as_float(w<<16);}
__device__ __forceinline__ float abf_hi(unsigned w){return __uint_as_float(w&0xffff0000u);}
__device__ __forceinline__ u32x4 mulgate(const u32x4&v,const u32x4&g){u32x4 r;
  r.x=cvtpk_s(abf_lo(v.x)*abf_lo(g.x),abf_hi(v.x)*abf_hi(g.x)); r.y=cvtpk_s(abf_lo(v.y)*abf_lo(g.y),abf_hi(v.y)*abf_hi(g.y));
  r.z=cvtpk_s(abf_lo(v.z)*abf_lo(g.z),abf_hi(v.z)*abf_hi(g.z)); r.w=cvtpk_s(abf_lo(v.w)*abf_lo(g.w),abf_hi(v.w)*abf_hi(g.w)); return r;}
template<int THRL> __device__ __forceinline__ void attn_unit(long qrow0,long kvrow0,int NT,int h,const bf16*Q,const bf16*__restrict__ K,const bf16*__restrict__ V,bf16*O,const bf16*__restrict__ Gt,char*shm){
  const int tid=threadIdx.x,lane=tid&63,r32=lane&31,hi=lane>>5; const int wid=__builtin_amdgcn_readfirstlane(tid>>6);
  const bf16*Qw=Q+(qrow0+wid*QBLK)*QP+h*D;
  const bf16*Kh=K+kvrow0*KP+(h>>2)*D,*Vh=V+kvrow0*KP+(h>>2)*D;
  const unsigned lds0=(unsigned)(uintptr_t)shm;
  float*wsf=(float*)(shm+LDS_WS)+wid*64;
  const bf16*ksrc=Kh+(long)lane*KP+wid*8;
  const bf16*vsrc=Vh+(long)(16*(wid&3)+(lane>>2))*KP+(wid>>2)*32+(lane&3)*8;
  const unsigned kdst=lds0+LDS_K+wid*1024, vdst=lds0+LDS_V+wid*1024;
  #define DMA_K(t,slot) glds16(ksrc+(long)(t)*KVBLK*KP,(unsigned)__builtin_amdgcn_readfirstlane(kdst+(slot)))
  #define DMA_V(t,slot) glds16(vsrc+(long)(t)*KVBLK*KP,(unsigned)__builtin_amdgcn_readfirstlane(vdst+(slot)))
  const int vb0=(int)(lds0+LDS_V)+((lane>>4)&1)*32+(lane&3)*8+(4*hi+((lane&15)>>2))*64;
  const char*Kbase=shm+LDS_K; bf16x8 kf[8];
  const lds_cptr shm3=(lds_cptr)shm; const lds_cptr kp0=shm3+LDS_K+hi*1024+r32*16; const lds_cptr vp0=shm3+LDS_V+((lane>>4)&1)*32+(lane&3)*8+(4*hi+((lane&15)>>2))*64;
  DMA_K(0,0);DMA_V(0,0);DMA_K(1,SLOTB);
  bf16x8 qr[4];
  #pragma unroll
  for(int d0=0;d0<4;++d0)qr[d0]=*reinterpret_cast<const bf16x8*>(&Qw[(long)r32*QP+d0*16+hi*8]);
  float mhat=0.f,l_reg=0.f;f32x16 o[2];o[0]=f32x16{};o[1]=f32x16{};f32x16 negm=f32x16{};asm volatile("":"+v"(negm));
  #define CMASK(P0,P1,t) do{}while(0)
  bool resc=false;
  #define START(P0,P1) do{ const float rm=rowmax(P0,P1); resc=false; \
    { const float dl=rm; mhat=fadd_s(mhat,dl); \
      _Pragma("unroll") for(int r=0;r<16;++r){P0[r]=fsub_s(P0[r],dl);P1[r]=fsub_s(P1[r],dl);} \
      _Pragma("unroll") for(int r=0;r<16;++r)negm[r]=-mhat; asm volatile("":"+v"(negm)); } \
    _Pragma("unroll") for(int r=0;r<16;++r)P0[r]=__builtin_amdgcn_exp2f(P0[r]); }while(0)
  #define RESC() do{ if(resc){ asm volatile("s_waitcnt lgkmcnt(0)":::"memory"); \
      _Pragma("unroll") for(int d_=0;d_<2;++d_) _Pragma("unroll") for(int r=0;r<16;++r)o[d_][r]*=wsf[crow(r,hi)]; } }while(0)
  f32x16 pA0,pA1,pB0,pB1;
  int sl_prev=0,sl_cur=0,sl_next=SLOTB;
  #define ROT() do{sl_prev=sl_cur;sl_cur=sl_next;sl_next=(sl_next==(NSLOT-1)*SLOTB)?0:sl_next+SLOTB;}while(0)
  DMA_K(2,2*SLOTB);
  WAIT_BAR(3);
  qkt(pA0,pA1,Kbase,qr,negm,r32,hi);asm volatile("s_nop 15\n\ts_nop 7":"+v"(pA0),"+v"(pA1));CMASK(pA0,pA1,0);
  START(pA0,pA1);
  _Pragma("unroll") for(int r=0;r<16;++r)pA1[r]=__builtin_amdgcn_exp2f(pA1[r]);
  WAIT_BAR(0);
  DMA_K(3,0);DMA_V(1,SLOTB);
  ROT();
  kload8(kf,kp0+sl_cur);
  WAIT_BAR(2);
  s16x4 vlo[8],vhi[8]; u32x4 pw0,pw1,pw2,pw3;
  #define PKW(P,B) cvtpk_s(P[B],P[B+1])
  #define PAF(k) __builtin_bit_cast(bf16x8,pw##k)
  #define VFR(i) (bf16x8){vlo[i][0],vlo[i][1],vlo[i][2],vlo[i][3],vhi[i][0],vhi[i][1],vhi[i][2],vhi[i][3]}
  #define PIN(x) asm volatile("":"+v"(x))
  #define MX3(a,b,c) __builtin_fmaxf(__builtin_fmaxf((a),(b)),(c))
  #define GAPA(MF,A0,A1,A2,A3,W0,W1,PW) do{ MF; sacc+=A0; sacc+=A1; sacc+=A2; sacc+=A3; PIN(sacc); W0; W1; PIN(PW); SBAR(); }while(0)
  #define EX(v) __builtin_amdgcn_exp2f(v)
  #define GAPB(MF,X,B) do{ MF; X[B]=EX(X[B]); X[B+1]=EX(X[B+1]); X[B+2]=EX(X[B+2]); X[B+3]=EX(X[B+3]); PIN(X); SBAR(); }while(0)
  #define VRD(i) do{ vlo[i]=vtr(vp_+(((i)>>2)*4096+((i)&3)*1024)); vhi[i]=vtr(vp_+(((i)>>2)*4096+((i)&3)*1024+512)); }while(0)
  #define KRD(G,j) do{ if(G){ kload2(kf,kp0+sl_next,j); SBAR(); } }while(0)
  #define STEP(C0,C1,P0,P1,t,GK,GV,GL) do{ SBAR(); \
    const lds_cptr vp_=vp0+sl_prev; \
    VRD(0); SBAR(); float sacc=(P0[0]+P0[1]); \
    GAPA(C0=__builtin_amdgcn_mfma_f32_32x32x16_bf16(kf[0],qr[0],negm,0,0,0), P0[2],P0[3],P0[4],P0[5],     pw0[0]=PKW(P0,0), pw0[1]=PKW(P0,2), pw0); \
    VRD(4); SBAR(); GAPA(C1=__builtin_amdgcn_mfma_f32_32x32x16_bf16(kf[1],qr[0],negm,0,0,0), P0[6],P0[7],P0[8],P0[9],     pw0[2]=PKW(P0,4), pw0[3]=PKW(P0,6), pw0); \
    VRD(1); SBAR(); GAPA(C0=__builtin_amdgcn_mfma_f32_32x32x16_bf16(kf[2],qr[1],C0,0,0,0),   P0[10],P0[11],P0[12],P0[13], pw1[0]=PKW(P0,8), pw1[1]=PKW(P0,10), pw1); \
    VRD(5); SBAR(); GAPA(C1=__builtin_amdgcn_mfma_f32_32x32x16_bf16(kf[3],qr[1],C1,0,0,0),   P0[14],P0[15],P1[0],P1[1],   pw1[2]=PKW(P0,12),pw1[3]=PKW(P0,14), pw1); \
    VRD(2); SBAR(); GAPA(C0=__builtin_amdgcn_mfma_f32_32x32x16_bf16(kf[4],qr[2],C0,0,0,0),   P1[2],P1[3],P1[4],P1[5],     pw2[0]=PKW(P1,0), pw2[1]=PKW(P1,2), pw2); \
    VRD(6); SBAR(); GAPA(C1=__builtin_amdgcn_mfma_f32_32x32x16_bf16(kf[5],qr[2],C1,0,0,0),   P1[6],P1[7],P1[8],P1[9],     pw2[2]=PKW(P1,4), pw2[3]=PKW(P1,6), pw2); \
    VRD(3); SBAR(); GAPA(C0=__builtin_amdgcn_mfma_f32_32x32x16_bf16(kf[6],qr[3],C0,0,0,0),   P1[10],P1[11],P1[12],P1[13], pw3[0]=PKW(P1,8), pw3[1]=PKW(P1,10), pw3); \
    VRD(7); SBAR(); GAPA(C1=__builtin_amdgcn_mfma_f32_32x32x16_bf16(kf[7],qr[3],C1,0,0,0),   P1[14],P1[15],0.f,0.f,       pw3[2]=PKW(P1,12),pw3[3]=PKW(P1,14), pw3); \
    l_reg+=sacc; \
    if(GK){DMA_K((t)+3,sl_cur);} if(GV){DMA_V((t)+1,sl_next);} \
    CMASK(C0,C1,t); \
    { float a=MX3(C0[0],C0[1],C1[0]),b=MX3(C0[2],C0[3],C1[1]); a=MX3(a,C1[2],C1[3]); \
      _Pragma("unroll") for(int r=4;r<16;r+=4){a=MX3(a,C0[r],C0[r+1]);b=MX3(b,C0[r+2],C0[r+3]);a=MX3(a,C1[r],C1[r+1]);b=MX3(b,C1[r+2],C1[r+3]);} \
      float rm=__builtin_fmaxf(a,b); { auto rr=__builtin_amdgcn_permlane32_swap(__float_as_uint(rm),__float_as_uint(rm),false,false); rm=__builtin_fmaxf(__uint_as_float(rr[0]),__uint_as_float(rr[1])); } \
      resc=false; \
      if(__builtin_expect(__any(rm>(float)THRL),0)){ const float dl=__builtin_fmaxf(rm,0.f); mhat+=dl; \
        _Pragma("unroll") for(int r=0;r<16;++r){C0[r]-=dl;C1[r]-=dl;} \
        _Pragma("unroll") for(int r=0;r<16;++r)negm[r]=-mhat; asm volatile("":"+v"(negm)); \
        const float f=__builtin_amdgcn_exp2f(-dl); l_reg*=f; if(hi==0)wsf[r32]=f; resc=true; } } \
    SBAR(); \
    GAPB(o[0]=__builtin_amdgcn_mfma_f32_32x32x16_bf16(PAF(0),VFR(0),o[0],0,0,0), C0,0); \
    GAPB(o[1]=__builtin_amdgcn_mfma_f32_32x32x16_bf16(PAF(0),VFR(4),o[1],0,0,0), C0,4); \
    KRD(GL,0); GAPB(o[0]=__builtin_amdgcn_mfma_f32_32x32x16_bf16(PAF(1),VFR(1),o[0],0,0,0), C0,8); \
    KRD(GL,1); GAPB(o[1]=__builtin_amdgcn_mfma_f32_32x32x16_bf16(PAF(1),VFR(5),o[1],0,0,0), C0,12); \
    KRD(GL,2); GAPB(o[0]=__builtin_amdgcn_mfma_f32_32x32x16_bf16(PAF(2),VFR(2),o[0],0,0,0), C1,0); \
    KRD(GL,3); GAPB(o[1]=__builtin_amdgcn_mfma_f32_32x32x16_bf16(PAF(2),VFR(6),o[1],0,0,0), C1,4); \
    GAPB(o[0]=__builtin_amdgcn_mfma_f32_32x32x16_bf16(PAF(3),VFR(3),o[0],0,0,0), C1,8); \
    GAPB(o[1]=__builtin_amdgcn_mfma_f32_32x32x16_bf16(PAF(3),VFR(7),o[1],0,0,0), C1,12); \
    }while(0)
  int t=1;
  #undef CMASK
  #define CMASK(P0,P1,t) do{}while(0)
  for(;t+5<NT;t+=2){
    STEP(pB0,pB1,pA0,pA1,t,true,true,true);     WAIT_BAR(2); RESC(); ROT();
    STEP(pA0,pA1,pB0,pB1,t+1,true,true,true);   WAIT_BAR(2); RESC(); ROT();
  }
  #undef CMASK
  #define CMASK(P0,P1,t) do{}while(0)
  #define ENDW(tt) do{ if((tt)+3<NT){WAIT_BAR(2);} else if((tt)+2<NT){WAIT_BAR(1);} else {WAIT_BAR(0);} }while(0)
  for(;t+1<NT;t+=2){
    STEP(pB0,pB1,pA0,pA1,t,(t+3<NT),(t+1<NT),(t+1<NT));       ENDW(t);   RESC(); ROT();
    STEP(pA0,pA1,pB0,pB1,t+1,(t+4<NT),(t+2<NT),(t+2<NT));     ENDW(t+1); RESC(); ROT();
  }
  STEP(pB0,pB1,pA0,pA1,NT-1,false,false,false); RESC();
  { float sacc=pB0[0]+pB0[1]; _Pragma("unroll") for(int r=2;r<16;++r)sacc+=pB0[r]; _Pragma("unroll") for(int r=0;r<16;++r)sacc+=pB1[r]; l_reg+=sacc;
    pw0=(u32x4){PKW(pB0,0),PKW(pB0,2),PKW(pB0,4),PKW(pB0,6)};pw1=(u32x4){PKW(pB0,8),PKW(pB0,10),PKW(pB0,12),PKW(pB0,14)};pw2=(u32x4){PKW(pB1,0),PKW(pB1,2),PKW(pB1,4),PKW(pB1,6)};pw3=(u32x4){PKW(pB1,8),PKW(pB1,10),PKW(pB1,12),PKW(pB1,14)};
    SBAR(); pv(o,vb0+sl_cur,PAF(0),PAF(1),PAF(2),PAF(3)); }
  #undef PKW
  #undef PAF
  #undef VFR
  #undef PIN
  #undef MX3
  #undef GAPA
  #undef GAPB
  #undef EX
  #undef VRD
  #undef KRD
  #undef STEP
  #undef ENDW
  {auto rr=__builtin_amdgcn_permlane32_swap(__float_as_uint(l_reg),__float_as_uint(l_reg),false,false);l_reg=__uint_as_float(rr[0])+__uint_as_float(rr[1]);}
  if(hi==0)wsf[32+r32]=l_reg;asm volatile("s_waitcnt lgkmcnt(0)":::"memory");
  float rli[16];
  #pragma unroll
  for(int r=0;r<16;++r)rli[r]=__builtin_amdgcn_rcpf(wsf[32+crow(r,hi)]);
  bf16*Ow=O+(qrow0+wid*QBLK)*QP+h*D; const bf16*Gw=Gt+(qrow0+wid*QBLK)*QP+h*D;
  { bf16*stg=(bf16*)(shm+LDS_OST)+wid*2048;
    #pragma unroll
    for(int r=0;r<16;++r){const int orow=crow(r,hi);
      #pragma unroll
      for(int d0=0;d0<2;++d0)stg[orow*64+d0*32+r32]=__float2bfloat16(o[d0][r]*rli[r]);}
    asm volatile("s_waitcnt lgkmcnt(0)":::"memory");
    #pragma unroll
    for(int i=0;i<4;++i){const int row=i*8+(lane>>3),ch=lane&7; const u32x4 v=*(const u32x4*)(stg+row*64+ch*8); const u32x4 gv=*(const u32x4*)(Gw+(long)row*QP+ch*8); ATTN_STORE16(Ow+(long)row*QP+ch*8,mulgate(v,gv));} }
  asm volatile("s_waitcnt lgkmcnt(0)\n\ts_barrier":::"memory");
  #undef DMA_K
  #undef DMA_V
  #undef CMASK
  #undef START
  #undef RESC
  #undef ROT
}
constexpr int ATTN_LDS_BYTES=LDS_BYTES;
#undef SBAR
#undef WAIT_BAR
}

constexpr int NWAVES = 8;
constexpr int D = 1024, TP = 8192, TS = 2048, NB = 8;
constexpr int MP = NB * TP, MS = NB * TS, M = MP + MS;
constexpr int INW = 6656, PLE = 256;
constexpr float EPS = 1e-6f;
#ifndef MK_N_LAUNCHES
#define MK_N_LAUNCHES 1
#endif
constexpr int N_LAUNCHES = MK_N_LAUNCHES;
constexpr int N_PHASES = 8;

constexpr size_t MiB = 1u << 20;
constexpr size_t WS_WIN = 2 * MiB;
constexpr size_t WS_WPOOL = 15 * MiB;
constexpr size_t WS_WAB = 16 * MiB;
constexpr size_t WS_WO = 20 * MiB;
constexpr size_t WS_WG = 22 * MiB;
constexpr size_t WS_WPLE = 24 * MiB;
constexpr size_t WS_PBF = 26 * MiB;
constexpr size_t WS_RA = 80 * MiB;
constexpr size_t WS_RB = 240 * MiB;
constexpr size_t WS_RC = 400 * MiB;
constexpr size_t WS_RD = 560 * MiB;
constexpr size_t WS_RE = 720 * MiB;
constexpr size_t WS_RK = 880 * MiB;
constexpr size_t WS_RV = 920 * MiB;
constexpr size_t WS_END = 960 * MiB;

constexpr int RING_BYTES = 131072;
constexpr int LDS_BYTES = 147456;

#define GAS __attribute__((address_space(1)))
#define LAS __attribute__((address_space(3)))
typedef unsigned short bf16;
typedef unsigned v4u __attribute__((ext_vector_type(4)));
typedef unsigned v2u __attribute__((ext_vector_type(2)));
typedef float f32x4 __attribute__((ext_vector_type(4)));
#define LDS_WAIT() asm volatile("s_waitcnt lgkmcnt(0)" ::: "memory")
#define VM_WAIT() asm volatile("s_waitcnt vmcnt(0)" ::: "memory")
__device__ __forceinline__ unsigned pk2(float lo, float hi) { return pg8::cvt_pk_bf16(lo, hi); }
__device__ __forceinline__ float blo(unsigned w) { return __uint_as_float(w << 16); }
__device__ __forceinline__ float bhi(unsigned w) { return __uint_as_float(w & 0xffff0000u); }

struct Args {
    const float *x_p, *x_s, *p_p, *p_s, *norm_pre, *w_in, *pool_w, *pool_scale, *w_a, *q_norm, *k_norm, *w_b, *w_out, *norm_post, *ple_norm, *w_gate, *w_ple;
    float* out; unsigned char* ws; int ph_lo, ph_hi;
};

__device__ __forceinline__ float wave_sum(float v) {
#pragma unroll
    for (int o = 1; o < 64; o <<= 1) v += __shfl_xor(v, o);
    return v;
}
__device__ __forceinline__ void p0_transpose_item(const float* W, int K, int N, bf16* WT, int row_off, int ldt, int koff, LAS float* scr, int item, int lane) {
    const int nblk = N / 32, kb = item / nblk, nb = item % nblk, k0 = 64 * kb, n0 = 32 * nb;
#pragma unroll 8
    for (int i = 0; i < 32; ++i) { const int kk = 2 * i + (lane >> 5); scr[kk * 33 + (lane & 31)] = W[(size_t)(k0 + kk) * N + n0 + (lane & 31)]; }
    LDS_WAIT(); asm volatile("" ::: "memory");
    const int c = lane & 7;
#pragma unroll
    for (int j = 0; j < 4; ++j) { const int n = (lane >> 3) + 8 * j; const LAS float* s = scr + (8 * c) * 33 + n;
        v4u o; o.x = pk2(s[0 * 33], s[1 * 33]); o.y = pk2(s[2 * 33], s[3 * 33]); o.z = pk2(s[4 * 33], s[5 * 33]); o.w = pk2(s[6 * 33], s[7 * 33]);
        *(GAS v4u*)(WT + (size_t)(row_off + n0 + n) * ldt + koff + k0 + 8 * c) = o; }
    LDS_WAIT(); asm volatile("" ::: "memory");
}
__device__ __forceinline__ const float* xrow_ptr(const Args& a, int m) { return m < MP ? a.x_p + (size_t)m * D : a.x_s + (size_t)(m - MP) * D; }

__device__ __forceinline__ void phase0(const Args& a, LAS unsigned char* lds, int vcu, int G) {
    int tid = threadIdx.x; asm volatile("" : "+v"(tid));
    const int lane = tid & 63, wave = __builtin_amdgcn_readfirstlane(tid >> 6);
    LAS float* scr = (LAS float*)(lds + wave * 16384);
    const int gw = vcu * NWAVES + wave, NGW = G * NWAVES;
    unsigned char* ws = a.ws;
    constexpr int I_IN = (D / 64) * (INW / 32), I_POOL = (256 / 64) * (256 / 32), I_SQ = (D / 64) * (D / 32), I_PLE = (PLE / 64) * (D / 32);
    constexpr int NITEMS = I_IN + 4 * I_POOL + 4 * I_SQ + I_PLE;
    for (int it = gw; it < NITEMS; it += NGW) {
        int r = it;
        if (r < I_IN) { p0_transpose_item(a.w_in, D, INW, (bf16*)(ws + WS_WIN), 0, D, 0, scr, r, lane); continue; } r -= I_IN;
        if (r < 4 * I_POOL) { const int g = r / I_POOL; p0_transpose_item(a.pool_w + (size_t)g * 65536, 256, 256, (bf16*)(ws + WS_WPOOL), g * 256, 256, 0, scr, r % I_POOL, lane); continue; } r -= 4 * I_POOL;
        if (r < I_SQ) { p0_transpose_item(a.w_a, D, D, (bf16*)(ws + WS_WAB), 0, 2048, 0, scr, r, lane); continue; } r -= I_SQ;
        if (r < I_SQ) { p0_transpose_item(a.w_b, D, D, (bf16*)(ws + WS_WAB), 0, 2048, 1024, scr, r, lane); continue; } r -= I_SQ;
        if (r < I_SQ) { p0_transpose_item(a.w_out, D, D, (bf16*)(ws + WS_WO), 0, D, 0, scr, r, lane); continue; } r -= I_SQ;
        if (r < I_SQ) { p0_transpose_item(a.w_gate, D, D, (bf16*)(ws + WS_WG), 0, D, 0, scr, r, lane); continue; } r -= I_SQ;
        p0_transpose_item(a.w_ple, PLE, D, (bf16*)(ws + WS_WPLE), 0, PLE, 0, scr, r, lane);
    }
    f32x4 gpre[4];
#pragma unroll
    for (int j = 0; j < 4; ++j) gpre[j] = ((const GAS f32x4*)a.norm_pre)[lane + 64 * j];
    bf16* H = (bf16*)(ws + WS_RA); bf16* PB = (bf16*)(ws + WS_PBF);
    for (int m = gw; m < M; m += NGW) {
        const GAS f32x4* xr = (const GAS f32x4*)xrow_ptr(a, m) + lane;
        f32x4 v[4]; float s = 0.f;
#pragma unroll
        for (int j = 0; j < 4; ++j) { v[j] = xr[64 * j]; s += (v[j].x * v[j].x + v[j].y * v[j].y) + (v[j].z * v[j].z + v[j].w * v[j].w); }
        const float rstd = 1.0f / sqrtf(wave_sum(s) * (1.f / D) + EPS);
        GAS v2u* o8 = (GAS v2u*)(H + (size_t)m * D) + lane;
#pragma unroll
        for (int j = 0; j < 4; ++j) { const f32x4 y = v[j] * rstd * gpre[j]; o8[64 * j] = (v2u){pk2(y.x, y.y), pk2(y.z, y.w)}; }
        const float* prow = m < MP ? a.p_p + (size_t)m * PLE : a.p_s + (size_t)(m - MP) * PLE;
        const f32x4 pv = ((const GAS f32x4*)prow)[lane];
        ((GAS v2u*)(PB + (size_t)m * PLE))[lane] = (v2u){pk2(pv.x, pv.y), pk2(pv.z, pv.w)};
    }
}

__device__ __forceinline__ void normrope16(bf16* ptr, int t, int qd, const float* gain, float scale) {
    const v4u w0 = ((const GAS v4u*)ptr)[0], w1 = ((const GAS v4u*)ptr)[1];
    float av[16];
    av[0] = blo(w0.x); av[1] = bhi(w0.x); av[2] = blo(w0.y); av[3] = bhi(w0.y); av[4] = blo(w0.z); av[5] = bhi(w0.z); av[6] = blo(w0.w); av[7] = bhi(w0.w);
    av[8] = blo(w1.x); av[9] = bhi(w1.x); av[10] = blo(w1.y); av[11] = bhi(w1.y); av[12] = blo(w1.z); av[13] = bhi(w1.z); av[14] = blo(w1.w); av[15] = bhi(w1.w);
    float ss = 0.f;
#pragma unroll
    for (int i = 0; i < 16; ++i) ss += av[i] * av[i];
    ss += __shfl_xor(ss, 1); ss += __shfl_xor(ss, 2);
    const float rstd = 1.0f / sqrtf(ss * (1.f / 64.f) + EPS);
    const float pos = (qd < 2) ? (float)(t >> 6) : (float)(t & 63);
    const float sgn = (qd & 1) ? 1.f : -1.f;
    float o[16];
#pragma unroll
    for (int i4 = 0; i4 < 4; ++i4) { const f32x4 g = ((const GAS f32x4*)(gain + qd * 16))[i4];
        av[4 * i4 + 0] *= rstd * g.x; av[4 * i4 + 1] *= rstd * g.y; av[4 * i4 + 2] *= rstd * g.z; av[4 * i4 + 3] *= rstd * g.w; }
#pragma unroll
    for (int i = 0; i < 16; ++i) {
        const float pr = __shfl_xor(av[i], 1);
        const float freq = __builtin_amdgcn_exp2f(-(float)i * 0.83048202372184058696f);
        float rev = pos * freq * 0.15915494309189533577f; rev = __builtin_amdgcn_fractf(rev);
        const float sn = __builtin_amdgcn_sinf(rev), cs = __builtin_amdgcn_cosf(rev);
        o[i] = (av[i] * cs + sgn * pr * sn) * scale;
    }
    v4u r0, r1;
    r0.x = pk2(o[0], o[1]); r0.y = pk2(o[2], o[3]); r0.z = pk2(o[4], o[5]); r0.w = pk2(o[6], o[7]);
    r1.x = pk2(o[8], o[9]); r1.y = pk2(o[10], o[11]); r1.z = pk2(o[12], o[13]); r1.w = pk2(o[14], o[15]);
    ((GAS v4u*)ptr)[0] = r0; ((GAS v4u*)ptr)[1] = r1;
}
__device__ __forceinline__ int tok_of_row(int m) { return m < MP ? (m & (TP - 1)) : (m & (TS - 1)); }
__device__ __forceinline__ void phase2(const Args& a, int vcu, int G) {
    int tid = threadIdx.x; asm volatile("" : "+v"(tid));
    const int lane = tid & 63, wave = __builtin_amdgcn_readfirstlane(tid >> 6);
    unsigned char* ws = a.ws;
    bf16* Q = (bf16*)(ws + WS_RD); bf16* K = (bf16*)(ws + WS_RK);
    const int gw = vcu * NWAVES + wave, NGW = G * NWAVES;
    constexpr float C2 = 0.125f * 1.4426950408889634f;
    for (int m = gw; m < M; m += NGW) normrope16(Q + (size_t)m * D + lane * 16, tok_of_row(m), lane & 3, a.q_norm, C2);
    for (int m4 = gw; m4 < M / 4; m4 += NGW) { const int m = m4 * 4 + (lane >> 4); normrope16(K + (size_t)m * 256 + (lane & 15) * 16, tok_of_row(m), lane & 3, a.k_norm, 1.0f); }
    const bf16* UA = (const bf16*)(ws + WS_RB); bf16* PO = (bf16*)(ws + WS_RA);
    const int cc = tid & 31, rsub = tid >> 5;
    for (int it = vcu; it < (M / 64) * 4; it += G) {
        const int g = it & 3, rb = it >> 2, half = 1 << g;
#pragma unroll 1
        for (int rr = 0; rr < 4; ++rr) {
            const int m = rb * 64 + rr * 16 + rsub;
            const int T = m < MP ? TP : TS, s0 = m < MP ? (m & ~(TP - 1)) : (m & ~(TS - 1)), t = m - s0;
            const int lo = max(t - half, 0), hi = min(t + half, T);
            float acc[8];
#pragma unroll
            for (int e = 0; e < 8; ++e) acc[e] = 0.f;
            const bf16* colp = UA + (size_t)s0 * D + g * 256 + cc * 8;
#pragma unroll 1
            for (int s = lo; s < hi; ++s) { const v4u w = *(const GAS v4u*)(colp + (size_t)s * D);
                acc[0] += blo(w.x); acc[1] += bhi(w.x); acc[2] += blo(w.y); acc[3] += bhi(w.y); acc[4] += blo(w.z); acc[5] += bhi(w.z); acc[6] += blo(w.w); acc[7] += bhi(w.w); }
            const v4u own = *(const GAS v4u*)(colp + (size_t)t * D);
            const float inv = 1.0f / (float)(hi - lo);
            v4u o; o.x = pk2(acc[0] * inv - blo(own.x), acc[1] * inv - bhi(own.x)); o.y = pk2(acc[2] * inv - blo(own.y), acc[3] * inv - bhi(own.y));
            o.z = pk2(acc[4] * inv - blo(own.z), acc[5] * inv - bhi(own.z)); o.w = pk2(acc[6] * inv - blo(own.w), acc[7] * inv - bhi(own.w));
            *(GAS v4u*)(PO + (size_t)m * D + g * 256 + cc * 8) = o;
        }
    }
}

__device__ __forceinline__ void phase6(const Args& a, int vcu, int G) {
    int tid = threadIdx.x; asm volatile("" : "+v"(tid));
    const int lane = tid & 63, wave = __builtin_amdgcn_readfirstlane(tid >> 6);
    unsigned char* ws = a.ws;
    const bf16* Y = (const bf16*)(ws + WS_RA); bf16* H2 = (bf16*)(ws + WS_RB);
    const int gw = vcu * NWAVES + wave, NGW = G * NWAVES;
    f32x4 gpost[4], gple[4];
#pragma unroll
    for (int j = 0; j < 4; ++j) { gpost[j] = ((const GAS f32x4*)a.norm_post)[lane + 64 * j]; gple[j] = ((const GAS f32x4*)a.ple_norm)[lane + 64 * j]; }
    for (int m = gw; m < M; m += NGW) {
        const GAS f32x4* xr = (const GAS f32x4*)xrow_ptr(a, m) + lane;
        const GAS v2u* yr = (const GAS v2u*)(Y + (size_t)m * D) + lane;
        f32x4 xv[4], yv[4]; float s = 0.f;
#pragma unroll
        for (int j = 0; j < 4; ++j) { xv[j] = xr[64 * j]; const v2u w = yr[64 * j]; yv[j] = (f32x4){blo(w.x), bhi(w.x), blo(w.y), bhi(w.y)};
            s += (yv[j].x * yv[j].x + yv[j].y * yv[j].y) + (yv[j].z * yv[j].z + yv[j].w * yv[j].w); }
        const float rstd = 1.0f / sqrtf(wave_sum(s) * (1.f / D) + EPS);
        float s2 = 0.f;
        GAS f32x4* orow = (GAS f32x4*)(a.out + (size_t)m * D) + lane;
#pragma unroll
        for (int j = 0; j < 4; ++j) { xv[j] = xv[j] + yv[j] * rstd * gpost[j]; orow[64 * j] = xv[j];
            s2 += (xv[j].x * xv[j].x + xv[j].y * xv[j].y) + (xv[j].z * xv[j].z + xv[j].w * xv[j].w); }
        const float rstd2 = 1.0f / sqrtf(wave_sum(s2) * (1.f / D) + EPS);
        GAS v2u* o8 = (GAS v2u*)(H2 + (size_t)m * D) + lane;
#pragma unroll
        for (int j = 0; j < 4; ++j) { const f32x4 y = xv[j] * rstd2 * gple[j]; o8[64 * j] = (v2u){pk2(y.x, y.y), pk2(y.z, y.w)}; }
    }
}

__device__ __forceinline__ bool attn_next(int i, int vcu, int G, long& qrow0, long& kvrow0, int& NT, int& h) {
    int samp, b, qb;
    if (G == 256) {
        if (i >= 20) return false;
        const int x = vcu >> 5, j = vcu & 31; b = x;
        if (i < 16) { samp = 0; h = (i >> 2) * 4 + (i & 3); qb = j; }
        else { samp = 1; h = (i - 16) * 4 + (j >> 3); qb = j & 7; }
    } else {
        const int uid = vcu + i * G; if (uid >= 5120) return false;
        if (uid < 4096) { samp = 0; b = uid >> 9; h = (uid >> 5) & 15; qb = uid & 31; }
        else { const int r = uid - 4096; samp = 1; b = r >> 7; h = (r >> 3) & 15; qb = r & 7; }
    }
    if (!samp) { kvrow0 = (long)b * TP; NT = TP / 64; } else { kvrow0 = (long)MP + (long)b * TS; NT = TS / 64; }
    qrow0 = kvrow0 + qb * 256;
    return true;
}

__global__ void __launch_bounds__(NWAVES * 64, 2) fwd_megakernel(Args args) {
    extern __shared__ __attribute__((aligned(16))) unsigned char lds_raw[];
    LAS unsigned char* lds = (LAS unsigned char*)lds_raw;
    const int G = gridDim.x; const int bx = blockIdx.x; const int vcu = (G % 8 == 0) ? (bx % 8) * (G / 8) + bx / 8 : bx;
    cg::grid_group grid = cg::this_grid();
    unsigned char* ws = args.ws;
    const int lo = args.ph_lo, hi = args.ph_hi;
#ifndef PH_MASK
#define PH_MASK 0xFF
#endif
#define IN(k) ((((PH_MASK) >> (k)) & 1) && lo <= (k) && (k) < hi)
#define SEAM(k) do { if (IN(k) && IN((k) + 1)) { VM_WAIT(); grid.sync(); VM_WAIT(); } } while (0)
    bf16* RA = (bf16*)(ws + WS_RA); bf16* RB = (bf16*)(ws + WS_RB); bf16* RC = (bf16*)(ws + WS_RC); bf16* RD = (bf16*)(ws + WS_RD); bf16* RE = (bf16*)(ws + WS_RE);
    bf16* RK = (bf16*)(ws + WS_RK); bf16* RV = (bf16*)(ws + WS_RV);
    bf16* MA = (bf16*)args.out; bf16* MB = (bf16*)args.out + (size_t)M * D;

    if (IN(0)) { phase0(args, lds, vcu, G); }
    SEAM(0);
    if (IN(1)) {
        pg8::Gemm g{RA, RA, (const bf16*)(ws + WS_WIN), D, D, D, D, 0};
        pg8::StaticOrder S; S.init(M, INW, G, bx);
        pg8::EpiIn E{RB, RC, RD, RK, RV, RE, MA, MB};
        pg8::gemm_phase<pg8::EpiIn, pg8::StaticOrder, true, true>(lds, g, S, E);
    }
    SEAM(1);
    if (IN(2)) { phase2(args, vcu, G); }
    SEAM(2);
    if (IN(3)) {
        long qrow0, kvrow0; int NT, h;
        for (int i = 0; attn_next(i, vcu, G, qrow0, kvrow0, NT, h); ++i)
            attn_body::attn_unit<8>(qrow0, kvrow0, NT, h, (const attn_body::bf16*)RD, (const attn_body::bf16*)RK, (const attn_body::bf16*)RV, (attn_body::bf16*)RD, (const attn_body::bf16*)RE, (char*)lds_raw);
        pg8::Gemm g{RA, RA, (const bf16*)(ws + WS_WPOOL), D, 256, 256, 256, 512};
        pg8::StaticOrder S; S.init(M, D, G, bx);
        pg8::EpiPool E{RB, RC, args.pool_scale};
        pg8::gemm_phase<pg8::EpiPool, pg8::StaticOrder, true, true>(lds, g, S, E);
    }
    SEAM(3);
    if (IN(4)) {
        pg8::Gemm g{RB, RD, (const bf16*)(ws + WS_WAB), D, 2048, 2048, 1024, 0};
        pg8::StaticOrder S; S.init(M, D, G, bx);
        pg8::EpiMerge E{RC, MA, MB};
        pg8::gemm_phase<pg8::EpiMerge, pg8::StaticOrder, true, true>(lds, g, S, E);
    }
    SEAM(4);
    if (IN(5)) {
        { pg8::Gemm g{RC, RC, (const bf16*)(ws + WS_WO), D, D, D, D, 0};
          pg8::StaticOrder S; S.init(M, D, G, bx);
          pg8::EpiPlain E{RA, D};
          pg8::gemm_phase<pg8::EpiPlain, pg8::StaticOrder, true, true>(lds, g, S, E); }
        { pg8::Gemm g{(const bf16*)(ws + WS_PBF), (const bf16*)(ws + WS_PBF), (const bf16*)(ws + WS_WPLE), PLE, PLE, PLE, PLE, 0};
          pg8::StaticOrder S; S.init(M, D, G, bx);
          pg8::EpiPlain E{RD, D};
          pg8::gemm_phase<pg8::EpiPlain, pg8::StaticOrder, true, true>(lds, g, S, E); }
    }
    SEAM(5);
    if (IN(6)) { phase6(args, vcu, G); }
    SEAM(6);
    if (IN(7)) {
        pg8::Gemm g{RB, RB, (const bf16*)(ws + WS_WG), D, D, D, D, 0};
        pg8::StaticOrder S; S.init(M, D, G, bx);
        pg8::EpiFinal E{args.out, RD};
        pg8::gemm_phase<pg8::EpiFinal, pg8::StaticOrder, true, true>(lds, g, S, E);
    }
#undef IN
#undef SEAM
}

extern "C" void kernel_launch(void* const* d_in, const int* in_sizes, int n_in, void* d_out, int out_size, void* d_ws, size_t ws_size, hipStream_t stream) {
    static int grid = 0;
    if (grid == 0) {
        if (n_in != 17 || in_sizes[0] != MP * D || in_sizes[1] != MS * D || out_size != M * D || ws_size < WS_END) {
            fprintf(stderr, "kernel_launch: unexpected shapes (n_in %d, in0 %d, out %d, ws %zu); nothing launched\n", n_in, n_in > 0 ? in_sizes[0] : -1, out_size, ws_size); grid = -1; return; }
        int dev = 0, cus = 0, per_cu = 0;
        if (hipGetDevice(&dev) != hipSuccess || hipDeviceGetAttribute(&cus, hipDeviceAttributeMultiprocessorCount, dev) != hipSuccess) { fprintf(stderr, "kernel_launch: device query failed\n"); grid = -1; return; }
        if (hipFuncSetAttribute((const void*)fwd_megakernel, hipFuncAttributeMaxDynamicSharedMemorySize, LDS_BYTES) != hipSuccess) { fprintf(stderr, "kernel_launch: hipFuncSetAttribute failed\n"); grid = -1; return; }
        if (hipOccupancyMaxActiveBlocksPerMultiprocessor(&per_cu, (const void*)fwd_megakernel, NWAVES * 64, LDS_BYTES) != hipSuccess || per_cu < 1) { fprintf(stderr, "kernel_launch: occupancy query says %d\n", per_cu); per_cu = 1; }
        (void)hipGetLastError();
        grid = cus * 1;
        (void)per_cu;
    }
    if (grid < 0) return;
    Args a{};
    a.x_p = (const float*)d_in[0]; a.x_s = (const float*)d_in[1]; a.p_p = (const float*)d_in[2]; a.p_s = (const float*)d_in[3]; a.norm_pre = (const float*)d_in[4];
    a.w_in = (const float*)d_in[5]; a.pool_w = (const float*)d_in[6]; a.pool_scale = (const float*)d_in[7]; a.w_a = (const float*)d_in[8]; a.q_norm = (const float*)d_in[9];
    a.k_norm = (const float*)d_in[10]; a.w_b = (const float*)d_in[11]; a.w_out = (const float*)d_in[12]; a.norm_post = (const float*)d_in[13]; a.ple_norm = (const float*)d_in[14];
    a.w_gate = (const float*)d_in[15]; a.w_ple = (const float*)d_in[16];
    a.out = (float*)d_out; a.ws = (unsigned char*)d_ws;
    if (N_LAUNCHES == 1) {
        a.ph_lo = 0; a.ph_hi = N_PHASES;
        void* kargs[] = {&a};
        hipError_t e = hipLaunchCooperativeKernel((const void*)fwd_megakernel, dim3(grid), dim3(NWAVES * 64), kargs, LDS_BYTES, stream);
        if (e != hipSuccess) fprintf(stderr, "kernel_launch: cooperative launch failed: %s (grid %d)\n", hipGetErrorString(e), grid);
    } else {
        for (int ph = 0; ph < N_PHASES; ++ph) {
            a.ph_lo = ph; a.ph_hi = ph + 1;
            hipLaunchKernelGGL(fwd_megakernel, dim3(grid), dim3(NWAVES * 64), LDS_BYTES, stream, a);
        }
    }
}
```

```cpp
#include <hip/hip_runtime.h>
#include <hip/hip_cooperative_groups.h>
#include <hip/hip_bf16.h>
#include <cstdio>
#include <cstdint>
#include <cmath>
namespace cg = cooperative_groups;

namespace pg8 {
#define PG8_LAS __attribute__((address_space(3)))
typedef unsigned short bf16_t;
typedef short bf16x8 __attribute__((ext_vector_type(8)));
typedef float f32x4 __attribute__((ext_vector_type(4)));
typedef unsigned u32x4 __attribute__((ext_vector_type(4)));
constexpr int BM = 256, BK = 64, HALF = 128, HTB = HALF * BK * 2  , STAGE_BYTES = 8 * HTB, NXCD = 8, WGM = 8;

__host__ __device__ __forceinline__ int lds_byte(int r, int c) { const int st = (r >> 4) * 2 + (c >> 5), rr = r & 15, cc = c & 31, ob = rr * 64 + cc * 2; return st * 1024 + (ob ^ (((ob >> 9) & 1) << 5)); }
__host__ __device__ __forceinline__ void stage_rc(int b, int& R, int& C) { const int st = b / 1024, sb = b % 1024, swz = sb ^ (((sb >> 9) & 1) << 5); R = (st >> 1) * 16 + swz / 64; C = (st & 1) * 32 + (swz % 64) / 2; }
__host__ __device__ __forceinline__ int perm32(int rho) { const int n = rho >> 4, i = rho & 15; return 8 * (i >> 2) + 4 * n + (i & 3); }

struct Unit { int pm, pn; };
struct Gemm { const bf16_t* A; const bf16_t* A2; const bf16_t* Bt; int lda, ldb, K, K1; size_t a_pn_off; };

struct StaticOrder {
    int nM, nN, nwg, G, c;
    __host__ __device__ void init(int M, int N, int G_, int c_) { nM = M / BM; nN = N / BM; nwg = nM * nN; G = G_; c = c_; }
    __host__ __device__ bool next(int i, Unit& u) const {
        const long L = (long)i * G + c; if (L >= nwg) return false;
        int wgid = (int)L; { const int q = nwg / NXCD, r = nwg % NXCD, xcd = wgid % NXCD, off = wgid / NXCD; wgid = (xcd < r ? xcd * (q + 1) : r * (q + 1) + (xcd - r) * q) + off; }
        const int nig = WGM * nN, gid = wgid / nig, fm = gid * WGM, gsz = (nM - fm) < WGM ? (nM - fm) : WGM;
        u.pm = fm + ((wgid % nig) % gsz); u.pn = (wgid % nig) / gsz; return true;
    }
    __device__ __forceinline__ void a_ready(const Unit&) const {}
    __device__ __forceinline__ void done(const Unit&) const {}
};

__device__ __forceinline__ unsigned cvt_pk_bf16(float lo, float hi) { unsigned r; asm volatile("v_cvt_pk_bf16_f32 %0, %1, %2" : "=v"(r) : "v"(lo), "v"(hi)); return r; }
__device__ __forceinline__ float bf_lo(unsigned w) { return __uint_as_float(w << 16); }
__device__ __forceinline__ float bf_hi(unsigned w) { return __uint_as_float(w & 0xffff0000u); }
__device__ __forceinline__ float fsigmoid(float x) { return __builtin_amdgcn_rcpf(1.0f + __builtin_amdgcn_exp2f(-1.4426950408889634f * x)); }
__device__ __forceinline__ float fsilu(float x) { return x * fsigmoid(x); }
__device__ __forceinline__ u32x4 pack8(const f32x4& v0, const f32x4& v1) { u32x4 w; w.x = cvt_pk_bf16(v0[0], v0[1]); w.y = cvt_pk_bf16(v0[2], v0[3]); w.z = cvt_pk_bf16(v1[0], v1[1]); w.w = cvt_pk_bf16(v1[2], v1[3]); return w; }
__device__ __forceinline__ void unpack8(const u32x4& w, f32x4& v0, f32x4& v1) { v0 = (f32x4){bf_lo(w.x), bf_hi(w.x), bf_lo(w.y), bf_hi(w.y)}; v1 = (f32x4){bf_lo(w.z), bf_hi(w.z), bf_lo(w.w), bf_hi(w.w)}; }

struct EpiIn {
    static constexpr bool PERM = true, AFTER_DRAIN = false, MID = false;
    bf16_t *ua, *sza, *q, *k, *v, *szb, *ma, *mb;
    __device__ __forceinline__ void operator()(const f32x4 (&acc)[2][2][4][2], const Unit& u, int wr, int wc, int fr, int fq) const {
        const int pn = u.pn; bf16_t* base; int ldc = 1024, ct; bool act = false;
        if (pn < 4) { base = ua; ct = pn; }
        else if (pn < 8) { base = sza; ct = pn - 4; act = true; }
        else if (pn < 12) { base = q; ct = pn - 8; }
        else if (pn == 12) { base = k; ct = 0; ldc = 256; }
        else if (pn == 13) { base = v; ct = 0; ldc = 256; }
        else if (pn < 18) { base = szb; ct = pn - 14; act = true; }
        else if (pn < 22) { base = ma; ct = pn - 18; }
        else { base = mb; ct = pn - 22; }
        const int row0 = u.pm * BM + wr * 64 + fr, col0 = ct * BM + wc * 32 + 8 * fq;
#pragma unroll
        for (int ai = 0; ai < 2; ++ai)
#pragma unroll
            for (int m = 0; m < 4; ++m) { bf16_t* rowp = base + (size_t)(row0 + ai * HALF + m * 16) * ldc + col0;
#pragma unroll
                for (int bj = 0; bj < 2; ++bj) { f32x4 v0 = acc[ai][bj][m][0], v1 = acc[ai][bj][m][1];
                    if (act) {
#pragma unroll
                        for (int e = 0; e < 4; ++e) { v0[e] = fsilu(v0[e]); v1[e] = fsilu(v1[e]); } }
                    *(u32x4*)(rowp + bj * HALF) = pack8(v0, v1); } }
    }
};
struct EpiPlain {
    static constexpr bool PERM = true, AFTER_DRAIN = false, MID = false;
    bf16_t* O; int ldc;
    __device__ __forceinline__ void operator()(const f32x4 (&acc)[2][2][4][2], const Unit& u, int wr, int wc, int fr, int fq) const {
        const int row0 = u.pm * BM + wr * 64 + fr, col0 = u.pn * BM + wc * 32 + 8 * fq;
#pragma unroll
        for (int ai = 0; ai < 2; ++ai)
#pragma unroll
            for (int m = 0; m < 4; ++m) { bf16_t* rowp = O + (size_t)(row0 + ai * HALF + m * 16) * ldc + col0;
#pragma unroll
                for (int bj = 0; bj < 2; ++bj) *(u32x4*)(rowp + bj * HALF) = pack8(acc[ai][bj][m][0], acc[ai][bj][m][1]); }
    }
};
struct EpiPool {
    static constexpr bool PERM = true, AFTER_DRAIN = false, MID = false;
    bf16_t* O; const bf16_t* sza; const float* pscale;
    __device__ __forceinline__ void operator()(const f32x4 (&acc)[2][2][4][2], const Unit& u, int wr, int wc, int fr, int fq) const {
        const int row0 = u.pm * BM + wr * 64 + fr, col0 = u.pn * BM + wc * 32 + 8 * fq;
        f32x4 ps[2][2];
#pragma unroll
        for (int bj = 0; bj < 2; ++bj)
#pragma unroll
            for (int n = 0; n < 2; ++n) ps[bj][n] = *(const f32x4*)(pscale + col0 + bj * HALF + 4 * n);
#pragma unroll
        for (int ai = 0; ai < 2; ++ai)
#pragma unroll
            for (int m = 0; m < 4; ++m) { const size_t off = (size_t)(row0 + ai * HALF + m * 16) * 1024 + col0;
#pragma unroll
                for (int bj = 0; bj < 2; ++bj) { const u32x4 gw = *(const u32x4*)(sza + off + bj * HALF); f32x4 g0, g1; unpack8(gw, g0, g1);
                    const f32x4 v0 = acc[ai][bj][m][0] * ps[bj][0] * g0, v1 = acc[ai][bj][m][1] * ps[bj][1] * g1;
                    *(u32x4*)(O + off + bj * HALF) = pack8(v0, v1); } }
    }
};
struct EpiMerge {
    static constexpr bool PERM = true, AFTER_DRAIN = false, MID = true;
    bf16_t* O; const bf16_t* ma; const bf16_t* mb;
    __device__ __forceinline__ void mid(f32x4 (&acc)[2][2][4][2], const Unit& u, int wr, int wc, int fr, int fq) const {
        int row0 = u.pm * BM + wr * 64 + fr, col0 = u.pn * BM + wc * 32 + 8 * fq;
        asm volatile("" : "+v"(row0), "+v"(col0));
#pragma unroll
        for (int ai = 0; ai < 2; ++ai)
#pragma unroll
            for (int m = 0; m < 4; ++m) { const size_t off = (size_t)(row0 + ai * HALF + m * 16) * 1024 + col0;
#pragma unroll
                for (int bj = 0; bj < 2; ++bj) { const u32x4 aw = *(const u32x4*)(ma + off + bj * HALF), bw = *(const u32x4*)(mb + off + bj * HALF);
                    f32x4 a0, a1, b0, b1; unpack8(aw, a0, a1); unpack8(bw, b0, b1);
#pragma unroll
                    for (int e = 0; e < 4; ++e) {
                        const float ea0 = __builtin_amdgcn_exp2f(-1.4426950408889634f * a0[e]), ea1 = __builtin_amdgcn_exp2f(-1.4426950408889634f * a1[e]);
                        const float eb0 = __builtin_amdgcn_exp2f(-1.4426950408889634f * fmaxf(b0[e], -60.f)), eb1 = __builtin_amdgcn_exp2f(-1.4426950408889634f * fmaxf(b1[e], -60.f));
                        acc[ai][bj][m][0][e] *= (1.0f + eb0) * __builtin_amdgcn_rcpf(1.0f + ea0);
                        acc[ai][bj][m][1][e] *= (1.0f + eb1) * __builtin_amdgcn_rcpf(1.0f + ea1); } }
                asm volatile("" : "+v"(acc[ai][0][m][0]), "+v"(acc[ai][0][m][1]), "+v"(acc[ai][1][m][0]), "+v"(acc[ai][1][m][1]) :: "memory"); }
    }
    __device__ __forceinline__ void operator()(const f32x4 (&acc)[2][2][4][2], const Unit& u, int wr, int wc, int fr, int fq) const {
        const int row0 = u.pm * BM + wr * 64 + fr, col0 = u.pn * BM + wc * 32 + 8 * fq;
#pragma unroll
        for (int ai = 0; ai < 2; ++ai)
#pragma unroll
            for (int m = 0; m < 4; ++m) { const size_t off = (size_t)(row0 + ai * HALF + m * 16) * 1024 + col0;
#pragma unroll
                for (int bj = 0; bj < 2; ++bj) { const u32x4 bw = *(const u32x4*)(mb + off + bj * HALF); f32x4 b0, b1; unpack8(bw, b0, b1); f32x4 v0 = acc[ai][bj][m][0], v1 = acc[ai][bj][m][1];
#pragma unroll
                    for (int e = 0; e < 4; ++e) { v0[e] *= fsigmoid(fmaxf(b0[e], -60.f)); v1[e] *= fsigmoid(fmaxf(b1[e], -60.f)); }
                    *(u32x4*)(O + off + bj * HALF) = pack8(v0, v1); } }
    }
};
struct EpiFinal {
    static constexpr bool PERM = true, AFTER_DRAIN = false, MID = false;
    float* out; const bf16_t* pe;
    __device__ __forceinline__ void operator()(const f32x4 (&acc)[2][2][4][2], const Unit& u, int wr, int wc, int fr, int fq) const {
        const int row0 = u.pm * BM + wr * 64 + fr, col0 = u.pn * BM + wc * 32 + 8 * fq;
#pragma unroll
        for (int ai = 0; ai < 2; ++ai)
#pragma unroll
            for (int m = 0; m < 4; ++m) { const size_t off = (size_t)(row0 + ai * HALF + m * 16) * 1024 + col0;
#pragma unroll
                for (int bj = 0; bj < 2; ++bj) { const u32x4 pw = *(const u32x4*)(pe + off + bj * HALF); f32x4 p0, p1; unpack8(pw, p0, p1);
                    float* op = out + off + bj * HALF; const f32x4 x0 = *(const f32x4*)op, x1 = *(const f32x4*)(op + 4);
                    f32x4 g0 = acc[ai][bj][m][0], g1 = acc[ai][bj][m][1];
#pragma unroll
                    for (int e = 0; e < 4; ++e) { g0[e] = x0[e] + fsigmoid(g0[e]) * p0[e]; g1[e] = x1[e] + fsigmoid(g1[e]) * p1[e]; }
                    *(f32x4*)op = g0; *(f32x4*)(op + 4) = g1; } }
    }
};

template <class Epi, class Sched, bool ALIGN_EPI = false, bool SP2 = false>
__device__ __forceinline__ void gemm_phase(PG8_LAS unsigned char* lds, const Gemm g, const Sched& S, const Epi& E) {
    const int tid = threadIdx.x, wid = __builtin_amdgcn_readfirstlane(tid >> 6), lane = tid & 63, wr = wid >> 2, wc = wid & 3, fr = lane & 15, fq = lane >> 4;
    const int nt = g.K / BK, nth = g.K1 / BK;
    unsigned voffA[2], voffB[2];
#pragma unroll
    for (int i = 0; i < 2; ++i) { int R, C; stage_rc(tid * 16 + i * 8192, R, C); const int Rb = Epi::PERM ? ((R & ~31) + perm32(R & 31)) : R;
        voffA[i] = (unsigned)(R * g.lda + C) * 2u; voffB[i] = (unsigned)(Rb * g.ldb + C) * 2u; }
    const size_t kstep = (size_t)(BK * 2);
    const size_t hstepA = (size_t)HALF * g.lda * 2, hstepB = (size_t)HALF * g.ldb * 2;
    const size_t tstepA = 2 * hstepA, tstepB = 2 * hstepB;
    const unsigned ldsw = (unsigned)wid * 1024u;
    const int aoff = lds_byte(wr * 64 + fr, fq * 8), boff = lds_byte(wc * 32 + fr, fq * 8);
#define PG8_SA(b, h) (((b) * 2 + (h)) * HTB)
#define PG8_SB(b, h) ((4 + (b) * 2 + (h)) * HTB)
#define PG8_STAGE(bufoff, gbase, voff) do { _Pragma("unroll") for (int _i = 0; _i < 2; ++_i) \
        __builtin_amdgcn_global_load_lds((const unsigned*)((const char*)(gbase) + (voff)[_i]), (PG8_LAS unsigned*)(lds + (bufoff) + ldsw + _i * 8192), 16, 0, 0); } while (0)
#define PG8_LDA(dst, b, h) do { _Pragma("unroll") for (int m = 0; m < 4; ++m) _Pragma("unroll") for (int k = 0; k < 2; ++k) dst[m][k] = *(const PG8_LAS bf16x8*)(lds + PG8_SA(b, h) + aoff + m * 2048 + k * 1024); } while (0)
#define PG8_LDB(dst, b, h) do { _Pragma("unroll") for (int n = 0; n < 2; ++n) _Pragma("unroll") for (int k = 0; k < 2; ++k) dst[n][k] = *(const PG8_LAS bf16x8*)(lds + PG8_SB(b, h) + boff + n * 2048 + k * 1024); } while (0)
#define PG8_MMA(ai, bj, At, Bt) do { __builtin_amdgcn_s_setprio(1); _Pragma("unroll") for (int m = 0; m < 4; ++m) _Pragma("unroll") for (int n = 0; n < 2; ++n) _Pragma("unroll") for (int k = 0; k < 2; ++k) \
        acc[ai][bj][m][n] = __builtin_amdgcn_mfma_f32_16x16x32_bf16(Bt[n][k], At[m][k], acc[ai][bj][m][n], 0, 0, 0); __builtin_amdgcn_s_setprio(0); } while (0)
#define PG8_WAIT_V(n) asm volatile("s_waitcnt vmcnt(" #n ")" ::: "memory")
#define PG8_WAIT_L(n) asm volatile("s_waitcnt lgkmcnt(" #n ")" ::: "memory")
#define PG8_BAR __builtin_amdgcn_s_barrier()
#define PG8_SCHED __builtin_amdgcn_sched_barrier(0)
    Unit cur, nxt; int ui = 0;
    if (!S.next(0, cur)) return;
    f32x4 acc[2][2][4][2];
#pragma unroll
    for (int a = 0; a < 2; ++a)
#pragma unroll
        for (int b = 0; b < 2; ++b)
#pragma unroll
            for (int m = 0; m < 4; ++m)
#pragma unroll
                for (int n = 0; n < 2; ++n) acc[a][b][m][n] = (f32x4){0.f, 0.f, 0.f, 0.f};
    bf16x8 At[4][2], B0[2][2], B1[2][2];
    const char* cA = (const char*)g.A + (size_t)cur.pm * tstepA + (size_t)cur.pn * g.a_pn_off; const char* cA2 = (const char*)g.A2 + (size_t)cur.pm * tstepA; const char* cB = (const char*)g.Bt + (size_t)cur.pn * tstepB;
    S.a_ready(cur);
    if constexpr (SP2) {
        PG8_STAGE(PG8_SB(0, 0), cB, voffB); PG8_STAGE(PG8_SB(0, 1), cB + hstepB, voffB); PG8_STAGE(PG8_SA(0, 0), cA, voffA); PG8_STAGE(PG8_SA(0, 1), cA + hstepA, voffA);
        if (wr == 1) PG8_BAR;
        PG8_WAIT_V(2); PG8_BAR;
        PG8_STAGE(PG8_SB(1, 0), cB + kstep, voffB); PG8_STAGE(PG8_SA(1, 0), cA + kstep, voffA); PG8_STAGE(PG8_SB(1, 1), cB + hstepB + kstep, voffB);
        PG8_WAIT_V(6); PG8_BAR;
    } else {
        PG8_STAGE(PG8_SB(0, 0), cB, voffB); PG8_STAGE(PG8_SA(0, 0), cA, voffA); PG8_STAGE(PG8_SB(0, 1), cB + hstepB, voffB); PG8_STAGE(PG8_SA(0, 1), cA + hstepA, voffA);
        if (wr == 1) PG8_BAR;
        PG8_WAIT_V(4); PG8_BAR;
        PG8_STAGE(PG8_SB(1, 0), cB + kstep, voffB); PG8_STAGE(PG8_SA(1, 0), cA + kstep, voffA); PG8_STAGE(PG8_SB(1, 1), cB + hstepB + kstep, voffB);
        PG8_WAIT_V(6); PG8_BAR;
    }
    for (;;) {
        const bool has_next = S.next(ui + 1, nxt);
        const char* nA = has_next ? (const char*)g.A + (size_t)nxt.pm * tstepA + (size_t)nxt.pn * g.a_pn_off : cA; const char* nA2 = has_next ? (const char*)g.A2 + (size_t)nxt.pm * tstepA : cA2; const char* nB = has_next ? (const char*)g.Bt + (size_t)nxt.pn * tstepB : cB;
        for (int t = 0; t < nt; t += 2) {
            const bool last = (t == nt - 2);
            if constexpr (Epi::MID) { if (t == nth) E.mid(acc, cur, wr, wc, fr, fq); }
            const char* a1 = (t + 1 < nth) ? cA + (size_t)(t + 1) * kstep : cA2 + (size_t)(t + 1 - nth) * kstep;
            const char* a2 = last ? nA : ((t + 2 < nth) ? cA + (size_t)(t + 2) * kstep : cA2 + (size_t)(t + 2 - nth) * kstep); const char* b2 = last ? nB : cB + (size_t)(t + 2) * kstep;
            const char* a3 = a2 + kstep; const char* b3 = b2 + kstep;
            if (last && has_next) S.a_ready(nxt);
            if constexpr (SP2) {
            PG8_LDB(B0, 0, 0); PG8_LDB(B1, 0, 1); PG8_SCHED; PG8_LDA(At, 0, 0); PG8_STAGE(PG8_SA(1, 1), a1 + hstepA, voffA);
            PG8_WAIT_V(8); PG8_WAIT_L(0); PG8_BAR; PG8_MMA(0, 0, At, B0); PG8_MMA(0, 1, At, B1); PG8_BAR; PG8_SCHED;
            PG8_LDA(At, 0, 1); PG8_STAGE(PG8_SB(0, 0), b2, voffB); PG8_STAGE(PG8_SB(0, 1), b2 + hstepB, voffB); PG8_STAGE(PG8_SA(0, 0), a2, voffA);
            PG8_WAIT_V(8); PG8_WAIT_L(0); PG8_BAR; PG8_MMA(1, 0, At, B0); PG8_MMA(1, 1, At, B1); PG8_BAR; PG8_SCHED;
            PG8_LDB(B0, 1, 0); PG8_LDB(B1, 1, 1); PG8_SCHED; PG8_LDA(At, 1, 0); PG8_STAGE(PG8_SA(0, 1), a2 + hstepA, voffA);
            PG8_WAIT_V(8); PG8_WAIT_L(0); PG8_BAR; PG8_MMA(0, 0, At, B0); PG8_MMA(0, 1, At, B1); PG8_BAR; PG8_SCHED;
            PG8_LDA(At, 1, 1); PG8_STAGE(PG8_SB(1, 0), b3, voffB); PG8_STAGE(PG8_SB(1, 1), b3 + hstepB, voffB); PG8_STAGE(PG8_SA(1, 0), a3, voffA);
            PG8_WAIT_V(8); PG8_WAIT_L(0); PG8_BAR; PG8_MMA(1, 0, At, B0); PG8_MMA(1, 1, At, B1); PG8_BAR; PG8_SCHED;
            } else {
            PG8_LDB(B0, 0, 0); PG8_SCHED; PG8_LDA(At, 0, 0); PG8_STAGE(PG8_SA(1, 1), a1 + hstepA, voffA);
            PG8_WAIT_L(8); PG8_BAR; PG8_WAIT_L(0); PG8_MMA(0, 0, At, B0); PG8_BAR; PG8_SCHED;
            PG8_LDB(B1, 0, 1); PG8_STAGE(PG8_SB(0, 0), b2, voffB);
            PG8_BAR; PG8_WAIT_L(0); PG8_MMA(0, 1, At, B1); PG8_BAR;
            PG8_LDA(At, 0, 1); PG8_STAGE(PG8_SA(0, 0), a2, voffA);
            PG8_BAR; PG8_WAIT_L(0); PG8_MMA(1, 0, At, B0); PG8_BAR; PG8_SCHED;
            PG8_STAGE(PG8_SB(0, 1), b2 + hstepB, voffB);
            PG8_WAIT_V(6); PG8_BAR; PG8_MMA(1, 1, At, B1); PG8_BAR;
            PG8_LDB(B0, 1, 0); PG8_SCHED; PG8_LDA(At, 1, 0); PG8_STAGE(PG8_SA(0, 1), a2 + hstepA, voffA);
            PG8_WAIT_L(8); PG8_BAR; PG8_WAIT_L(0); PG8_MMA(0, 0, At, B0); PG8_BAR; PG8_SCHED;
            PG8_LDB(B1, 1, 1); PG8_STAGE(PG8_SB(1, 0), b3, voffB);
            PG8_BAR; PG8_WAIT_L(0); PG8_MMA(0, 1, At, B1); PG8_BAR;
            PG8_LDA(At, 1, 1); PG8_STAGE(PG8_SA(1, 0), a3, voffA);
            PG8_BAR; PG8_WAIT_L(0); PG8_MMA(1, 0, At, B0); PG8_BAR; PG8_SCHED;
            PG8_STAGE(PG8_SB(1, 1), b3 + hstepB, voffB);
            PG8_WAIT_V(6); PG8_BAR; PG8_MMA(1, 1, At, B1); PG8_BAR;
            }
        }
        if constexpr (ALIGN_EPI) { if (wr == 0) PG8_BAR; }
        if constexpr (!Epi::AFTER_DRAIN) { E(acc, cur, wr, wc, fr, fq); S.done(cur); }
        if (!has_next) break;
#pragma unroll
        for (int a = 0; a < 2; ++a)
#pragma unroll
            for (int b = 0; b < 2; ++b)
#pragma unroll
                for (int m = 0; m < 4; ++m)
#pragma unroll
                    for (int n = 0; n < 2; ++n) acc[a][b][m][n] = (f32x4){0.f, 0.f, 0.f, 0.f};
        cur = nxt; cA = nA; cA2 = nA2; cB = nB; ++ui;
        if constexpr (ALIGN_EPI) { if (wr == 1) PG8_BAR; }
    }
    PG8_WAIT_V(0);
    if constexpr (!ALIGN_EPI) { if (wr == 0) PG8_BAR; }
    PG8_BAR;
    if constexpr (Epi::AFTER_DRAIN) { E.fused(acc, cur, wr, wc, fr, fq, lds, wid, lane); S.done(cur); }
#undef PG8_SA
#undef PG8_SB
#undef PG8_STAGE
#undef PG8_LDA
#undef PG8_LDB
#undef PG8_MMA
#undef PG8_WAIT_V
#undef PG8_WAIT_L
#undef PG8_BAR
#undef PG8_SCHED
}
}

namespace attn_body {
using bf16=__hip_bfloat16;
using bf16x8=__attribute__((ext_vector_type(8)))short;
using s16x4=__attribute__((ext_vector_type(4)))short;
using f32x16=__attribute__((ext_vector_type(16)))float;
using u32x4=__attribute__((ext_vector_type(4)))unsigned;
constexpr int D=64,QP=1024,KP=256;
constexpr int NW=8,QBLK=32,QB=QBLK*NW,KVBLK=64;

__device__ __forceinline__ int crow(int r,int hi){return (r&3)+8*(r>>2)+4*hi;}
#define SBAR() __builtin_amdgcn_sched_barrier(0)
__device__ __forceinline__ void cmask(f32x16&p0,f32x16&p1,int jb,int qrel,int hi){
  const float NEG=-INFINITY; int kb=64*jb+4*hi;
  #pragma unroll
  for(int r=0;r<16;++r){int kv=kb+(r&3)+8*(r>>2); if(kv>qrel)p0[r]=NEG; if(kv+32>qrel)p1[r]=NEG;}
}

constexpr int NSLOT=3, SLOTB=8192;
constexpr int LDS_K=0, LDS_V=NSLOT*SLOTB, LDS_WS=2*NSLOT*SLOTB, LDS_OST=LDS_WS+NW*64*4, LDS_BYTES=LDS_OST+NW*4096;
constexpr float C2=0.125f*1.4426950408889634f;
__device__ __forceinline__ void glds16(const void*gsrc,unsigned lds_dst){unsigned keep;
  asm volatile("s_mov_b32 %0, m0\n\ts_mov_b32 m0, %2\n\ts_nop 0\n\tglobal_load_lds_dwordx4 %1, off\n\ts_mov_b32 m0, %0":"=&s"(keep):"v"(gsrc),"s"(lds_dst):"memory");}
__device__ __forceinline__ float max3f(float a,float b,float c){float r;asm("v_max3_f32 %0, %1, %2, %3":"=v"(r):"v"(a),"v"(b),"v"(c));return r;}
__device__ __forceinline__ float max2f(float a,float b){float r;asm("v_max_f32_e32 %0, %1, %2":"=v"(r):"v"(a),"v"(b));return r;}
__device__ __forceinline__ float fadd_s(float a,float b){float r;asm("v_add_f32_e32 %0, %1, %2":"=v"(r):"v"(a),"v"(b));return r;}
__device__ __forceinline__ float fsub_s(float a,float b){float r;asm("v_sub_f32_e32 %0, %1, %2":"=v"(r):"v"(a),"v"(b));return r;}
typedef float f32x2_t __attribute__((ext_vector_type(2))); typedef __bf16 bf16x2_t __attribute__((ext_vector_type(2)));
__device__ __forceinline__ unsigned cvtpk_s(float lo,float hi){f32x2_t v={lo,hi};bf16x2_t b=__builtin_convertvector(v,bf16x2_t);return __builtin_bit_cast(unsigned,b);}
#define WAIT_BAR(N) asm volatile("s_waitcnt vmcnt(" #N ") lgkmcnt(0)\n\ts_barrier":::"memory")

__device__ __forceinline__ void qkt(f32x16&p0,f32x16&p1,const char*Kslot,const bf16x8*qr,const f32x16&negm,int r32,int hi){
  const char*kb=Kslot+hi*1024+r32*16;
  #pragma unroll
  for(int d0=0;d0<4;++d0){
    const bf16x8 b0=*reinterpret_cast<const bf16x8*>(kb+d0*2048);
    const bf16x8 b1=*reinterpret_cast<const bf16x8*>(kb+d0*2048+512);
    if(d0==0){p0=__builtin_amdgcn_mfma_f32_32x32x16_bf16(b0,qr[0],negm,0,0,0);p1=__builtin_amdgcn_mfma_f32_32x32x16_bf16(b1,qr[0],negm,0,0,0);}
    else{p0=__builtin_amdgcn_mfma_f32_32x32x16_bf16(b0,qr[d0],p0,0,0,0);p1=__builtin_amdgcn_mfma_f32_32x32x16_bf16(b1,qr[d0],p1,0,0,0);}}
}
typedef __attribute__((address_space(3))) const char* lds_cptr;
typedef short v4i16_t __attribute__((ext_vector_type(4)));
__device__ __forceinline__ void kload8(bf16x8*kf,lds_cptr kp){
  kf[0]=*(const __attribute__((address_space(3))) bf16x8*)(kp);      kf[1]=*(const __attribute__((address_space(3))) bf16x8*)(kp+512);
  kf[2]=*(const __attribute__((address_space(3))) bf16x8*)(kp+2048); kf[3]=*(const __attribute__((address_space(3))) bf16x8*)(kp+2560);
  kf[4]=*(const __attribute__((address_space(3))) bf16x8*)(kp+4096); kf[5]=*(const __attribute__((address_space(3))) bf16x8*)(kp+4608);
  kf[6]=*(const __attribute__((address_space(3))) bf16x8*)(kp+6144); kf[7]=*(const __attribute__((address_space(3))) bf16x8*)(kp+6656);
}
__device__ __forceinline__ void kload2(bf16x8*kf,lds_cptr kp,int j){ kf[2*j]=*(const __attribute__((address_space(3))) bf16x8*)(kp+j*2048); kf[2*j+1]=*(const __attribute__((address_space(3))) bf16x8*)(kp+j*2048+512); }
__device__ __forceinline__ s16x4 vtr(lds_cptr p){ return __builtin_bit_cast(s16x4,__builtin_amdgcn_ds_read_tr16_b64_v4i16((__attribute__((address_space(3))) v4i16_t*)p)); }
__device__ __forceinline__ float rowmax(const f32x16&p0,const f32x16&p1){
  float a=max3f(p0[0],p0[1],p1[0]),b=max3f(p0[2],p0[3],p1[1]);a=max3f(a,p1[2],p1[3]);
  #pragma unroll
  for(int r=4;r<16;r+=4){a=max3f(a,p0[r],p0[r+1]);b=max3f(b,p0[r+2],p0[r+3]);a=max3f(a,p1[r],p1[r+1]);b=max3f(b,p1[r+2],p1[r+3]);}
  const float m=max2f(a,b);
  auto rr=__builtin_amdgcn_permlane32_swap(__float_as_uint(m),__float_as_uint(m),false,false);
  return max2f(__uint_as_float(rr[0]),__uint_as_float(rr[1]));
}
__device__ __forceinline__ void pv(f32x16*o,int vb,bf16x8 pa0,bf16x8 pa1,bf16x8 pa2,bf16x8 pa3){
  #pragma unroll
  for(int d0=0;d0<2;++d0){s16x4 lo[4],hi[4];
    #pragma unroll
    for(int ks=0;ks<4;++ks){
      asm volatile("ds_read_b64_tr_b16 %0,%1 offset:%c2":"=&v"(lo[ks]):"v"(vb),"i"(d0*4096+ks*1024):"memory");
      asm volatile("ds_read_b64_tr_b16 %0,%1 offset:%c2":"=&v"(hi[ks]):"v"(vb),"i"(d0*4096+ks*1024+512):"memory");}
    asm volatile("s_waitcnt lgkmcnt(0)":::"memory");SBAR();
    #define PK(k) (bf16x8){lo[k][0],lo[k][1],lo[k][2],lo[k][3],hi[k][0],hi[k][1],hi[k][2],hi[k][3]}
    o[d0]=__builtin_amdgcn_mfma_f32_32x32x16_bf16(pa0,PK(0),o[d0],0,0,0);
    o[d0]=__builtin_amdgcn_mfma_f32_32x32x16_bf16(pa1,PK(1),o[d0],0,0,0);
    o[d0]=__builtin_amdgcn_mfma_f32_32x32x16_bf16(pa2,PK(2),o[d0],0,0,0);
    o[d0]=__builtin_amdgcn_mfma_f32_32x32x16_bf16(pa3,PK(3),o[d0],0,0,0);
    #undef PK
  }
}
#define ATTN_STORE16(p,v) (*(u32x4*)(p)=(v))
__device__ __forceinline__ float abf_lo(unsigned w){return __uint_as_float(w<<16);}
__device__ __forceinline__ float abf_hi(unsigned w){return __uint_as_float(w&0xffff0000u);}
__device__ __forceinline__ u32x4 mulgate(const u32x4&v,const u32x4&g){u32x4 r;
  r.x=cvtpk_s(abf_lo(v.x)*abf_lo(g.x),abf_hi(v.x)*abf_hi(g.x)); r.y=cvtpk_s(abf_lo(v.y)*abf_lo(g.y),abf_hi(v.y)*abf_hi(g.y));
  r.z=cvtpk_s(abf_lo(v.z)*abf_lo(g.z),abf_hi(v.z)*abf_hi(g.z)); r.w=cvtpk_s(abf_lo(v.w)*abf_lo(g.w),abf_hi(v.w)*abf_hi(g.w)); return r;}
template<int THRL> __device__ __forceinline__ void attn_unit(long qrow0,long kvrow0,int NT,int h,const bf16*Q,const bf16*__restrict__ K,const bf16*__restrict__ V,bf16*O,const bf16*__restrict__ Gt,char*shm){
  const int tid=threadIdx.x,lane=tid&63,r32=lane&31,hi=lane>>5; const int wid=__builtin_amdgcn_readfirstlane(tid>>6);
  const bf16*Qw=Q+(qrow0+wid*QBLK)*QP+h*D;
  const bf16*Kh=K+kvrow0*KP+(h>>2)*D,*Vh=V+kvrow0*KP+(h>>2)*D;
  const unsigned lds0=(unsigned)(uintptr_t)shm;
  float*wsf=(float*)(shm+LDS_WS)+wid*64;
  const bf16*ksrc=Kh+(long)lane*KP+wid*8;
  const bf16*vsrc=Vh+(long)(16*(wid&3)+(lane>>2))*KP+(wid>>2)*32+(lane&3)*8;
  const unsigned kdst=lds0+LDS_K+wid*1024, vdst=lds0+LDS_V+wid*1024;
  #define DMA_K(t,slot) glds16(ksrc+(long)(t)*KVBLK*KP,(unsigned)__builtin_amdgcn_readfirstlane(kdst+(slot)))
  #define DMA_V(t,slot) glds16(vsrc+(long)(t)*KVBLK*KP,(unsigned)__builtin_amdgcn_readfirstlane(vdst+(slot)))
  const int vb0=(int)(lds0+LDS_V)+((lane>>4)&1)*32+(lane&3)*8+(4*hi+((lane&15)>>2))*64;
  const char*Kbase=shm+LDS_K; bf16x8 kf[8];
  const lds_cptr shm3=(lds_cptr)shm; const lds_cptr kp0=shm3+LDS_K+hi*1024+r32*16; const lds_cptr vp0=shm3+LDS_V+((lane>>4)&1)*32+(lane&3)*8+(4*hi+((lane&15)>>2))*64;
  DMA_K(0,0);DMA_V(0,0);DMA_K(1,SLOTB);
  bf16x8 qr[4];
  #pragma unroll
  for(int d0=0;d0<4;++d0)qr[d0]=*reinterpret_cast<const bf16x8*>(&Qw[(long)r32*QP+d0*16+hi*8]);
  float mhat=0.f,l_reg=0.f;f32x16 o[2];o[0]=f32x16{};o[1]=f32x16{};f32x16 negm=f32x16{};asm volatile("":"+v"(negm));
  #define CMASK(P0,P1,t) do{}while(0)
  bool resc=false;
  #define START(P0,P1) do{ const float rm=rowmax(P0,P1); resc=false; \
    { const float dl=rm; mhat=fadd_s(mhat,dl); \
      _Pragma("unroll") for(int r=0;r<16;++r){P0[r]=fsub_s(P0[r],dl);P1[r]=fsub_s(P1[r],dl);} \
      _Pragma("unroll") for(int r=0;r<16;++r)negm[r]=-mhat; asm volatile("":"+v"(negm)); } \
    _Pragma("unroll") for(int r=0;r<16;++r)P0[r]=__builtin_amdgcn_exp2f(P0[r]); }while(0)
  #define RESC() do{ if(resc){ asm volatile("s_waitcnt lgkmcnt(0)":::"memory"); \
      _Pragma("unroll") for(int d_=0;d_<2;++d_) _Pragma("unroll") for(int r=0;r<16;++r)o[d_][r]*=wsf[crow(r,hi)]; } }while(0)
  f32x16 pA0,pA1,pB0,pB1;
  int sl_prev=0,sl_cur=0,sl_next=SLOTB;
  #define ROT() do{sl_prev=sl_cur;sl_cur=sl_next;sl_next=(sl_next==(NSLOT-1)*SLOTB)?0:sl_next+SLOTB;}while(0)
  DMA_K(2,2*SLOTB);
  WAIT_BAR(3);
  qkt(pA0,pA1,Kbase,qr,negm,r32,hi);asm volatile("s_nop 15\n\ts_nop 7":"+v"(pA0),"+v"(pA1));CMASK(pA0,pA1,0);
  START(pA0,pA1);
  _Pragma("unroll") for(int r=0;r<16;++r)pA1[r]=__builtin_amdgcn_exp2f(pA1[r]);
  WAIT_BAR(0);
  DMA_K(3,0);DMA_V(1,SLOTB);
  ROT();
  kload8(kf,kp0+sl_cur);
  WAIT_BAR(2);
  s16x4 vlo[8],vhi[8]; u32x4 pw0,pw1,pw2,pw3;
  #define PKW(P,B) cvtpk_s(P[B],P[B+1])
  #define PAF(k) __builtin_bit_cast(bf16x8,pw##k)
  #define VFR(i) (bf16x8){vlo[i][0],vlo[i][1],vlo[i][2],vlo[i][3],vhi[i][0],vhi[i][1],vhi[i][2],vhi[i][3]}
  #define PIN(x) asm volatile("":"+v"(x))
  #define MX3(a,b,c) __builtin_fmaxf(__builtin_fmaxf((a),(b)),(c))
  #define GAPA(MF,A0,A1,A2,A3,W0,W1,PW) do{ MF; sacc+=A0; sacc+=A1; sacc+=A2; sacc+=A3; PIN(sacc); W0; W1; PIN(PW); SBAR(); }while(0)
  #define EX(v) __builtin_amdgcn_exp2f(v)
  #define GAPB(MF,X,B) do{ MF; X[B]=EX(X[B]); X[B+1]=EX(X[B+1]); X[B+2]=EX(X[B+2]); X[B+3]=EX(X[B+3]); PIN(X); SBAR(); }while(0)
  #define VRD(i) do{ vlo[i]=vtr(vp_+(((i)>>2)*4096+((i)&3)*1024)); vhi[i]=vtr(vp_+(((i)>>2)*4096+((i)&3)*1024+512)); }while(0)
  #define KRD(G,j) do{ if(G){ kload2(kf,kp0+sl_next,j); SBAR(); } }while(0)
  #define STEP(C0,C1,P0,P1,t,GK,GV,GL) do{ SBAR(); \
    const lds_cptr vp_=vp0+sl_prev; \
    VRD(0); SBAR(); float sacc=(P0[0]+P0[1]); \
    GAPA(C0=__builtin_amdgcn_mfma_f32_32x32x16_bf16(kf[0],qr[0],negm,0,0,0), P0[2],P0[3],P0[4],P0[5],     pw0[0]=PKW(P0,0), pw0[1]=PKW(P0,2), pw0); \
    VRD(4); SBAR(); GAPA(C1=__builtin_amdgcn_mfma_f32_32x32x16_bf16(kf[1],qr[0],negm,0,0,0), P0[6],P0[7],P0[8],P0[9],     pw0[2]=PKW(P0,4), pw0[3]=PKW(P0,6), pw0); \
    VRD(1); SBAR(); GAPA(C0=__builtin_amdgcn_mfma_f32_32x32x16_bf16(kf[2],qr[1],C0,0,0,0),   P0[10],P0[11],P0[12],P0[13], pw1[0]=PKW(P0,8), pw1[1]=PKW(P0,10), pw1); \
    VRD(5); SBAR(); GAPA(C1=__builtin_amdgcn_mfma_f32_32x32x16_bf16(kf[3],qr[1],C1,0,0,0),   P0[14],P0[15],P1[0],P1[1],   pw1[2]=PKW(P0,12),pw1[3]=PKW(P0,14), pw1); \
    VRD(2); SBAR(); GAPA(C0=__builtin_amdgcn_mfma_f32_32x32x16_bf16(kf[4],qr[2],C0,0,0,0),   P1[2],P1[3],P1[4],P1[5],     pw2[0]=PKW(P1,0), pw2[1]=PKW(P1,2), pw2); \
    VRD(6); SBAR(); GAPA(C1=__builtin_amdgcn_mfma_f32_32x32x16_bf16(kf[5],qr[2],C1,0,0,0),   P1[6],P1[7],P1[8],P1[9],     pw2[2]=PKW(P1,4), pw2[3]=PKW(P1,6), pw2); \
    VRD(3); SBAR(); GAPA(C0=__builtin_amdgcn_mfma_f32_32x32x16_bf16(kf[6],qr[3],C0,0,0,0),   P1[10],P1[11],P1[12],P1[13], pw3[0]=PKW(P1,8), pw3[1]=PKW(P1,10), pw3); \
    VRD(7); SBAR(); GAPA(C1=__builtin_amdgcn_mfma_f32_32x32x16_bf16(kf[7],qr[3],C1,0,0,0),   P1[14],P1[15],0.f,0.f,       pw3[2]=PKW(P1,12),pw3[3]=PKW(P1,14), pw3); \
    l_reg+=sacc; \
    if(GK){DMA_K((t)+3,sl_cur);} if(GV){DMA_V((t)+1,sl_next);} \
    CMASK(C0,C1,t); \
    { float a=MX3(C0[0],C0[1],C1[0]),b=MX3(C0[2],C0[3],C1[1]); a=MX3(a,C1[2],C1[3]); \
      _Pragma("unroll") for(int r=4;r<16;r+=4){a=MX3(a,C0[r],C0[r+1]);b=MX3(b,C0[r+2],C0[r+3]);a=MX3(a,C1[r],C1[r+1]);b=MX3(b,C1[r+2],C1[r+3]);} \
      float rm=__builtin_fmaxf(a,b); { auto rr=__builtin_amdgcn_permlane32_swap(__float_as_uint(rm),__float_as_uint(rm),false,false); rm=__builtin_fmaxf(__uint_as_float(rr[0]),__uint_as_float(rr[1])); } \
      resc=false; \
      if(__builtin_expect(__any(rm>(float)THRL),0)){ const float dl=__builtin_fmaxf(rm,0.f); mhat+=dl; \
        _Pragma("unroll") for(int r=0;r<16;++r){C0[r]-=dl;C1[r]-=dl;} \
        _Pragma("unroll") for(int r=0;r<16;++r)negm[r]=-mhat; asm volatile("":"+v"(negm)); \
        const float f=__builtin_amdgcn_exp2f(-dl); l_reg*=f; if(hi==0)wsf[r32]=f; resc=true; } } \
    SBAR(); \
    GAPB(o[0]=__builtin_amdgcn_mfma_f32_32x32x16_bf16(PAF(0),VFR(0),o[0],0,0,0), C0,0); \
    GAPB(o[1]=__builtin_amdgcn_mfma_f32_32x32x16_bf16(PAF(0),VFR(4),o[1],0,0,0), C0,4); \
    KRD(GL,0); GAPB(o[0]=__builtin_amdgcn_mfma_f32_32x32x16_bf16(PAF(1),VFR(1),o[0],0,0,0), C0,8); \
    KRD(GL,1); GAPB(o[1]=__builtin_amdgcn_mfma_f32_32x32x16_bf16(PAF(1),VFR(5),o[1],0,0,0), C0,12); \
    KRD(GL,2); GAPB(o[0]=__builtin_amdgcn_mfma_f32_32x32x16_bf16(PAF(2),VFR(2),o[0],0,0,0), C1,0); \
    KRD(GL,3); GAPB(o[1]=__builtin_amdgcn_mfma_f32_32x32x16_bf16(PAF(2),VFR(6),o[1],0,0,0), C1,4); \
    GAPB(o[0]=__builtin_amdgcn_mfma_f32_32x32x16_bf16(PAF(3),VFR(3),o[0],0,0,0), C1,8); \
    GAPB(o[1]=__builtin_amdgcn_mfma_f32_32x32x16_bf16(PAF(3),VFR(7),o[1],0,0,0), C1,12); \
    }while(0)
  int t=1;
  #undef CMASK
  #define CMASK(P0,P1,t) do{}while(0)
  for(;t+5<NT;t+=2){
    STEP(pB0,pB1,pA0,pA1,t,true,true,true);     WAIT_BAR(2); RESC(); ROT();
    STEP(pA0,pA1,pB0,pB1,t+1,true,true,true);   WAIT_BAR(2); RESC(); ROT();
  }
  #undef CMASK
  #define CMASK(P0,P1,t) do{}while(0)
  #define ENDW(tt) do{ if((tt)+3<NT){WAIT_BAR(2);} else if((tt)+2<NT){WAIT_BAR(1);} else {WAIT_BAR(0);} }while(0)
  for(;t+1<NT;t+=2){
    STEP(pB0,pB1,pA0,pA1,t,(t+3<NT),(t+1<NT),(t+1<NT));       ENDW(t);   RESC(); ROT();
    STEP(pA0,pA1,pB0,pB1,t+1,(t+4<NT),(t+2<NT),(t+2<NT));     ENDW(t+1); RESC(); ROT();
  }
  STEP(pB0,pB1,pA0,pA1,NT-1,false,false,false); RESC();
  { float sacc=pB0[0]+pB0[1]; _Pragma("unroll") for(int r=2;r<16;++r)sacc+=pB0[r]; _Pragma("unroll") for(int r=0;r<16;++r)sacc+=pB1[r]; l_reg+=sacc;
    pw0=(u32x4){PKW(pB0,0),PKW(pB0,2),PKW(pB0,4),PKW(pB0,6)};pw1=(u32x4){PKW(pB0,8),PKW(pB0,10),PKW(pB0,12),PKW(pB0,14)};pw2=(u32x4){PKW(pB1,0),PKW(pB1,2),PKW(pB1,4),PKW(pB1,6)};pw3=(u32x4){PKW(pB1,8),PKW(pB1,10),PKW(pB1,12),PKW(pB1,14)};
    SBAR(); pv(o,vb0+sl_cur,PAF(0),PAF(1),PAF(2),PAF(3)); }
  #undef PKW
  #undef PAF
  #undef VFR
  #undef PIN
  #undef MX3
  #undef GAPA
  #undef GAPB
  #undef EX
  #undef VRD
  #undef KRD
  #undef STEP
  #undef ENDW
  {auto rr=__builtin_amdgcn_permlane32_swap(__float_as_uint(l_reg),__float_as_uint(l_reg),false,false);l_reg=__uint_as_float(rr[0])+__uint_as_float(rr[1]);}
  if(hi==0)wsf[32+r32]=l_reg;asm volatile("s_waitcnt lgkmcnt(0)":::"memory");
  float rli[16];
  #pragma unroll
  for(int r=0;r<16;++r)rli[r]=__builtin_amdgcn_rcpf(wsf[32+crow(r,hi)]);
  bf16*Ow=O+(qrow0+wid*QBLK)*QP+h*D; const bf16*Gw=Gt+(qrow0+wid*QBLK)*QP+h*D;
  { bf16*stg=(bf16*)(shm+LDS_OST)+wid*2048;
    #pragma unroll
    for(int r=0;r<16;++r){const int orow=crow(r,hi);
      #pragma unroll
      for(int d0=0;d0<2;++d0)stg[orow*64+d0*32+r32]=__float2bfloat16(o[d0][r]*rli[r]);}
    asm volatile("s_waitcnt lgkmcnt(0)":::"memory");
    #pragma unroll
    for(int i=0;i<4;++i){const int row=i*8+(lane>>3),ch=lane&7; const u32x4 v=*(const u32x4*)(stg+row*64+ch*8); const u32x4 gv=*(const u32x4*)(Gw+(long)row*QP+ch*8); ATTN_STORE16(Ow+(long)row*QP+ch*8,mulgate(v,gv));} }
  asm volatile("s_waitcnt lgkmcnt(0)\n\ts_barrier":::"memory");
  #undef DMA_K
  #undef DMA_V
  #undef CMASK
  #undef START
  #undef RESC
  #undef ROT
}
constexpr int ATTN_LDS_BYTES=LDS_BYTES;
#undef SBAR
#undef WAIT_BAR
}

constexpr int NWAVES = 8;
constexpr int D = 1024, TP = 8192, TS = 2048, NB = 8;
constexpr int MP = NB * TP, MS = NB * TS, M = MP + MS;
constexpr int INW = 6656, PLE = 256;
constexpr float EPS = 1e-6f;
#ifndef MK_N_LAUNCHES
#define MK_N_LAUNCHES 1
#endif
constexpr int N_LAUNCHES = MK_N_LAUNCHES;
constexpr int N_PHASES = 8;

constexpr size_t MiB = 1u << 20;
constexpr size_t WS_CTL = 0, CTL_ZERO_BYTES = 64 * 1024;
constexpr size_t WS_WIN = 2 * MiB;
constexpr size_t WS_WPOOL = 15 * MiB;
constexpr size_t WS_WAB = 16 * MiB;
constexpr size_t WS_WO = 20 * MiB;
constexpr size_t WS_WG = 22 * MiB;
constexpr size_t WS_WPLE = 24 * MiB;
constexpr size_t WS_PBF = 26 * MiB;
constexpr size_t WS_RA = 80 * MiB;
constexpr size_t WS_RB = 240 * MiB;
constexpr size_t WS_RC = 400 * MiB;
constexpr size_t WS_RD = 560 * MiB;
constexpr size_t WS_RE = 720 * MiB;
constexpr size_t WS_RK = 880 * MiB;
constexpr size_t WS_RV = 920 * MiB;
constexpr size_t WS_END = 960 * MiB;

constexpr int RING_BYTES = 131072;
constexpr int LDS_BYTES = 147456;
constexpr int MISC_OFF = RING_BYTES;

#define GAS __attribute__((address_space(1)))
#define LAS __attribute__((address_space(3)))
typedef unsigned short bf16;
typedef unsigned v4u __attribute__((ext_vector_type(4)));
typedef unsigned v2u __attribute__((ext_vector_type(2)));
typedef float f32x4 __attribute__((ext_vector_type(4)));
#define LDS_WAIT() asm volatile("s_waitcnt lgkmcnt(0)" ::: "memory")
#define VM_WAIT() asm volatile("s_waitcnt vmcnt(0)" ::: "memory")
__device__ __forceinline__ unsigned pk2(float lo, float hi) { return pg8::cvt_pk_bf16(lo, hi); }
__device__ __forceinline__ float blo(unsigned w) { return __uint_as_float(w << 16); }
__device__ __forceinline__ float bhi(unsigned w) { return __uint_as_float(w & 0xffff0000u); }

#define XB_TMO      128
#define XB_XCNT(j)  (256  + 64 * (j))
#define XB_XSUB(j)  (1280 + 64 * (j))
#define XB_XGEN(j)  (2304 + 64 * (j))
#define XB_TOP      3328
#define XB_TOPGEN   3392
#define XCD_BAR_WORDS 3456
#define XB_SPIN_CAP (1u << 18)

__device__ __forceinline__ unsigned xb_ld(unsigned* p)              { return __hip_atomic_load(p, __ATOMIC_RELAXED, __HIP_MEMORY_SCOPE_AGENT); }
__device__ __forceinline__ unsigned xb_add(unsigned* p, unsigned v) { return __hip_atomic_fetch_add(p, v, __ATOMIC_RELAXED, __HIP_MEMORY_SCOPE_AGENT); }
__device__ __forceinline__ unsigned xb_xcc_id() { return (unsigned)__builtin_amdgcn_s_getreg((3 << 11) | 20) & 0xFu; }
#define XB_SPIN(cond, bar) do { unsigned _sp = 0; while (cond) { __builtin_amdgcn_s_sleep(1); \
    if ((++_sp & 255u) == 0u) { if (xb_ld(&(bar)[XB_TMO])) break; if (_sp > XB_SPIN_CAP) { atomicAdd(&(bar)[XB_TMO], 1u); break; } } } } while (0)

struct XcdBarrier {
    unsigned* bar; unsigned x;
    volatile LAS unsigned* st;
};

__device__ __forceinline__ XcdBarrier xcd_barrier_post(unsigned* bar, volatile LAS unsigned* st) {
    XcdBarrier b; b.bar = bar; b.x = xb_xcc_id(); b.st = st;
    if (threadIdx.x == 0) (void)xb_add(&bar[XB_XCNT(b.x)], 1u);
    return b;
}
__device__ __forceinline__ void xcd_barrier_complete(unsigned* bar, unsigned x, unsigned& nloc, unsigned& nx) {
    const unsigned G = gridDim.x * gridDim.y * gridDim.z;
    unsigned sum, cnt, mine, sp = 0u;
    for (;;) {
        sum = 0u; cnt = 0u; mine = 0u;
#pragma unroll
        for (unsigned j = 0; j < 16; ++j) { const unsigned c = xb_ld(&bar[XB_XCNT(j)]); sum += c; cnt += (c > 0u) ? 1u : 0u; mine = (j == x) ? c : mine; }
        if (sum == G) break;
        __builtin_amdgcn_s_sleep(1);
        if ((++sp & 255u) == 0u) { if (xb_ld(&bar[XB_TMO])) break; if (sp > XB_SPIN_CAP) { atomicAdd(&bar[XB_TMO], 1u); break; } }
    }
    nloc = mine > 0u ? mine : 1u; nx = cnt > 0u ? cnt : 1u;
}

__device__ __forceinline__ void xcd_barrier(const XcdBarrier& b) {
    asm volatile("s_waitcnt vmcnt(0)" ::: "memory");
    __syncthreads();
    if (threadIdx.x == 0) {
        unsigned* bar = b.bar;
        __builtin_amdgcn_s_waitcnt(0);
        unsigned nloc = b.st[0], nx = b.st[1];
        if (nloc == 0u) { xcd_barrier_complete(bar, b.x, nloc, nx); b.st[0] = nloc; b.st[1] = nx; }
        const unsigned old = xb_add(&bar[XB_XSUB(b.x)], 1u);
        const unsigned gen = old / nloc;
        if (old + 1u == (gen + 1u) * nloc) {
            __builtin_amdgcn_fence(__ATOMIC_RELEASE, "agent");
            asm volatile("s_waitcnt vmcnt(0)" ::: "memory");
            const unsigned og = xb_add(&bar[XB_TOP], 1u);
            const unsigned tg = og / nx;
            if (og + 1u == (tg + 1u) * nx) xb_add(&bar[XB_TOPGEN], 1u);
            else XB_SPIN(xb_ld(&bar[XB_TOPGEN]) == tg, bar);
            __builtin_amdgcn_fence(__ATOMIC_ACQUIRE, "agent");
            xb_add(&bar[XB_XGEN(b.x)], 1u);
            asm volatile("s_waitcnt vmcnt(0)" ::: "memory");
        } else {
            XB_SPIN(xb_ld(&bar[XB_XGEN(b.x)]) == gen, bar);
            __builtin_amdgcn_fence(__ATOMIC_ACQUIRE, "agent");
            asm volatile("s_waitcnt vmcnt(0)" ::: "memory");
        }
    }
    __syncthreads();
}

struct Args {
    const float *x_p, *x_s, *p_p, *p_s, *norm_pre, *w_in, *pool_w, *pool_scale, *w_a, *q_norm, *k_norm, *w_b, *w_out, *norm_post, *ple_norm, *w_gate, *w_ple;
    float* out; unsigned char* ws; int ph_lo, ph_hi;
};

__device__ __forceinline__ float wave_sum(float v) {
#pragma unroll
    for (int o = 1; o < 64; o <<= 1) v += __shfl_xor(v, o);
    return v;
}
__device__ __forceinline__ void p0_transpose_item(const float* W, int K, int N, bf16* WT, int row_off, int ldt, int koff, LAS float* scr, int item, int lane) {
    const int nblk = N / 32, kb = item / nblk, nb = item % nblk, k0 = 64 * kb, n0 = 32 * nb;
#pragma unroll 8
    for (int i = 0; i < 32; ++i) { const int kk = 2 * i + (lane >> 5); scr[kk * 33 + (lane & 31)] = W[(size_t)(k0 + kk) * N + n0 + (lane & 31)]; }
    LDS_WAIT(); asm volatile("" ::: "memory");
    const int c = lane & 7;
#pragma unroll
    for (int j = 0; j < 4; ++j) { const int n = (lane >> 3) + 8 * j; const LAS float* s = scr + (8 * c) * 33 + n;
        v4u o; o.x = pk2(s[0 * 33], s[1 * 33]); o.y = pk2(s[2 * 33], s[3 * 33]); o.z = pk2(s[4 * 33], s[5 * 33]); o.w = pk2(s[6 * 33], s[7 * 33]);
        *(GAS v4u*)(WT + (size_t)(row_off + n0 + n) * ldt + koff + k0 + 8 * c) = o; }
    LDS_WAIT(); asm volatile("" ::: "memory");
}
__device__ __forceinline__ const float* xrow_ptr(const Args& a, int m) { return m < MP ? a.x_p + (size_t)m * D : a.x_s + (size_t)(m - MP) * D; }

__device__ __forceinline__ void phase0(const Args& a, LAS unsigned char* lds, int vcu, int G) {
    int tid = threadIdx.x; asm volatile("" : "+v"(tid));
    const int lane = tid & 63, wave = __builtin_amdgcn_readfirstlane(tid >> 6);
    LAS float* scr = (LAS float*)(lds + wave * 16384);
    const int gw = vcu * NWAVES + wave, NGW = G * NWAVES;
    unsigned char* ws = a.ws;
    constexpr int I_IN = (D / 64) * (INW / 32), I_POOL = (256 / 64) * (256 / 32), I_SQ = (D / 64) * (D / 32), I_PLE = (PLE / 64) * (D / 32);
    constexpr int NITEMS = I_IN + 4 * I_POOL + 4 * I_SQ + I_PLE;
    for (int it = gw; it < NITEMS; it += NGW) {
        int r = it;
        if (r < I_IN) { p0_transpose_item(a.w_in, D, INW, (bf16*)(ws + WS_WIN), 0, D, 0, scr, r, lane); continue; } r -= I_IN;
        if (r < 4 * I_POOL) { const int g = r / I_POOL; p0_transpose_item(a.pool_w + (size_t)g * 65536, 256, 256, (bf16*)(ws + WS_WPOOL), g * 256, 256, 0, scr, r % I_POOL, lane); continue; } r -= 4 * I_POOL;
        if (r < I_SQ) { p0_transpose_item(a.w_a, D, D, (bf16*)(ws + WS_WAB), 0, 2048, 0, scr, r, lane); continue; } r -= I_SQ;
        if (r < I_SQ) { p0_transpose_item(a.w_b, D, D, (bf16*)(ws + WS_WAB), 0, 2048, 1024, scr, r, lane); continue; } r -= I_SQ;
        if (r < I_SQ) { p0_transpose_item(a.w_out, D, D, (bf16*)(ws + WS_WO), 0, D, 0, scr, r, lane); continue; } r -= I_SQ;
        if (r < I_SQ) { p0_transpose_item(a.w_gate, D, D, (bf16*)(ws + WS_WG), 0, D, 0, scr, r, lane); continue; } r -= I_SQ;
        p0_transpose_item(a.w_ple, PLE, D, (bf16*)(ws + WS_WPLE), 0, PLE, 0, scr, r, lane);
    }
    f32x4 gpre[4];
#pragma unroll
    for (int j = 0; j < 4; ++j) gpre[j] = ((const GAS f32x4*)a.norm_pre)[lane + 64 * j];
    bf16* H = (bf16*)(ws + WS_RA); bf16* PB = (bf16*)(ws + WS_PBF);
    for (int m = gw; m < M; m += NGW) {
        const GAS f32x4* xr = (const GAS f32x4*)xrow_ptr(a, m) + lane;
        f32x4 v[4]; float s = 0.f;
#pragma unroll
        for (int j = 0; j < 4; ++j) { v[j] = xr[64 * j]; s += (v[j].x * v[j].x + v[j].y * v[j].y) + (v[j].z * v[j].z + v[j].w * v[j].w); }
        const float rstd = 1.0f / sqrtf(wave_sum(s) * (1.f / D) + EPS);
        GAS v2u* o8 = (GAS v2u*)(H + (size_t)m * D) + lane;
#pragma unroll
        for (int j = 0; j < 4; ++j) { const f32x4 y = v[j] * rstd * gpre[j]; o8[64 * j] = (v2u){pk2(y.x, y.y), pk2(y.z, y.w)}; }
        const float* prow = m < MP ? a.p_p + (size_t)m * PLE : a.p_s + (size_t)(m - MP) * PLE;
        const f32x4 pv = ((const GAS f32x4*)prow)[lane];
        ((GAS v2u*)(PB + (size_t)m * PLE))[lane] = (v2u){pk2(pv.x, pv.y), pk2(pv.z, pv.w)};
    }
}

__device__ __forceinline__ void normrope16(bf16* ptr, int t, int qd, const float* gain, float scale) {
    const v4u w0 = ((const GAS v4u*)ptr)[0], w1 = ((const GAS v4u*)ptr)[1];
    float av[16];
    av[0] = blo(w0.x); av[1] = bhi(w0.x); av[2] = blo(w0.y); av[3] = bhi(w0.y); av[4] = blo(w0.z); av[5] = bhi(w0.z); av[6] = blo(w0.w); av[7] = bhi(w0.w);
    av[8] = blo(w1.x); av[9] = bhi(w1.x); av[10] = blo(w1.y); av[11] = bhi(w1.y); av[12] = blo(w1.z); av[13] = bhi(w1.z); av[14] = blo(w1.w); av[15] = bhi(w1.w);
    float ss = 0.f;
#pragma unroll
    for (int i = 0; i < 16; ++i) ss += av[i] * av[i];
    ss += __shfl_xor(ss, 1); ss += __shfl_xor(ss, 2);
    const float rstd = 1.0f / sqrtf(ss * (1.f / 64.f) + EPS);
    const float pos = (qd < 2) ? (float)(t >> 6) : (float)(t & 63);
    const float sgn = (qd & 1) ? 1.f : -1.f;
    float o[16];
#pragma unroll
    for (int i4 = 0; i4 < 4; ++i4) { const f32x4 g = ((const GAS f32x4*)(gain + qd * 16))[i4];
        av[4 * i4 + 0] *= rstd * g.x; av[4 * i4 + 1] *= rstd * g.y; av[4 * i4 + 2] *= rstd * g.z; av[4 * i4 + 3] *= rstd * g.w; }
#pragma unroll
    for (int i = 0; i < 16; ++i) {
        const float pr = __shfl_xor(av[i], 1);
        const float freq = __builtin_amdgcn_exp2f(-(float)i * 0.83048202372184058696f);
        float rev = pos * freq * 0.15915494309189533577f; rev = __builtin_amdgcn_fractf(rev);
        const float sn = __builtin_amdgcn_sinf(rev), cs = __builtin_amdgcn_cosf(rev);
        o[i] = (av[i] * cs + sgn * pr * sn) * scale;
    }
    v4u r0, r1;
    r0.x = pk2(o[0], o[1]); r0.y = pk2(o[2], o[3]); r0.z = pk2(o[4], o[5]); r0.w = pk2(o[6], o[7]);
    r1.x = pk2(o[8], o[9]); r1.y = pk2(o[10], o[11]); r1.z = pk2(o[12], o[13]); r1.w = pk2(o[14], o[15]);
    ((GAS v4u*)ptr)[0] = r0; ((GAS v4u*)ptr)[1] = r1;
}
__device__ __forceinline__ int tok_of_row(int m) { return m < MP ? (m & (TP - 1)) : (m & (TS - 1)); }
__device__ __forceinline__ void phase2(const Args& a, int vcu, int G) {
    int tid = threadIdx.x; asm volatile("" : "+v"(tid));
    const int lane = tid & 63, wave = __builtin_amdgcn_readfirstlane(tid >> 6);
    unsigned char* ws = a.ws;
    bf16* Q = (bf16*)(ws + WS_RD); bf16* K = (bf16*)(ws + WS_RK);
    const int gw = vcu * NWAVES + wave, NGW = G * NWAVES;
    constexpr float C2 = 0.125f * 1.4426950408889634f;
    for (int m = gw; m < M; m += NGW) normrope16(Q + (size_t)m * D + lane * 16, tok_of_row(m), lane & 3, a.q_norm, C2);
    for (int m4 = gw; m4 < M / 4; m4 += NGW) { const int m = m4 * 4 + (lane >> 4); normrope16(K + (size_t)m * 256 + (lane & 15) * 16, tok_of_row(m), lane & 3, a.k_norm, 1.0f); }
    const bf16* UA = (const bf16*)(ws + WS_RB); bf16* PO = (bf16*)(ws + WS_RA);
    const int cc = tid & 31, rsub = tid >> 5;
    for (int it = vcu; it < (M / 64) * 4; it += G) {
        const int g = it & 3, rb = it >> 2, half = 1 << g;
#pragma unroll 1
        for (int rr = 0; rr < 4; ++rr) {
            const int m = rb * 64 + rr * 16 + rsub;
            const int T = m < MP ? TP : TS, s0 = m < MP ? (m & ~(TP - 1)) : (m & ~(TS - 1)), t = m - s0;
            const int lo = max(t - half, 0), hi = min(t + half, T);
            float acc[8];
#pragma unroll
            for (int e = 0; e < 8; ++e) acc[e] = 0.f;
            const bf16* colp = UA + (size_t)s0 * D + g * 256 + cc * 8;
#pragma unroll 1
            for (int s = lo; s < hi; ++s) { const v4u w = *(const GAS v4u*)(colp + (size_t)s * D);
                acc[0] += blo(w.x); acc[1] += bhi(w.x); acc[2] += blo(w.y); acc[3] += bhi(w.y); acc[4] += blo(w.z); acc[5] += bhi(w.z); acc[6] += blo(w.w); acc[7] += bhi(w.w); }
            const v4u own = *(const GAS v4u*)(colp + (size_t)t * D);
            const float inv = 1.0f / (float)(hi - lo);
            v4u o; o.x = pk2(acc[0] * inv - blo(own.x), acc[1] * inv - bhi(own.x)); o.y = pk2(acc[2] * inv - blo(own.y), acc[3] * inv - bhi(own.y));
            o.z = pk2(acc[4] * inv - blo(own.z), acc[5] * inv - bhi(own.z)); o.w = pk2(acc[6] * inv - blo(own.w), acc[7] * inv - bhi(own.w));
            *(GAS v4u*)(PO + (size_t)m * D + g * 256 + cc * 8) = o;
        }
    }
}

__device__ __forceinline__ void phase6(const Args& a, int vcu, int G) {
    int tid = threadIdx.x; asm volatile("" : "+v"(tid));
    const int lane = tid & 63, wave = __builtin_amdgcn_readfirstlane(tid >> 6);
    unsigned char* ws = a.ws;
    const bf16* Y = (const bf16*)(ws + WS_RA); bf16* H2 = (bf16*)(ws + WS_RB);
    const int gw = vcu * NWAVES + wave, NGW = G * NWAVES;
    f32x4 gpost[4], gple[4];
#pragma unroll
    for (int j = 0; j < 4; ++j) { gpost[j] = ((const GAS f32x4*)a.norm_post)[lane + 64 * j]; gple[j] = ((const GAS f32x4*)a.ple_norm)[lane + 64 * j]; }
    for (int m = gw; m < M; m += NGW) {
        const GAS f32x4* xr = (const GAS f32x4*)xrow_ptr(a, m) + lane;
        const GAS v2u* yr = (const GAS v2u*)(Y + (size_t)m * D) + lane;
        f32x4 xv[4], yv[4]; float s = 0.f;
#pragma unroll
        for (int j = 0; j < 4; ++j) { xv[j] = xr[64 * j]; const v2u w = yr[64 * j]; yv[j] = (f32x4){blo(w.x), bhi(w.x), blo(w.y), bhi(w.y)};
            s += (yv[j].x * yv[j].x + yv[j].y * yv[j].y) + (yv[j].z * yv[j].z + yv[j].w * yv[j].w); }
        const float rstd = 1.0f / sqrtf(wave_sum(s) * (1.f / D) + EPS);
        float s2 = 0.f;
        GAS f32x4* orow = (GAS f32x4*)(a.out + (size_t)m * D) + lane;
#pragma unroll
        for (int j = 0; j < 4; ++j) { xv[j] = xv[j] + yv[j] * rstd * gpost[j]; orow[64 * j] = xv[j];
            s2 += (xv[j].x * xv[j].x + xv[j].y * xv[j].y) + (xv[j].z * xv[j].z + xv[j].w * xv[j].w); }
        const float rstd2 = 1.0f / sqrtf(wave_sum(s2) * (1.f / D) + EPS);
        GAS v2u* o8 = (GAS v2u*)(H2 + (size_t)m * D) + lane;
#pragma unroll
        for (int j = 0; j < 4; ++j) { const f32x4 y = xv[j] * rstd2 * gple[j]; o8[64 * j] = (v2u){pk2(y.x, y.y), pk2(y.z, y.w)}; }
    }
}

__device__ __forceinline__ bool attn_next(int i, int vcu, int G, long& qrow0, long& kvrow0, int& NT, int& h) {
    int samp, b, qb;
    if (G == 256) {
        if (i >= 20) return false;
        const int x = vcu >> 5, j = vcu & 31; b = x;
        if (i < 16) { samp = 0; h = (i >> 2) * 4 + (i & 3); qb = j; }
        else { samp = 1; h = (i - 16) * 4 + (j >> 3); qb = j & 7; }
    } else {
        const int uid = vcu + i * G; if (uid >= 5120) return false;
        if (uid < 4096) { samp = 0; b = uid >> 9; h = (uid >> 5) & 15; qb = uid & 31; }
        else { const int r = uid - 4096; samp = 1; b = r >> 7; h = (r >> 3) & 15; qb = r & 7; }
    }
    if (!samp) { kvrow0 = (long)b * TP; NT = TP / 64; } else { kvrow0 = (long)MP + (long)b * TS; NT = TS / 64; }
    qrow0 = kvrow0 + qb * 256;
    return true;
}

__global__ void __launch_bounds__(NWAVES * 64, 2) fwd_megakernel(Args args) {
    extern __shared__ __attribute__((aligned(16))) unsigned char lds_raw[];
    LAS unsigned char* lds = (LAS unsigned char*)lds_raw;
    const int G = gridDim.x; const int bx = blockIdx.x; const int vcu = (G % 8 == 0) ? (bx % 8) * (G / 8) + bx / 8 : bx;
    cg::grid_group grid = cg::this_grid();
    unsigned char* ws = args.ws;
    const int lo = args.ph_lo, hi = args.ph_hi;
#ifndef PH_MASK
#define PH_MASK 0xFF
#endif
#define IN(k) ((((PH_MASK) >> (k)) & 1) && lo <= (k) && (k) < hi)
#ifndef DUP_MASK
#define DUP_MASK 0
#endif
#define REPS(k) ((((DUP_MASK) >> (k)) & 1) ? 2 : 1)
#define SEAM(k) do { if (IN(k) && IN((k) + 1)) { if ((k) == 0) { VM_WAIT(); grid.sync(); VM_WAIT(); } else { xcd_barrier(bar); } } } while (0)
    volatile LAS unsigned* MISC = (volatile LAS unsigned*)(lds + MISC_OFF);
    if (threadIdx.x < 32) MISC[threadIdx.x] = 0u;
    __syncthreads();
    XcdBarrier bar = xcd_barrier_post((unsigned*)(ws + WS_CTL), MISC);
    bf16* RA = (bf16*)(ws + WS_RA); bf16* RB = (bf16*)(ws + WS_RB); bf16* RC = (bf16*)(ws + WS_RC); bf16* RD = (bf16*)(ws + WS_RD); bf16* RE = (bf16*)(ws + WS_RE);
    bf16* RK = (bf16*)(ws + WS_RK); bf16* RV = (bf16*)(ws + WS_RV);
    bf16* MA = (bf16*)args.out; bf16* MB = (bf16*)args.out + (size_t)M * D;

    if (IN(0)) { for (int rep = 0; rep < REPS(0); ++rep) phase0(args, lds, vcu, G); }
    SEAM(0);
    if (IN(1)) for (int rep = 0; rep < REPS(1); ++rep) {
        pg8::Gemm g{RA, RA, (const bf16*)(ws + WS_WIN), D, D, D, D, 0};
        pg8::StaticOrder S; S.init(M, INW, G, bx);
        pg8::EpiIn E{RB, RC, RD, RK, RV, RE, MA, MB};
        pg8::gemm_phase<pg8::EpiIn, pg8::StaticOrder, true, true>(lds, g, S, E);
    }
    SEAM(1);
    if (IN(2)) { phase2(args, vcu, G); }
    SEAM(2);
    if (IN(3)) {
        long qrow0, kvrow0; int NT, h;
        for (int rep = 0; rep < REPS(3); ++rep)
        for (int i = 0; attn_next(i, vcu, G, qrow0, kvrow0, NT, h); ++i)
            attn_body::attn_unit<8>(qrow0, kvrow0, NT, h, (const attn_body::bf16*)RD, (const attn_body::bf16*)RK, (const attn_body::bf16*)RV, (attn_body::bf16*)((REPS(3) == 2 && rep == 0) ? RB : RD), (const attn_body::bf16*)RE, (char*)lds_raw);
        pg8::Gemm g{RA, RA, (const bf16*)(ws + WS_WPOOL), D, 256, 256, 256, 512};
        pg8::StaticOrder S; S.init(M, D, G, bx);
        pg8::EpiPool E{RB, RC, args.pool_scale};
        pg8::gemm_phase<pg8::EpiPool, pg8::StaticOrder, true, true>(lds, g, S, E);
    }
    SEAM(3);
    if (IN(4)) for (int rep = 0; rep < REPS(4); ++rep) {
        pg8::Gemm g{RB, RD, (const bf16*)(ws + WS_WAB), D, 2048, 2048, 1024, 0};
        pg8::StaticOrder S; S.init(M, D, G, bx);
        pg8::EpiMerge E{RC, MA, MB};
        pg8::gemm_phase<pg8::EpiMerge, pg8::StaticOrder, true, true>(lds, g, S, E);
    }
    SEAM(4);
    if (IN(5)) for (int rep = 0; rep < REPS(5); ++rep) {
        { pg8::Gemm g{RC, RC, (const bf16*)(ws + WS_WO), D, D, D, D, 0};
          pg8::StaticOrder S; S.init(M, D, G, bx);
          pg8::EpiPlain E{RA, D};
          pg8::gemm_phase<pg8::EpiPlain, pg8::StaticOrder, true, true>(lds, g, S, E); }
        { pg8::Gemm g{(const bf16*)(ws + WS_PBF), (const bf16*)(ws + WS_PBF), (const bf16*)(ws + WS_WPLE), PLE, PLE, PLE, PLE, 0};
          pg8::StaticOrder S; S.init(M, D, G, bx);
          pg8::EpiPlain E{RD, D};
          pg8::gemm_phase<pg8::EpiPlain, pg8::StaticOrder, true, true>(lds, g, S, E); }
    }
    SEAM(5);
    if (IN(6)) { for (int rep = 0; rep < REPS(6); ++rep) phase6(args, vcu, G); }
    SEAM(6);
    if (IN(7)) {
        pg8::Gemm g{RB, RB, (const bf16*)(ws + WS_WG), D, D, D, D, 0};
        pg8::StaticOrder S; S.init(M, D, G, bx);
        pg8::EpiFinal E{args.out, RD};
        pg8::gemm_phase<pg8::EpiFinal, pg8::StaticOrder, true, true>(lds, g, S, E);
    }
#undef IN
#undef SEAM
}

extern "C" void kernel_launch(void* const* d_in, const int* in_sizes, int n_in, void* d_out, int out_size, void* d_ws, size_t ws_size, hipStream_t stream) {
    static int grid = 0;
    if (grid == 0) {
        if (n_in != 17 || in_sizes[0] != MP * D || in_sizes[1] != MS * D || out_size != M * D || ws_size < WS_END) {
            fprintf(stderr, "kernel_launch: unexpected shapes (n_in %d, in0 %d, out %d, ws %zu); nothing launched\n", n_in, n_in > 0 ? in_sizes[0] : -1, out_size, ws_size); grid = -1; return; }
        int dev = 0, cus = 0, per_cu = 0;
        if (hipGetDevice(&dev) != hipSuccess || hipDeviceGetAttribute(&cus, hipDeviceAttributeMultiprocessorCount, dev) != hipSuccess) { fprintf(stderr, "kernel_launch: device query failed\n"); grid = -1; return; }
        if (hipFuncSetAttribute((const void*)fwd_megakernel, hipFuncAttributeMaxDynamicSharedMemorySize, LDS_BYTES) != hipSuccess) { fprintf(stderr, "kernel_launch: hipFuncSetAttribute failed\n"); grid = -1; return; }
        if (hipOccupancyMaxActiveBlocksPerMultiprocessor(&per_cu, (const void*)fwd_megakernel, NWAVES * 64, LDS_BYTES) != hipSuccess || per_cu < 1) { fprintf(stderr, "kernel_launch: occupancy query says %d\n", per_cu); per_cu = 1; }
        (void)hipGetLastError();
        grid = cus * 1;
        (void)per_cu;
    }
    if (grid < 0) return;
    if (hipMemsetAsync((char*)d_ws + WS_CTL, 0, CTL_ZERO_BYTES, stream) != hipSuccess) { fprintf(stderr, "kernel_launch: memset of control words failed\n"); return; }
    Args a{};
    a.x_p = (const float*)d_in[0]; a.x_s = (const float*)d_in[1]; a.p_p = (const float*)d_in[2]; a.p_s = (const float*)d_in[3]; a.norm_pre = (const float*)d_in[4];
    a.w_in = (const float*)d_in[5]; a.pool_w = (const float*)d_in[6]; a.pool_scale = (const float*)d_in[7]; a.w_a = (const float*)d_in[8]; a.q_norm = (const float*)d_in[9];
    a.k_norm = (const float*)d_in[10]; a.w_b = (const float*)d_in[11]; a.w_out = (const float*)d_in[12]; a.norm_post = (const float*)d_in[13]; a.ple_norm = (const float*)d_in[14];
    a.w_gate = (const float*)d_in[15]; a.w_ple = (const float*)d_in[16];
    a.out = (float*)d_out; a.ws = (unsigned char*)d_ws;
    if (N_LAUNCHES == 1) {
        a.ph_lo = 0; a.ph_hi = N_PHASES;
        void* kargs[] = {&a};
        hipError_t e = hipLaunchCooperativeKernel((const void*)fwd_megakernel, dim3(grid), dim3(NWAVES * 64), kargs, LDS_BYTES, stream);
        if (e != hipSuccess) fprintf(stderr, "kernel_launch: cooperative launch failed: %s (grid %d)\n", hipGetErrorString(e), grid);
    } else {
        for (int ph = 0; ph < N_PHASES; ++ph) {
            a.ph_lo = ph; a.ph_hi = ph + 1;
            hipLaunchKernelGGL(fwd_megakernel, dim3(grid), dim3(NWAVES * 64), LDS_BYTES, stream, a);
        }
    }
}
```

```cpp
#include <hip/hip_runtime.h>
#include <hip/hip_cooperative_groups.h>
#include <hip/hip_bf16.h>
#include <cstdio>
#include <cstdint>
#include <cmath>
namespace cg = cooperative_groups;

namespace pg8 {
#define PG8_LAS __attribute__((address_space(3)))
typedef unsigned short bf16_t;
typedef short bf16x8 __attribute__((ext_vector_type(8)));
typedef float f32x4 __attribute__((ext_vector_type(4)));
typedef unsigned u32x4 __attribute__((ext_vector_type(4)));
constexpr int BM = 256, BK = 64, HALF = 128, HTB = HALF * BK * 2  , STAGE_BYTES = 8 * HTB, NXCD = 8, WGM = 8;

__host__ __device__ __forceinline__ int lds_byte(int r, int c) { const int st = (r >> 4) * 2 + (c >> 5), rr = r & 15, cc = c & 31, ob = rr * 64 + cc * 2; return st * 1024 + (ob ^ (((ob >> 9) & 1) << 5)); }
__host__ __device__ __forceinline__ void stage_rc(int b, int& R, int& C) { const int st = b / 1024, sb = b % 1024, swz = sb ^ (((sb >> 9) & 1) << 5); R = (st >> 1) * 16 + swz / 64; C = (st & 1) * 32 + (swz % 64) / 2; }
__host__ __device__ __forceinline__ int perm32(int rho) { const int n = rho >> 4, i = rho & 15; return 8 * (i >> 2) + 4 * n + (i & 3); }

struct Unit { int pm, pn; };
struct Gemm { const bf16_t* A; const bf16_t* A2; const bf16_t* Bt; int lda, ldb, K, K1; size_t a_pn_off; };

struct StaticOrder {
    int nM, nN, nwg, G, c;
    __host__ __device__ void init(int M, int N, int G_, int c_) { nM = M / BM; nN = N / BM; nwg = nM * nN; G = G_; c = c_; }
    __host__ __device__ bool next(int i, Unit& u) const {
        const long L = (long)i * G + c; if (L >= nwg) return false;
        int wgid = (int)L; { const int q = nwg / NXCD, r = nwg % NXCD, xcd = wgid % NXCD, off = wgid / NXCD; wgid = (xcd < r ? xcd * (q + 1) : r * (q + 1) + (xcd - r) * q) + off; }
        const int nig = WGM * nN, gid = wgid / nig, fm = gid * WGM, gsz = (nM - fm) < WGM ? (nM - fm) : WGM;
        u.pm = fm + ((wgid % nig) % gsz); u.pn = (wgid % nig) / gsz; return true;
    }
    __device__ __forceinline__ void a_ready(const Unit&) const {}
    __device__ __forceinline__ void done(const Unit&) const {}
};

__device__ __forceinline__ unsigned cvt_pk_bf16(float lo, float hi) { unsigned r; asm volatile("v_cvt_pk_bf16_f32 %0, %1, %2" : "=v"(r) : "v"(lo), "v"(hi)); return r; }
__device__ __forceinline__ float bf_lo(unsigned w) { return __uint_as_float(w << 16); }
__device__ __forceinline__ float bf_hi(unsigned w) { return __uint_as_float(w & 0xffff0000u); }
__device__ __forceinline__ float fsigmoid(float x) { return __builtin_amdgcn_rcpf(1.0f + __builtin_amdgcn_exp2f(-1.4426950408889634f * x)); }
__device__ __forceinline__ float fsilu(float x) { return x * fsigmoid(x); }
__device__ __forceinline__ u32x4 pack8(const f32x4& v0, const f32x4& v1) { u32x4 w; w.x = cvt_pk_bf16(v0[0], v0[1]); w.y = cvt_pk_bf16(v0[2], v0[3]); w.z = cvt_pk_bf16(v1[0], v1[1]); w.w = cvt_pk_bf16(v1[2], v1[3]); return w; }
__device__ __forceinline__ void unpack8(const u32x4& w, f32x4& v0, f32x4& v1) { v0 = (f32x4){bf_lo(w.x), bf_hi(w.x), bf_lo(w.y), bf_hi(w.y)}; v1 = (f32x4){bf_lo(w.z), bf_hi(w.z), bf_lo(w.w), bf_hi(w.w)}; }

struct EpiIn {
    static constexpr bool PERM = true, AFTER_DRAIN = false, MID = false;
    bf16_t *ua, *sza, *q, *k, *v, *szb, *ma, *mb;
    __device__ __forceinline__ void operator()(const f32x4 (&acc)[2][2][4][2], const Unit& u, int wr, int wc, int fr, int fq) const {
        const int pn = u.pn; bf16_t* base; int ldc = 1024, ct; bool act = false;
        if (pn < 4) { base = ua; ct = pn; }
        else if (pn < 8) { base = sza; ct = pn - 4; act = true; }
        else if (pn < 12) { base = q; ct = pn - 8; }
        else if (pn == 12) { base = k; ct = 0; ldc = 256; }
        else if (pn == 13) { base = v; ct = 0; ldc = 256; }
        else if (pn < 18) { base = szb; ct = pn - 14; act = true; }
        else if (pn < 22) { base = ma; ct = pn - 18; }
        else { base = mb; ct = pn - 22; }
        int row0 = u.pm * BM + wr * 64 + fr, col0 = ct * BM + wc * 32 + 8 * fq; asm volatile("" : "+v"(row0), "+v"(col0));
#pragma unroll
        for (int ai = 0; ai < 2; ++ai)
#pragma unroll
            for (int m = 0; m < 4; ++m) { bf16_t* rowp = base + (size_t)(row0 + ai * HALF + m * 16) * ldc + col0;
#pragma unroll
                for (int bj = 0; bj < 2; ++bj) { f32x4 v0 = acc[ai][bj][m][0], v1 = acc[ai][bj][m][1];
                    if (act) {
#pragma unroll
                        for (int e = 0; e < 4; ++e) { v0[e] = fsilu(v0[e]); v1[e] = fsilu(v1[e]); } }
                    *(u32x4*)(rowp + bj * HALF) = pack8(v0, v1); } }
    }
};
struct EpiPlain {
    static constexpr bool PERM = true, AFTER_DRAIN = false, MID = false;
    bf16_t* O; int ldc;
    __device__ __forceinline__ void operator()(const f32x4 (&acc)[2][2][4][2], const Unit& u, int wr, int wc, int fr, int fq) const {
        int row0 = u.pm * BM + wr * 64 + fr, col0 = u.pn * BM + wc * 32 + 8 * fq; asm volatile("" : "+v"(row0), "+v"(col0));
#pragma unroll
        for (int ai = 0; ai < 2; ++ai)
#pragma unroll
            for (int m = 0; m < 4; ++m) { bf16_t* rowp = O + (size_t)(row0 + ai * HALF + m * 16) * ldc + col0;
#pragma unroll
                for (int bj = 0; bj < 2; ++bj) *(u32x4*)(rowp + bj * HALF) = pack8(acc[ai][bj][m][0], acc[ai][bj][m][1]); }
    }
};
struct EpiMerge {
    static constexpr bool PERM = true, AFTER_DRAIN = false, MID = true;
    bf16_t* O; const bf16_t* ma; const bf16_t* mb;
    __device__ __forceinline__ void mid(f32x4 (&acc)[2][2][4][2], const Unit& u, int wr, int wc, int fr, int fq) const {
        int row0 = u.pm * BM + wr * 64 + fr, col0 = u.pn * BM + wc * 32 + 8 * fq;
        asm volatile("" : "+v"(row0), "+v"(col0));
#pragma unroll
        for (int ai = 0; ai < 2; ++ai)
#pragma unroll
            for (int m = 0; m < 4; ++m) { const size_t off = (size_t)(row0 + ai * HALF + m * 16) * 1024 + col0;
#pragma unroll
                for (int bj = 0; bj < 2; ++bj) { const u32x4 aw = *(const u32x4*)(ma + off + bj * HALF), bw = *(const u32x4*)(mb + off + bj * HALF);
                    f32x4 a0, a1, b0, b1; unpack8(aw, a0, a1); unpack8(bw, b0, b1);
#pragma unroll
                    for (int e = 0; e < 4; ++e) {
                        const float ea0 = __builtin_amdgcn_exp2f(-1.4426950408889634f * a0[e]), ea1 = __builtin_amdgcn_exp2f(-1.4426950408889634f * a1[e]);
                        const float eb0 = __builtin_amdgcn_exp2f(-1.4426950408889634f * fmaxf(b0[e], -60.f)), eb1 = __builtin_amdgcn_exp2f(-1.4426950408889634f * fmaxf(b1[e], -60.f));
                        acc[ai][bj][m][0][e] *= (1.0f + eb0) * __builtin_amdgcn_rcpf(1.0f + ea0);
                        acc[ai][bj][m][1][e] *= (1.0f + eb1) * __builtin_amdgcn_rcpf(1.0f + ea1); } }
                asm volatile("" : "+v"(acc[ai][0][m][0]), "+v"(acc[ai][0][m][1]), "+v"(acc[ai][1][m][0]), "+v"(acc[ai][1][m][1]) :: "memory"); }
    }
    __device__ __forceinline__ void operator()(const f32x4 (&acc)[2][2][4][2], const Unit& u, int wr, int wc, int fr, int fq) const {
        int row0 = u.pm * BM + wr * 64 + fr, col0 = u.pn * BM + wc * 32 + 8 * fq; asm volatile("" : "+v"(row0), "+v"(col0));
#pragma unroll
        for (int ai = 0; ai < 2; ++ai)
#pragma unroll
            for (int m = 0; m < 4; ++m) { const size_t off = (size_t)(row0 + ai * HALF + m * 16) * 1024 + col0;
#pragma unroll
                for (int bj = 0; bj < 2; ++bj) { const u32x4 bw = *(const u32x4*)(mb + off + bj * HALF); f32x4 b0, b1; unpack8(bw, b0, b1); f32x4 v0 = acc[ai][bj][m][0], v1 = acc[ai][bj][m][1];
#pragma unroll
                    for (int e = 0; e < 4; ++e) { v0[e] *= fsigmoid(fmaxf(b0[e], -60.f)); v1[e] *= fsigmoid(fmaxf(b1[e], -60.f)); }
                    *(u32x4*)(O + off + bj * HALF) = pack8(v0, v1); } }
    }
};
struct EpiFinal {
    static constexpr bool PERM = true, AFTER_DRAIN = false, MID = false;
    float* out; const bf16_t* pe;
    __device__ __forceinline__ void operator()(const f32x4 (&acc)[2][2][4][2], const Unit& u, int wr, int wc, int fr, int fq) const {
        int row0 = u.pm * BM + wr * 64 + fr, col0 = u.pn * BM + wc * 32 + 8 * fq; asm volatile("" : "+v"(row0), "+v"(col0));
#pragma unroll
        for (int ai = 0; ai < 2; ++ai)
#pragma unroll
            for (int m = 0; m < 4; ++m) { const size_t off = (size_t)(row0 + ai * HALF + m * 16) * 1024 + col0;
#pragma unroll
                for (int bj = 0; bj < 2; ++bj) { const u32x4 pw = *(const u32x4*)(pe + off + bj * HALF); f32x4 p0, p1; unpack8(pw, p0, p1);
                    float* op = out + off + bj * HALF; const f32x4 x0 = *(const f32x4*)op, x1 = *(const f32x4*)(op + 4);
                    f32x4 g0 = acc[ai][bj][m][0], g1 = acc[ai][bj][m][1];
#pragma unroll
                    for (int e = 0; e < 4; ++e) { g0[e] = x0[e] + fsigmoid(g0[e]) * p0[e]; g1[e] = x1[e] + fsigmoid(g1[e]) * p1[e]; }
                    *(f32x4*)op = g0; *(f32x4*)(op + 4) = g1; } }
    }
};

struct DupOrder {
    StaticOrder S; int dup;
    __device__ void init(int M_, int N_, int G_, int c_, int dup_) { S.init(M_, N_, G_, c_); dup = dup_; }
    __device__ bool next(int i, Unit& u) const { if (dup > 1) { const int rounds = S.nwg / S.G; if (i >= dup * rounds) return false; i %= rounds; } return S.next(i, u); }
    __device__ __forceinline__ void a_ready(const Unit&) const {}
    __device__ __forceinline__ void done(const Unit&) const {}
};
template <class Epi, class Sched, bool ALIGN_EPI = false, bool SP2 = false>
__device__ __forceinline__ void gemm_phase(PG8_LAS unsigned char* lds, const Gemm g, const Sched& S, const Epi& E) {
    const int tid = threadIdx.x, wid = __builtin_amdgcn_readfirstlane(tid >> 6), lane = tid & 63, wr = wid >> 2, wc = wid & 3, fr = lane & 15, fq = lane >> 4;
    const int nt = g.K / BK, nth = g.K1 / BK;
    unsigned voffA[2], voffB[2];
#pragma unroll
    for (int i = 0; i < 2; ++i) { int R, C; stage_rc(tid * 16 + i * 8192, R, C); const int Rb = Epi::PERM ? ((R & ~31) + perm32(R & 31)) : R;
        voffA[i] = (unsigned)(R * g.lda + C) * 2u; voffB[i] = (unsigned)(Rb * g.ldb + C) * 2u; }
    const size_t kstep = (size_t)(BK * 2);
    const size_t hstepA = (size_t)HALF * g.lda * 2, hstepB = (size_t)HALF * g.ldb * 2;
    const size_t tstepA = 2 * hstepA, tstepB = 2 * hstepB;
    const unsigned ldsw = (unsigned)wid * 1024u;
    const int aoff = lds_byte(wr * 64 + fr, fq * 8), boff = lds_byte(wc * 32 + fr, fq * 8);
#define PG8_SA(b, h) (((b) * 2 + (h)) * HTB)
#define PG8_SB(b, h) ((4 + (b) * 2 + (h)) * HTB)
#define PG8_STAGE(bufoff, gbase, voff) do { _Pragma("unroll") for (int _i = 0; _i < 2; ++_i) \
        __builtin_amdgcn_global_load_lds((const unsigned*)((const char*)(gbase) + (voff)[_i]), (PG8_LAS unsigned*)(lds + (bufoff) + ldsw + _i * 8192), 16, 0, 0); } while (0)
#define PG8_LDA(dst, b, h) do { _Pragma("unroll") for (int m = 0; m < 4; ++m) _Pragma("unroll") for (int k = 0; k < 2; ++k) dst[m][k] = *(const PG8_LAS bf16x8*)(lds + PG8_SA(b, h) + aoff + m * 2048 + k * 1024); } while (0)
#define PG8_LDB(dst, b, h) do { _Pragma("unroll") for (int n = 0; n < 2; ++n) _Pragma("unroll") for (int k = 0; k < 2; ++k) dst[n][k] = *(const PG8_LAS bf16x8*)(lds + PG8_SB(b, h) + boff + n * 2048 + k * 1024); } while (0)
#define PG8_MMA(ai, bj, At, Bt) do { __builtin_amdgcn_s_setprio(1); _Pragma("unroll") for (int m = 0; m < 4; ++m) _Pragma("unroll") for (int n = 0; n < 2; ++n) _Pragma("unroll") for (int k = 0; k < 2; ++k) \
        acc[ai][bj][m][n] = __builtin_amdgcn_mfma_f32_16x16x32_bf16(Bt[n][k], At[m][k], acc[ai][bj][m][n], 0, 0, 0); __builtin_amdgcn_s_setprio(0); } while (0)
#define PG8_WAIT_V(n) asm volatile("s_waitcnt vmcnt(" #n ")" ::: "memory")
#define PG8_WAIT_L(n) asm volatile("s_waitcnt lgkmcnt(" #n ")" ::: "memory")
#define PG8_BAR __builtin_amdgcn_s_barrier()
#define PG8_SCHED __builtin_amdgcn_sched_barrier(0)
    Unit cur, nxt; int ui = 0;
    if (!S.next(0, cur)) return;
    f32x4 acc[2][2][4][2];
#pragma unroll
    for (int a = 0; a < 2; ++a)
#pragma unroll
        for (int b = 0; b < 2; ++b)
#pragma unroll
            for (int m = 0; m < 4; ++m)
#pragma unroll
                for (int n = 0; n < 2; ++n) acc[a][b][m][n] = (f32x4){0.f, 0.f, 0.f, 0.f};
    bf16x8 At[4][2], B0[2][2], B1[2][2];
    const char* cA = (const char*)g.A + (size_t)cur.pm * tstepA + (size_t)cur.pn * g.a_pn_off; const char* cA2 = (const char*)g.A2 + (size_t)cur.pm * tstepA; const char* cB = (const char*)g.Bt + (size_t)cur.pn * tstepB;
    S.a_ready(cur);
    if constexpr (SP2) {
        PG8_STAGE(PG8_SB(0, 0), cB, voffB); PG8_STAGE(PG8_SB(0, 1), cB + hstepB, voffB); PG8_STAGE(PG8_SA(0, 0), cA, voffA); PG8_STAGE(PG8_SA(0, 1), cA + hstepA, voffA);
        if (wr == 1) PG8_BAR;
        PG8_WAIT_V(2); PG8_BAR;
        PG8_STAGE(PG8_SB(1, 0), cB + kstep, voffB); PG8_STAGE(PG8_SA(1, 0), cA + kstep, voffA); PG8_STAGE(PG8_SB(1, 1), cB + hstepB + kstep, voffB);
        PG8_WAIT_V(6); PG8_BAR;
    } else {
        PG8_STAGE(PG8_SB(0, 0), cB, voffB); PG8_STAGE(PG8_SA(0, 0), cA, voffA); PG8_STAGE(PG8_SB(0, 1), cB + hstepB, voffB); PG8_STAGE(PG8_SA(0, 1), cA + hstepA, voffA);
        if (wr == 1) PG8_BAR;
        PG8_WAIT_V(4); PG8_BAR;
        PG8_STAGE(PG8_SB(1, 0), cB + kstep, voffB); PG8_STAGE(PG8_SA(1, 0), cA + kstep, voffA); PG8_STAGE(PG8_SB(1, 1), cB + hstepB + kstep, voffB);
        PG8_WAIT_V(6); PG8_BAR;
    }
    for (;;) {
        const bool has_next = S.next(ui + 1, nxt);
        const char* nA = has_next ? (const char*)g.A + (size_t)nxt.pm * tstepA + (size_t)nxt.pn * g.a_pn_off : cA; const char* nA2 = has_next ? (const char*)g.A2 + (size_t)nxt.pm * tstepA : cA2; const char* nB = has_next ? (const char*)g.Bt + (size_t)nxt.pn * tstepB : cB;
        for (int t = 0; t < nt; t += 2) {
            const bool last = (t == nt - 2);
            if constexpr (Epi::MID) { if (t == nth) E.mid(acc, cur, wr, wc, fr, fq); }
            const char* a1 = (t + 1 < nth) ? cA + (size_t)(t + 1) * kstep : cA2 + (size_t)(t + 1 - nth) * kstep;
            const char* a2 = last ? nA : ((t + 2 < nth) ? cA + (size_t)(t + 2) * kstep : cA2 + (size_t)(t + 2 - nth) * kstep); const char* b2 = last ? nB : cB + (size_t)(t + 2) * kstep;
            const char* a3 = a2 + kstep; const char* b3 = b2 + kstep;
            if (last && has_next) S.a_ready(nxt);
            if constexpr (SP2) {
            PG8_LDB(B0, 0, 0); PG8_LDB(B1, 0, 1); PG8_SCHED; PG8_LDA(At, 0, 0); PG8_STAGE(PG8_SA(1, 1), a1 + hstepA, voffA);
            PG8_WAIT_V(8); PG8_WAIT_L(0); PG8_BAR; PG8_MMA(0, 0, At, B0); PG8_MMA(0, 1, At, B1); PG8_BAR; PG8_SCHED;
            PG8_LDA(At, 0, 1); PG8_STAGE(PG8_SB(0, 0), b2, voffB); PG8_STAGE(PG8_SB(0, 1), b2 + hstepB, voffB); PG8_STAGE(PG8_SA(0, 0), a2, voffA);
            PG8_WAIT_V(8); PG8_WAIT_L(0); PG8_BAR; PG8_MMA(1, 0, At, B0); PG8_MMA(1, 1, At, B1); PG8_BAR; PG8_SCHED;
            PG8_LDB(B0, 1, 0); PG8_LDB(B1, 1, 1); PG8_SCHED; PG8_LDA(At, 1, 0); PG8_STAGE(PG8_SA(0, 1), a2 + hstepA, voffA);
            PG8_WAIT_V(8); PG8_WAIT_L(0); PG8_BAR; PG8_MMA(0, 0, At, B0); PG8_MMA(0, 1, At, B1); PG8_BAR; PG8_SCHED;
            PG8_LDA(At, 1, 1); PG8_STAGE(PG8_SB(1, 0), b3, voffB); PG8_STAGE(PG8_SB(1, 1), b3 + hstepB, voffB); PG8_STAGE(PG8_SA(1, 0), a3, voffA);
            PG8_WAIT_V(8); PG8_WAIT_L(0); PG8_BAR; PG8_MMA(1, 0, At, B0); PG8_MMA(1, 1, At, B1); PG8_BAR; PG8_SCHED;
            } else {
            PG8_LDB(B0, 0, 0); PG8_SCHED; PG8_LDA(At, 0, 0); PG8_STAGE(PG8_SA(1, 1), a1 + hstepA, voffA);
            PG8_WAIT_L(8); PG8_BAR; PG8_WAIT_L(0); PG8_MMA(0, 0, At, B0); PG8_BAR; PG8_SCHED;
            PG8_LDB(B1, 0, 1); PG8_STAGE(PG8_SB(0, 0), b2, voffB);
            PG8_BAR; PG8_WAIT_L(0); PG8_MMA(0, 1, At, B1); PG8_BAR;
            PG8_LDA(At, 0, 1); PG8_STAGE(PG8_SA(0, 0), a2, voffA);
            PG8_BAR; PG8_WAIT_L(0); PG8_MMA(1, 0, At, B0); PG8_BAR; PG8_SCHED;
            PG8_STAGE(PG8_SB(0, 1), b2 + hstepB, voffB);
            PG8_WAIT_V(6); PG8_BAR; PG8_MMA(1, 1, At, B1); PG8_BAR;
            PG8_LDB(B0, 1, 0); PG8_SCHED; PG8_LDA(At, 1, 0); PG8_STAGE(PG8_SA(0, 1), a2 + hstepA, voffA);
            PG8_WAIT_L(8); PG8_BAR; PG8_WAIT_L(0); PG8_MMA(0, 0, At, B0); PG8_BAR; PG8_SCHED;
            PG8_LDB(B1, 1, 1); PG8_STAGE(PG8_SB(1, 0), b3, voffB);
            PG8_BAR; PG8_WAIT_L(0); PG8_MMA(0, 1, At, B1); PG8_BAR;
            PG8_LDA(At, 1, 1); PG8_STAGE(PG8_SA(1, 0), a3, voffA);
            PG8_BAR; PG8_WAIT_L(0); PG8_MMA(1, 0, At, B0); PG8_BAR; PG8_SCHED;
            PG8_STAGE(PG8_SB(1, 1), b3 + hstepB, voffB);
            PG8_WAIT_V(6); PG8_BAR; PG8_MMA(1, 1, At, B1); PG8_BAR;
            }
        }
        if constexpr (ALIGN_EPI) { if (wr == 0) PG8_BAR; }
        if constexpr (!Epi::AFTER_DRAIN) { E(acc, cur, wr, wc, fr, fq); S.done(cur); }
        if (!has_next) break;
#pragma unroll
        for (int a = 0; a < 2; ++a)
#pragma unroll
            for (int b = 0; b < 2; ++b)
#pragma unroll
                for (int m = 0; m < 4; ++m)
#pragma unroll
                    for (int n = 0; n < 2; ++n) acc[a][b][m][n] = (f32x4){0.f, 0.f, 0.f, 0.f};
        cur = nxt; cA = nA; cA2 = nA2; cB = nB; ++ui;
        if constexpr (ALIGN_EPI) { if (wr == 1) PG8_BAR; }
    }
    PG8_WAIT_V(0);
    if constexpr (!ALIGN_EPI) { if (wr == 0) PG8_BAR; }
    PG8_BAR;
    if constexpr (Epi::AFTER_DRAIN) { E.fused(acc, cur, wr, wc, fr, fq, lds, wid, lane); S.done(cur); }
#undef PG8_SA
#undef PG8_SB
#undef PG8_STAGE
#undef PG8_LDA
#undef PG8_LDB
#undef PG8_MMA
#undef PG8_WAIT_V
#undef PG8_WAIT_L
#undef PG8_BAR
#undef PG8_SCHED
}
}

namespace attn_body {
using bf16=__hip_bfloat16;
using bf16x8=__attribute__((ext_vector_type(8)))short;
using s16x4=__attribute__((ext_vector_type(4)))short;
using f32x16=__attribute__((ext_vector_type(16)))float;
using u32x4=__attribute__((ext_vector_type(4)))unsigned;
constexpr int D=64,QP=1024,KP=256;
constexpr int NW=8,QBLK=32,QB=QBLK*NW,KVBLK=64;

__device__ __forceinline__ int crow(int r,int hi){return (r&3)+8*(r>>2)+4*hi;}
#define SBAR() __builtin_amdgcn_sched_barrier(0)
__device__ __forceinline__ void cmask(f32x16&p0,f32x16&p1,int jb,int qrel,int hi){
  const float NEG=-INFINITY; int kb=64*jb+4*hi;
  #pragma unroll
  for(int r=0;r<16;++r){int kv=kb+(r&3)+8*(r>>2); if(kv>qrel)p0[r]=NEG; if(kv+32>qrel)p1[r]=NEG;}
}

constexpr int NSLOT=3, SLOTB=8192;
constexpr int LDS_K=0, LDS_V=NSLOT*SLOTB, LDS_WS=2*NSLOT*SLOTB, LDS_OST=LDS_WS+NW*64*4, LDS_BYTES=LDS_OST+NW*4096;
constexpr float C2=0.125f*1.4426950408889634f;
__device__ __forceinline__ void glds16(const void*gsrc,unsigned lds_dst){unsigned keep;
  asm volatile("s_mov_b32 %0, m0\n\ts_mov_b32 m0, %2\n\ts_nop 0\n\tglobal_load_lds_dwordx4 %1, off\n\ts_mov_b32 m0, %0":"=&s"(keep):"v"(gsrc),"s"(lds_dst):"memory");}
__device__ __forceinline__ float max3f(float a,float b,float c){float r;asm("v_max3_f32 %0, %1, %2, %3":"=v"(r):"v"(a),"v"(b),"v"(c));return r;}
__device__ __forceinline__ float max2f(float a,float b){float r;asm("v_max_f32_e32 %0, %1, %2":"=v"(r):"v"(a),"v"(b));return r;}
__device__ __forceinline__ float fadd_s(float a,float b){float r;asm("v_add_f32_e32 %0, %1, %2":"=v"(r):"v"(a),"v"(b));return r;}
__device__ __forceinline__ float fsub_s(float a,float b){float r;asm("v_sub_f32_e32 %0, %1, %2":"=v"(r):"v"(a),"v"(b));return r;}
typedef float f32x2_t __attribute__((ext_vector_type(2))); typedef __bf16 bf16x2_t __attribute__((ext_vector_type(2)));
__device__ __forceinline__ unsigned cvtpk_s(float lo,float hi){f32x2_t v={lo,hi};bf16x2_t b=__builtin_convertvector(v,bf16x2_t);return __builtin_bit_cast(unsigned,b);}
#define WAIT_BAR(N) asm volatile("s_waitcnt vmcnt(" #N ") lgkmcnt(0)\n\ts_barrier":::"memory")

__device__ __forceinline__ void qkt(f32x16&p0,f32x16&p1,const char*Kslot,const bf16x8*qr,const f32x16&negm,int r32,int hi){
  const char*kb=Kslot+hi*1024+r32*16;
  #pragma unroll
  for(int d0=0;d0<4;++d0){
    const bf16x8 b0=*reinterpret_cast<const bf16x8*>(kb+d0*2048);
    const bf16x8 b1=*reinterpret_cast<const bf16x8*>(kb+d0*2048+512);
    if(d0==0){p0=__builtin_amdgcn_mfma_f32_32x32x16_bf16(b0,qr[0],negm,0,0,0);p1=__builtin_amdgcn_mfma_f32_32x32x16_bf16(b1,qr[0],negm,0,0,0);}
    else{p0=__builtin_amdgcn_mfma_f32_32x32x16_bf16(b0,qr[d0],p0,0,0,0);p1=__builtin_amdgcn_mfma_f32_32x32x16_bf16(b1,qr[d0],p1,0,0,0);}}
}
typedef __attribute__((address_space(3))) const char* lds_cptr;
typedef short v4i16_t __attribute__((ext_vector_type(4)));
__device__ __forceinline__ void kload8(bf16x8*kf,lds_cptr kp){
  kf[0]=*(const __attribute__((address_space(3))) bf16x8*)(kp);      kf[1]=*(const __attribute__((address_space(3))) bf16x8*)(kp+512);
  kf[2]=*(const __attribute__((address_space(3))) bf16x8*)(kp+2048); kf[3]=*(const __attribute__((address_space(3))) bf16x8*)(kp+2560);
  kf[4]=*(const __attribute__((address_space(3))) bf16x8*)(kp+4096); kf[5]=*(const __attribute__((address_space(3))) bf16x8*)(kp+4608);
  kf[6]=*(const __attribute__((address_space(3))) bf16x8*)(kp+6144); kf[7]=*(const __attribute__((address_space(3))) bf16x8*)(kp+6656);
}
__device__ __forceinline__ void kload2(bf16x8*kf,lds_cptr kp,int j){ kf[2*j]=*(const __attribute__((address_space(3))) bf16x8*)(kp+j*2048); kf[2*j+1]=*(const __attribute__((address_space(3))) bf16x8*)(kp+j*2048+512); }
__device__ __forceinline__ s16x4 vtr(lds_cptr p){ return __builtin_bit_cast(s16x4,__builtin_amdgcn_ds_read_tr16_b64_v4i16((__attribute__((address_space(3))) v4i16_t*)p)); }
__device__ __forceinline__ float rowmax(const f32x16&p0,const f32x16&p1){
  float a=max3f(p0[0],p0[1],p1[0]),b=max3f(p0[2],p0[3],p1[1]);a=max3f(a,p1[2],p1[3]);
  #pragma unroll
  for(int r=4;r<16;r+=4){a=max3f(a,p0[r],p0[r+1]);b=max3f(b,p0[r+2],p0[r+3]);a=max3f(a,p1[r],p1[r+1]);b=max3f(b,p1[r+2],p1[r+3]);}
  const float m=max2f(a,b);
  auto rr=__builtin_amdgcn_permlane32_swap(__float_as_uint(m),__float_as_uint(m),false,false);
  return max2f(__uint_as_float(rr[0]),__uint_as_float(rr[1]));
}
__device__ __forceinline__ void pv(f32x16*o,int vb,bf16x8 pa0,bf16x8 pa1,bf16x8 pa2,bf16x8 pa3){
  #pragma unroll
  for(int d0=0;d0<2;++d0){s16x4 lo[4],hi[4];
    #pragma unroll
    for(int ks=0;ks<4;++ks){
      asm volatile("ds_read_b64_tr_b16 %0,%1 offset:%c2":"=&v"(lo[ks]):"v"(vb),"i"(d0*4096+ks*1024):"memory");
      asm volatile("ds_read_b64_tr_b16 %0,%1 offset:%c2":"=&v"(hi[ks]):"v"(vb),"i"(d0*4096+ks*1024+512):"memory");}
    asm volatile("s_waitcnt lgkmcnt(0)":::"memory");SBAR();
    #define PK(k) (bf16x8){lo[k][0],lo[k][1],lo[k][2],lo[k][3],hi[k][0],hi[k][1],hi[k][2],hi[k][3]}
    o[d0]=__builtin_amdgcn_mfma_f32_32x32x16_bf16(pa0,PK(0),o[d0],0,0,0);
    o[d0]=__builtin_amdgcn_mfma_f32_32x32x16_bf16(pa1,PK(1),o[d0],0,0,0);
    o[d0]=__builtin_amdgcn_mfma_f32_32x32x16_bf16(pa2,PK(2),o[d0],0,0,0);
    o[d0]=__builtin_amdgcn_mfma_f32_32x32x16_bf16(pa3,PK(3),o[d0],0,0,0);
    #undef PK
  }
}
#define ATTN_STORE16(p,v) (*(u32x4*)(p)=(v))
__device__ __forceinline__ float abf_lo(unsigned w){return __uint_as_float(w<<16);}
__device__ __forceinline__ float abf_hi(unsigned w){return __uint_as_float(w&0xffff0000u);}
__device__ __forceinline__ u32x4 mulgate(const u32x4&v,const u32x4&g){u32x4 r;
  r.x=cvtpk_s(abf_lo(v.x)*abf_lo(g.x),abf_hi(v.x)*abf_hi(g.x)); r.y=cvtpk_s(abf_lo(v.y)*abf_lo(g.y),abf_hi(v.y)*abf_hi(g.y));
  r.z=cvtpk_s(abf_lo(v.z)*abf_lo(g.z),abf_hi(v.z)*abf_hi(g.z)); r.w=cvtpk_s(abf_lo(v.w)*abf_lo(g.w),abf_hi(v.w)*abf_hi(g.w)); return r;}
__device__ __forceinline__ void qnormrope(bf16x8*qr,const float*__restrict__ qn,int t,int hi){
  typedef float f4_t __attribute__((ext_vector_type(4)));
  float y[4][8]; float ss=0.f;
  #pragma unroll
  for(int d0=0;d0<4;++d0){ const u32x4 w=__builtin_bit_cast(u32x4,qr[d0]);
    #pragma unroll
    for(int i=0;i<4;++i){ y[d0][2*i]=__uint_as_float(w[i]<<16); y[d0][2*i+1]=__uint_as_float(w[i]&0xffff0000u); ss+=y[d0][2*i]*y[d0][2*i]+y[d0][2*i+1]*y[d0][2*i+1]; } }
  ss+=__shfl_xor(ss,32);
  const float rstd=1.0f/sqrtf(ss*(1.0f/64.0f)+1e-6f);
  #pragma unroll
  for(int d0=0;d0<4;++d0){ const f4_t g0=*(const f4_t*)(qn+16*d0+8*hi), g1=*(const f4_t*)(qn+16*d0+8*hi+4);
    #pragma unroll
    for(int i=0;i<4;++i){ y[d0][i]*=rstd*g0[i]; y[d0][4+i]*=rstd*g1[i]; } }
  const float prow=(float)(t>>6), pcol=(float)(t&63);
  #pragma unroll
  for(int j=0;j<8;++j){
    const float freq=__builtin_amdgcn_exp2f(-(float)(8*hi+j)*0.83048202372184058696f)*0.15915494309189533577f;
    const float rr=__builtin_amdgcn_fractf(prow*freq), rc=__builtin_amdgcn_fractf(pcol*freq);
    const float sr=__builtin_amdgcn_sinf(rr), cr=__builtin_amdgcn_cosf(rr), sc=__builtin_amdgcn_sinf(rc), cc=__builtin_amdgcn_cosf(rc);
    const float a0=y[0][j], b0=y[1][j], a1=y[2][j], b1=y[3][j];
    y[0][j]=(a0*cr-b0*sr)*C2; y[1][j]=(b0*cr+a0*sr)*C2; y[2][j]=(a1*cc-b1*sc)*C2; y[3][j]=(b1*cc+a1*sc)*C2; }
  #pragma unroll
  for(int d0=0;d0<4;++d0){ u32x4 w; w.x=cvtpk_s(y[d0][0],y[d0][1]); w.y=cvtpk_s(y[d0][2],y[d0][3]); w.z=cvtpk_s(y[d0][4],y[d0][5]); w.w=cvtpk_s(y[d0][6],y[d0][7]); qr[d0]=__builtin_bit_cast(bf16x8,w); }
}
template<int THRL> __device__ __forceinline__ void attn_unit(long qrow0,long kvrow0,int NT,int h,const bf16*Q,const bf16*__restrict__ K,const bf16*__restrict__ V,bf16*O,const bf16*__restrict__ Gt,const float*__restrict__ qn,char*shm){
  const int tid=threadIdx.x,lane=tid&63,r32=lane&31,hi=lane>>5; const int wid=__builtin_amdgcn_readfirstlane(tid>>6);
  const bf16*Qw=Q+(qrow0+wid*QBLK)*QP+h*D;
  const bf16*Kh=K+kvrow0*KP+(h>>2)*D,*Vh=V+kvrow0*KP+(h>>2)*D;
  const unsigned lds0=(unsigned)(uintptr_t)shm;
  float*wsf=(float*)(shm+LDS_WS)+wid*64;
  const bf16*ksrc=Kh+(long)lane*KP+wid*8;
  const bf16*vsrc=Vh+(long)(16*(wid&3)+(lane>>2))*KP+(wid>>2)*32+(lane&3)*8;
  const unsigned kdst=lds0+LDS_K+wid*1024, vdst=lds0+LDS_V+wid*1024;
  #define DMA_K(t,slot) glds16(ksrc+(long)(t)*KVBLK*KP,(unsigned)__builtin_amdgcn_readfirstlane(kdst+(slot)))
  #define DMA_V(t,slot) glds16(vsrc+(long)(t)*KVBLK*KP,(unsigned)__builtin_amdgcn_readfirstlane(vdst+(slot)))
  const int vb0=(int)(lds0+LDS_V)+((lane>>4)&1)*32+(lane&3)*8+(4*hi+((lane&15)>>2))*64;
  const char*Kbase=shm+LDS_K; bf16x8 kf[8];
  const lds_cptr shm3=(lds_cptr)shm; const lds_cptr kp0=shm3+LDS_K+hi*1024+r32*16; const lds_cptr vp0=shm3+LDS_V+((lane>>4)&1)*32+(lane&3)*8+(4*hi+((lane&15)>>2))*64;
  DMA_K(0,0);DMA_V(0,0);DMA_K(1,SLOTB);
  bf16x8 qr[4];
  #pragma unroll
  for(int d0=0;d0<4;++d0)qr[d0]=*reinterpret_cast<const bf16x8*>(&Qw[(long)r32*QP+d0*16+hi*8]);
  qnormrope(qr,qn,(int)(qrow0-kvrow0)+wid*QBLK+r32,hi);
  float mhat=0.f,l_reg=0.f;f32x16 o[2];o[0]=f32x16{};o[1]=f32x16{};f32x16 negm=f32x16{};asm volatile("":"+v"(negm));
  #define CMASK(P0,P1,t) do{}while(0)
  bool resc=false;
  #define START(P0,P1) do{ const float rm=rowmax(P0,P1); resc=false; \
    { const float dl=rm; mhat=fadd_s(mhat,dl); \
      _Pragma("unroll") for(int r=0;r<16;++r){P0[r]=fsub_s(P0[r],dl);P1[r]=fsub_s(P1[r],dl);} \
      _Pragma("unroll") for(int r=0;r<16;++r)negm[r]=-mhat; asm volatile("":"+v"(negm)); } \
    _Pragma("unroll") for(int r=0;r<16;++r)P0[r]=__builtin_amdgcn_exp2f(P0[r]); }while(0)
  #define RESC() do{ if(resc){ asm volatile("s_waitcnt lgkmcnt(0)":::"memory"); \
      _Pragma("unroll") for(int d_=0;d_<2;++d_) _Pragma("unroll") for(int r=0;r<16;++r)o[d_][r]*=wsf[crow(r,hi)]; } }while(0)
  f32x16 pA0,pA1,pB0,pB1;
  int sl_prev=0,sl_cur=0,sl_next=SLOTB;
  #define ROT() do{sl_prev=sl_cur;sl_cur=sl_next;sl_next=(sl_next==(NSLOT-1)*SLOTB)?0:sl_next+SLOTB;}while(0)
  DMA_K(2,2*SLOTB);
  WAIT_BAR(3);
  qkt(pA0,pA1,Kbase,qr,negm,r32,hi);asm volatile("s_nop 15\n\ts_nop 7":"+v"(pA0),"+v"(pA1));CMASK(pA0,pA1,0);
  START(pA0,pA1);
  _Pragma("unroll") for(int r=0;r<16;++r)pA1[r]=__builtin_amdgcn_exp2f(pA1[r]);
  WAIT_BAR(0);
  DMA_K(3,0);DMA_V(1,SLOTB);
  ROT();
  kload8(kf,kp0+sl_cur);
  WAIT_BAR(2);
  s16x4 vlo[8],vhi[8]; u32x4 pw0,pw1,pw2,pw3;
  #define PKW(P,B) cvtpk_s(P[B],P[B+1])
  #define PAF(k) __builtin_bit_cast(bf16x8,pw##k)
  #define VFR(i) (bf16x8){vlo[i][0],vlo[i][1],vlo[i][2],vlo[i][3],vhi[i][0],vhi[i][1],vhi[i][2],vhi[i][3]}
  #define PIN(x) asm volatile("":"+v"(x))
  #define MX3(a,b,c) __builtin_fmaxf(__builtin_fmaxf((a),(b)),(c))
  #define GAPA(MF,A0,A1,A2,A3,W0,W1,PW) do{ MF; sacc+=A0; sacc+=A1; sacc+=A2; sacc+=A3; PIN(sacc); W0; W1; PIN(PW); SBAR(); }while(0)
  #define EX(v) __builtin_amdgcn_exp2f(v)
  #define GAPB(MF,X,B) do{ MF; X[B]=EX(X[B]); X[B+1]=EX(X[B+1]); X[B+2]=EX(X[B+2]); X[B+3]=EX(X[B+3]); PIN(X); SBAR(); }while(0)
  #define VRD(i) do{ vlo[i]=vtr(vp_+(((i)>>2)*4096+((i)&3)*1024)); vhi[i]=vtr(vp_+(((i)>>2)*4096+((i)&3)*1024+512)); }while(0)
  #define KRD(G,j) do{ if(G){ kload2(kf,kp0+sl_next,j); SBAR(); } }while(0)
  #define STEP(C0,C1,P0,P1,t,GK,GV,GL) do{ SBAR(); \
    const lds_cptr vp_=vp0+sl_prev; \
    VRD(0); SBAR(); float sacc=(P0[0]+P0[1]); \
    GAPA(C0=__builtin_amdgcn_mfma_f32_32x32x16_bf16(kf[0],qr[0],negm,0,0,0), P0[2],P0[3],P0[4],P0[5],     pw0[0]=PKW(P0,0), pw0[1]=PKW(P0,2), pw0); \
    VRD(4); SBAR(); GAPA(C1=__builtin_amdgcn_mfma_f32_32x32x16_bf16(kf[1],qr[0],negm,0,0,0), P0[6],P0[7],P0[8],P0[9],     pw0[2]=PKW(P0,4), pw0[3]=PKW(P0,6), pw0); \
    VRD(1); SBAR(); GAPA(C0=__builtin_amdgcn_mfma_f32_32x32x16_bf16(kf[2],qr[1],C0,0,0,0),   P0[10],P0[11],P0[12],P0[13], pw1[0]=PKW(P0,8), pw1[1]=PKW(P0,10), pw1); \
    VRD(5); SBAR(); GAPA(C1=__builtin_amdgcn_mfma_f32_32x32x16_bf16(kf[3],qr[1],C1,0,0,0),   P0[14],P0[15],P1[0],P1[1],   pw1[2]=PKW(P0,12),pw1[3]=PKW(P0,14), pw1); \
    VRD(2); SBAR(); GAPA(C0=__builtin_amdgcn_mfma_f32_32x32x16_bf16(kf[4],qr[2],C0,0,0,0),   P1[2],P1[3],P1[4],P1[5],     pw2[0]=PKW(P1,0), pw2[1]=PKW(P1,2), pw2); \
    VRD(6); SBAR(); GAPA(C1=__builtin_amdgcn_mfma_f32_32x32x16_bf16(kf[5],qr[2],C1,0,0,0),   P1[6],P1[7],P1[8],P1[9],     pw2[2]=PKW(P1,4), pw2[3]=PKW(P1,6), pw2); \
    VRD(3); SBAR(); GAPA(C0=__builtin_amdgcn_mfma_f32_32x32x16_bf16(kf[6],qr[3],C0,0,0,0),   P1[10],P1[11],P1[12],P1[13], pw3[0]=PKW(P1,8), pw3[1]=PKW(P1,10), pw3); \
    VRD(7); SBAR(); GAPA(C1=__builtin_amdgcn_mfma_f32_32x32x16_bf16(kf[7],qr[3],C1,0,0,0),   P1[14],P1[15],0.f,0.f,       pw3[2]=PKW(P1,12),pw3[3]=PKW(P1,14), pw3); \
    l_reg+=sacc; \
    if(GK){DMA_K((t)+3,sl_cur);} if(GV){DMA_V((t)+1,sl_next);} \
    CMASK(C0,C1,t); \
    { float a=MX3(C0[0],C0[1],C1[0]),b=MX3(C0[2],C0[3],C1[1]); a=MX3(a,C1[2],C1[3]); \
      _Pragma("unroll") for(int r=4;r<16;r+=4){a=MX3(a,C0[r],C0[r+1]);b=MX3(b,C0[r+2],C0[r+3]);a=MX3(a,C1[r],C1[r+1]);b=MX3(b,C1[r+2],C1[r+3]);} \
      float rm=__builtin_fmaxf(a,b); { auto rr=__builtin_amdgcn_permlane32_swap(__float_as_uint(rm),__float_as_uint(rm),false,false); rm=__builtin_fmaxf(__uint_as_float(rr[0]),__uint_as_float(rr[1])); } \
      resc=false; \
      if(__builtin_expect(__any(rm>(float)THRL),0)){ const float dl=__builtin_fmaxf(rm,0.f); mhat+=dl; \
        _Pragma("unroll") for(int r=0;r<16;++r){C0[r]-=dl;C1[r]-=dl;} \
        _Pragma("unroll") for(int r=0;r<16;++r)negm[r]=-mhat; asm volatile("":"+v"(negm)); \
        const float f=__builtin_amdgcn_exp2f(-dl); l_reg*=f; if(hi==0)wsf[r32]=f; resc=true; } } \
    SBAR(); \
    GAPB(o[0]=__builtin_amdgcn_mfma_f32_32x32x16_bf16(PAF(0),VFR(0),o[0],0,0,0), C0,0); \
    GAPB(o[1]=__builtin_amdgcn_mfma_f32_32x32x16_bf16(PAF(0),VFR(4),o[1],0,0,0), C0,4); \
    KRD(GL,0); GAPB(o[0]=__builtin_amdgcn_mfma_f32_32x32x16_bf16(PAF(1),VFR(1),o[0],0,0,0), C0,8); \
    KRD(GL,1); GAPB(o[1]=__builtin_amdgcn_mfma_f32_32x32x16_bf16(PAF(1),VFR(5),o[1],0,0,0), C0,12); \
    KRD(GL,2); GAPB(o[0]=__builtin_amdgcn_mfma_f32_32x32x16_bf16(PAF(2),VFR(2),o[0],0,0,0), C1,0); \
    KRD(GL,3); GAPB(o[1]=__builtin_amdgcn_mfma_f32_32x32x16_bf16(PAF(2),VFR(6),o[1],0,0,0), C1,4); \
    GAPB(o[0]=__builtin_amdgcn_mfma_f32_32x32x16_bf16(PAF(3),VFR(3),o[0],0,0,0), C1,8); \
    GAPB(o[1]=__builtin_amdgcn_mfma_f32_32x32x16_bf16(PAF(3),VFR(7),o[1],0,0,0), C1,12); \
    }while(0)
  int t=1;
  #undef CMASK
  #define CMASK(P0,P1,t) do{}while(0)
  for(;t+5<NT;t+=2){
    STEP(pB0,pB1,pA0,pA1,t,true,true,true);     WAIT_BAR(2); RESC(); ROT();
    STEP(pA0,pA1,pB0,pB1,t+1,true,true,true);   WAIT_BAR(2); RESC(); ROT();
  }
  #undef CMASK
  #define CMASK(P0,P1,t) do{}while(0)
  #define ENDW(tt) do{ if((tt)+3<NT){WAIT_BAR(2);} else if((tt)+2<NT){WAIT_BAR(1);} else {WAIT_BAR(0);} }while(0)
  for(;t+1<NT;t+=2){
    STEP(pB0,pB1,pA0,pA1,t,(t+3<NT),(t+1<NT),(t+1<NT));       ENDW(t);   RESC(); ROT();
    STEP(pA0,pA1,pB0,pB1,t+1,(t+4<NT),(t+2<NT),(t+2<NT));     ENDW(t+1); RESC(); ROT();
  }
  STEP(pB0,pB1,pA0,pA1,NT-1,false,false,false); RESC();
  { float sacc=pB0[0]+pB0[1]; _Pragma("unroll") for(int r=2;r<16;++r)sacc+=pB0[r]; _Pragma("unroll") for(int r=0;r<16;++r)sacc+=pB1[r]; l_reg+=sacc;
    pw0=(u32x4){PKW(pB0,0),PKW(pB0,2),PKW(pB0,4),PKW(pB0,6)};pw1=(u32x4){PKW(pB0,8),PKW(pB0,10),PKW(pB0,12),PKW(pB0,14)};pw2=(u32x4){PKW(pB1,0),PKW(pB1,2),PKW(pB1,4),PKW(pB1,6)};pw3=(u32x4){PKW(pB1,8),PKW(pB1,10),PKW(pB1,12),PKW(pB1,14)};
    SBAR(); pv(o,vb0+sl_cur,PAF(0),PAF(1),PAF(2),PAF(3)); }
  #undef PKW
  #undef PAF
  #undef VFR
  #undef PIN
  #undef MX3
  #undef GAPA
  #undef GAPB
  #undef EX
  #undef VRD
  #undef KRD
  #undef STEP
  #undef ENDW
  {auto rr=__builtin_amdgcn_permlane32_swap(__float_as_uint(l_reg),__float_as_uint(l_reg),false,false);l_reg=__uint_as_float(rr[0])+__uint_as_float(rr[1]);}
  if(hi==0)wsf[32+r32]=l_reg;asm volatile("s_waitcnt lgkmcnt(0)":::"memory");
  float rli[16];
  #pragma unroll
  for(int r=0;r<16;++r)rli[r]=__builtin_amdgcn_rcpf(wsf[32+crow(r,hi)]);
  bf16*Ow=O+(qrow0+wid*QBLK)*QP+h*D; const bf16*Gw=Gt+(qrow0+wid*QBLK)*QP+h*D;
  { bf16*stg=(bf16*)(shm+LDS_OST)+wid*2048;
    #pragma unroll
    for(int r=0;r<16;++r){const int orow=crow(r,hi);
      #pragma unroll
      for(int d0=0;d0<2;++d0)stg[orow*64+d0*32+r32]=__float2bfloat16(o[d0][r]*rli[r]);}
    asm volatile("s_waitcnt lgkmcnt(0)":::"memory");
    #pragma unroll
    for(int i=0;i<4;++i){const int row=i*8+(lane>>3),ch=lane&7; const u32x4 v=*(const u32x4*)(stg+row*64+ch*8); const u32x4 gv=*(const u32x4*)(Gw+(long)row*QP+ch*8); ATTN_STORE16(Ow+(long)row*QP+ch*8,mulgate(v,gv));} }
  asm volatile("s_waitcnt lgkmcnt(0)\n\ts_barrier":::"memory");
  #undef DMA_K
  #undef DMA_V
  #undef CMASK
  #undef START
  #undef RESC
  #undef ROT
}
constexpr int ATTN_LDS_BYTES=LDS_BYTES;
#undef SBAR
#undef WAIT_BAR
}

constexpr int NWAVES = 8;
constexpr int D = 1024, TP = 8192, TS = 2048, NB = 8;
constexpr int MP = NB * TP, MS = NB * TS, M = MP + MS;
constexpr int INW = 6656, PLE = 256;
constexpr float EPS = 1e-6f;
#ifndef MK_N_LAUNCHES
#define MK_N_LAUNCHES 1
#endif
constexpr int N_LAUNCHES = MK_N_LAUNCHES;
constexpr int N_PHASES = 8;

constexpr size_t MiB = 1u << 20;
constexpr size_t WS_CTL = 0, CTL_ZERO_BYTES = 64 * 1024;
constexpr size_t WS_WIN = 2 * MiB;
constexpr size_t WS_WAB = 16 * MiB;
constexpr size_t WS_WO = 20 * MiB;
constexpr size_t WS_WG = 22 * MiB;
constexpr size_t WS_WPLE = 24 * MiB;
constexpr size_t WS_PBF = 26 * MiB;
constexpr size_t WS_RA = 80 * MiB;
constexpr size_t WS_RB = 240 * MiB;
constexpr size_t WS_RC = 400 * MiB;
constexpr size_t WS_RD = 560 * MiB;
constexpr size_t WS_RE = 720 * MiB;
constexpr size_t WS_RK = 880 * MiB;
constexpr size_t WS_RV = 920 * MiB;
constexpr size_t WS_END = 960 * MiB;

constexpr int RING_BYTES = 131072;
constexpr int LDS_BYTES = 147456;
constexpr int MISC_OFF = LDS_BYTES - 256;

#define GAS __attribute__((address_space(1)))
#define LAS __attribute__((address_space(3)))
typedef unsigned short bf16;
typedef unsigned v4u __attribute__((ext_vector_type(4)));
typedef unsigned v2u __attribute__((ext_vector_type(2)));
typedef float f32x4 __attribute__((ext_vector_type(4)));
#define LDS_WAIT() asm volatile("s_waitcnt lgkmcnt(0)" ::: "memory")
#define VM_WAIT() asm volatile("s_waitcnt vmcnt(0)" ::: "memory")
__device__ __forceinline__ unsigned pk2(float lo, float hi) { return pg8::cvt_pk_bf16(lo, hi); }
__device__ __forceinline__ float blo(unsigned w) { return __uint_as_float(w << 16); }
__device__ __forceinline__ float bhi(unsigned w) { return __uint_as_float(w & 0xffff0000u); }

#define XB_TMO      128
#define XB_XCNT(j)  (256  + 64 * (j))
#define XB_XSUB(j)  (1280 + 64 * (j))
#define XB_XGEN(j)  (2304 + 64 * (j))
#define XB_TOP      3328
#define XB_TOPGEN   3392
#define XCD_BAR_WORDS 3456
#define XB_SPIN_CAP (1u << 18)

__device__ __forceinline__ unsigned xb_ld(unsigned* p)              { return __hip_atomic_load(p, __ATOMIC_RELAXED, __HIP_MEMORY_SCOPE_AGENT); }
__device__ __forceinline__ unsigned xb_add(unsigned* p, unsigned v) { return __hip_atomic_fetch_add(p, v, __ATOMIC_RELAXED, __HIP_MEMORY_SCOPE_AGENT); }
__device__ __forceinline__ unsigned xb_xcc_id() { return (unsigned)__builtin_amdgcn_s_getreg((3 << 11) | 20) & 0xFu; }
#define XB_SPIN(cond, bar) do { unsigned _sp = 0; while (cond) { __builtin_amdgcn_s_sleep(1); \
    if ((++_sp & 255u) == 0u) { if (xb_ld(&(bar)[XB_TMO])) break; if (_sp > XB_SPIN_CAP) { atomicAdd(&(bar)[XB_TMO], 1u); break; } } } } while (0)

struct XcdBarrier {
    unsigned* bar; unsigned x;
    volatile LAS unsigned* st;
};

__device__ __forceinline__ XcdBarrier xcd_barrier_post(unsigned* bar, volatile LAS unsigned* st) {
    XcdBarrier b; b.bar = bar; b.x = xb_xcc_id(); b.st = st;
    if (threadIdx.x == 0) (void)xb_add(&bar[XB_XCNT(b.x)], 1u);
    return b;
}
__device__ __forceinline__ void xcd_barrier_complete(unsigned* bar, unsigned x, unsigned& nloc, unsigned& nx) {
    const unsigned G = gridDim.x * gridDim.y * gridDim.z;
    unsigned sum, cnt, mine, sp = 0u;
    for (;;) {
        sum = 0u; cnt = 0u; mine = 0u;
#pragma unroll
        for (unsigned j = 0; j < 16; ++j) { const unsigned c = xb_ld(&bar[XB_XCNT(j)]); sum += c; cnt += (c > 0u) ? 1u : 0u; mine = (j == x) ? c : mine; }
        if (sum == G) break;
        __builtin_amdgcn_s_sleep(1);
        if ((++sp & 255u) == 0u) { if (xb_ld(&bar[XB_TMO])) break; if (sp > XB_SPIN_CAP) { atomicAdd(&bar[XB_TMO], 1u); break; } }
    }
    nloc = mine > 0u ? mine : 1u; nx = cnt > 0u ? cnt : 1u;
}

__device__ __forceinline__ void xcd_barrier(const XcdBarrier& b) {
    asm volatile("s_waitcnt vmcnt(0)" ::: "memory");
    __syncthreads();
    if (threadIdx.x == 0) {
        unsigned* bar = b.bar;
        __builtin_amdgcn_s_waitcnt(0);
        unsigned nloc = b.st[0], nx = b.st[1];
        if (nloc == 0u) { xcd_barrier_complete(bar, b.x, nloc, nx); b.st[0] = nloc; b.st[1] = nx; }
        const unsigned old = xb_add(&bar[XB_XSUB(b.x)], 1u);
        const unsigned gen = old / nloc;
        if (old + 1u == (gen + 1u) * nloc) {
            __builtin_amdgcn_fence(__ATOMIC_RELEASE, "agent");
            asm volatile("s_waitcnt vmcnt(0)" ::: "memory");
            const unsigned og = xb_add(&bar[XB_TOP], 1u);
            const unsigned tg = og / nx;
            if (og + 1u == (tg + 1u) * nx) xb_add(&bar[XB_TOPGEN], 1u);
            else XB_SPIN(xb_ld(&bar[XB_TOPGEN]) == tg, bar);
            __builtin_amdgcn_fence(__ATOMIC_ACQUIRE, "agent");
            xb_add(&bar[XB_XGEN(b.x)], 1u);
            asm volatile("s_waitcnt vmcnt(0)" ::: "memory");
        } else {
            XB_SPIN(xb_ld(&bar[XB_XGEN(b.x)]) == gen, bar);
            __builtin_amdgcn_fence(__ATOMIC_ACQUIRE, "agent");
            asm volatile("s_waitcnt vmcnt(0)" ::: "memory");
        }
    }
    __syncthreads();
}

struct Args {
    const float *x_p, *x_s, *p_p, *p_s, *norm_pre, *w_in, *pool_w, *pool_scale, *w_a, *q_norm, *k_norm, *w_b, *w_out, *norm_post, *ple_norm, *w_gate, *w_ple;
    float* out; unsigned char* ws; int ph_lo, ph_hi;
};

__device__ __forceinline__ float wave_sum(float v) {
#pragma unroll
    for (int o = 1; o < 64; o <<= 1) v += __shfl_xor(v, o);
    return v;
}
__device__ __forceinline__ void p0_transpose_item(const float* W, int K, int N, bf16* WT, int row_off, int ldt, int koff, LAS float* scr, int item, int lane) {
    const int nblk = N / 32, kb = item / nblk, nb = item % nblk, k0 = 64 * kb, n0 = 32 * nb;
#pragma unroll 8
    for (int i = 0; i < 32; ++i) { const int kk = 2 * i + (lane >> 5); scr[kk * 33 + (lane & 31)] = W[(size_t)(k0 + kk) * N + n0 + (lane & 31)]; }
    LDS_WAIT(); asm volatile("" ::: "memory");
    const int c = lane & 7;
#pragma unroll
    for (int j = 0; j < 4; ++j) { const int n = (lane >> 3) + 8 * j; const LAS float* s = scr + (8 * c) * 33 + n;
        v4u o; o.x = pk2(s[0 * 33], s[1 * 33]); o.y = pk2(s[2 * 33], s[3 * 33]); o.z = pk2(s[4 * 33], s[5 * 33]); o.w = pk2(s[6 * 33], s[7 * 33]);
        *(GAS v4u*)(WT + (size_t)(row_off + n0 + n) * ldt + koff + k0 + 8 * c) = o; }
    LDS_WAIT(); asm volatile("" ::: "memory");
}
__device__ __forceinline__ const float* xrow_ptr(const Args& a, int m) { return m < MP ? a.x_p + (size_t)m * D : a.x_s + (size_t)(m - MP) * D; }

__device__ __forceinline__ void phase0(const Args& a, LAS unsigned char* lds, int vcu, int G) {
    int tid = threadIdx.x; asm volatile("" : "+v"(tid));
    const int lane = tid & 63, wave = __builtin_amdgcn_readfirstlane(tid >> 6);
    LAS float* scr = (LAS float*)(lds + wave * 16384);
    const int gw = vcu * NWAVES + wave, NGW = G * NWAVES;
    unsigned char* ws = a.ws;
    {
        LAS float* At = (LAS float*)lds; LAS float* Bt = (LAS float*)(lds + 64 * 257 * 4 + 64);
        bf16* WT = (bf16*)(ws + WS_WIN);
        for (int tile = vcu; tile < 256; tile += G) {
            const int kb = tile >> 4, g = (tile >> 2) & 3, db = tile & 3, k0 = 64 * kb, d0 = 64 * db;
#pragma unroll
            for (int i = 0; i < 8; ++i) { const int row = (tid >> 6) + 8 * i, c4 = tid & 63;
                const f32x4 v = *(const GAS f32x4*)(a.w_in + (size_t)(k0 + row) * INW + g * 256 + 4 * c4);
                LAS float* d = At + row * 257 + 4 * c4; d[0] = v.x; d[1] = v.y; d[2] = v.z; d[3] = v.w; }
#pragma unroll
            for (int i = 0; i < 8; ++i) { const int c = (tid >> 4) + 32 * i, c4 = tid & 15;
                *(LAS f32x4*)(Bt + c * 64 + 4 * c4) = *(const GAS f32x4*)(a.pool_w + (size_t)g * 65536 + (size_t)c * 256 + d0 + 4 * c4); }
            __syncthreads();
            float acc[8];
#pragma unroll
            for (int j = 0; j < 8; ++j) acc[j] = 0.f;
#pragma unroll 4
            for (int c = 0; c < 256; ++c) { const float av = At[lane * 257 + c]; const f32x4 b0 = *(const LAS f32x4*)(Bt + c * 64 + wave * 8), b1 = *(const LAS f32x4*)(Bt + c * 64 + wave * 8 + 4);
                acc[0] += av * b0.x; acc[1] += av * b0.y; acc[2] += av * b0.z; acc[3] += av * b0.w; acc[4] += av * b1.x; acc[5] += av * b1.y; acc[6] += av * b1.z; acc[7] += av * b1.w; }
#pragma unroll
            for (int j = 0; j < 8; ++j) WT[(size_t)(g * 256 + d0 + wave * 8 + j) * D + k0 + lane] = (bf16)(pk2(acc[j], 0.f) & 0xffffu);
            __syncthreads();
        }
    }
    constexpr int I_IN = (D / 64) * ((INW - 1024) / 32), I_SQ = (D / 64) * (D / 32), I_PLE = (PLE / 64) * (D / 32);
    constexpr int NITEMS = I_IN + 4 * I_SQ + I_PLE;
    for (int it = gw; it < NITEMS; it += NGW) {
        int r = it;
        if (r < I_IN) { const int kb = r / 176, nb = 32 + r % 176; p0_transpose_item(a.w_in, D, INW, (bf16*)(ws + WS_WIN), 0, D, 0, scr, kb * (INW / 32) + nb, lane); continue; } r -= I_IN;
        if (r < I_SQ) { p0_transpose_item(a.w_a, D, D, (bf16*)(ws + WS_WAB), 0, 2048, 0, scr, r, lane); continue; } r -= I_SQ;
        if (r < I_SQ) { p0_transpose_item(a.w_b, D, D, (bf16*)(ws + WS_WAB), 0, 2048, 1024, scr, r, lane); continue; } r -= I_SQ;
        if (r < I_SQ) { p0_transpose_item(a.w_out, D, D, (bf16*)(ws + WS_WO), 0, D, 0, scr, r, lane); continue; } r -= I_SQ;
        if (r < I_SQ) { p0_transpose_item(a.w_gate, D, D, (bf16*)(ws + WS_WG), 0, D, 0, scr, r, lane); continue; } r -= I_SQ;
        p0_transpose_item(a.w_ple, PLE, D, (bf16*)(ws + WS_WPLE), 0, PLE, 0, scr, r, lane);
    }
    f32x4 gpre[4];
#pragma unroll
    for (int j = 0; j < 4; ++j) gpre[j] = ((const GAS f32x4*)a.norm_pre)[lane + 64 * j];
    bf16* H = (bf16*)(ws + WS_RA); bf16* PB = (bf16*)(ws + WS_PBF);
    for (int m = gw; m < M; m += NGW) {
        const GAS f32x4* xr = (const GAS f32x4*)xrow_ptr(a, m) + lane;
        f32x4 v[4]; float s = 0.f;
#pragma unroll
        for (int j = 0; j < 4; ++j) { v[j] = xr[64 * j]; s += (v[j].x * v[j].x + v[j].y * v[j].y) + (v[j].z * v[j].z + v[j].w * v[j].w); }
        const float rstd = 1.0f / sqrtf(wave_sum(s) * (1.f / D) + EPS);
        GAS v2u* o8 = (GAS v2u*)(H + (size_t)m * D) + lane;
#pragma unroll
        for (int j = 0; j < 4; ++j) { const f32x4 y = v[j] * rstd * gpre[j]; o8[64 * j] = (v2u){pk2(y.x, y.y), pk2(y.z, y.w)}; }
        const float* prow = m < MP ? a.p_p + (size_t)m * PLE : a.p_s + (size_t)(m - MP) * PLE;
        const f32x4 pv = ((const GAS f32x4*)prow)[lane];
        ((GAS v2u*)(PB + (size_t)m * PLE))[lane] = (v2u){pk2(pv.x, pv.y), pk2(pv.z, pv.w)};
    }
}

__device__ __forceinline__ void normrope16(bf16* ptr, int t, int qd, const float* gain, float scale) {
    const v4u w0 = ((const GAS v4u*)ptr)[0], w1 = ((const GAS v4u*)ptr)[1];
    float av[16];
    av[0] = blo(w0.x); av[1] = bhi(w0.x); av[2] = blo(w0.y); av[3] = bhi(w0.y); av[4] = blo(w0.z); av[5] = bhi(w0.z); av[6] = blo(w0.w); av[7] = bhi(w0.w);
    av[8] = blo(w1.x); av[9] = bhi(w1.x); av[10] = blo(w1.y); av[11] = bhi(w1.y); av[12] = blo(w1.z); av[13] = bhi(w1.z); av[14] = blo(w1.w); av[15] = bhi(w1.w);
    float ss = 0.f;
#pragma unroll
    for (int i = 0; i < 16; ++i) ss += av[i] * av[i];
    ss += __shfl_xor(ss, 1); ss += __shfl_xor(ss, 2);
    const float rstd = 1.0f / sqrtf(ss * (1.f / 64.f) + EPS);
    const float pos = (qd < 2) ? (float)(t >> 6) : (float)(t & 63);
    const float sgn = (qd & 1) ? 1.f : -1.f;
    float o[16];
#pragma unroll
    for (int i4 = 0; i4 < 4; ++i4) { const f32x4 g = ((const GAS f32x4*)(gain + qd * 16))[i4];
        av[4 * i4 + 0] *= rstd * g.x; av[4 * i4 + 1] *= rstd * g.y; av[4 * i4 + 2] *= rstd * g.z; av[4 * i4 + 3] *= rstd * g.w; }
#pragma unroll
    for (int i = 0; i < 16; ++i) {
        const float pr = __shfl_xor(av[i], 1);
        const float freq = __builtin_amdgcn_exp2f(-(float)i * 0.83048202372184058696f);
        float rev = pos * freq * 0.15915494309189533577f; rev = __builtin_amdgcn_fractf(rev);
        const float sn = __builtin_amdgcn_sinf(rev), cs = __builtin_amdgcn_cosf(rev);
        o[i] = (av[i] * cs + sgn * pr * sn) * scale;
    }
    v4u r0, r1;
    r0.x = pk2(o[0], o[1]); r0.y = pk2(o[2], o[3]); r0.z = pk2(o[4], o[5]); r0.w = pk2(o[6], o[7]);
    r1.x = pk2(o[8], o[9]); r1.y = pk2(o[10], o[11]); r1.z = pk2(o[12], o[13]); r1.w = pk2(o[14], o[15]);
    ((GAS v4u*)ptr)[0] = r0; ((GAS v4u*)ptr)[1] = r1;
}
__device__ __forceinline__ int tok_of_row(int m) { return m < MP ? (m & (TP - 1)) : (m & (TS - 1)); }
__device__ __forceinline__ void phase2(const Args& a, int vcu, int G) {
    int tid = threadIdx.x; asm volatile("" : "+v"(tid));
    const int lane = tid & 63, wave = __builtin_amdgcn_readfirstlane(tid >> 6);
    bf16* K = (bf16*)(a.ws + WS_RK);
    const int gw = vcu * NWAVES + wave, NGW = G * NWAVES;
    for (int m4 = gw; m4 < M / 4; m4 += NGW) { const int m = m4 * 4 + (lane >> 4); normrope16(K + (size_t)m * 256 + (lane & 15) * 16, tok_of_row(m), lane & 3, a.k_norm, 1.0f); }
}
template <int W> __device__ __forceinline__ void pool_item(const bf16* Z, const bf16* SZA, bf16* AO, const float* pscale, int g, int rb, int cc, int rsub) {
    const f32x4 ps0 = *(const GAS f32x4*)(pscale + g * 256 + cc * 8), ps1 = *(const GAS f32x4*)(pscale + g * 256 + cc * 8 + 4);
    constexpr int half = W / 2;
#pragma unroll 1
    for (int rr = 0; rr < 4; ++rr) {
        const int m = rb * 64 + rr * 16 + rsub;
        const int T = m < MP ? TP : TS, s0 = m < MP ? (m & ~(TP - 1)) : (m & ~(TS - 1)), t = m - s0;
        const bf16* colp = Z + (size_t)s0 * D + g * 256 + cc * 8;
        v4u wv[W];
#pragma unroll
        for (int i = 0; i < W; ++i) { const int sidx = t - half + i; const int sc = min(max(sidx, 0), T - 1); wv[i] = *(const GAS v4u*)(colp + (size_t)sc * D); }
        const v4u gz = *(const GAS v4u*)(SZA + (size_t)m * D + g * 256 + cc * 8);
        float acc[8];
#pragma unroll
        for (int e = 0; e < 8; ++e) acc[e] = 0.f;
#pragma unroll
        for (int i = 0; i < W; ++i) { const int sidx = t - half + i; const float wgt = (sidx >= 0 && sidx < T) ? 1.f : 0.f; const v4u w = wv[i];
            acc[0] += wgt * blo(w.x); acc[1] += wgt * bhi(w.x); acc[2] += wgt * blo(w.y); acc[3] += wgt * bhi(w.y); acc[4] += wgt * blo(w.z); acc[5] += wgt * bhi(w.z); acc[6] += wgt * blo(w.w); acc[7] += wgt * bhi(w.w); }
        const v4u own = wv[half];
        const int lo = max(t - half, 0), hi = min(t + half, T);
        const float inv = 1.0f / (float)(hi - lo);
        v4u o; o.x = pk2((acc[0] * inv - blo(own.x)) * ps0.x * blo(gz.x), (acc[1] * inv - bhi(own.x)) * ps0.y * bhi(gz.x));
        o.y = pk2((acc[2] * inv - blo(own.y)) * ps0.z * blo(gz.y), (acc[3] * inv - bhi(own.y)) * ps0.w * bhi(gz.y));
        o.z = pk2((acc[4] * inv - blo(own.z)) * ps1.x * blo(gz.z), (acc[5] * inv - bhi(own.z)) * ps1.y * bhi(gz.z));
        o.w = pk2((acc[6] * inv - blo(own.w)) * ps1.z * blo(gz.w), (acc[7] * inv - bhi(own.w)) * ps1.w * bhi(gz.w));
        *(GAS v4u*)(AO + (size_t)m * D + g * 256 + cc * 8) = o;
    }
}
__device__ __forceinline__ void pool_tail(const Args& a, int vcu, int G) {
    int tid = threadIdx.x; asm volatile("" : "+v"(tid));
    unsigned char* ws = a.ws;
    const bf16* Z = (const bf16*)(ws + WS_RB); const bf16* SZA = (const bf16*)(ws + WS_RC); bf16* AO = (bf16*)(ws + WS_RA);
    const int cc = tid & 31, rsub = tid >> 5;
    for (int it = vcu; it < (M / 64) * 4; it += G) {
        const int g = it & 3, rb = it >> 2;
        if (g == 0) pool_item<2>(Z, SZA, AO, a.pool_scale, g, rb, cc, rsub);
        else if (g == 1) pool_item<4>(Z, SZA, AO, a.pool_scale, g, rb, cc, rsub);
        else if (g == 2) pool_item<8>(Z, SZA, AO, a.pool_scale, g, rb, cc, rsub);
        else pool_item<16>(Z, SZA, AO, a.pool_scale, g, rb, cc, rsub);
    }
}

__device__ __forceinline__ void phase6(const Args& a, int vcu, int G) {
    int tid = threadIdx.x; asm volatile("" : "+v"(tid));
    const int lane = tid & 63, wave = __builtin_amdgcn_readfirstlane(tid >> 6);
    unsigned char* ws = a.ws;
    const bf16* Y = (const bf16*)(ws + WS_RA); bf16* H2 = (bf16*)(ws + WS_RB);
    const int gw = vcu * NWAVES + wave, NGW = G * NWAVES;
    f32x4 gpost[4], gple[4];
#pragma unroll
    for (int j = 0; j < 4; ++j) { gpost[j] = ((const GAS f32x4*)a.norm_post)[lane + 64 * j]; gple[j] = ((const GAS f32x4*)a.ple_norm)[lane + 64 * j]; }
    for (int m = gw; m < M; m += NGW) {
        const GAS f32x4* xr = (const GAS f32x4*)xrow_ptr(a, m) + lane;
        const GAS v2u* yr = (const GAS v2u*)(Y + (size_t)m * D) + lane;
        f32x4 xv[4], yv[4]; float s = 0.f;
#pragma unroll
        for (int j = 0; j < 4; ++j) { xv[j] = xr[64 * j]; const v2u w = yr[64 * j]; yv[j] = (f32x4){blo(w.x), bhi(w.x), blo(w.y), bhi(w.y)};
            s += (yv[j].x * yv[j].x + yv[j].y * yv[j].y) + (yv[j].z * yv[j].z + yv[j].w * yv[j].w); }
        const float rstd = 1.0f / sqrtf(wave_sum(s) * (1.f / D) + EPS);
        float s2 = 0.f;
        GAS f32x4* orow = (GAS f32x4*)(a.out + (size_t)m * D) + lane;
#pragma unroll
        for (int j = 0; j < 4; ++j) { xv[j] = xv[j] + yv[j] * rstd * gpost[j]; orow[64 * j] = xv[j];
            s2 += (xv[j].x * xv[j].x + xv[j].y * xv[j].y) + (xv[j].z * xv[j].z + xv[j].w * xv[j].w); }
        const float rstd2 = 1.0f / sqrtf(wave_sum(s2) * (1.f / D) + EPS);
        GAS v2u* o8 = (GAS v2u*)(H2 + (size_t)m * D) + lane;
#pragma unroll
        for (int j = 0; j < 4; ++j) { const f32x4 y = xv[j] * rstd2 * gple[j]; o8[64 * j] = (v2u){pk2(y.x, y.y), pk2(y.z, y.w)}; }
    }
}

__device__ __forceinline__ bool attn_next(int i, int vcu, int G, long& qrow0, long& kvrow0, int& NT, int& h) {
    int samp, b, qb;
    if (G == 256) {
        if (i >= 20) return false;
        const int x = vcu >> 5, j = vcu & 31; b = x;
        if (i < 16) { samp = 0; h = (i >> 2) * 4 + (i & 3); qb = j; }
        else { samp = 1; h = (i - 16) * 4 + (j >> 3); qb = j & 7; }
    } else {
        const int uid = vcu + i * G; if (uid >= 5120) return false;
        if (uid < 4096) { samp = 0; b = uid >> 9; h = (uid >> 5) & 15; qb = uid & 31; }
        else { const int r = uid - 4096; samp = 1; b = r >> 7; h = (r >> 3) & 15; qb = r & 7; }
    }
    if (!samp) { kvrow0 = (long)b * TP; NT = TP / 64; } else { kvrow0 = (long)MP + (long)b * TS; NT = TS / 64; }
    qrow0 = kvrow0 + qb * 256;
    return true;
}

__global__ void __launch_bounds__(NWAVES * 64, 2) fwd_megakernel(Args args) {
    extern __shared__ __attribute__((aligned(16))) unsigned char lds_raw[];
    LAS unsigned char* lds = (LAS unsigned char*)lds_raw;
    const int G = gridDim.x; const int bx = blockIdx.x; const int vcu = (G % 8 == 0) ? (bx % 8) * (G / 8) + bx / 8 : bx;
    cg::grid_group grid = cg::this_grid();
    unsigned char* ws = args.ws;
    const int lo = args.ph_lo, hi = args.ph_hi;
#ifndef PH_MASK
#define PH_MASK 0xFF
#endif
#define IN(k) ((((PH_MASK) >> (k)) & 1) && lo <= (k) && (k) < hi)
#ifndef DUP_MASK
#define DUP_MASK 0
#endif
#define REPS(k) ((((DUP_MASK) >> (k)) & 1) ? 2 : 1)
#define SEAM(k) do { if (IN(k) && IN((k) + 1)) { if ((k) == 0) { VM_WAIT(); grid.sync(); VM_WAIT(); } else { xcd_barrier(bar); } } } while (0)
    volatile LAS unsigned* MISC = (volatile LAS unsigned*)(lds + MISC_OFF);
    if (threadIdx.x < 32) MISC[threadIdx.x] = 0u;
    __syncthreads();
    XcdBarrier bar = xcd_barrier_post((unsigned*)(ws + WS_CTL), MISC);
    bf16* RA = (bf16*)(ws + WS_RA); bf16* RB = (bf16*)(ws + WS_RB); bf16* RC = (bf16*)(ws + WS_RC); bf16* RD = (bf16*)(ws + WS_RD); bf16* RE = (bf16*)(ws + WS_RE);
    bf16* RK = (bf16*)(ws + WS_RK); bf16* RV = (bf16*)(ws + WS_RV);
    bf16* MA = (bf16*)args.out; bf16* MB = (bf16*)args.out + (size_t)M * D;

    if (IN(0)) { for (int rep = 0; rep < REPS(0); ++rep) phase0(args, lds, vcu, G); }
    SEAM(0);
    if (IN(1)) for (int rep = 0; rep < REPS(1); ++rep) {
        pg8::Gemm g{RA, RA, (const bf16*)(ws + WS_WIN), D, D, D, D, 0};
        pg8::StaticOrder S; S.init(M, INW, G, bx);
        pg8::EpiIn E{RB, RC, RD, RK, RV, RE, MA, MB};
        pg8::gemm_phase<pg8::EpiIn, pg8::StaticOrder, true, true>(lds, g, S, E);
    }
    SEAM(1);
    if (IN(2)) { phase2(args, vcu, G); }
    SEAM(2);
    if (IN(3)) {
        long qrow0, kvrow0; int NT, h;
        for (int rep = 0; rep < REPS(3); ++rep)
        for (int i = 0; attn_next(i, vcu, G, qrow0, kvrow0, NT, h); ++i)
            attn_body::attn_unit<8>(qrow0, kvrow0, NT, h, (const attn_body::bf16*)RD, (const attn_body::bf16*)RK, (const attn_body::bf16*)RV, (attn_body::bf16*)((REPS(3) == 2 && rep == 0) ? RB : RD), (const attn_body::bf16*)RE, args.q_norm, (char*)lds_raw);
        for (int rep = 0; rep < REPS(8); ++rep) pool_tail(args, vcu, G);
    }
    SEAM(3);
    if (IN(4)) {
        pg8::Gemm g{RA, RD, (const bf16*)(ws + WS_WAB), D, 2048, 2048, 1024, 0};
        pg8::DupOrder S; S.init(M, D, G, bx, REPS(4));
        pg8::EpiMerge E{RC, MA, MB};
        pg8::gemm_phase<pg8::EpiMerge, pg8::DupOrder, true, true>(lds, g, S, E);
    }
    SEAM(4);
    if (IN(5)) {
        { pg8::Gemm g{RC, RC, (const bf16*)(ws + WS_WO), D, D, D, D, 0};
          pg8::DupOrder S; S.init(M, D, G, bx, REPS(5));
          pg8::EpiPlain E{RA, D};
          pg8::gemm_phase<pg8::EpiPlain, pg8::DupOrder, true, true>(lds, g, S, E); }
        { pg8::Gemm g{(const bf16*)(ws + WS_PBF), (const bf16*)(ws + WS_PBF), (const bf16*)(ws + WS_WPLE), PLE, PLE, PLE, PLE, 0};
          pg8::DupOrder S; S.init(M, D, G, bx, REPS(9));
          pg8::EpiPlain E{RD, D};
          pg8::gemm_phase<pg8::EpiPlain, pg8::DupOrder, true, true>(lds, g, S, E); }
    }
    SEAM(5);
    if (IN(6)) { for (int rep = 0; rep < REPS(6); ++rep) phase6(args, vcu, G); }
    SEAM(6);
    if (IN(7)) {
        pg8::Gemm g{RB, RB, (const bf16*)(ws + WS_WG), D, D, D, D, 0};
        pg8::StaticOrder S; S.init(M, D, G, bx);
        pg8::EpiFinal E{args.out, RD};
        pg8::gemm_phase<pg8::EpiFinal, pg8::StaticOrder, true, true>(lds, g, S, E);
    }
#undef IN
#undef SEAM
}

extern "C" void kernel_launch(void* const* d_in, const int* in_sizes, int n_in, void* d_out, int out_size, void* d_ws, size_t ws_size, hipStream_t stream) {
    static int grid = 0;
    if (grid == 0) {
        if (n_in != 17 || in_sizes[0] != MP * D || in_sizes[1] != MS * D || out_size != M * D || ws_size < WS_END) {
            fprintf(stderr, "kernel_launch: unexpected shapes (n_in %d, in0 %d, out %d, ws %zu); nothing launched\n", n_in, n_in > 0 ? in_sizes[0] : -1, out_size, ws_size); grid = -1; return; }
        int dev = 0, cus = 0, per_cu = 0;
        if (hipGetDevice(&dev) != hipSuccess || hipDeviceGetAttribute(&cus, hipDeviceAttributeMultiprocessorCount, dev) != hipSuccess) { fprintf(stderr, "kernel_launch: device query failed\n"); grid = -1; return; }
        if (hipFuncSetAttribute((const void*)fwd_megakernel, hipFuncAttributeMaxDynamicSharedMemorySize, LDS_BYTES) != hipSuccess) { fprintf(stderr, "kernel_launch: hipFuncSetAttribute failed\n"); grid = -1; return; }
        if (hipOccupancyMaxActiveBlocksPerMultiprocessor(&per_cu, (const void*)fwd_megakernel, NWAVES * 64, LDS_BYTES) != hipSuccess || per_cu < 1) { fprintf(stderr, "kernel_launch: occupancy query says %d\n", per_cu); per_cu = 1; }
        (void)hipGetLastError();
        grid = cus * 1;
        (void)per_cu;
    }
    if (grid < 0) return;
    if (hipMemsetAsync((char*)d_ws + WS_CTL, 0, CTL_ZERO_BYTES, stream) != hipSuccess) { fprintf(stderr, "kernel_launch: memset of control words failed\n"); return; }
    Args a{};
    a.x_p = (const float*)d_in[0]; a.x_s = (const float*)d_in[1]; a.p_p = (const float*)d_in[2]; a.p_s = (const float*)d_in[3]; a.norm_pre = (const float*)d_in[4];
    a.w_in = (const float*)d_in[5]; a.pool_w = (const float*)d_in[6]; a.pool_scale = (const float*)d_in[7]; a.w_a = (const float*)d_in[8]; a.q_norm = (const float*)d_in[9];
    a.k_norm = (const float*)d_in[10]; a.w_b = (const float*)d_in[11]; a.w_out = (const float*)d_in[12]; a.norm_post = (const float*)d_in[13]; a.ple_norm = (const float*)d_in[14];
    a.w_gate = (const float*)d_in[15]; a.w_ple = (const float*)d_in[16];
    a.out = (float*)d_out; a.ws = (unsigned char*)d_ws;
    if (N_LAUNCHES == 1) {
        a.ph_lo = 0; a.ph_hi = N_PHASES;
        void* kargs[] = {&a};
        hipError_t e = hipLaunchCooperativeKernel((const void*)fwd_megakernel, dim3(grid), dim3(NWAVES * 64), kargs, LDS_BYTES, stream);
        if (e != hipSuccess) fprintf(stderr, "kernel_launch: cooperative launch failed: %s (grid %d)\n", hipGetErrorString(e), grid);
    } else {
        for (int ph = 0; ph < N_PHASES; ++ph) {
            a.ph_lo = ph; a.ph_hi = ph + 1;
            hipLaunchKernelGGL(fwd_megakernel, dim3(grid), dim3(NWAVES * 64), LDS_BYTES, stream, a);
        }
    }
}
```

```cpp
#include <hip/hip_runtime.h>
#include <hip/hip_cooperative_groups.h>
#include <hip/hip_bf16.h>
#include <cstdio>
#include <cstdint>
#include <cmath>
namespace cg = cooperative_groups;

namespace pg8 {
#define PG8_LAS __attribute__((address_space(3)))
typedef unsigned short bf16_t;
typedef short bf16x8 __attribute__((ext_vector_type(8)));
typedef float f32x4 __attribute__((ext_vector_type(4)));
typedef unsigned u32x4 __attribute__((ext_vector_type(4)));
constexpr int BM = 256, BK = 64, HALF = 128, HTB = HALF * BK * 2  , STAGE_BYTES = 8 * HTB, NXCD = 8, WGM = 8;

__host__ __device__ __forceinline__ int lds_byte(int r, int c) { const int st = (r >> 4) * 2 + (c >> 5), rr = r & 15, cc = c & 31, ob = rr * 64 + cc * 2; return st * 1024 + (ob ^ (((ob >> 9) & 1) << 5)); }
__host__ __device__ __forceinline__ void stage_rc(int b, int& R, int& C) { const int st = b / 1024, sb = b % 1024, swz = sb ^ (((sb >> 9) & 1) << 5); R = (st >> 1) * 16 + swz / 64; C = (st & 1) * 32 + (swz % 64) / 2; }
__host__ __device__ __forceinline__ int perm32(int rho) { const int n = rho >> 4, i = rho & 15; return 8 * (i >> 2) + 4 * n + (i & 3); }

struct Unit { int pm, pn; };
struct Gemm { const bf16_t* A; const bf16_t* A2; const bf16_t* Bt; int lda, ldb, K, K1; size_t a_pn_off; };

struct StaticOrder {
    int nM, nN, nwg, G, c;
    __host__ __device__ void init(int M, int N, int G_, int c_) { nM = M / BM; nN = N / BM; nwg = nM * nN; G = G_; c = c_; }
    __host__ __device__ bool next(int i, Unit& u) const {
        const long L = (long)i * G + c; if (L >= nwg) return false;
        int wgid = (int)L; { const int q = nwg / NXCD, r = nwg % NXCD, xcd = wgid % NXCD, off = wgid / NXCD; wgid = (xcd < r ? xcd * (q + 1) : r * (q + 1) + (xcd - r) * q) + off; }
        const int nig = WGM * nN, gid = wgid / nig, fm = gid * WGM, gsz = (nM - fm) < WGM ? (nM - fm) : WGM;
        u.pm = fm + ((wgid % nig) % gsz); u.pn = (wgid % nig) / gsz; return true;
    }
    __device__ __forceinline__ void a_ready(const Unit&) const {}
    __device__ __forceinline__ void done(const Unit&) const {}
};

__device__ __forceinline__ unsigned cvt_pk_bf16(float lo, float hi) { unsigned r; asm volatile("v_cvt_pk_bf16_f32 %0, %1, %2" : "=v"(r) : "v"(lo), "v"(hi)); return r; }
__device__ __forceinline__ float bf_lo(unsigned w) { return __uint_as_float(w << 16); }
__device__ __forceinline__ float bf_hi(unsigned w) { return __uint_as_float(w & 0xffff0000u); }
__device__ __forceinline__ float fsigmoid(float x) { return __builtin_amdgcn_rcpf(1.0f + __builtin_amdgcn_exp2f(-1.4426950408889634f * x)); }
__device__ __forceinline__ float fsilu(float x) { return x * fsigmoid(x); }
__device__ __forceinline__ u32x4 pack8(const f32x4& v0, const f32x4& v1) { u32x4 w; w.x = cvt_pk_bf16(v0[0], v0[1]); w.y = cvt_pk_bf16(v0[2], v0[3]); w.z = cvt_pk_bf16(v1[0], v1[1]); w.w = cvt_pk_bf16(v1[2], v1[3]); return w; }
__device__ __forceinline__ void unpack8(const u32x4& w, f32x4& v0, f32x4& v1) { v0 = (f32x4){bf_lo(w.x), bf_hi(w.x), bf_lo(w.y), bf_hi(w.y)}; v1 = (f32x4){bf_lo(w.z), bf_hi(w.z), bf_lo(w.w), bf_hi(w.w)}; }

struct EpiIn {
    static constexpr bool PERM = true, AFTER_DRAIN = false, MID = false;
    bf16_t *ua, *sza, *q, *k, *v, *szb, *ma, *mb;
    __device__ __forceinline__ void operator()(const f32x4 (&acc)[2][2][4][2], const Unit& u, int wr, int wc, int fr, int fq) const {
        const int pn = u.pn; bf16_t* base; int ldc = 1024, ct; bool act = false;
        if (pn < 4) { base = ua; ct = pn; }
        else if (pn < 8) { base = sza; ct = pn - 4; act = true; }
        else if (pn < 12) { base = q; ct = pn - 8; }
        else if (pn == 12) { base = k; ct = 0; ldc = 256; }
        else if (pn == 13) { base = v; ct = 0; ldc = 256; }
        else if (pn < 18) { base = szb; ct = pn - 14; act = true; }
        else if (pn < 22) { base = ma; ct = pn - 18; }
        else { base = mb; ct = pn - 22; }
        int row0 = u.pm * BM + wr * 64 + fr, col0 = ct * BM + wc * 32 + 8 * fq; asm volatile("" : "+v"(row0), "+v"(col0));
#pragma unroll
        for (int ai = 0; ai < 2; ++ai)
#pragma unroll
            for (int m = 0; m < 4; ++m) { bf16_t* rowp = base + (size_t)(row0 + ai * HALF + m * 16) * ldc + col0;
#pragma unroll
                for (int bj = 0; bj < 2; ++bj) { f32x4 v0 = acc[ai][bj][m][0], v1 = acc[ai][bj][m][1];
                    if (act) {
#pragma unroll
                        for (int e = 0; e < 4; ++e) { v0[e] = fsilu(v0[e]); v1[e] = fsilu(v1[e]); } }
                    *(u32x4*)(rowp + bj * HALF) = pack8(v0, v1); } }
    }
};
struct EpiPlain {
    static constexpr bool PERM = true, AFTER_DRAIN = false, MID = false;
    bf16_t* O; int ldc;
    __device__ __forceinline__ void operator()(const f32x4 (&acc)[2][2][4][2], const Unit& u, int wr, int wc, int fr, int fq) const {
        int row0 = u.pm * BM + wr * 64 + fr, col0 = u.pn * BM + wc * 32 + 8 * fq; asm volatile("" : "+v"(row0), "+v"(col0));
#pragma unroll
        for (int ai = 0; ai < 2; ++ai)
#pragma unroll
            for (int m = 0; m < 4; ++m) { bf16_t* rowp = O + (size_t)(row0 + ai * HALF + m * 16) * ldc + col0;
#pragma unroll
                for (int bj = 0; bj < 2; ++bj) *(u32x4*)(rowp + bj * HALF) = pack8(acc[ai][bj][m][0], acc[ai][bj][m][1]); }
    }
};
struct EpiMerge {
    static constexpr bool PERM = true, AFTER_DRAIN = false, MID = true;
    bf16_t* O; const bf16_t* ma; const bf16_t* mb;
    __device__ __forceinline__ void mid(f32x4 (&acc)[2][2][4][2], const Unit& u, int wr, int wc, int fr, int fq) const {
        int row0 = u.pm * BM + wr * 64 + fr, col0 = u.pn * BM + wc * 32 + 8 * fq;
        asm volatile("" : "+v"(row0), "+v"(col0));
#pragma unroll
        for (int ai = 0; ai < 2; ++ai) {
            u32x4 aw[4][2], bw[4][2];
#pragma unroll
            for (int m = 0; m < 4; ++m) { const size_t off = (size_t)(row0 + ai * HALF + m * 16) * 1024 + col0;
#pragma unroll
                for (int bj = 0; bj < 2; ++bj) { aw[m][bj] = *(const u32x4*)(ma + off + bj * HALF); bw[m][bj] = *(const u32x4*)(mb + off + bj * HALF); } }
#pragma unroll
            for (int m = 0; m < 4; ++m)
#pragma unroll
                for (int bj = 0; bj < 2; ++bj) { f32x4 a0, a1, b0, b1; unpack8(aw[m][bj], a0, a1); unpack8(bw[m][bj], b0, b1);
#pragma unroll
                    for (int e = 0; e < 4; ++e) {
                        const float ea0 = __builtin_amdgcn_exp2f(-1.4426950408889634f * a0[e]), ea1 = __builtin_amdgcn_exp2f(-1.4426950408889634f * a1[e]);
                        const float eb0 = __builtin_amdgcn_exp2f(-1.4426950408889634f * fmaxf(b0[e], -60.f)), eb1 = __builtin_amdgcn_exp2f(-1.4426950408889634f * fmaxf(b1[e], -60.f));
                        acc[ai][bj][m][0][e] *= (1.0f + eb0) * __builtin_amdgcn_rcpf(1.0f + ea0);
                        acc[ai][bj][m][1][e] *= (1.0f + eb1) * __builtin_amdgcn_rcpf(1.0f + ea1); } }
#pragma unroll
            for (int m = 0; m < 4; ++m) asm volatile("" : "+v"(acc[ai][0][m][0]), "+v"(acc[ai][0][m][1]), "+v"(acc[ai][1][m][0]), "+v"(acc[ai][1][m][1]) :: "memory");
        }
    }
    __device__ __forceinline__ void operator()(const f32x4 (&acc)[2][2][4][2], const Unit& u, int wr, int wc, int fr, int fq) const {
        int row0 = u.pm * BM + wr * 64 + fr, col0 = u.pn * BM + wc * 32 + 8 * fq; asm volatile("" : "+v"(row0), "+v"(col0));
#pragma unroll
        for (int ai = 0; ai < 2; ++ai)
#pragma unroll
            for (int m = 0; m < 4; ++m) { const size_t off = (size_t)(row0 + ai * HALF + m * 16) * 1024 + col0;
#pragma unroll
                for (int bj = 0; bj < 2; ++bj) { const u32x4 bw = *(const u32x4*)(mb + off + bj * HALF); f32x4 b0, b1; unpack8(bw, b0, b1); f32x4 v0 = acc[ai][bj][m][0], v1 = acc[ai][bj][m][1];
#pragma unroll
                    for (int e = 0; e < 4; ++e) { v0[e] *= fsigmoid(fmaxf(b0[e], -60.f)); v1[e] *= fsigmoid(fmaxf(b1[e], -60.f)); }
                    *(u32x4*)(O + off + bj * HALF) = pack8(v0, v1); } }
    }
};
struct EpiFinal {
    static constexpr bool PERM = true, AFTER_DRAIN = false, MID = false;
    float* out; const bf16_t* x1b; const bf16_t* pe; const float* r2;
    __device__ __forceinline__ void operator()(const f32x4 (&acc)[2][2][4][2], const Unit& u, int wr, int wc, int fr, int fq) const {
        int row0 = u.pm * BM + wr * 64 + fr, col0 = u.pn * BM + wc * 32 + 8 * fq; asm volatile("" : "+v"(row0), "+v"(col0));
#pragma unroll
        for (int ai = 0; ai < 2; ++ai)
#pragma unroll
            for (int m = 0; m < 4; ++m) { const int row = row0 + ai * HALF + m * 16; const size_t off = (size_t)row * 1024 + col0; const float rs = r2[row];
#pragma unroll
                for (int bj = 0; bj < 2; ++bj) { const u32x4 pw = *(const u32x4*)(pe + off + bj * HALF), xw = *(const u32x4*)(x1b + off + bj * HALF);
                    f32x4 p0, p1, x0, x1; unpack8(pw, p0, p1); unpack8(xw, x0, x1);
                    float* op = out + off + bj * HALF;
                    f32x4 g0 = acc[ai][bj][m][0], g1 = acc[ai][bj][m][1];
#pragma unroll
                    for (int e = 0; e < 4; ++e) { g0[e] = x0[e] + fsigmoid(rs * g0[e]) * p0[e]; g1[e] = x1[e] + fsigmoid(rs * g1[e]) * p1[e]; }
                    *(f32x4*)op = g0; *(f32x4*)(op + 4) = g1; } }
    }
};
struct DupOrder {
    StaticOrder S; int dup;
    __device__ void init(int M_, int N_, int G_, int c_, int dup_) { S.init(M_, N_, G_, c_); dup = dup_; }
    __device__ bool next(int i, Unit& u) const { if (dup > 1) { const int rounds = S.nwg / S.G; if (i >= dup * rounds) return false; i %= rounds; } return S.next(i, u); }
    __device__ __forceinline__ void a_ready(const Unit&) const {}
    __device__ __forceinline__ void done(const Unit&) const {}
};
template <class Epi, class Sched, bool ALIGN_EPI = false, bool SP2 = false>
__device__ __forceinline__ void gemm_phase(PG8_LAS unsigned char* lds, const Gemm g, const Sched& S, const Epi& E) {
    const int tid = threadIdx.x, wid = __builtin_amdgcn_readfirstlane(tid >> 6), lane = tid & 63, wr = wid >> 2, wc = wid & 3, fr = lane & 15, fq = lane >> 4;
    const int nt = g.K / BK, nth = g.K1 / BK;
    unsigned voffA[2], voffB[2];
#pragma unroll
    for (int i = 0; i < 2; ++i) { int R, C; stage_rc(tid * 16 + i * 8192, R, C); const int Rb = Epi::PERM ? ((R & ~31) + perm32(R & 31)) : R;
        voffA[i] = (unsigned)(R * g.lda + C) * 2u; voffB[i] = (unsigned)(Rb * g.ldb + C) * 2u; }
    const size_t kstep = (size_t)(BK * 2);
    const size_t hstepA = (size_t)HALF * g.lda * 2, hstepB = (size_t)HALF * g.ldb * 2;
    const size_t tstepA = 2 * hstepA, tstepB = 2 * hstepB;
    const unsigned ldsw = (unsigned)wid * 1024u;
    const int aoff = lds_byte(wr * 64 + fr, fq * 8), boff = lds_byte(wc * 32 + fr, fq * 8);
#define PG8_SA(b, h) (((b) * 2 + (h)) * HTB)
#define PG8_SB(b, h) ((4 + (b) * 2 + (h)) * HTB)
#define PG8_STAGE(bufoff, gbase, voff) do { _Pragma("unroll") for (int _i = 0; _i < 2; ++_i) \
        __builtin_amdgcn_global_load_lds((const unsigned*)((const char*)(gbase) + (voff)[_i]), (PG8_LAS unsigned*)(lds + (bufoff) + ldsw + _i * 8192), 16, 0, 0); } while (0)
#define PG8_LDA(dst, b, h) do { _Pragma("unroll") for (int m = 0; m < 4; ++m) _Pragma("unroll") for (int k = 0; k < 2; ++k) dst[m][k] = *(const PG8_LAS bf16x8*)(lds + PG8_SA(b, h) + aoff + m * 2048 + k * 1024); } while (0)
#define PG8_LDB(dst, b, h) do { _Pragma("unroll") for (int n = 0; n < 2; ++n) _Pragma("unroll") for (int k = 0; k < 2; ++k) dst[n][k] = *(const PG8_LAS bf16x8*)(lds + PG8_SB(b, h) + boff + n * 2048 + k * 1024); } while (0)
#define PG8_MMA(ai, bj, At, Bt) do { __builtin_amdgcn_s_setprio(1); _Pragma("unroll") for (int m = 0; m < 4; ++m) _Pragma("unroll") for (int n = 0; n < 2; ++n) _Pragma("unroll") for (int k = 0; k < 2; ++k) \
        acc[ai][bj][m][n] = __builtin_amdgcn_mfma_f32_16x16x32_bf16(Bt[n][k], At[m][k], acc[ai][bj][m][n], 0, 0, 0); __builtin_amdgcn_s_setprio(0); } while (0)
#define PG8_WAIT_V(n) asm volatile("s_waitcnt vmcnt(" #n ")" ::: "memory")
#define PG8_WAIT_L(n) asm volatile("s_waitcnt lgkmcnt(" #n ")" ::: "memory")
#define PG8_BAR __builtin_amdgcn_s_barrier()
#define PG8_SCHED __builtin_amdgcn_sched_barrier(0)
    Unit cur, nxt; int ui = 0;
    if (!S.next(0, cur)) return;
    f32x4 acc[2][2][4][2];
#pragma unroll
    for (int a = 0; a < 2; ++a)
#pragma unroll
        for (int b = 0; b < 2; ++b)
#pragma unroll
            for (int m = 0; m < 4; ++m)
#pragma unroll
                for (int n = 0; n < 2; ++n) acc[a][b][m][n] = (f32x4){0.f, 0.f, 0.f, 0.f};
    bf16x8 At[4][2], B0[2][2], B1[2][2];
    const char* cA = (const char*)g.A + (size_t)cur.pm * tstepA + (size_t)cur.pn * g.a_pn_off; const char* cA2 = (const char*)g.A2 + (size_t)cur.pm * tstepA; const char* cB = (const char*)g.Bt + (size_t)cur.pn * tstepB;
    S.a_ready(cur);
    if constexpr (SP2) {
        PG8_STAGE(PG8_SB(0, 0), cB, voffB); PG8_STAGE(PG8_SB(0, 1), cB + hstepB, voffB); PG8_STAGE(PG8_SA(0, 0), cA, voffA); PG8_STAGE(PG8_SA(0, 1), cA + hstepA, voffA);
        if (wr == 1) PG8_BAR;
        PG8_WAIT_V(2); PG8_BAR;
        PG8_STAGE(PG8_SB(1, 0), cB + kstep, voffB); PG8_STAGE(PG8_SA(1, 0), cA + kstep, voffA); PG8_STAGE(PG8_SB(1, 1), cB + hstepB + kstep, voffB);
        PG8_WAIT_V(6); PG8_BAR;
    } else {
        PG8_STAGE(PG8_SB(0, 0), cB, voffB); PG8_STAGE(PG8_SA(0, 0), cA, voffA); PG8_STAGE(PG8_SB(0, 1), cB + hstepB, voffB); PG8_STAGE(PG8_SA(0, 1), cA + hstepA, voffA);
        if (wr == 1) PG8_BAR;
        PG8_WAIT_V(4); PG8_BAR;
        PG8_STAGE(PG8_SB(1, 0), cB + kstep, voffB); PG8_STAGE(PG8_SA(1, 0), cA + kstep, voffA); PG8_STAGE(PG8_SB(1, 1), cB + hstepB + kstep, voffB);
        PG8_WAIT_V(6); PG8_BAR;
    }
    for (;;) {
        const bool has_next = S.next(ui + 1, nxt);
        const char* nA = has_next ? (const char*)g.A + (size_t)nxt.pm * tstepA + (size_t)nxt.pn * g.a_pn_off : cA; const char* nA2 = has_next ? (const char*)g.A2 + (size_t)nxt.pm * tstepA : cA2; const char* nB = has_next ? (const char*)g.Bt + (size_t)nxt.pn * tstepB : cB;
        for (int t = 0; t < nt; t += 2) {
            const bool last = (t == nt - 2);
            if constexpr (Epi::MID) { if (t == nth) E.mid(acc, cur, wr, wc, fr, fq); }
            const char* a1 = (t + 1 < nth) ? cA + (size_t)(t + 1) * kstep : cA2 + (size_t)(t + 1 - nth) * kstep;
            const char* a2 = last ? nA : ((t + 2 < nth) ? cA + (size_t)(t + 2) * kstep : cA2 + (size_t)(t + 2 - nth) * kstep); const char* b2 = last ? nB : cB + (size_t)(t + 2) * kstep;
            const char* a3 = a2 + kstep; const char* b3 = b2 + kstep;
            if (last && has_next) S.a_ready(nxt);
            if constexpr (SP2) {
            PG8_LDB(B0, 0, 0); PG8_LDB(B1, 0, 1); PG8_SCHED; PG8_LDA(At, 0, 0); PG8_STAGE(PG8_SA(1, 1), a1 + hstepA, voffA);
            PG8_WAIT_V(8); PG8_WAIT_L(0); PG8_BAR; PG8_MMA(0, 0, At, B0); PG8_MMA(0, 1, At, B1); PG8_BAR; PG8_SCHED;
            PG8_LDA(At, 0, 1); PG8_STAGE(PG8_SB(0, 0), b2, voffB); PG8_STAGE(PG8_SB(0, 1), b2 + hstepB, voffB); PG8_STAGE(PG8_SA(0, 0), a2, voffA);
            PG8_WAIT_V(8); PG8_WAIT_L(0); PG8_BAR; PG8_MMA(1, 0, At, B0); PG8_MMA(1, 1, At, B1); PG8_BAR; PG8_SCHED;
            PG8_LDB(B0, 1, 0); PG8_LDB(B1, 1, 1); PG8_SCHED; PG8_LDA(At, 1, 0); PG8_STAGE(PG8_SA(0, 1), a2 + hstepA, voffA);
            PG8_WAIT_V(8); PG8_WAIT_L(0); PG8_BAR; PG8_MMA(0, 0, At, B0); PG8_MMA(0, 1, At, B1); PG8_BAR; PG8_SCHED;
            PG8_LDA(At, 1, 1); PG8_STAGE(PG8_SB(1, 0), b3, voffB); PG8_STAGE(PG8_SB(1, 1), b3 + hstepB, voffB); PG8_STAGE(PG8_SA(1, 0), a3, voffA);
            PG8_WAIT_V(8); PG8_WAIT_L(0); PG8_BAR; PG8_MMA(1, 0, At, B0); PG8_MMA(1, 1, At, B1); PG8_BAR; PG8_SCHED;
            } else {
            PG8_LDB(B0, 0, 0); PG8_SCHED; PG8_LDA(At, 0, 0); PG8_STAGE(PG8_SA(1, 1), a1 + hstepA, voffA);
            PG8_WAIT_L(8); PG8_BAR; PG8_WAIT_L(0); PG8_MMA(0, 0, At, B0); PG8_BAR; PG8_SCHED;
            PG8_LDB(B1, 0, 1); PG8_STAGE(PG8_SB(0, 0), b2, voffB);
            PG8_BAR; PG8_WAIT_L(0); PG8_MMA(0, 1, At, B1); PG8_BAR;
            PG8_LDA(At, 0, 1); PG8_STAGE(PG8_SA(0, 0), a2, voffA);
            PG8_BAR; PG8_WAIT_L(0); PG8_MMA(1, 0, At, B0); PG8_BAR; PG8_SCHED;
            PG8_STAGE(PG8_SB(0, 1), b2 + hstepB, voffB);
            PG8_WAIT_V(6); PG8_BAR; PG8_MMA(1, 1, At, B1); PG8_BAR;
            PG8_LDB(B0, 1, 0); PG8_SCHED; PG8_LDA(At, 1, 0); PG8_STAGE(PG8_SA(0, 1), a2 + hstepA, voffA);
            PG8_WAIT_L(8); PG8_BAR; PG8_WAIT_L(0); PG8_MMA(0, 0, At, B0); PG8_BAR; PG8_SCHED;
            PG8_LDB(B1, 1, 1); PG8_STAGE(PG8_SB(1, 0), b3, voffB);
            PG8_BAR; PG8_WAIT_L(0); PG8_MMA(0, 1, At, B1); PG8_BAR;
            PG8_LDA(At, 1, 1); PG8_STAGE(PG8_SA(1, 0), a3, voffA);
            PG8_BAR; PG8_WAIT_L(0); PG8_MMA(1, 0, At, B0); PG8_BAR; PG8_SCHED;
            PG8_STAGE(PG8_SB(1, 1), b3 + hstepB, voffB);
            PG8_WAIT_V(6); PG8_BAR; PG8_MMA(1, 1, At, B1); PG8_BAR;
            }
        }
        if constexpr (ALIGN_EPI) { if (wr == 0) PG8_BAR; }
        if constexpr (!Epi::AFTER_DRAIN) { E(acc, cur, wr, wc, fr, fq); S.done(cur); }
        if (!has_next) break;
#pragma unroll
        for (int a = 0; a < 2; ++a)
#pragma unroll
            for (int b = 0; b < 2; ++b)
#pragma unroll
                for (int m = 0; m < 4; ++m)
#pragma unroll
                    for (int n = 0; n < 2; ++n) acc[a][b][m][n] = (f32x4){0.f, 0.f, 0.f, 0.f};
        cur = nxt; cA = nA; cA2 = nA2; cB = nB; ++ui;
        if constexpr (ALIGN_EPI) { if (wr == 1) PG8_BAR; }
    }
    PG8_WAIT_V(0);
    if constexpr (!ALIGN_EPI) { if (wr == 0) PG8_BAR; }
    PG8_BAR;
    if constexpr (Epi::AFTER_DRAIN) { E.fused(acc, cur, wr, wc, fr, fq, lds, wid, lane); S.done(cur); }
#undef PG8_SA
#undef PG8_SB
#undef PG8_STAGE
#undef PG8_LDA
#undef PG8_LDB
#undef PG8_MMA
#undef PG8_WAIT_V
#undef PG8_WAIT_L
#undef PG8_BAR
#undef PG8_SCHED
}
}

namespace attn_body {
using bf16=__hip_bfloat16;
using bf16x8=__attribute__((ext_vector_type(8)))short;
using s16x4=__attribute__((ext_vector_type(4)))short;
using f32x16=__attribute__((ext_vector_type(16)))float;
using u32x4=__attribute__((ext_vector_type(4)))unsigned;
constexpr int D=64,QP=1024,KP=256;
constexpr int NW=8,QBLK=32,QB=QBLK*NW,KVBLK=64;

__device__ __forceinline__ int crow(int r,int hi){return (r&3)+8*(r>>2)+4*hi;}
#define SBAR() __builtin_amdgcn_sched_barrier(0)
__device__ __forceinline__ void cmask(f32x16&p0,f32x16&p1,int jb,int qrel,int hi){
  const float NEG=-INFINITY; int kb=64*jb+4*hi;
  #pragma unroll
  for(int r=0;r<16;++r){int kv=kb+(r&3)+8*(r>>2); if(kv>qrel)p0[r]=NEG; if(kv+32>qrel)p1[r]=NEG;}
}

constexpr int NSLOT=3, SLOTB=8192;
constexpr int LDS_K=0, LDS_V=NSLOT*SLOTB, LDS_WS=2*NSLOT*SLOTB, LDS_OST=LDS_WS+NW*64*4, LDS_BYTES=LDS_OST+NW*4096;
constexpr float C2=0.125f*1.4426950408889634f;
__device__ __forceinline__ void glds16(const void*gsrc,unsigned lds_dst){unsigned keep;
  asm volatile("s_mov_b32 %0, m0\n\ts_mov_b32 m0, %2\n\ts_nop 0\n\tglobal_load_lds_dwordx4 %1, off\n\ts_mov_b32 m0, %0":"=&s"(keep):"v"(gsrc),"s"(lds_dst):"memory");}
__device__ __forceinline__ float max3f(float a,float b,float c){float r;asm("v_max3_f32 %0, %1, %2, %3":"=v"(r):"v"(a),"v"(b),"v"(c));return r;}
__device__ __forceinline__ float max2f(float a,float b){float r;asm("v_max_f32_e32 %0, %1, %2":"=v"(r):"v"(a),"v"(b));return r;}
__device__ __forceinline__ float fadd_s(float a,float b){float r;asm("v_add_f32_e32 %0, %1, %2":"=v"(r):"v"(a),"v"(b));return r;}
__device__ __forceinline__ float fsub_s(float a,float b){float r;asm("v_sub_f32_e32 %0, %1, %2":"=v"(r):"v"(a),"v"(b));return r;}
typedef float f32x2_t __attribute__((ext_vector_type(2))); typedef __bf16 bf16x2_t __attribute__((ext_vector_type(2)));
__device__ __forceinline__ unsigned cvtpk_s(float lo,float hi){f32x2_t v={lo,hi};bf16x2_t b=__builtin_convertvector(v,bf16x2_t);return __builtin_bit_cast(unsigned,b);}
#define WAIT_BAR(N) asm volatile("s_waitcnt vmcnt(" #N ") lgkmcnt(0)\n\ts_barrier":::"memory")

__device__ __forceinline__ void qkt(f32x16&p0,f32x16&p1,const char*Kslot,const bf16x8*qr,const f32x16&negm,int r32,int hi){
  const char*kb=Kslot+hi*1024+r32*16;
  #pragma unroll
  for(int d0=0;d0<4;++d0){
    const bf16x8 b0=*reinterpret_cast<const bf16x8*>(kb+d0*2048);
    const bf16x8 b1=*reinterpret_cast<const bf16x8*>(kb+d0*2048+512);
    if(d0==0){p0=__builtin_amdgcn_mfma_f32_32x32x16_bf16(b0,qr[0],negm,0,0,0);p1=__builtin_amdgcn_mfma_f32_32x32x16_bf16(b1,qr[0],negm,0,0,0);}
    else{p0=__builtin_amdgcn_mfma_f32_32x32x16_bf16(b0,qr[d0],p0,0,0,0);p1=__builtin_amdgcn_mfma_f32_32x32x16_bf16(b1,qr[d0],p1,0,0,0);}}
}
typedef __attribute__((address_space(3))) const char* lds_cptr;
typedef short v4i16_t __attribute__((ext_vector_type(4)));
__device__ __forceinline__ void kload8(bf16x8*kf,lds_cptr kp){
  kf[0]=*(const __attribute__((address_space(3))) bf16x8*)(kp);      kf[1]=*(const __attribute__((address_space(3))) bf16x8*)(kp+512);
  kf[2]=*(const __attribute__((address_space(3))) bf16x8*)(kp+2048); kf[3]=*(const __attribute__((address_space(3))) bf16x8*)(kp+2560);
  kf[4]=*(const __attribute__((address_space(3))) bf16x8*)(kp+4096); kf[5]=*(const __attribute__((address_space(3))) bf16x8*)(kp+4608);
  kf[6]=*(const __attribute__((address_space(3))) bf16x8*)(kp+6144); kf[7]=*(const __attribute__((address_space(3))) bf16x8*)(kp+6656);
}
__device__ __forceinline__ void kload2(bf16x8*kf,lds_cptr kp,int j){ kf[2*j]=*(const __attribute__((address_space(3))) bf16x8*)(kp+j*2048); kf[2*j+1]=*(const __attribute__((address_space(3))) bf16x8*)(kp+j*2048+512); }
__device__ __forceinline__ s16x4 vtr(lds_cptr p){ return __builtin_bit_cast(s16x4,__builtin_amdgcn_ds_read_tr16_b64_v4i16((__attribute__((address_space(3))) v4i16_t*)p)); }
__device__ __forceinline__ float rowmax(const f32x16&p0,const f32x16&p1){
  float a=max3f(p0[0],p0[1],p1[0]),b=max3f(p0[2],p0[3],p1[1]);a=max3f(a,p1[2],p1[3]);
  #pragma unroll
  for(int r=4;r<16;r+=4){a=max3f(a,p0[r],p0[r+1]);b=max3f(b,p0[r+2],p0[r+3]);a=max3f(a,p1[r],p1[r+1]);b=max3f(b,p1[r+2],p1[r+3]);}
  const float m=max2f(a,b);
  auto rr=__builtin_amdgcn_permlane32_swap(__float_as_uint(m),__float_as_uint(m),false,false);
  return max2f(__uint_as_float(rr[0]),__uint_as_float(rr[1]));
}
__device__ __forceinline__ void pv(f32x16*o,int vb,bf16x8 pa0,bf16x8 pa1,bf16x8 pa2,bf16x8 pa3){
  #pragma unroll
  for(int d0=0;d0<2;++d0){s16x4 lo[4],hi[4];
    #pragma unroll
    for(int ks=0;ks<4;++ks){
      asm volatile("ds_read_b64_tr_b16 %0,%1 offset:%c2":"=&v"(lo[ks]):"v"(vb),"i"(d0*4096+ks*1024):"memory");
      asm volatile("ds_read_b64_tr_b16 %0,%1 offset:%c2":"=&v"(hi[ks]):"v"(vb),"i"(d0*4096+ks*1024+512):"memory");}
    asm volatile("s_waitcnt lgkmcnt(0)":::"memory");SBAR();
    #define PK(k) (bf16x8){lo[k][0],lo[k][1],lo[k][2],lo[k][3],hi[k][0],hi[k][1],hi[k][2],hi[k][3]}
    o[d0]=__builtin_amdgcn_mfma_f32_32x32x16_bf16(pa0,PK(0),o[d0],0,0,0);
    o[d0]=__builtin_amdgcn_mfma_f32_32x32x16_bf16(pa1,PK(1),o[d0],0,0,0);
    o[d0]=__builtin_amdgcn_mfma_f32_32x32x16_bf16(pa2,PK(2),o[d0],0,0,0);
    o[d0]=__builtin_amdgcn_mfma_f32_32x32x16_bf16(pa3,PK(3),o[d0],0,0,0);
    #undef PK
  }
}
#define ATTN_STORE16(p,v) (*(u32x4*)(p)=(v))
__device__ __forceinline__ float abf_lo(unsigned w){return __uint_as_float(w<<16);}
__device__ __forceinline__ float abf_hi(unsigned w){return __uint_as_float(w&0xffff0000u);}
__device__ __forceinline__ u32x4 mulgate(const u32x4&v,const u32x4&g){u32x4 r;
  r.x=cvtpk_s(abf_lo(v.x)*abf_lo(g.x),abf_hi(v.x)*abf_hi(g.x)); r.y=cvtpk_s(abf_lo(v.y)*abf_lo(g.y),abf_hi(v.y)*abf_hi(g.y));
  r.z=cvtpk_s(abf_lo(v.z)*abf_lo(g.z),abf_hi(v.z)*abf_hi(g.z)); r.w=cvtpk_s(abf_lo(v.w)*abf_lo(g.w),abf_hi(v.w)*abf_hi(g.w)); return r;}
__device__ __forceinline__ void qnormrope(bf16x8*qr,const float*__restrict__ qn,int t,int hi){
  typedef float f4_t __attribute__((ext_vector_type(4)));
  float y[4][8]; float ss=0.f;
  #pragma unroll
  for(int d0=0;d0<4;++d0){ const u32x4 w=__builtin_bit_cast(u32x4,qr[d0]);
    #pragma unroll
    for(int i=0;i<4;++i){ y[d0][2*i]=__uint_as_float(w[i]<<16); y[d0][2*i+1]=__uint_as_float(w[i]&0xffff0000u); ss+=y[d0][2*i]*y[d0][2*i]+y[d0][2*i+1]*y[d0][2*i+1]; } }
  ss+=__shfl_xor(ss,32);
  const float rstd=1.0f/sqrtf(ss*(1.0f/64.0f)+1e-6f);
  #pragma unroll
  for(int d0=0;d0<4;++d0){ const f4_t g0=*(const f4_t*)(qn+16*d0+8*hi), g1=*(const f4_t*)(qn+16*d0+8*hi+4);
    #pragma unroll
    for(int i=0;i<4;++i){ y[d0][i]*=rstd*g0[i]; y[d0][4+i]*=rstd*g1[i]; } }
  const float prow=(float)(t>>6), pcol=(float)(t&63);
  #pragma unroll
  for(int j=0;j<8;++j){
    const float freq=__builtin_amdgcn_exp2f(-(float)(8*hi+j)*0.83048202372184058696f)*0.15915494309189533577f;
    const float rr=__builtin_amdgcn_fractf(prow*freq), rc=__builtin_amdgcn_fractf(pcol*freq);
    const float sr=__builtin_amdgcn_sinf(rr), cr=__builtin_amdgcn_cosf(rr), sc=__builtin_amdgcn_sinf(rc), cc=__builtin_amdgcn_cosf(rc);
    const float a0=y[0][j], b0=y[1][j], a1=y[2][j], b1=y[3][j];
    y[0][j]=(a0*cr-b0*sr)*C2; y[1][j]=(b0*cr+a0*sr)*C2; y[2][j]=(a1*cc-b1*sc)*C2; y[3][j]=(b1*cc+a1*sc)*C2; }
  #pragma unroll
  for(int d0=0;d0<4;++d0){ u32x4 w; w.x=cvtpk_s(y[d0][0],y[d0][1]); w.y=cvtpk_s(y[d0][2],y[d0][3]); w.z=cvtpk_s(y[d0][4],y[d0][5]); w.w=cvtpk_s(y[d0][6],y[d0][7]); qr[d0]=__builtin_bit_cast(bf16x8,w); }
}
template<int THRL> __device__ __forceinline__ void attn_unit(long qrow0,long kvrow0,int NT,int h,const bf16*Q,const bf16*__restrict__ K,const bf16*__restrict__ V,bf16*O,const bf16*__restrict__ Gt,const float*__restrict__ qn,char*shm){
  const int tid=threadIdx.x,lane=tid&63,r32=lane&31,hi=lane>>5; const int wid=__builtin_amdgcn_readfirstlane(tid>>6);
  const bf16*Qw=Q+(qrow0+wid*QBLK)*QP+h*D;
  const bf16*Kh=K+kvrow0*KP+(h>>2)*D,*Vh=V+kvrow0*KP+(h>>2)*D;
  const unsigned lds0=(unsigned)(uintptr_t)shm;
  float*wsf=(float*)(shm+LDS_WS)+wid*64;
  const bf16*ksrc=Kh+(long)lane*KP+wid*8;
  const bf16*vsrc=Vh+(long)(16*(wid&3)+(lane>>2))*KP+(wid>>2)*32+(lane&3)*8;
  const unsigned kdst=lds0+LDS_K+wid*1024, vdst=lds0+LDS_V+wid*1024;
  #define DMA_K(t,slot) glds16(ksrc+(long)(t)*KVBLK*KP,(unsigned)__builtin_amdgcn_readfirstlane(kdst+(slot)))
  #define DMA_V(t,slot) glds16(vsrc+(long)(t)*KVBLK*KP,(unsigned)__builtin_amdgcn_readfirstlane(vdst+(slot)))
  const int vb0=(int)(lds0+LDS_V)+((lane>>4)&1)*32+(lane&3)*8+(4*hi+((lane&15)>>2))*64;
  const char*Kbase=shm+LDS_K; bf16x8 kf[8];
  const lds_cptr shm3=(lds_cptr)shm; const lds_cptr kp0=shm3+LDS_K+hi*1024+r32*16; const lds_cptr vp0=shm3+LDS_V+((lane>>4)&1)*32+(lane&3)*8+(4*hi+((lane&15)>>2))*64;
  DMA_K(0,0);DMA_V(0,0);DMA_K(1,SLOTB);
  bf16x8 qr[4];
  #pragma unroll
  for(int d0=0;d0<4;++d0)qr[d0]=*reinterpret_cast<const bf16x8*>(&Qw[(long)r32*QP+d0*16+hi*8]);
  qnormrope(qr,qn,(int)(qrow0-kvrow0)+wid*QBLK+r32,hi);
  float mhat=0.f,l_reg=0.f;f32x16 o[2];o[0]=f32x16{};o[1]=f32x16{};f32x16 negm=f32x16{};asm volatile("":"+v"(negm));
  #define CMASK(P0,P1,t) do{}while(0)
  bool resc=false;
  #define START(P0,P1) do{ const float rm=rowmax(P0,P1); resc=false; \
    { const float dl=rm; mhat=fadd_s(mhat,dl); \
      _Pragma("unroll") for(int r=0;r<16;++r){P0[r]=fsub_s(P0[r],dl);P1[r]=fsub_s(P1[r],dl);} \
      _Pragma("unroll") for(int r=0;r<16;++r)negm[r]=-mhat; asm volatile("":"+v"(negm)); } \
    _Pragma("unroll") for(int r=0;r<16;++r)P0[r]=__builtin_amdgcn_exp2f(P0[r]); }while(0)
  #define RESC() do{ if(resc){ asm volatile("s_waitcnt lgkmcnt(0)":::"memory"); \
      _Pragma("unroll") for(int d_=0;d_<2;++d_) _Pragma("unroll") for(int r=0;r<16;++r)o[d_][r]*=wsf[crow(r,hi)]; } }while(0)
  f32x16 pA0,pA1,pB0,pB1;
  int sl_prev=0,sl_cur=0,sl_next=SLOTB;
  #define ROT() do{sl_prev=sl_cur;sl_cur=sl_next;sl_next=(sl_next==(NSLOT-1)*SLOTB)?0:sl_next+SLOTB;}while(0)
  DMA_K(2,2*SLOTB);
  WAIT_BAR(3);
  qkt(pA0,pA1,Kbase,qr,negm,r32,hi);asm volatile("s_nop 15\n\ts_nop 7":"+v"(pA0),"+v"(pA1));CMASK(pA0,pA1,0);
  START(pA0,pA1);
  _Pragma("unroll") for(int r=0;r<16;++r)pA1[r]=__builtin_amdgcn_exp2f(pA1[r]);
  WAIT_BAR(0);
  DMA_K(3,0);DMA_V(1,SLOTB);
  ROT();
  kload8(kf,kp0+sl_cur);
  WAIT_BAR(2);
  s16x4 vlo[8],vhi[8]; u32x4 pw0,pw1,pw2,pw3;
  #define PKW(P,B) cvtpk_s(P[B],P[B+1])
  #define PAF(k) __builtin_bit_cast(bf16x8,pw##k)
  #define VFR(i) (bf16x8){vlo[i][0],vlo[i][1],vlo[i][2],vlo[i][3],vhi[i][0],vhi[i][1],vhi[i][2],vhi[i][3]}
  #define PIN(x) asm volatile("":"+v"(x))
  #define MX3(a,b,c) __builtin_fmaxf(__builtin_fmaxf((a),(b)),(c))
  #define GAPA(MF,A0,A1,A2,A3,W0,W1,PW) do{ MF; sacc+=A0; sacc+=A1; sacc+=A2; sacc+=A3; PIN(sacc); W0; W1; PIN(PW); SBAR(); }while(0)
  #define EX(v) __builtin_amdgcn_exp2f(v)
  #define GAPB(MF,X,B) do{ MF; X[B]=EX(X[B]); X[B+1]=EX(X[B+1]); X[B+2]=EX(X[B+2]); X[B+3]=EX(X[B+3]); PIN(X); SBAR(); }while(0)
  #define VRD(i) do{ vlo[i]=vtr(vp_+(((i)>>2)*4096+((i)&3)*1024)); vhi[i]=vtr(vp_+(((i)>>2)*4096+((i)&3)*1024+512)); }while(0)
  #define KRD(G,j) do{ if(G){ kload2(kf,kp0+sl_next,j); SBAR(); } }while(0)
  #define STEP(C0,C1,P0,P1,t,GK,GV,GL) do{ SBAR(); \
    const lds_cptr vp_=vp0+sl_prev; \
    VRD(0); SBAR(); float sacc=(P0[0]+P0[1]); \
    GAPA(C0=__builtin_amdgcn_mfma_f32_32x32x16_bf16(kf[0],qr[0],negm,0,0,0), P0[2],P0[3],P0[4],P0[5],     pw0[0]=PKW(P0,0), pw0[1]=PKW(P0,2), pw0); \
    VRD(4); SBAR(); GAPA(C1=__builtin_amdgcn_mfma_f32_32x32x16_bf16(kf[1],qr[0],negm,0,0,0), P0[6],P0[7],P0[8],P0[9],     pw0[2]=PKW(P0,4), pw0[3]=PKW(P0,6), pw0); \
    VRD(1); SBAR(); GAPA(C0=__builtin_amdgcn_mfma_f32_32x32x16_bf16(kf[2],qr[1],C0,0,0,0),   P0[10],P0[11],P0[12],P0[13], pw1[0]=PKW(P0,8), pw1[1]=PKW(P0,10), pw1); \
    VRD(5); SBAR(); GAPA(C1=__builtin_amdgcn_mfma_f32_32x32x16_bf16(kf[3],qr[1],C1,0,0,0),   P0[14],P0[15],P1[0],P1[1],   pw1[2]=PKW(P0,12),pw1[3]=PKW(P0,14), pw1); \
    VRD(2); SBAR(); GAPA(C0=__builtin_amdgcn_mfma_f32_32x32x16_bf16(kf[4],qr[2],C0,0,0,0),   P1[2],P1[3],P1[4],P1[5],     pw2[0]=PKW(P1,0), pw2[1]=PKW(P1,2), pw2); \
    VRD(6); SBAR(); GAPA(C1=__builtin_amdgcn_mfma_f32_32x32x16_bf16(kf[5],qr[2],C1,0,0,0),   P1[6],P1[7],P1[8],P1[9],     pw2[2]=PKW(P1,4), pw2[3]=PKW(P1,6), pw2); \
    VRD(3); SBAR(); GAPA(C0=__builtin_amdgcn_mfma_f32_32x32x16_bf16(kf[6],qr[3],C0,0,0,0),   P1[10],P1[11],P1[12],P1[13], pw3[0]=PKW(P1,8), pw3[1]=PKW(P1,10), pw3); \
    VRD(7); SBAR(); GAPA(C1=__builtin_amdgcn_mfma_f32_32x32x16_bf16(kf[7],qr[3],C1,0,0,0),   P1[14],P1[15],0.f,0.f,       pw3[2]=PKW(P1,12),pw3[3]=PKW(P1,14), pw3); \
    l_reg+=sacc; \
    if(GK){DMA_K((t)+3,sl_cur);} if(GV){DMA_V((t)+1,sl_next);} \
    CMASK(C0,C1,t); \
    { float a=MX3(C0[0],C0[1],C1[0]),b=MX3(C0[2],C0[3],C1[1]); a=MX3(a,C1[2],C1[3]); \
      _Pragma("unroll") for(int r=4;r<16;r+=4){a=MX3(a,C0[r],C0[r+1]);b=MX3(b,C0[r+2],C0[r+3]);a=MX3(a,C1[r],C1[r+1]);b=MX3(b,C1[r+2],C1[r+3]);} \
      float rm=__builtin_fmaxf(a,b); { auto rr=__builtin_amdgcn_permlane32_swap(__float_as_uint(rm),__float_as_uint(rm),false,false); rm=__builtin_fmaxf(__uint_as_float(rr[0]),__uint_as_float(rr[1])); } \
      resc=false; \
      if(__builtin_expect(__any(rm>(float)THRL),0)){ const float dl=__builtin_fmaxf(rm,0.f); mhat+=dl; \
        _Pragma("unroll") for(int r=0;r<16;++r){C0[r]-=dl;C1[r]-=dl;} \
        _Pragma("unroll") for(int r=0;r<16;++r)negm[r]=-mhat; asm volatile("":"+v"(negm)); \
        const float f=__builtin_amdgcn_exp2f(-dl); l_reg*=f; if(hi==0)wsf[r32]=f; resc=true; } } \
    SBAR(); \
    GAPB(o[0]=__builtin_amdgcn_mfma_f32_32x32x16_bf16(PAF(0),VFR(0),o[0],0,0,0), C0,0); \
    GAPB(o[1]=__builtin_amdgcn_mfma_f32_32x32x16_bf16(PAF(0),VFR(4),o[1],0,0,0), C0,4); \
    KRD(GL,0); GAPB(o[0]=__builtin_amdgcn_mfma_f32_32x32x16_bf16(PAF(1),VFR(1),o[0],0,0,0), C0,8); \
    KRD(GL,1); GAPB(o[1]=__builtin_amdgcn_mfma_f32_32x32x16_bf16(PAF(1),VFR(5),o[1],0,0,0), C0,12); \
    KRD(GL,2); GAPB(o[0]=__builtin_amdgcn_mfma_f32_32x32x16_bf16(PAF(2),VFR(2),o[0],0,0,0), C1,0); \
    KRD(GL,3); GAPB(o[1]=__builtin_amdgcn_mfma_f32_32x32x16_bf16(PAF(2),VFR(6),o[1],0,0,0), C1,4); \
    GAPB(o[0]=__builtin_amdgcn_mfma_f32_32x32x16_bf16(PAF(3),VFR(3),o[0],0,0,0), C1,8); \
    GAPB(o[1]=__builtin_amdgcn_mfma_f32_32x32x16_bf16(PAF(3),VFR(7),o[1],0,0,0), C1,12); \
    }while(0)
  int t=1;
  #undef CMASK
  #define CMASK(P0,P1,t) do{}while(0)
  for(;t+5<NT;t+=2){
    STEP(pB0,pB1,pA0,pA1,t,true,true,true);     WAIT_BAR(2); RESC(); ROT();
    STEP(pA0,pA1,pB0,pB1,t+1,true,true,true);   WAIT_BAR(2); RESC(); ROT();
  }
  #undef CMASK
  #define CMASK(P0,P1,t) do{}while(0)
  #define ENDW(tt) do{ if((tt)+3<NT){WAIT_BAR(2);} else if((tt)+2<NT){WAIT_BAR(1);} else {WAIT_BAR(0);} }while(0)
  for(;t+1<NT;t+=2){
    STEP(pB0,pB1,pA0,pA1,t,(t+3<NT),(t+1<NT),(t+1<NT));       ENDW(t);   RESC(); ROT();
    STEP(pA0,pA1,pB0,pB1,t+1,(t+4<NT),(t+2<NT),(t+2<NT));     ENDW(t+1); RESC(); ROT();
  }
  STEP(pB0,pB1,pA0,pA1,NT-1,false,false,false); RESC();
  { float sacc=pB0[0]+pB0[1]; _Pragma("unroll") for(int r=2;r<16;++r)sacc+=pB0[r]; _Pragma("unroll") for(int r=0;r<16;++r)sacc+=pB1[r]; l_reg+=sacc;
    pw0=(u32x4){PKW(pB0,0),PKW(pB0,2),PKW(pB0,4),PKW(pB0,6)};pw1=(u32x4){PKW(pB0,8),PKW(pB0,10),PKW(pB0,12),PKW(pB0,14)};pw2=(u32x4){PKW(pB1,0),PKW(pB1,2),PKW(pB1,4),PKW(pB1,6)};pw3=(u32x4){PKW(pB1,8),PKW(pB1,10),PKW(pB1,12),PKW(pB1,14)};
    SBAR(); pv(o,vb0+sl_cur,PAF(0),PAF(1),PAF(2),PAF(3)); }
  #undef PKW
  #undef PAF
  #undef VFR
  #undef PIN
  #undef MX3
  #undef GAPA
  #undef GAPB
  #undef EX
  #undef VRD
  #undef KRD
  #undef STEP
  #undef ENDW
  {auto rr=__builtin_amdgcn_permlane32_swap(__float_as_uint(l_reg),__float_as_uint(l_reg),false,false);l_reg=__uint_as_float(rr[0])+__uint_as_float(rr[1]);}
  if(hi==0)wsf[32+r32]=l_reg;asm volatile("s_waitcnt lgkmcnt(0)":::"memory");
  float rli[16];
  #pragma unroll
  for(int r=0;r<16;++r)rli[r]=__builtin_amdgcn_rcpf(wsf[32+crow(r,hi)]);
  bf16*Ow=O+(qrow0+wid*QBLK)*QP+h*D; const bf16*Gw=Gt+(qrow0+wid*QBLK)*QP+h*D;
  { bf16*stg=(bf16*)(shm+LDS_OST)+wid*2048;
    #pragma unroll
    for(int r=0;r<16;++r){const int orow=crow(r,hi);
      #pragma unroll
      for(int d0=0;d0<2;++d0)stg[orow*64+d0*32+r32]=__float2bfloat16(o[d0][r]*rli[r]);}
    asm volatile("s_waitcnt lgkmcnt(0)":::"memory");
    #pragma unroll
    for(int i=0;i<4;++i){const int row=i*8+(lane>>3),ch=lane&7; const u32x4 v=*(const u32x4*)(stg+row*64+ch*8); const u32x4 gv=*(const u32x4*)(Gw+(long)row*QP+ch*8); ATTN_STORE16(Ow+(long)row*QP+ch*8,mulgate(v,gv));} }
  asm volatile("s_waitcnt lgkmcnt(0)\n\ts_barrier":::"memory");
  #undef DMA_K
  #undef DMA_V
  #undef CMASK
  #undef START
  #undef RESC
  #undef ROT
}
constexpr int ATTN_LDS_BYTES=LDS_BYTES;
#undef SBAR
#undef WAIT_BAR
}

constexpr int NWAVES = 8;
constexpr int D = 1024, TP = 8192, TS = 2048, NB = 8;
constexpr int MP = NB * TP, MS = NB * TS, M = MP + MS;
constexpr int INW = 6656, PLE = 256;
constexpr float EPS = 1e-6f;
#ifndef MK_N_LAUNCHES
#define MK_N_LAUNCHES 1
#endif
constexpr int N_LAUNCHES = MK_N_LAUNCHES;
constexpr int N_PHASES = 8;

constexpr size_t MiB = 1u << 20;
constexpr size_t WS_CTL = 0, CTL_ZERO_BYTES = 64 * 1024;
constexpr size_t WS_R2 = 1 * MiB;
constexpr size_t WS_WIN = 2 * MiB;
constexpr size_t WS_WAB = 16 * MiB;
constexpr size_t WS_WO = 20 * MiB;
constexpr size_t WS_WG = 22 * MiB;
constexpr size_t WS_WPLE = 24 * MiB;
constexpr size_t WS_PBF = 26 * MiB;
constexpr size_t WS_RA = 80 * MiB;
constexpr size_t WS_RB = 240 * MiB;
constexpr size_t WS_RC = 400 * MiB;
constexpr size_t WS_RD = 560 * MiB;
constexpr size_t WS_RE = 720 * MiB;
constexpr size_t WS_RK = 880 * MiB;
constexpr size_t WS_RV = 920 * MiB;
constexpr size_t WS_END = 960 * MiB;

constexpr int RING_BYTES = 131072;
constexpr int LDS_BYTES = 147456;
constexpr int MISC_OFF = LDS_BYTES - 256;

#define GAS __attribute__((address_space(1)))
#define LAS __attribute__((address_space(3)))
typedef unsigned short bf16;
typedef unsigned v4u __attribute__((ext_vector_type(4)));
typedef unsigned v2u __attribute__((ext_vector_type(2)));
typedef float f32x4 __attribute__((ext_vector_type(4)));
#define LDS_WAIT() asm volatile("s_waitcnt lgkmcnt(0)" ::: "memory")
#define VM_WAIT() asm volatile("s_waitcnt vmcnt(0)" ::: "memory")
__device__ __forceinline__ unsigned pk2(float lo, float hi) { return pg8::cvt_pk_bf16(lo, hi); }
__device__ __forceinline__ float blo(unsigned w) { return __uint_as_float(w << 16); }
__device__ __forceinline__ float bhi(unsigned w) { return __uint_as_float(w & 0xffff0000u); }

#define XB_TMO      128
#define XB_XCNT(j)  (256  + 64 * (j))
#define XB_XSUB(j)  (1280 + 64 * (j))
#define XB_XGEN(j)  (2304 + 64 * (j))
#define XB_TOP      3328
#define XB_TOPGEN   3392
#define XCD_BAR_WORDS 3456
#define XB_SPIN_CAP (1u << 18)

__device__ __forceinline__ unsigned xb_ld(unsigned* p)              { return __hip_atomic_load(p, __ATOMIC_RELAXED, __HIP_MEMORY_SCOPE_AGENT); }
__device__ __forceinline__ unsigned xb_add(unsigned* p, unsigned v) { return __hip_atomic_fetch_add(p, v, __ATOMIC_RELAXED, __HIP_MEMORY_SCOPE_AGENT); }
__device__ __forceinline__ unsigned xb_xcc_id() { return (unsigned)__builtin_amdgcn_s_getreg((3 << 11) | 20) & 0xFu; }
#define XB_SPIN(cond, bar) do { unsigned _sp = 0; while (cond) { __builtin_amdgcn_s_sleep(1); \
    if ((++_sp & 255u) == 0u) { if (xb_ld(&(bar)[XB_TMO])) break; if (_sp > XB_SPIN_CAP) { atomicAdd(&(bar)[XB_TMO], 1u); break; } } } } while (0)

struct XcdBarrier {
    unsigned* bar; unsigned x;
    volatile LAS unsigned* st;
};

__device__ __forceinline__ XcdBarrier xcd_barrier_post(unsigned* bar, volatile LAS unsigned* st) {
    XcdBarrier b; b.bar = bar; b.x = xb_xcc_id(); b.st = st;
    if (threadIdx.x == 0) (void)xb_add(&bar[XB_XCNT(b.x)], 1u);
    return b;
}
__device__ __forceinline__ void xcd_barrier_complete(unsigned* bar, unsigned x, unsigned& nloc, unsigned& nx) {
    const unsigned G = gridDim.x * gridDim.y * gridDim.z;
    unsigned sum, cnt, mine, sp = 0u;
    for (;;) {
        sum = 0u; cnt = 0u; mine = 0u;
#pragma unroll
        for (unsigned j = 0; j < 16; ++j) { const unsigned c = xb_ld(&bar[XB_XCNT(j)]); sum += c; cnt += (c > 0u) ? 1u : 0u; mine = (j == x) ? c : mine; }
        if (sum == G) break;
        __builtin_amdgcn_s_sleep(1);
        if ((++sp & 255u) == 0u) { if (xb_ld(&bar[XB_TMO])) break; if (sp > XB_SPIN_CAP) { atomicAdd(&bar[XB_TMO], 1u); break; } }
    }
    nloc = mine > 0u ? mine : 1u; nx = cnt > 0u ? cnt : 1u;
}

__device__ __forceinline__ void xcd_barrier(const XcdBarrier& b) {
    asm volatile("s_waitcnt vmcnt(0)" ::: "memory");
    __syncthreads();
    if (threadIdx.x == 0) {
        unsigned* bar = b.bar;
        __builtin_amdgcn_s_waitcnt(0);
        unsigned nloc = b.st[0], nx = b.st[1];
        if (nloc == 0u) { xcd_barrier_complete(bar, b.x, nloc, nx); b.st[0] = nloc; b.st[1] = nx; }
        const unsigned old = xb_add(&bar[XB_XSUB(b.x)], 1u);
        const unsigned gen = old / nloc;
        if (old + 1u == (gen + 1u) * nloc) {
            __builtin_amdgcn_fence(__ATOMIC_RELEASE, "agent");
            asm volatile("s_waitcnt vmcnt(0)" ::: "memory");
            const unsigned og = xb_add(&bar[XB_TOP], 1u);
            const unsigned tg = og / nx;
            if (og + 1u == (tg + 1u) * nx) xb_add(&bar[XB_TOPGEN], 1u);
            else XB_SPIN(xb_ld(&bar[XB_TOPGEN]) == tg, bar);
            __builtin_amdgcn_fence(__ATOMIC_ACQUIRE, "agent");
            xb_add(&bar[XB_XGEN(b.x)], 1u);
            asm volatile("s_waitcnt vmcnt(0)" ::: "memory");
        } else {
            XB_SPIN(xb_ld(&bar[XB_XGEN(b.x)]) == gen, bar);
            __builtin_amdgcn_fence(__ATOMIC_ACQUIRE, "agent");
            asm volatile("s_waitcnt vmcnt(0)" ::: "memory");
        }
    }
    __syncthreads();
}

struct Args {
    const float *x_p, *x_s, *p_p, *p_s, *norm_pre, *w_in, *pool_w, *pool_scale, *w_a, *q_norm, *k_norm, *w_b, *w_out, *norm_post, *ple_norm, *w_gate, *w_ple;
    float* out; unsigned char* ws; int ph_lo, ph_hi;
};

__device__ __forceinline__ float wave_sum(float v) {
#pragma unroll
    for (int o = 1; o < 64; o <<= 1) v += __shfl_xor(v, o);
    return v;
}
__device__ __forceinline__ void p0_transpose_item(const float* W, int K, int N, bf16* WT, int row_off, int ldt, int koff, LAS float* scr, int item, int lane, const float* kscale = nullptr) {
    const int nblk = N / 32, kb = item / nblk, nb = item % nblk, k0 = 64 * kb, n0 = 32 * nb;
#pragma unroll 8
    for (int i = 0; i < 32; ++i) { const int kk = 2 * i + (lane >> 5); float wv = W[(size_t)(k0 + kk) * N + n0 + (lane & 31)]; if (kscale) wv *= kscale[k0 + kk]; scr[kk * 33 + (lane & 31)] = wv; }
    LDS_WAIT(); asm volatile("" ::: "memory");
    const int c = lane & 7;
#pragma unroll
    for (int j = 0; j < 4; ++j) { const int n = (lane >> 3) + 8 * j; const LAS float* s = scr + (8 * c) * 33 + n;
        v4u o; o.x = pk2(s[0 * 33], s[1 * 33]); o.y = pk2(s[2 * 33], s[3 * 33]); o.z = pk2(s[4 * 33], s[5 * 33]); o.w = pk2(s[6 * 33], s[7 * 33]);
        *(GAS v4u*)(WT + (size_t)(row_off + n0 + n) * ldt + koff + k0 + 8 * c) = o; }
    LDS_WAIT(); asm volatile("" ::: "memory");
}
__device__ __forceinline__ const float* xrow_ptr(const Args& a, int m) { return m < MP ? a.x_p + (size_t)m * D : a.x_s + (size_t)(m - MP) * D; }

__device__ __forceinline__ void phase0(const Args& a, LAS unsigned char* lds, int vcu, int G) {
    int tid = threadIdx.x; asm volatile("" : "+v"(tid));
    const int lane = tid & 63, wave = __builtin_amdgcn_readfirstlane(tid >> 6);
    LAS float* scr = (LAS float*)(lds + wave * 16384);
    const int gw = vcu * NWAVES + wave, NGW = G * NWAVES;
    unsigned char* ws = a.ws;
    {
        LAS float* At = (LAS float*)lds; LAS float* Bt = (LAS float*)(lds + 64 * 257 * 4 + 64);
        bf16* WT = (bf16*)(ws + WS_WIN);
        for (int tile = vcu; tile < 256; tile += G) {
            const int kb = tile >> 4, g = (tile >> 2) & 3, db = tile & 3, k0 = 64 * kb, d0 = 64 * db;
#pragma unroll
            for (int i = 0; i < 8; ++i) { const int row = (tid >> 6) + 8 * i, c4 = tid & 63;
                const f32x4 v = *(const GAS f32x4*)(a.w_in + (size_t)(k0 + row) * INW + g * 256 + 4 * c4);
                LAS float* d = At + row * 257 + 4 * c4; d[0] = v.x; d[1] = v.y; d[2] = v.z; d[3] = v.w; }
#pragma unroll
            for (int i = 0; i < 8; ++i) { const int c = (tid >> 4) + 32 * i, c4 = tid & 15;
                *(LAS f32x4*)(Bt + c * 64 + 4 * c4) = *(const GAS f32x4*)(a.pool_w + (size_t)g * 65536 + (size_t)c * 256 + d0 + 4 * c4); }
            __syncthreads();
            float acc[8];
#pragma unroll
            for (int j = 0; j < 8; ++j) acc[j] = 0.f;
#pragma unroll 4
            for (int c = 0; c < 256; ++c) { const float av = At[lane * 257 + c]; const f32x4 b0 = *(const LAS f32x4*)(Bt + c * 64 + wave * 8), b1 = *(const LAS f32x4*)(Bt + c * 64 + wave * 8 + 4);
                acc[0] += av * b0.x; acc[1] += av * b0.y; acc[2] += av * b0.z; acc[3] += av * b0.w; acc[4] += av * b1.x; acc[5] += av * b1.y; acc[6] += av * b1.z; acc[7] += av * b1.w; }
#pragma unroll
            for (int j = 0; j < 8; ++j) WT[(size_t)(g * 256 + d0 + wave * 8 + j) * D + k0 + lane] = (bf16)(pk2(acc[j], 0.f) & 0xffffu);
            __syncthreads();
        }
    }
    constexpr int I_IN = (D / 64) * ((INW - 1024) / 32), I_SQ = (D / 64) * (D / 32), I_PLE = (PLE / 64) * (D / 32);
    constexpr int NITEMS = I_IN + 4 * I_SQ + I_PLE;
    for (int it = gw; it < NITEMS; it += NGW) {
        int r = it;
        if (r < I_IN) { const int kb = r / 176, nb = 32 + r % 176; p0_transpose_item(a.w_in, D, INW, (bf16*)(ws + WS_WIN), 0, D, 0, scr, kb * (INW / 32) + nb, lane); continue; } r -= I_IN;
        if (r < I_SQ) { p0_transpose_item(a.w_a, D, D, (bf16*)(ws + WS_WAB), 0, 2048, 0, scr, r, lane); continue; } r -= I_SQ;
        if (r < I_SQ) { p0_transpose_item(a.w_b, D, D, (bf16*)(ws + WS_WAB), 0, 2048, 1024, scr, r, lane); continue; } r -= I_SQ;
        if (r < I_SQ) { p0_transpose_item(a.w_out, D, D, (bf16*)(ws + WS_WO), 0, D, 0, scr, r, lane); continue; } r -= I_SQ;
        if (r < I_SQ) { p0_transpose_item(a.w_gate, D, D, (bf16*)(ws + WS_WG), 0, D, 0, scr, r, lane, a.ple_norm); continue; } r -= I_SQ;
        p0_transpose_item(a.w_ple, PLE, D, (bf16*)(ws + WS_WPLE), 0, PLE, 0, scr, r, lane);
    }
    f32x4 gpre[4];
#pragma unroll
    for (int j = 0; j < 4; ++j) gpre[j] = ((const GAS f32x4*)a.norm_pre)[lane + 64 * j];
    bf16* H = (bf16*)(ws + WS_RA); bf16* PB = (bf16*)(ws + WS_PBF);
    for (int m = gw; m < M; m += NGW) {
        const GAS f32x4* xr = (const GAS f32x4*)xrow_ptr(a, m) + lane;
        f32x4 v[4]; float s = 0.f;
#pragma unroll
        for (int j = 0; j < 4; ++j) { v[j] = xr[64 * j]; s += (v[j].x * v[j].x + v[j].y * v[j].y) + (v[j].z * v[j].z + v[j].w * v[j].w); }
        const float rstd = 1.0f / sqrtf(wave_sum(s) * (1.f / D) + EPS);
        GAS v2u* o8 = (GAS v2u*)(H + (size_t)m * D) + lane;
#pragma unroll
        for (int j = 0; j < 4; ++j) { const f32x4 y = v[j] * rstd * gpre[j]; o8[64 * j] = (v2u){pk2(y.x, y.y), pk2(y.z, y.w)}; }
        const float* prow = m < MP ? a.p_p + (size_t)m * PLE : a.p_s + (size_t)(m - MP) * PLE;
        const f32x4 pv = ((const GAS f32x4*)prow)[lane];
        ((GAS v2u*)(PB + (size_t)m * PLE))[lane] = (v2u){pk2(pv.x, pv.y), pk2(pv.z, pv.w)};
    }
}

__device__ __forceinline__ void normrope16(bf16* ptr, int t, int qd, const float* gain, float scale) {
    const v4u w0 = ((const GAS v4u*)ptr)[0], w1 = ((const GAS v4u*)ptr)[1];
    float av[16];
    av[0] = blo(w0.x); av[1] = bhi(w0.x); av[2] = blo(w0.y); av[3] = bhi(w0.y); av[4] = blo(w0.z); av[5] = bhi(w0.z); av[6] = blo(w0.w); av[7] = bhi(w0.w);
    av[8] = blo(w1.x); av[9] = bhi(w1.x); av[10] = blo(w1.y); av[11] = bhi(w1.y); av[12] = blo(w1.z); av[13] = bhi(w1.z); av[14] = blo(w1.w); av[15] = bhi(w1.w);
    float ss = 0.f;
#pragma unroll
    for (int i = 0; i < 16; ++i) ss += av[i] * av[i];
    ss += __shfl_xor(ss, 1); ss += __shfl_xor(ss, 2);
    const float rstd = 1.0f / sqrtf(ss * (1.f / 64.f) + EPS);
    const float pos = (qd < 2) ? (float)(t >> 6) : (float)(t & 63);
    const float sgn = (qd & 1) ? 1.f : -1.f;
    float o[16];
#pragma unroll
    for (int i4 = 0; i4 < 4; ++i4) { const f32x4 g = ((const GAS f32x4*)(gain + qd * 16))[i4];
        av[4 * i4 + 0] *= rstd * g.x; av[4 * i4 + 1] *= rstd * g.y; av[4 * i4 + 2] *= rstd * g.z; av[4 * i4 + 3] *= rstd * g.w; }
#pragma unroll
    for (int i = 0; i < 16; ++i) {
        const float pr = __shfl_xor(av[i], 1);
        const float freq = __builtin_amdgcn_exp2f(-(float)i * 0.83048202372184058696f);
        float rev = pos * freq * 0.15915494309189533577f; rev = __builtin_amdgcn_fractf(rev);
        const float sn = __builtin_amdgcn_sinf(rev), cs = __builtin_amdgcn_cosf(rev);
        o[i] = (av[i] * cs + sgn * pr * sn) * scale;
    }
    v4u r0, r1;
    r0.x = pk2(o[0], o[1]); r0.y = pk2(o[2], o[3]); r0.z = pk2(o[4], o[5]); r0.w = pk2(o[6], o[7]);
    r1.x = pk2(o[8], o[9]); r1.y = pk2(o[10], o[11]); r1.z = pk2(o[12], o[13]); r1.w = pk2(o[14], o[15]);
    ((GAS v4u*)ptr)[0] = r0; ((GAS v4u*)ptr)[1] = r1;
}
__device__ __forceinline__ int tok_of_row(int m) { return m < MP ? (m & (TP - 1)) : (m & (TS - 1)); }
__device__ __forceinline__ void phase2(const Args& a, int vcu, int G) {
    int tid = threadIdx.x; asm volatile("" : "+v"(tid));
    const int lane = tid & 63, wave = __builtin_amdgcn_readfirstlane(tid >> 6);
    bf16* K = (bf16*)(a.ws + WS_RK);
    const int gw = vcu * NWAVES + wave, NGW = G * NWAVES;
    for (int m4 = gw; m4 < M / 4; m4 += NGW) { const int m = m4 * 4 + (lane >> 4); normrope16(K + (size_t)m * 256 + (lane & 15) * 16, tok_of_row(m), lane & 3, a.k_norm, 1.0f); }
}
template <int W> __device__ __forceinline__ void pool_item(const bf16* Z, const bf16* SZA, bf16* AO, const float* pscale, int g, int rb, int cc, int rsub) {
    const f32x4 ps0 = *(const GAS f32x4*)(pscale + g * 256 + cc * 8), ps1 = *(const GAS f32x4*)(pscale + g * 256 + cc * 8 + 4);
    constexpr int half = W / 2;
#pragma unroll 1
    for (int rr = 0; rr < 4; ++rr) {
        const int m = rb * 64 + rr * 16 + rsub;
        const int T = m < MP ? TP : TS, s0 = m < MP ? (m & ~(TP - 1)) : (m & ~(TS - 1)), t = m - s0;
        const bf16* colp = Z + (size_t)s0 * D + g * 256 + cc * 8;
        v4u wv[W];
#pragma unroll
        for (int i = 0; i < W; ++i) { const int sidx = t - half + i; const int sc = min(max(sidx, 0), T - 1); wv[i] = *(const GAS v4u*)(colp + (size_t)sc * D); }
        const v4u gz = *(const GAS v4u*)(SZA + (size_t)m * D + g * 256 + cc * 8);
        float acc[8];
#pragma unroll
        for (int e = 0; e < 8; ++e) acc[e] = 0.f;
#pragma unroll
        for (int i = 0; i < W; ++i) { const int sidx = t - half + i; const float wgt = (sidx >= 0 && sidx < T) ? 1.f : 0.f; const v4u w = wv[i];
            acc[0] += wgt * blo(w.x); acc[1] += wgt * bhi(w.x); acc[2] += wgt * blo(w.y); acc[3] += wgt * bhi(w.y); acc[4] += wgt * blo(w.z); acc[5] += wgt * bhi(w.z); acc[6] += wgt * blo(w.w); acc[7] += wgt * bhi(w.w); }
        const v4u own = wv[half];
        const int lo = max(t - half, 0), hi = min(t + half, T);
        const float inv = 1.0f / (float)(hi - lo);
        v4u o; o.x = pk2((acc[0] * inv - blo(own.x)) * ps0.x * blo(gz.x), (acc[1] * inv - bhi(own.x)) * ps0.y * bhi(gz.x));
        o.y = pk2((acc[2] * inv - blo(own.y)) * ps0.z * blo(gz.y), (acc[3] * inv - bhi(own.y)) * ps0.w * bhi(gz.y));
        o.z = pk2((acc[4] * inv - blo(own.z)) * ps1.x * blo(gz.z), (acc[5] * inv - bhi(own.z)) * ps1.y * bhi(gz.z));
        o.w = pk2((acc[6] * inv - blo(own.w)) * ps1.z * blo(gz.w), (acc[7] * inv - bhi(own.w)) * ps1.w * bhi(gz.w));
        *(GAS v4u*)(AO + (size_t)m * D + g * 256 + cc * 8) = o;
    }
}
__device__ __forceinline__ void pool_tail(const Args& a, int vcu, int G) {
    int tid = threadIdx.x; asm volatile("" : "+v"(tid));
    unsigned char* ws = a.ws;
    const bf16* Z = (const bf16*)(ws + WS_RB); const bf16* SZA = (const bf16*)(ws + WS_RC); bf16* AO = (bf16*)(ws + WS_RA);
    const int cc = tid & 31, rsub = tid >> 5;
    for (int it = vcu; it < (M / 64) * 4; it += G) {
        const int g = it & 3, rb = it >> 2;
        if (g == 0) pool_item<2>(Z, SZA, AO, a.pool_scale, g, rb, cc, rsub);
        else if (g == 1) pool_item<4>(Z, SZA, AO, a.pool_scale, g, rb, cc, rsub);
        else if (g == 2) pool_item<8>(Z, SZA, AO, a.pool_scale, g, rb, cc, rsub);
        else pool_item<16>(Z, SZA, AO, a.pool_scale, g, rb, cc, rsub);
    }
}

__device__ __forceinline__ void phase6(const Args& a, int vcu, int G) {
    int tid = threadIdx.x; asm volatile("" : "+v"(tid));
    const int lane = tid & 63, wave = __builtin_amdgcn_readfirstlane(tid >> 6);
    unsigned char* ws = a.ws;
    const bf16* Y = (const bf16*)(ws + WS_RA); bf16* X1 = (bf16*)(ws + WS_RB); float* R2 = (float*)(ws + WS_R2);
    const int gw = vcu * NWAVES + wave, NGW = G * NWAVES;
    f32x4 gpost[4];
#pragma unroll
    for (int j = 0; j < 4; ++j) gpost[j] = ((const GAS f32x4*)a.norm_post)[lane + 64 * j];
    for (int m = gw; m < M; m += NGW) {
        const GAS f32x4* xr = (const GAS f32x4*)xrow_ptr(a, m) + lane;
        const GAS v2u* yr = (const GAS v2u*)(Y + (size_t)m * D) + lane;
        f32x4 xv[4], yv[4]; float s = 0.f;
#pragma unroll
        for (int j = 0; j < 4; ++j) { xv[j] = xr[64 * j]; const v2u w = yr[64 * j]; yv[j] = (f32x4){blo(w.x), bhi(w.x), blo(w.y), bhi(w.y)};
            s += (yv[j].x * yv[j].x + yv[j].y * yv[j].y) + (yv[j].z * yv[j].z + yv[j].w * yv[j].w); }
        const float rstd = 1.0f / sqrtf(wave_sum(s) * (1.f / D) + EPS);
        float s2 = 0.f;
        GAS v2u* o8 = (GAS v2u*)(X1 + (size_t)m * D) + lane;
#pragma unroll
        for (int j = 0; j < 4; ++j) { xv[j] = xv[j] + yv[j] * rstd * gpost[j]; o8[64 * j] = (v2u){pk2(xv[j].x, xv[j].y), pk2(xv[j].z, xv[j].w)};
            s2 += (xv[j].x * xv[j].x + xv[j].y * xv[j].y) + (xv[j].z * xv[j].z + xv[j].w * xv[j].w); }
        const float rstd2 = 1.0f / sqrtf(wave_sum(s2) * (1.f / D) + EPS);
        if (lane == 0) R2[m] = rstd2;
    }
}

__device__ __forceinline__ bool attn_next(int i, int vcu, int G, long& qrow0, long& kvrow0, int& NT, int& h) {
    int samp, b, qb;
    if (G == 256) {
        if (i >= 20) return false;
        const int x = vcu >> 5, j = vcu & 31; b = x;
        if (i < 16) { samp = 0; h = (i >> 2) * 4 + (i & 3); qb = j; }
        else { samp = 1; h = (i - 16) * 4 + (j >> 3); qb = j & 7; }
    } else {
        const int uid = vcu + i * G; if (uid >= 5120) return false;
        if (uid < 4096) { samp = 0; b = uid >> 9; h = (uid >> 5) & 15; qb = uid & 31; }
        else { const int r = uid - 4096; samp = 1; b = r >> 7; h = (r >> 3) & 15; qb = r & 7; }
    }
    if (!samp) { kvrow0 = (long)b * TP; NT = TP / 64; } else { kvrow0 = (long)MP + (long)b * TS; NT = TS / 64; }
    qrow0 = kvrow0 + qb * 256;
    return true;
}

__global__ void __launch_bounds__(NWAVES * 64, 2) fwd_megakernel(Args args) {
    extern __shared__ __attribute__((aligned(16))) unsigned char lds_raw[];
    LAS unsigned char* lds = (LAS unsigned char*)lds_raw;
    const int G = gridDim.x; const int bx = blockIdx.x; const int vcu = (G % 8 == 0) ? (bx % 8) * (G / 8) + bx / 8 : bx;
    cg::grid_group grid = cg::this_grid();
    unsigned char* ws = args.ws;
    const int lo = args.ph_lo, hi = args.ph_hi;
#ifndef PH_MASK
#define PH_MASK 0xFF
#endif
#define IN(k) ((((PH_MASK) >> (k)) & 1) && lo <= (k) && (k) < hi)
#ifndef DUP_MASK
#define DUP_MASK 0
#endif
#define REPS(k) ((((DUP_MASK) >> (k)) & 1) ? 2 : 1)
#define SEAM(k) do { if (IN(k) && IN((k) + 1)) { if ((k) == 0) { VM_WAIT(); grid.sync(); VM_WAIT(); } else { xcd_barrier(bar); } } } while (0)
    volatile LAS unsigned* MISC = (volatile LAS unsigned*)(lds + MISC_OFF);
    if (threadIdx.x < 32) MISC[threadIdx.x] = 0u;
    __syncthreads();
    XcdBarrier bar = xcd_barrier_post((unsigned*)(ws + WS_CTL), MISC);
    bf16* RA = (bf16*)(ws + WS_RA); bf16* RB = (bf16*)(ws + WS_RB); bf16* RC = (bf16*)(ws + WS_RC); bf16* RD = (bf16*)(ws + WS_RD); bf16* RE = (bf16*)(ws + WS_RE);
    bf16* RK = (bf16*)(ws + WS_RK); bf16* RV = (bf16*)(ws + WS_RV);
    bf16* MA = (bf16*)args.out; bf16* MB = (bf16*)args.out + (size_t)M * D;

    if (IN(0)) { for (int rep = 0; rep < REPS(0); ++rep) phase0(args, lds, vcu, G); }
    SEAM(0);
    if (IN(1)) for (int rep = 0; rep < REPS(1); ++rep) {
        pg8::Gemm g{RA, RA, (const bf16*)(ws + WS_WIN), D, D, D, D, 0};
        pg8::StaticOrder S; S.init(M, INW, G, bx);
        pg8::EpiIn E{RB, RC, RD, RK, RV, RE, MA, MB};
        pg8::gemm_phase<pg8::EpiIn, pg8::StaticOrder, true, true>(lds, g, S, E);
    }
    SEAM(1);
    if (IN(2)) { phase2(args, vcu, G); }
    SEAM(2);
    if (IN(3)) {
        long qrow0, kvrow0; int NT, h;
        for (int rep = 0; rep < REPS(3); ++rep)
        for (int i = 0; attn_next(i, vcu, G, qrow0, kvrow0, NT, h); ++i)
            attn_body::attn_unit<8>(qrow0, kvrow0, NT, h, (const attn_body::bf16*)RD, (const attn_body::bf16*)RK, (const attn_body::bf16*)RV, (attn_body::bf16*)((REPS(3) == 2 && rep == 0) ? RB : RD), (const attn_body::bf16*)RE, args.q_norm, (char*)lds_raw);
        for (int rep = 0; rep < REPS(8); ++rep) pool_tail(args, vcu, G);
    }
    SEAM(3);
    if (IN(4)) {
        pg8::Gemm g{RA, RD, (const bf16*)(ws + WS_WAB), D, 2048, 2048, 1024, 0};
        pg8::DupOrder S; S.init(M, D, G, bx, REPS(4));
        pg8::EpiMerge E{RC, MA, MB};
        pg8::gemm_phase<pg8::EpiMerge, pg8::DupOrder, true, true>(lds, g, S, E);
    }
    SEAM(4);
    if (IN(5)) {
        { pg8::Gemm g{RC, RC, (const bf16*)(ws + WS_WO), D, D, D, D, 0};
          pg8::DupOrder S; S.init(M, D, G, bx, REPS(5));
          pg8::EpiPlain E{RA, D};
          pg8::gemm_phase<pg8::EpiPlain, pg8::DupOrder, true, true>(lds, g, S, E); }
        { pg8::Gemm g{(const bf16*)(ws + WS_PBF), (const bf16*)(ws + WS_PBF), (const bf16*)(ws + WS_WPLE), PLE, PLE, PLE, PLE, 0};
          pg8::DupOrder S; S.init(M, D, G, bx, REPS(9));
          pg8::EpiPlain E{RD, D};
          pg8::gemm_phase<pg8::EpiPlain, pg8::DupOrder, true, true>(lds, g, S, E); }
    }
    SEAM(5);
    if (IN(6)) { for (int rep = 0; rep < REPS(6); ++rep) phase6(args, vcu, G); }
    SEAM(6);
    if (IN(7)) {
        pg8::Gemm g{RB, RB, (const bf16*)(ws + WS_WG), D, D, D, D, 0};
        pg8::StaticOrder S; S.init(M, D, G, bx);
        pg8::EpiFinal E{args.out, RB, RD, (const float*)(ws + WS_R2)};
        pg8::gemm_phase<pg8::EpiFinal, pg8::StaticOrder, true, true>(lds, g, S, E);
    }
#undef IN
#undef SEAM
}

extern "C" void kernel_launch(void* const* d_in, const int* in_sizes, int n_in, void* d_out, int out_size, void* d_ws, size_t ws_size, hipStream_t stream) {
    static int grid = 0;
    if (grid == 0) {
        if (n_in != 17 || in_sizes[0] != MP * D || in_sizes[1] != MS * D || out_size != M * D || ws_size < WS_END) {
            fprintf(stderr, "kernel_launch: unexpected shapes (n_in %d, in0 %d, out %d, ws %zu); nothing launched\n", n_in, n_in > 0 ? in_sizes[0] : -1, out_size, ws_size); grid = -1; return; }
        int dev = 0, cus = 0, per_cu = 0;
        if (hipGetDevice(&dev) != hipSuccess || hipDeviceGetAttribute(&cus, hipDeviceAttributeMultiprocessorCount, dev) != hipSuccess) { fprintf(stderr, "kernel_launch: device query failed\n"); grid = -1; return; }
        if (hipFuncSetAttribute((const void*)fwd_megakernel, hipFuncAttributeMaxDynamicSharedMemorySize, LDS_BYTES) != hipSuccess) { fprintf(stderr, "kernel_launch: hipFuncSetAttribute failed\n"); grid = -1; return; }
        if (hipOccupancyMaxActiveBlocksPerMultiprocessor(&per_cu, (const void*)fwd_megakernel, NWAVES * 64, LDS_BYTES) != hipSuccess || per_cu < 1) { fprintf(stderr, "kernel_launch: occupancy query says %d\n", per_cu); per_cu = 1; }
        (void)hipGetLastError();
        grid = cus * 1;
        (void)per_cu;
    }
    if (grid < 0) return;
    if (hipMemsetAsync((char*)d_ws + WS_CTL, 0, CTL_ZERO_BYTES, stream) != hipSuccess) { fprintf(stderr, "kernel_launch: memset of control words failed\n"); return; }
    Args a{};
    a.x_p = (const float*)d_in[0]; a.x_s = (const float*)d_in[1]; a.p_p = (const float*)d_in[2]; a.p_s = (const float*)d_in[3]; a.norm_pre = (const float*)d_in[4];
    a.w_in = (const float*)d_in[5]; a.pool_w = (const float*)d_in[6]; a.pool_scale = (const float*)d_in[7]; a.w_a = (const float*)d_in[8]; a.q_norm = (const float*)d_in[9];
    a.k_norm = (const float*)d_in[10]; a.w_b = (const float*)d_in[11]; a.w_out = (const float*)d_in[12]; a.norm_post = (const float*)d_in[13]; a.ple_norm = (const float*)d_in[14];
    a.w_gate = (const float*)d_in[15]; a.w_ple = (const float*)d_in[16];
    a.out = (float*)d_out; a.ws = (unsigned char*)d_ws;
    if (N_LAUNCHES == 1) {
        a.ph_lo = 0; a.ph_hi = N_PHASES;
        void* kargs[] = {&a};
        hipError_t e = hipLaunchCooperativeKernel((const void*)fwd_megakernel, dim3(grid), dim3(NWAVES * 64), kargs, LDS_BYTES, stream);
        if (e != hipSuccess) fprintf(stderr, "kernel_launch: cooperative launch failed: %s (grid %d)\n", hipGetErrorString(e), grid);
    } else {
        for (int ph = 0; ph < N_PHASES; ++ph) {
            a.ph_lo = ph; a.ph_hi = ph + 1;
            hipLaunchKernelGGL(fwd_megakernel, dim3(grid), dim3(NWAVES * 64), LDS_BYTES, stream, a);
        }
    }
}
```

```cpp
#include <hip/hip_runtime.h>
#include <hip/hip_cooperative_groups.h>
#include <hip/hip_bf16.h>
#include <cstdio>
#include <cstdint>
#include <cmath>
namespace cg = cooperative_groups;

namespace pg8 {
#define PG8_LAS __attribute__((address_space(3)))
typedef unsigned short bf16_t;
typedef short bf16x8 __attribute__((ext_vector_type(8)));
typedef float f32x4 __attribute__((ext_vector_type(4)));
typedef unsigned u32x4 __attribute__((ext_vector_type(4)));
constexpr int BM = 256, BK = 64, HALF = 128, HTB = HALF * BK * 2  , STAGE_BYTES = 8 * HTB, NXCD = 8, WGM = 8;

__host__ __device__ __forceinline__ int lds_byte(int r, int c) { const int st = (r >> 4) * 2 + (c >> 5), rr = r & 15, cc = c & 31, ob = rr * 64 + cc * 2; return st * 1024 + (ob ^ (((ob >> 9) & 1) << 5)); }
__host__ __device__ __forceinline__ void stage_rc(int b, int& R, int& C) { const int st = b / 1024, sb = b % 1024, swz = sb ^ (((sb >> 9) & 1) << 5); R = (st >> 1) * 16 + swz / 64; C = (st & 1) * 32 + (swz % 64) / 2; }
__host__ __device__ __forceinline__ int perm32(int rho) { const int n = rho >> 4, i = rho & 15; return 8 * (i >> 2) + 4 * n + (i & 3); }

struct Unit { int pm, pn; };
struct Gemm { const bf16_t* A; const bf16_t* A2; const bf16_t* Bt; int lda, ldb, K, K1; size_t a_pn_off; };

struct StaticOrder {
    int nM, nN, nwg, G, c;
    __host__ __device__ void init(int M, int N, int G_, int c_) { nM = M / BM; nN = N / BM; nwg = nM * nN; G = G_; c = c_; }
    __host__ __device__ bool next(int i, Unit& u) const {
        const long L = (long)i * G + c; if (L >= nwg) return false;
        int wgid = (int)L; { const int q = nwg / NXCD, r = nwg % NXCD, xcd = wgid % NXCD, off = wgid / NXCD; wgid = (xcd < r ? xcd * (q + 1) : r * (q + 1) + (xcd - r) * q) + off; }
        const int nig = WGM * nN, gid = wgid / nig, fm = gid * WGM, gsz = (nM - fm) < WGM ? (nM - fm) : WGM;
        u.pm = fm + ((wgid % nig) % gsz); u.pn = (wgid % nig) / gsz; return true;
    }
    __device__ __forceinline__ void a_ready(const Unit&) const {}
    __device__ __forceinline__ void done(const Unit&) const {}
};

__device__ __forceinline__ unsigned cvt_pk_bf16(float lo, float hi) { unsigned r; asm volatile("v_cvt_pk_bf16_f32 %0, %1, %2" : "=v"(r) : "v"(lo), "v"(hi)); return r; }
__device__ __forceinline__ float bf_lo(unsigned w) { return __uint_as_float(w << 16); }
__device__ __forceinline__ float bf_hi(unsigned w) { return __uint_as_float(w & 0xffff0000u); }
__device__ __forceinline__ float fsigmoid(float x) { return __builtin_amdgcn_rcpf(1.0f + __builtin_amdgcn_exp2f(-1.4426950408889634f * x)); }
__device__ __forceinline__ float fsilu(float x) { return x * fsigmoid(x); }
__device__ __forceinline__ u32x4 pack8(const f32x4& v0, const f32x4& v1) { u32x4 w; w.x = cvt_pk_bf16(v0[0], v0[1]); w.y = cvt_pk_bf16(v0[2], v0[3]); w.z = cvt_pk_bf16(v1[0], v1[1]); w.w = cvt_pk_bf16(v1[2], v1[3]); return w; }
__device__ __forceinline__ void unpack8(const u32x4& w, f32x4& v0, f32x4& v1) { v0 = (f32x4){bf_lo(w.x), bf_hi(w.x), bf_lo(w.y), bf_hi(w.y)}; v1 = (f32x4){bf_lo(w.z), bf_hi(w.z), bf_lo(w.w), bf_hi(w.w)}; }

struct EpiIn {
    static constexpr bool PERM = true, AFTER_DRAIN = false, MID = false;
    bf16_t *ua, *sza, *q, *k, *v, *szb, *ma, *mb;
    __device__ __forceinline__ void operator()(const f32x4 (&acc)[2][2][4][2], const Unit& u, int wr, int wc, int fr, int fq) const {
        const int pn = u.pn; bf16_t* base; int ldc = 1024, ct; bool act = false;
        if (pn < 4) { base = ua; ct = pn; }
        else if (pn < 8) { base = sza; ct = pn - 4; act = true; }
        else if (pn < 12) { base = q; ct = pn - 8; }
        else if (pn == 12) { base = k; ct = 0; ldc = 256; }
        else if (pn == 13) { base = v; ct = 0; ldc = 256; }
        else if (pn < 18) { base = szb; ct = pn - 14; act = true; }
        else if (pn < 22) { base = ma; ct = pn - 18; }
        else { base = mb; ct = pn - 22; }
        int row0 = u.pm * BM + wr * 64 + fr, col0 = ct * BM + wc * 32 + 8 * fq; asm volatile("" : "+v"(row0), "+v"(col0));
#pragma unroll
        for (int ai = 0; ai < 2; ++ai)
#pragma unroll
            for (int m = 0; m < 4; ++m) { bf16_t* rowp = base + (size_t)(row0 + ai * HALF + m * 16) * ldc + col0;
#pragma unroll
                for (int bj = 0; bj < 2; ++bj) { f32x4 v0 = acc[ai][bj][m][0], v1 = acc[ai][bj][m][1];
                    if (act) {
#pragma unroll
                        for (int e = 0; e < 4; ++e) { v0[e] = fsilu(v0[e]); v1[e] = fsilu(v1[e]); } }
                    *(u32x4*)(rowp + bj * HALF) = pack8(v0, v1); } }
    }
};
struct EpiPlain {
    static constexpr bool PERM = true, AFTER_DRAIN = false, MID = false;
    bf16_t* O; int ldc;
    __device__ __forceinline__ void operator()(const f32x4 (&acc)[2][2][4][2], const Unit& u, int wr, int wc, int fr, int fq) const {
        int row0 = u.pm * BM + wr * 64 + fr, col0 = u.pn * BM + wc * 32 + 8 * fq; asm volatile("" : "+v"(row0), "+v"(col0));
#pragma unroll
        for (int ai = 0; ai < 2; ++ai)
#pragma unroll
            for (int m = 0; m < 4; ++m) { bf16_t* rowp = O + (size_t)(row0 + ai * HALF + m * 16) * ldc + col0;
#pragma unroll
                for (int bj = 0; bj < 2; ++bj) *(u32x4*)(rowp + bj * HALF) = pack8(acc[ai][bj][m][0], acc[ai][bj][m][1]); }
    }
};
struct EpiMerge {
    static constexpr bool PERM = true, AFTER_DRAIN = false, MID = true;
    bf16_t* O; const bf16_t* ma; const bf16_t* mb;
    __device__ __forceinline__ void mid(f32x4 (&acc)[2][2][4][2], const Unit& u, int wr, int wc, int fr, int fq) const {
        int row0 = u.pm * BM + wr * 64 + fr, col0 = u.pn * BM + wc * 32 + 8 * fq;
        asm volatile("" : "+v"(row0), "+v"(col0));
#pragma unroll
        for (int ai = 0; ai < 2; ++ai) {
            u32x4 aw[4][2], bw[4][2];
#pragma unroll
            for (int m = 0; m < 4; ++m) { const size_t off = (size_t)(row0 + ai * HALF + m * 16) * 1024 + col0;
#pragma unroll
                for (int bj = 0; bj < 2; ++bj) { aw[m][bj] = *(const u32x4*)(ma + off + bj * HALF); bw[m][bj] = *(const u32x4*)(mb + off + bj * HALF); } }
#pragma unroll
            for (int m = 0; m < 4; ++m)
#pragma unroll
                for (int bj = 0; bj < 2; ++bj) { f32x4 a0, a1, b0, b1; unpack8(aw[m][bj], a0, a1); unpack8(bw[m][bj], b0, b1);
#pragma unroll
                    for (int e = 0; e < 4; ++e) {
                        const float ea0 = __builtin_amdgcn_exp2f(-1.4426950408889634f * a0[e]), ea1 = __builtin_amdgcn_exp2f(-1.4426950408889634f * a1[e]);
                        const float eb0 = __builtin_amdgcn_exp2f(-1.4426950408889634f * fmaxf(b0[e], -60.f)), eb1 = __builtin_amdgcn_exp2f(-1.4426950408889634f * fmaxf(b1[e], -60.f));
                        acc[ai][bj][m][0][e] *= (1.0f + eb0) * __builtin_amdgcn_rcpf(1.0f + ea0);
                        acc[ai][bj][m][1][e] *= (1.0f + eb1) * __builtin_amdgcn_rcpf(1.0f + ea1); } }
#pragma unroll
            for (int m = 0; m < 4; ++m) asm volatile("" : "+v"(acc[ai][0][m][0]), "+v"(acc[ai][0][m][1]), "+v"(acc[ai][1][m][0]), "+v"(acc[ai][1][m][1]) :: "memory");
        }
    }
    __device__ __forceinline__ void operator()(const f32x4 (&acc)[2][2][4][2], const Unit& u, int wr, int wc, int fr, int fq) const {
        int row0 = u.pm * BM + wr * 64 + fr, col0 = u.pn * BM + wc * 32 + 8 * fq; asm volatile("" : "+v"(row0), "+v"(col0));
#pragma unroll
        for (int ai = 0; ai < 2; ++ai)
#pragma unroll
            for (int m = 0; m < 4; ++m) { const size_t off = (size_t)(row0 + ai * HALF + m * 16) * 1024 + col0;
#pragma unroll
                for (int bj = 0; bj < 2; ++bj) { const u32x4 bw = *(const u32x4*)(mb + off + bj * HALF); f32x4 b0, b1; unpack8(bw, b0, b1); f32x4 v0 = acc[ai][bj][m][0], v1 = acc[ai][bj][m][1];
#pragma unroll
                    for (int e = 0; e < 4; ++e) { v0[e] *= fsigmoid(fmaxf(b0[e], -60.f)); v1[e] *= fsigmoid(fmaxf(b1[e], -60.f)); }
                    *(u32x4*)(O + off + bj * HALF) = pack8(v0, v1); } }
    }
};
struct EpiFinal {
    static constexpr bool PERM = true, AFTER_DRAIN = false, MID = false;
    float* out; const bf16_t* x1b; const bf16_t* pe; const float* r2;
    __device__ __forceinline__ void operator()(const f32x4 (&acc)[2][2][4][2], const Unit& u, int wr, int wc, int fr, int fq) const {
        int row0 = u.pm * BM + wr * 64 + fr, col0 = u.pn * BM + wc * 32 + 8 * fq; asm volatile("" : "+v"(row0), "+v"(col0));
#pragma unroll
        for (int ai = 0; ai < 2; ++ai)
#pragma unroll
            for (int m = 0; m < 4; ++m) { const int row = row0 + ai * HALF + m * 16; const size_t off = (size_t)row * 1024 + col0; const float rs = r2[row];
#pragma unroll
                for (int bj = 0; bj < 2; ++bj) { const u32x4 pw = *(const u32x4*)(pe + off + bj * HALF), xw = *(const u32x4*)(x1b + off + bj * HALF);
                    f32x4 p0, p1, x0, x1; unpack8(pw, p0, p1); unpack8(xw, x0, x1);
                    float* op = out + off + bj * HALF;
                    f32x4 g0 = acc[ai][bj][m][0], g1 = acc[ai][bj][m][1];
#pragma unroll
                    for (int e = 0; e < 4; ++e) { g0[e] = x0[e] + fsigmoid(rs * g0[e]) * p0[e]; g1[e] = x1[e] + fsigmoid(rs * g1[e]) * p1[e]; }
                    *(f32x4*)op = g0; *(f32x4*)(op + 4) = g1; } }
    }
};
struct DupOrder {
    StaticOrder S; int dup;
    __device__ void init(int M_, int N_, int G_, int c_, int dup_) { S.init(M_, N_, G_, c_); dup = dup_; }
    __device__ bool next(int i, Unit& u) const { if (dup > 1) { const int rounds = S.nwg / S.G; if (i >= dup * rounds) return false; i %= rounds; } return S.next(i, u); }
    __device__ __forceinline__ void a_ready(const Unit&) const {}
    __device__ __forceinline__ void done(const Unit&) const {}
};
template <class Epi, class Sched, bool ALIGN_EPI = false, bool SP2 = false>
__device__ __forceinline__ void gemm_phase(PG8_LAS unsigned char* lds, const Gemm g, const Sched& S, const Epi& E) {
    const int tid = threadIdx.x, wid = __builtin_amdgcn_readfirstlane(tid >> 6), lane = tid & 63, wr = wid >> 2, wc = wid & 3, fr = lane & 15, fq = lane >> 4;
    const int nt = g.K / BK, nth = g.K1 / BK;
    unsigned voffA[2], voffB[2];
#pragma unroll
    for (int i = 0; i < 2; ++i) { int R, C; stage_rc(tid * 16 + i * 8192, R, C); const int Rb = Epi::PERM ? ((R & ~31) + perm32(R & 31)) : R;
        voffA[i] = (unsigned)(R * g.lda + C) * 2u; voffB[i] = (unsigned)(Rb * g.ldb + C) * 2u; }
    const size_t kstep = (size_t)(BK * 2);
    const size_t hstepA = (size_t)HALF * g.lda * 2, hstepB = (size_t)HALF * g.ldb * 2;
    const size_t tstepA = 2 * hstepA, tstepB = 2 * hstepB;
    const unsigned ldsw = (unsigned)wid * 1024u;
    const int aoff = lds_byte(wr * 64 + fr, fq * 8), boff = lds_byte(wc * 32 + fr, fq * 8);
#define PG8_SA(b, h) (((b) * 2 + (h)) * HTB)
#define PG8_SB(b, h) ((4 + (b) * 2 + (h)) * HTB)
#define PG8_STAGE(bufoff, gbase, voff) do { _Pragma("unroll") for (int _i = 0; _i < 2; ++_i) \
        __builtin_amdgcn_global_load_lds((const unsigned*)((const char*)(gbase) + (voff)[_i]), (PG8_LAS unsigned*)(lds + (bufoff) + ldsw + _i * 8192), 16, 0, 0); } while (0)
#define PG8_LDA(dst, b, h) do { _Pragma("unroll") for (int m = 0; m < 4; ++m) _Pragma("unroll") for (int k = 0; k < 2; ++k) dst[m][k] = *(const PG8_LAS bf16x8*)(lds + PG8_SA(b, h) + aoff + m * 2048 + k * 1024); } while (0)
#define PG8_LDB(dst, b, h) do { _Pragma("unroll") for (int n = 0; n < 2; ++n) _Pragma("unroll") for (int k = 0; k < 2; ++k) dst[n][k] = *(const PG8_LAS bf16x8*)(lds + PG8_SB(b, h) + boff + n * 2048 + k * 1024); } while (0)
#define PG8_MMA(ai, bj, At, Bt) do { __builtin_amdgcn_s_setprio(1); _Pragma("unroll") for (int m = 0; m < 4; ++m) _Pragma("unroll") for (int n = 0; n < 2; ++n) _Pragma("unroll") for (int k = 0; k < 2; ++k) \
        acc[ai][bj][m][n] = __builtin_amdgcn_mfma_f32_16x16x32_bf16(Bt[n][k], At[m][k], acc[ai][bj][m][n], 0, 0, 0); __builtin_amdgcn_s_setprio(0); } while (0)
#define PG8_WAIT_V(n) asm volatile("s_waitcnt vmcnt(" #n ")" ::: "memory")
#define PG8_WAIT_L(n) asm volatile("s_waitcnt lgkmcnt(" #n ")" ::: "memory")
#define PG8_BAR __builtin_amdgcn_s_barrier()
#define PG8_SCHED __builtin_amdgcn_sched_barrier(0)
    Unit cur, nxt; int ui = 0;
    if (!S.next(0, cur)) return;
    f32x4 acc[2][2][4][2];
#pragma unroll
    for (int a = 0; a < 2; ++a)
#pragma unroll
        for (int b = 0; b < 2; ++b)
#pragma unroll
            for (int m = 0; m < 4; ++m)
#pragma unroll
                for (int n = 0; n < 2; ++n) acc[a][b][m][n] = (f32x4){0.f, 0.f, 0.f, 0.f};
    bf16x8 At[4][2], B0[2][2], B1[2][2];
    const char* cA = (const char*)g.A + (size_t)cur.pm * tstepA + (size_t)cur.pn * g.a_pn_off; const char* cA2 = (const char*)g.A2 + (size_t)cur.pm * tstepA; const char* cB = (const char*)g.Bt + (size_t)cur.pn * tstepB;
    S.a_ready(cur);
    if constexpr (SP2) {
        PG8_STAGE(PG8_SB(0, 0), cB, voffB); PG8_STAGE(PG8_SB(0, 1), cB + hstepB, voffB); PG8_STAGE(PG8_SA(0, 0), cA, voffA); PG8_STAGE(PG8_SA(0, 1), cA + hstepA, voffA);
        if (wr == 1) PG8_BAR;
        PG8_WAIT_V(2); PG8_BAR;
        PG8_STAGE(PG8_SB(1, 0), cB + kstep, voffB); PG8_STAGE(PG8_SA(1, 0), cA + kstep, voffA); PG8_STAGE(PG8_SB(1, 1), cB + hstepB + kstep, voffB);
        PG8_WAIT_V(6); PG8_BAR;
    } else {
        PG8_STAGE(PG8_SB(0, 0), cB, voffB); PG8_STAGE(PG8_SA(0, 0), cA, voffA); PG8_STAGE(PG8_SB(0, 1), cB + hstepB, voffB); PG8_STAGE(PG8_SA(0, 1), cA + hstepA, voffA);
        if (wr == 1) PG8_BAR;
        PG8_WAIT_V(4); PG8_BAR;
        PG8_STAGE(PG8_SB(1, 0), cB + kstep, voffB); PG8_STAGE(PG8_SA(1, 0), cA + kstep, voffA); PG8_STAGE(PG8_SB(1, 1), cB + hstepB + kstep, voffB);
        PG8_WAIT_V(6); PG8_BAR;
    }
    for (;;) {
        const bool has_next = S.next(ui + 1, nxt);
        const char* nA = has_next ? (const char*)g.A + (size_t)nxt.pm * tstepA + (size_t)nxt.pn * g.a_pn_off : cA; const char* nA2 = has_next ? (const char*)g.A2 + (size_t)nxt.pm * tstepA : cA2; const char* nB = has_next ? (const char*)g.Bt + (size_t)nxt.pn * tstepB : cB;
        for (int t = 0; t < nt; t += 2) {
            const bool last = (t == nt - 2);
            if constexpr (Epi::MID) { if (t == nth) E.mid(acc, cur, wr, wc, fr, fq); }
            const char* a1 = (t + 1 < nth) ? cA + (size_t)(t + 1) * kstep : cA2 + (size_t)(t + 1 - nth) * kstep;
            const char* a2 = last ? nA : ((t + 2 < nth) ? cA + (size_t)(t + 2) * kstep : cA2 + (size_t)(t + 2 - nth) * kstep); const char* b2 = last ? nB : cB + (size_t)(t + 2) * kstep;
            const char* a3 = a2 + kstep; const char* b3 = b2 + kstep;
            if (last && has_next) S.a_ready(nxt);
            if constexpr (SP2) {
            PG8_LDB(B0, 0, 0); PG8_LDB(B1, 0, 1); PG8_SCHED; PG8_LDA(At, 0, 0); PG8_STAGE(PG8_SA(1, 1), a1 + hstepA, voffA);
            PG8_WAIT_V(8); PG8_WAIT_L(0); PG8_BAR; PG8_MMA(0, 0, At, B0); PG8_MMA(0, 1, At, B1); PG8_BAR; PG8_SCHED;
            PG8_LDA(At, 0, 1); PG8_STAGE(PG8_SB(0, 0), b2, voffB); PG8_STAGE(PG8_SB(0, 1), b2 + hstepB, voffB); PG8_STAGE(PG8_SA(0, 0), a2, voffA);
            PG8_WAIT_V(8); PG8_WAIT_L(0); PG8_BAR; PG8_MMA(1, 0, At, B0); PG8_MMA(1, 1, At, B1); PG8_BAR; PG8_SCHED;
            PG8_LDB(B0, 1, 0); PG8_LDB(B1, 1, 1); PG8_SCHED; PG8_LDA(At, 1, 0); PG8_STAGE(PG8_SA(0, 1), a2 + hstepA, voffA);
            PG8_WAIT_V(8); PG8_WAIT_L(0); PG8_BAR; PG8_MMA(0, 0, At, B0); PG8_MMA(0, 1, At, B1); PG8_BAR; PG8_SCHED;
            PG8_LDA(At, 1, 1); PG8_STAGE(PG8_SB(1, 0), b3, voffB); PG8_STAGE(PG8_SB(1, 1), b3 + hstepB, voffB); PG8_STAGE(PG8_SA(1, 0), a3, voffA);
            PG8_WAIT_V(8); PG8_WAIT_L(0); PG8_BAR; PG8_MMA(1, 0, At, B0); PG8_MMA(1, 1, At, B1); PG8_BAR; PG8_SCHED;
            } else {
            PG8_LDB(B0, 0, 0); PG8_SCHED; PG8_LDA(At, 0, 0); PG8_STAGE(PG8_SA(1, 1), a1 + hstepA, voffA);
            PG8_WAIT_L(8); PG8_BAR; PG8_WAIT_L(0); PG8_MMA(0, 0, At, B0); PG8_BAR; PG8_SCHED;
            PG8_LDB(B1, 0, 1); PG8_STAGE(PG8_SB(0, 0), b2, voffB);
            PG8_BAR; PG8_WAIT_L(0); PG8_MMA(0, 1, At, B1); PG8_BAR;
            PG8_LDA(At, 0, 1); PG8_STAGE(PG8_SA(0, 0), a2, voffA);
            PG8_BAR; PG8_WAIT_L(0); PG8_MMA(1, 0, At, B0); PG8_BAR; PG8_SCHED;
            PG8_STAGE(PG8_SB(0, 1), b2 + hstepB, voffB);
            PG8_WAIT_V(6); PG8_BAR; PG8_MMA(1, 1, At, B1); PG8_BAR;
            PG8_LDB(B0, 1, 0); PG8_SCHED; PG8_LDA(At, 1, 0); PG8_STAGE(PG8_SA(0, 1), a2 + hstepA, voffA);
            PG8_WAIT_L(8); PG8_BAR; PG8_WAIT_L(0); PG8_MMA(0, 0, At, B0); PG8_BAR; PG8_SCHED;
            PG8_LDB(B1, 1, 1); PG8_STAGE(PG8_SB(1, 0), b3, voffB);
            PG8_BAR; PG8_WAIT_L(0); PG8_MMA(0, 1, At, B1); PG8_BAR;
            PG8_LDA(At, 1, 1); PG8_STAGE(PG8_SA(1, 0), a3, voffA);
            PG8_BAR; PG8_WAIT_L(0); PG8_MMA(1, 0, At, B0); PG8_BAR; PG8_SCHED;
            PG8_STAGE(PG8_SB(1, 1), b3 + hstepB, voffB);
            PG8_WAIT_V(6); PG8_BAR; PG8_MMA(1, 1, At, B1); PG8_BAR;
            }
        }
        if constexpr (ALIGN_EPI) { if (wr == 0) PG8_BAR; }
        if constexpr (!Epi::AFTER_DRAIN) { E(acc, cur, wr, wc, fr, fq); S.done(cur); }
        if (!has_next) break;
#pragma unroll
        for (int a = 0; a < 2; ++a)
#pragma unroll
            for (int b = 0; b < 2; ++b)
#pragma unroll
                for (int m = 0; m < 4; ++m)
#pragma unroll
                    for (int n = 0; n < 2; ++n) acc[a][b][m][n] = (f32x4){0.f, 0.f, 0.f, 0.f};
        cur = nxt; cA = nA; cA2 = nA2; cB = nB; ++ui;
        if constexpr (ALIGN_EPI) { if (wr == 1) PG8_BAR; }
    }
    PG8_WAIT_V(0);
    if constexpr (!ALIGN_EPI) { if (wr == 0) PG8_BAR; }
    PG8_BAR;
    if constexpr (Epi::AFTER_DRAIN) { E.fused(acc, cur, wr, wc, fr, fq, lds, wid, lane); S.done(cur); }
#undef PG8_SA
#undef PG8_SB
#undef PG8_STAGE
#undef PG8_LDA
#undef PG8_LDB
#undef PG8_MMA
#undef PG8_WAIT_V
#undef PG8_WAIT_L
#undef PG8_BAR
#undef PG8_SCHED
}
}

namespace attn_body {
using bf16=__hip_bfloat16;
using bf16x8=__attribute__((ext_vector_type(8)))short;
using s16x4=__attribute__((ext_vector_type(4)))short;
using f32x16=__attribute__((ext_vector_type(16)))float;
using u32x4=__attribute__((ext_vector_type(4)))unsigned;
constexpr int D=64,QP=1024,KP=256;
constexpr int NW=8,QBLK=32,QB=QBLK*NW,KVBLK=64;

__device__ __forceinline__ int crow(int r,int hi){return (r&3)+8*(r>>2)+4*hi;}
#define SBAR() __builtin_amdgcn_sched_barrier(0)
__device__ __forceinline__ void cmask(f32x16&p0,f32x16&p1,int jb,int qrel,int hi){
  const float NEG=-INFINITY; int kb=64*jb+4*hi;
  #pragma unroll
  for(int r=0;r<16;++r){int kv=kb+(r&3)+8*(r>>2); if(kv>qrel)p0[r]=NEG; if(kv+32>qrel)p1[r]=NEG;}
}

constexpr int NSLOT=3, SLOTB=8192;
constexpr int LDS_K=0, LDS_V=NSLOT*SLOTB, LDS_WS=2*NSLOT*SLOTB, LDS_OST=LDS_WS+NW*64*4, LDS_BYTES=LDS_OST+NW*4096;
constexpr float C2=0.125f*1.4426950408889634f;
__device__ __forceinline__ void glds16(const void*gsrc,unsigned lds_dst){unsigned keep;
  asm volatile("s_mov_b32 %0, m0\n\ts_mov_b32 m0, %2\n\ts_nop 0\n\tglobal_load_lds_dwordx4 %1, off\n\ts_mov_b32 m0, %0":"=&s"(keep):"v"(gsrc),"s"(lds_dst):"memory");}
__device__ __forceinline__ float max3f(float a,float b,float c){float r;asm("v_max3_f32 %0, %1, %2, %3":"=v"(r):"v"(a),"v"(b),"v"(c));return r;}
__device__ __forceinline__ float max2f(float a,float b){float r;asm("v_max_f32_e32 %0, %1, %2":"=v"(r):"v"(a),"v"(b));return r;}
__device__ __forceinline__ float fadd_s(float a,float b){float r;asm("v_add_f32_e32 %0, %1, %2":"=v"(r):"v"(a),"v"(b));return r;}
__device__ __forceinline__ float fsub_s(float a,float b){float r;asm("v_sub_f32_e32 %0, %1, %2":"=v"(r):"v"(a),"v"(b));return r;}
typedef float f32x2_t __attribute__((ext_vector_type(2))); typedef __bf16 bf16x2_t __attribute__((ext_vector_type(2)));
__device__ __forceinline__ unsigned cvtpk_s(float lo,float hi){f32x2_t v={lo,hi};bf16x2_t b=__builtin_convertvector(v,bf16x2_t);return __builtin_bit_cast(unsigned,b);}
#define WAIT_BAR(N) asm volatile("s_waitcnt vmcnt(" #N ") lgkmcnt(0)\n\ts_barrier":::"memory")

__device__ __forceinline__ void qkt(f32x16&p0,f32x16&p1,const char*Kslot,const bf16x8*qr,const f32x16&negm,int r32,int hi){
  const char*kb=Kslot+hi*1024+r32*16;
  #pragma unroll
  for(int d0=0;d0<4;++d0){
    const bf16x8 b0=*reinterpret_cast<const bf16x8*>(kb+d0*2048);
    const bf16x8 b1=*reinterpret_cast<const bf16x8*>(kb+d0*2048+512);
    if(d0==0){p0=__builtin_amdgcn_mfma_f32_32x32x16_bf16(b0,qr[0],negm,0,0,0);p1=__builtin_amdgcn_mfma_f32_32x32x16_bf16(b1,qr[0],negm,0,0,0);}
    else{p0=__builtin_amdgcn_mfma_f32_32x32x16_bf16(b0,qr[d0],p0,0,0,0);p1=__builtin_amdgcn_mfma_f32_32x32x16_bf16(b1,qr[d0],p1,0,0,0);}}
}
typedef __attribute__((address_space(3))) const char* lds_cptr;
typedef short v4i16_t __attribute__((ext_vector_type(4)));
__device__ __forceinline__ void kload8(bf16x8*kf,lds_cptr kp){
  kf[0]=*(const __attribute__((address_space(3))) bf16x8*)(kp);      kf[1]=*(const __attribute__((address_space(3))) bf16x8*)(kp+512);
  kf[2]=*(const __attribute__((address_space(3))) bf16x8*)(kp+2048); kf[3]=*(const __attribute__((address_space(3))) bf16x8*)(kp+2560);
  kf[4]=*(const __attribute__((address_space(3))) bf16x8*)(kp+4096); kf[5]=*(const __attribute__((address_space(3))) bf16x8*)(kp+4608);
  kf[6]=*(const __attribute__((address_space(3))) bf16x8*)(kp+6144); kf[7]=*(const __attribute__((address_space(3))) bf16x8*)(kp+6656);
}
__device__ __forceinline__ void kload2(bf16x8*kf,lds_cptr kp,int j){ kf[2*j]=*(const __attribute__((address_space(3))) bf16x8*)(kp+j*2048); kf[2*j+1]=*(const __attribute__((address_space(3))) bf16x8*)(kp+j*2048+512); }
__device__ __forceinline__ s16x4 vtr(lds_cptr p){ return __builtin_bit_cast(s16x4,__builtin_amdgcn_ds_read_tr16_b64_v4i16((__attribute__((address_space(3))) v4i16_t*)p)); }
__device__ __forceinline__ float rowmax(const f32x16&p0,const f32x16&p1){
  float a=max3f(p0[0],p0[1],p1[0]),b=max3f(p0[2],p0[3],p1[1]);a=max3f(a,p1[2],p1[3]);
  #pragma unroll
  for(int r=4;r<16;r+=4){a=max3f(a,p0[r],p0[r+1]);b=max3f(b,p0[r+2],p0[r+3]);a=max3f(a,p1[r],p1[r+1]);b=max3f(b,p1[r+2],p1[r+3]);}
  const float m=max2f(a,b);
  auto rr=__builtin_amdgcn_permlane32_swap(__float_as_uint(m),__float_as_uint(m),false,false);
  return max2f(__uint_as_float(rr[0]),__uint_as_float(rr[1]));
}
__device__ __forceinline__ void pv(f32x16*o,int vb,bf16x8 pa0,bf16x8 pa1,bf16x8 pa2,bf16x8 pa3){
  #pragma unroll
  for(int d0=0;d0<2;++d0){s16x4 lo[4],hi[4];
    #pragma unroll
    for(int ks=0;ks<4;++ks){
      asm volatile("ds_read_b64_tr_b16 %0,%1 offset:%c2":"=&v"(lo[ks]):"v"(vb),"i"(d0*4096+ks*1024):"memory");
      asm volatile("ds_read_b64_tr_b16 %0,%1 offset:%c2":"=&v"(hi[ks]):"v"(vb),"i"(d0*4096+ks*1024+512):"memory");}
    asm volatile("s_waitcnt lgkmcnt(0)":::"memory");SBAR();
    #define PK(k) (bf16x8){lo[k][0],lo[k][1],lo[k][2],lo[k][3],hi[k][0],hi[k][1],hi[k][2],hi[k][3]}
    o[d0]=__builtin_amdgcn_mfma_f32_32x32x16_bf16(pa0,PK(0),o[d0],0,0,0);
    o[d0]=__builtin_amdgcn_mfma_f32_32x32x16_bf16(pa1,PK(1),o[d0],0,0,0);
    o[d0]=__builtin_amdgcn_mfma_f32_32x32x16_bf16(pa2,PK(2),o[d0],0,0,0);
    o[d0]=__builtin_amdgcn_mfma_f32_32x32x16_bf16(pa3,PK(3),o[d0],0,0,0);
    #undef PK
  }
}
#define ATTN_STORE16(p,v) (*(u32x4*)(p)=(v))
__device__ __forceinline__ float abf_lo(unsigned w){return __uint_as_float(w<<16);}
__device__ __forceinline__ float abf_hi(unsigned w){return __uint_as_float(w&0xffff0000u);}
__device__ __forceinline__ u32x4 mulgate(const u32x4&v,const u32x4&g){u32x4 r;
  r.x=cvtpk_s(abf_lo(v.x)*abf_lo(g.x),abf_hi(v.x)*abf_hi(g.x)); r.y=cvtpk_s(abf_lo(v.y)*abf_lo(g.y),abf_hi(v.y)*abf_hi(g.y));
  r.z=cvtpk_s(abf_lo(v.z)*abf_lo(g.z),abf_hi(v.z)*abf_hi(g.z)); r.w=cvtpk_s(abf_lo(v.w)*abf_lo(g.w),abf_hi(v.w)*abf_hi(g.w)); return r;}
__device__ __forceinline__ void qnormrope(bf16x8*qr,const float*__restrict__ qn,int t,int hi){
  typedef float f4_t __attribute__((ext_vector_type(4)));
  float y[4][8]; float ss=0.f;
  #pragma unroll
  for(int d0=0;d0<4;++d0){ const u32x4 w=__builtin_bit_cast(u32x4,qr[d0]);
    #pragma unroll
    for(int i=0;i<4;++i){ y[d0][2*i]=__uint_as_float(w[i]<<16); y[d0][2*i+1]=__uint_as_float(w[i]&0xffff0000u); ss+=y[d0][2*i]*y[d0][2*i]+y[d0][2*i+1]*y[d0][2*i+1]; } }
  ss+=__shfl_xor(ss,32);
  const float rstd=1.0f/sqrtf(ss*(1.0f/64.0f)+1e-6f);
  #pragma unroll
  for(int d0=0;d0<4;++d0){ const f4_t g0=*(const f4_t*)(qn+16*d0+8*hi), g1=*(const f4_t*)(qn+16*d0+8*hi+4);
    #pragma unroll
    for(int i=0;i<4;++i){ y[d0][i]*=rstd*g0[i]; y[d0][4+i]*=rstd*g1[i]; } }
  const float prow=(float)(t>>6), pcol=(float)(t&63);
  #pragma unroll
  for(int j=0;j<8;++j){
    const float freq=__builtin_amdgcn_exp2f(-(float)(8*hi+j)*0.83048202372184058696f)*0.15915494309189533577f;
    const float rr=__builtin_amdgcn_fractf(prow*freq), rc=__builtin_amdgcn_fractf(pcol*freq);
    const float sr=__builtin_amdgcn_sinf(rr), cr=__builtin_amdgcn_cosf(rr), sc=__builtin_amdgcn_sinf(rc), cc=__builtin_amdgcn_cosf(rc);
    const float a0=y[0][j], b0=y[1][j], a1=y[2][j], b1=y[3][j];
    y[0][j]=(a0*cr-b0*sr)*C2; y[1][j]=(b0*cr+a0*sr)*C2; y[2][j]=(a1*cc-b1*sc)*C2; y[3][j]=(b1*cc+a1*sc)*C2; }
  #pragma unroll
  for(int d0=0;d0<4;++d0){ u32x4 w; w.x=cvtpk_s(y[d0][0],y[d0][1]); w.y=cvtpk_s(y[d0][2],y[d0][3]); w.z=cvtpk_s(y[d0][4],y[d0][5]); w.w=cvtpk_s(y[d0][6],y[d0][7]); qr[d0]=__builtin_bit_cast(bf16x8,w); }
}
template<int THRL> __device__ __forceinline__ void attn_unit(long qrow0,long kvrow0,int NT,int h,const bf16*Q,const bf16*__restrict__ K,const bf16*__restrict__ V,bf16*O,const bf16*__restrict__ Gt,const float*__restrict__ qn,bool track,char*shm){
  const int tid=threadIdx.x,lane=tid&63,r32=lane&31,hi=lane>>5; const int wid=__builtin_amdgcn_readfirstlane(tid>>6);
  const bf16*Qw=Q+(qrow0+wid*QBLK)*QP+h*D;
  const bf16*Kh=K+kvrow0*KP+(h>>2)*D,*Vh=V+kvrow0*KP+(h>>2)*D;
  const unsigned lds0=(unsigned)(uintptr_t)shm;
  float*wsf=(float*)(shm+LDS_WS)+wid*64;
  const bf16*ksrc=Kh+(long)lane*KP+wid*8;
  const bf16*vsrc=Vh+(long)(16*(wid&3)+(lane>>2))*KP+(wid>>2)*32+(lane&3)*8;
  const unsigned kdst=lds0+LDS_K+wid*1024, vdst=lds0+LDS_V+wid*1024;
  #define DMA_K(t,slot) glds16(ksrc+(long)(t)*KVBLK*KP,(unsigned)__builtin_amdgcn_readfirstlane(kdst+(slot)))
  #define DMA_V(t,slot) glds16(vsrc+(long)(t)*KVBLK*KP,(unsigned)__builtin_amdgcn_readfirstlane(vdst+(slot)))
  const int vb0=(int)(lds0+LDS_V)+((lane>>4)&1)*32+(lane&3)*8+(4*hi+((lane&15)>>2))*64;
  const char*Kbase=shm+LDS_K; bf16x8 kf[8];
  const lds_cptr shm3=(lds_cptr)shm; const lds_cptr kp0=shm3+LDS_K+hi*1024+r32*16; const lds_cptr vp0=shm3+LDS_V+((lane>>4)&1)*32+(lane&3)*8+(4*hi+((lane&15)>>2))*64;
  DMA_K(0,0);DMA_V(0,0);DMA_K(1,SLOTB);
  bf16x8 qr[4];
  #pragma unroll
  for(int d0=0;d0<4;++d0)qr[d0]=*reinterpret_cast<const bf16x8*>(&Qw[(long)r32*QP+d0*16+hi*8]);
  qnormrope(qr,qn,(int)(qrow0-kvrow0)+wid*QBLK+r32,hi);
  float mhat=0.f,l_reg=0.f;f32x16 o[2];o[0]=f32x16{};o[1]=f32x16{};f32x16 negm=f32x16{};asm volatile("":"+v"(negm));
  #define CMASK(P0,P1,t) do{}while(0)
  bool resc=false;
  #define START(P0,P1) do{ const float rm=rowmax(P0,P1); resc=false; \
    { const float dl=rm; mhat=fadd_s(mhat,dl); \
      _Pragma("unroll") for(int r=0;r<16;++r){P0[r]=fsub_s(P0[r],dl);P1[r]=fsub_s(P1[r],dl);} \
      _Pragma("unroll") for(int r=0;r<16;++r)negm[r]=-mhat; asm volatile("":"+v"(negm)); } \
    _Pragma("unroll") for(int r=0;r<16;++r)P0[r]=__builtin_amdgcn_exp2f(P0[r]); }while(0)
  #define RESC() do{ if(resc){ asm volatile("s_waitcnt lgkmcnt(0)":::"memory"); \
      _Pragma("unroll") for(int d_=0;d_<2;++d_) _Pragma("unroll") for(int r=0;r<16;++r)o[d_][r]*=wsf[crow(r,hi)]; } }while(0)
  f32x16 pA0,pA1,pB0,pB1;
  int sl_prev=0,sl_cur=0,sl_next=SLOTB;
  #define ROT() do{sl_prev=sl_cur;sl_cur=sl_next;sl_next=(sl_next==(NSLOT-1)*SLOTB)?0:sl_next+SLOTB;}while(0)
  DMA_K(2,2*SLOTB);
  WAIT_BAR(3);
  qkt(pA0,pA1,Kbase,qr,negm,r32,hi);asm volatile("s_nop 15\n\ts_nop 7":"+v"(pA0),"+v"(pA1));CMASK(pA0,pA1,0);
  START(pA0,pA1);
  _Pragma("unroll") for(int r=0;r<16;++r)pA1[r]=__builtin_amdgcn_exp2f(pA1[r]);
  WAIT_BAR(0);
  DMA_K(3,0);DMA_V(1,SLOTB);
  ROT();
  kload8(kf,kp0+sl_cur);
  WAIT_BAR(2);
  s16x4 vlo[8],vhi[8]; u32x4 pw0,pw1,pw2,pw3;
  #define PKW(P,B) cvtpk_s(P[B],P[B+1])
  #define PAF(k) __builtin_bit_cast(bf16x8,pw##k)
  #define VFR(i) (bf16x8){vlo[i][0],vlo[i][1],vlo[i][2],vlo[i][3],vhi[i][0],vhi[i][1],vhi[i][2],vhi[i][3]}
  #define PIN(x) asm volatile("":"+v"(x))
  #define MX3(a,b,c) __builtin_fmaxf(__builtin_fmaxf((a),(b)),(c))
  #define GAPA(MF,A0,A1,A2,A3,W0,W1,PW) do{ MF; sacc+=A0; sacc+=A1; sacc+=A2; sacc+=A3; PIN(sacc); W0; W1; PIN(PW); SBAR(); }while(0)
  #define EX(v) __builtin_amdgcn_exp2f(v)
  #define GAPB(MF,X,B) do{ MF; X[B]=EX(X[B]); X[B+1]=EX(X[B+1]); X[B+2]=EX(X[B+2]); X[B+3]=EX(X[B+3]); PIN(X); SBAR(); }while(0)
  #define VRD(i) do{ vlo[i]=vtr(vp_+(((i)>>2)*4096+((i)&3)*1024)); vhi[i]=vtr(vp_+(((i)>>2)*4096+((i)&3)*1024+512)); }while(0)
  #define KRD(G,j) do{ if(G){ kload2(kf,kp0+sl_next,j); SBAR(); } }while(0)
  #define STEP(C0,C1,P0,P1,t,GK,GV,GL) do{ SBAR(); \
    const lds_cptr vp_=vp0+sl_prev; \
    VRD(0); SBAR(); float sacc=(P0[0]+P0[1]); \
    GAPA(C0=__builtin_amdgcn_mfma_f32_32x32x16_bf16(kf[0],qr[0],negm,0,0,0), P0[2],P0[3],P0[4],P0[5],     pw0[0]=PKW(P0,0), pw0[1]=PKW(P0,2), pw0); \
    VRD(4); SBAR(); GAPA(C1=__builtin_amdgcn_mfma_f32_32x32x16_bf16(kf[1],qr[0],negm,0,0,0), P0[6],P0[7],P0[8],P0[9],     pw0[2]=PKW(P0,4), pw0[3]=PKW(P0,6), pw0); \
    VRD(1); SBAR(); GAPA(C0=__builtin_amdgcn_mfma_f32_32x32x16_bf16(kf[2],qr[1],C0,0,0,0),   P0[10],P0[11],P0[12],P0[13], pw1[0]=PKW(P0,8), pw1[1]=PKW(P0,10), pw1); \
    VRD(5); SBAR(); GAPA(C1=__builtin_amdgcn_mfma_f32_32x32x16_bf16(kf[3],qr[1],C1,0,0,0),   P0[14],P0[15],P1[0],P1[1],   pw1[2]=PKW(P0,12),pw1[3]=PKW(P0,14), pw1); \
    VRD(2); SBAR(); GAPA(C0=__builtin_amdgcn_mfma_f32_32x32x16_bf16(kf[4],qr[2],C0,0,0,0),   P1[2],P1[3],P1[4],P1[5],     pw2[0]=PKW(P1,0), pw2[1]=PKW(P1,2), pw2); \
    VRD(6); SBAR(); GAPA(C1=__builtin_amdgcn_mfma_f32_32x32x16_bf16(kf[5],qr[2],C1,0,0,0),   P1[6],P1[7],P1[8],P1[9],     pw2[2]=PKW(P1,4), pw2[3]=PKW(P1,6), pw2); \
    VRD(3); SBAR(); GAPA(C0=__builtin_amdgcn_mfma_f32_32x32x16_bf16(kf[6],qr[3],C0,0,0,0),   P1[10],P1[11],P1[12],P1[13], pw3[0]=PKW(P1,8), pw3[1]=PKW(P1,10), pw3); \
    VRD(7); SBAR(); GAPA(C1=__builtin_amdgcn_mfma_f32_32x32x16_bf16(kf[7],qr[3],C1,0,0,0),   P1[14],P1[15],0.f,0.f,       pw3[2]=PKW(P1,12),pw3[3]=PKW(P1,14), pw3); \
    l_reg+=sacc; \
    if(GK){DMA_K((t)+3,sl_cur);} if(GV){DMA_V((t)+1,sl_next);} \
    CMASK(C0,C1,t); \
    if(track){ float a=MX3(C0[0],C0[1],C1[0]),b=MX3(C0[2],C0[3],C1[1]); a=MX3(a,C1[2],C1[3]); \
      _Pragma("unroll") for(int r=4;r<16;r+=4){a=MX3(a,C0[r],C0[r+1]);b=MX3(b,C0[r+2],C0[r+3]);a=MX3(a,C1[r],C1[r+1]);b=MX3(b,C1[r+2],C1[r+3]);} \
      float rm=__builtin_fmaxf(a,b); { auto rr=__builtin_amdgcn_permlane32_swap(__float_as_uint(rm),__float_as_uint(rm),false,false); rm=__builtin_fmaxf(__uint_as_float(rr[0]),__uint_as_float(rr[1])); } \
      resc=false; \
      if(__builtin_expect(__any(rm>(float)THRL),0)){ const float dl=__builtin_fmaxf(rm,0.f); mhat+=dl; \
        _Pragma("unroll") for(int r=0;r<16;++r){C0[r]-=dl;C1[r]-=dl;} \
        _Pragma("unroll") for(int r=0;r<16;++r)negm[r]=-mhat; asm volatile("":"+v"(negm)); \
        const float f=__builtin_amdgcn_exp2f(-dl); l_reg*=f; if(hi==0)wsf[r32]=f; resc=true; } } \
    SBAR(); \
    GAPB(o[0]=__builtin_amdgcn_mfma_f32_32x32x16_bf16(PAF(0),VFR(0),o[0],0,0,0), C0,0); \
    GAPB(o[1]=__builtin_amdgcn_mfma_f32_32x32x16_bf16(PAF(0),VFR(4),o[1],0,0,0), C0,4); \
    KRD(GL,0); GAPB(o[0]=__builtin_amdgcn_mfma_f32_32x32x16_bf16(PAF(1),VFR(1),o[0],0,0,0), C0,8); \
    KRD(GL,1); GAPB(o[1]=__builtin_amdgcn_mfma_f32_32x32x16_bf16(PAF(1),VFR(5),o[1],0,0,0), C0,12); \
    KRD(GL,2); GAPB(o[0]=__builtin_amdgcn_mfma_f32_32x32x16_bf16(PAF(2),VFR(2),o[0],0,0,0), C1,0); \
    KRD(GL,3); GAPB(o[1]=__builtin_amdgcn_mfma_f32_32x32x16_bf16(PAF(2),VFR(6),o[1],0,0,0), C1,4); \
    GAPB(o[0]=__builtin_amdgcn_mfma_f32_32x32x16_bf16(PAF(3),VFR(3),o[0],0,0,0), C1,8); \
    GAPB(o[1]=__builtin_amdgcn_mfma_f32_32x32x16_bf16(PAF(3),VFR(7),o[1],0,0,0), C1,12); \
    }while(0)
  int t=1;
  #undef CMASK
  #define CMASK(P0,P1,t) do{}while(0)
  for(;t+5<NT;t+=2){
    STEP(pB0,pB1,pA0,pA1,t,true,true,true);     WAIT_BAR(2); RESC(); ROT();
    STEP(pA0,pA1,pB0,pB1,t+1,true,true,true);   WAIT_BAR(2); RESC(); ROT();
  }
  #undef CMASK
  #define CMASK(P0,P1,t) do{}while(0)
  #define ENDW(tt) do{ if((tt)+3<NT){WAIT_BAR(2);} else if((tt)+2<NT){WAIT_BAR(1);} else {WAIT_BAR(0);} }while(0)
  for(;t+1<NT;t+=2){
    STEP(pB0,pB1,pA0,pA1,t,(t+3<NT),(t+1<NT),(t+1<NT));       ENDW(t);   RESC(); ROT();
    STEP(pA0,pA1,pB0,pB1,t+1,(t+4<NT),(t+2<NT),(t+2<NT));     ENDW(t+1); RESC(); ROT();
  }
  STEP(pB0,pB1,pA0,pA1,NT-1,false,false,false); RESC();
  { float sacc=pB0[0]+pB0[1]; _Pragma("unroll") for(int r=2;r<16;++r)sacc+=pB0[r]; _Pragma("unroll") for(int r=0;r<16;++r)sacc+=pB1[r]; l_reg+=sacc;
    pw0=(u32x4){PKW(pB0,0),PKW(pB0,2),PKW(pB0,4),PKW(pB0,6)};pw1=(u32x4){PKW(pB0,8),PKW(pB0,10),PKW(pB0,12),PKW(pB0,14)};pw2=(u32x4){PKW(pB1,0),PKW(pB1,2),PKW(pB1,4),PKW(pB1,6)};pw3=(u32x4){PKW(pB1,8),PKW(pB1,10),PKW(pB1,12),PKW(pB1,14)};
    SBAR(); pv(o,vb0+sl_cur,PAF(0),PAF(1),PAF(2),PAF(3)); }
  #undef PKW
  #undef PAF
  #undef VFR
  #undef PIN
  #undef MX3
  #undef GAPA
  #undef GAPB
  #undef EX
  #undef VRD
  #undef KRD
  #undef STEP
  #undef ENDW
  {auto rr=__builtin_amdgcn_permlane32_swap(__float_as_uint(l_reg),__float_as_uint(l_reg),false,false);l_reg=__uint_as_float(rr[0])+__uint_as_float(rr[1]);}
  if(hi==0)wsf[32+r32]=l_reg;asm volatile("s_waitcnt lgkmcnt(0)":::"memory");
  float rli[16];
  #pragma unroll
  for(int r=0;r<16;++r)rli[r]=__builtin_amdgcn_rcpf(wsf[32+crow(r,hi)]);
  bf16*Ow=O+(qrow0+wid*QBLK)*QP+h*D; const bf16*Gw=Gt+(qrow0+wid*QBLK)*QP+h*D;
  { bf16*stg=(bf16*)(shm+LDS_OST)+wid*2048;
    #pragma unroll
    for(int r=0;r<16;++r){const int orow=crow(r,hi);
      #pragma unroll
      for(int d0=0;d0<2;++d0)stg[orow*64+d0*32+r32]=__float2bfloat16(o[d0][r]*rli[r]);}
    asm volatile("s_waitcnt lgkmcnt(0)":::"memory");
    #pragma unroll
    for(int i=0;i<4;++i){const int row=i*8+(lane>>3),ch=lane&7; const u32x4 v=*(const u32x4*)(stg+row*64+ch*8); const u32x4 gv=*(const u32x4*)(Gw+(long)row*QP+ch*8); ATTN_STORE16(Ow+(long)row*QP+ch*8,mulgate(v,gv));} }
  asm volatile("s_waitcnt lgkmcnt(0)\n\ts_barrier":::"memory");
  #undef DMA_K
  #undef DMA_V
  #undef CMASK
  #undef START
  #undef RESC
  #undef ROT
}
constexpr int ATTN_LDS_BYTES=LDS_BYTES;
#undef SBAR
#undef WAIT_BAR
}

constexpr int NWAVES = 8;
constexpr int D = 1024, TP = 8192, TS = 2048, NB = 8;
constexpr int MP = NB * TP, MS = NB * TS, M = MP + MS;
constexpr int INW = 6656, PLE = 256;
constexpr float EPS = 1e-6f;
#ifndef MK_N_LAUNCHES
#define MK_N_LAUNCHES 1
#endif
constexpr int N_LAUNCHES = MK_N_LAUNCHES;
constexpr int N_PHASES = 8;

constexpr size_t MiB = 1u << 20;
constexpr size_t WS_CTL = 0, CTL_ZERO_BYTES = 64 * 1024;
constexpr size_t WS_R2 = 1 * MiB;
constexpr size_t WS_WIN = 2 * MiB;
constexpr size_t WS_WAB = 16 * MiB;
constexpr size_t WS_WO = 20 * MiB;
constexpr size_t WS_WG = 22 * MiB;
constexpr size_t WS_WPLE = 24 * MiB;
constexpr size_t WS_PBF = 26 * MiB;
constexpr size_t WS_RA = 80 * MiB;
constexpr size_t WS_RB = 240 * MiB;
constexpr size_t WS_RC = 400 * MiB;
constexpr size_t WS_RD = 560 * MiB;
constexpr size_t WS_RE = 720 * MiB;
constexpr size_t WS_RK = 880 * MiB;
constexpr size_t WS_RV = 920 * MiB;
constexpr size_t WS_END = 960 * MiB;

constexpr int RING_BYTES = 131072;
constexpr int LDS_BYTES = 147456;
constexpr int MISC_OFF = LDS_BYTES - 256;

#define GAS __attribute__((address_space(1)))
#define LAS __attribute__((address_space(3)))
typedef unsigned short bf16;
typedef unsigned v4u __attribute__((ext_vector_type(4)));
typedef unsigned v2u __attribute__((ext_vector_type(2)));
typedef float f32x4 __attribute__((ext_vector_type(4)));
#define LDS_WAIT() asm volatile("s_waitcnt lgkmcnt(0)" ::: "memory")
#define VM_WAIT() asm volatile("s_waitcnt vmcnt(0)" ::: "memory")
__device__ __forceinline__ unsigned pk2(float lo, float hi) { return pg8::cvt_pk_bf16(lo, hi); }
__device__ __forceinline__ float blo(unsigned w) { return __uint_as_float(w << 16); }
__device__ __forceinline__ float bhi(unsigned w) { return __uint_as_float(w & 0xffff0000u); }

#define XB_TMO      128
#define XB_XCNT(j)  (256  + 64 * (j))
#define XB_XSUB(j)  (1280 + 64 * (j))
#define XB_XGEN(j)  (2304 + 64 * (j))
#define XB_TOP      3328
#define XB_TOPGEN   3392
#define XCD_BAR_WORDS 3456
#define XB_SPIN_CAP (1u << 18)

__device__ __forceinline__ unsigned xb_ld(unsigned* p)              { return __hip_atomic_load(p, __ATOMIC_RELAXED, __HIP_MEMORY_SCOPE_AGENT); }
__device__ __forceinline__ unsigned xb_add(unsigned* p, unsigned v) { return __hip_atomic_fetch_add(p, v, __ATOMIC_RELAXED, __HIP_MEMORY_SCOPE_AGENT); }
__device__ __forceinline__ unsigned xb_xcc_id() { return (unsigned)__builtin_amdgcn_s_getreg((3 << 11) | 20) & 0xFu; }
#define XB_SPIN(cond, bar) do { unsigned _sp = 0; while (cond) { __builtin_amdgcn_s_sleep(1); \
    if ((++_sp & 255u) == 0u) { if (xb_ld(&(bar)[XB_TMO])) break; if (_sp > XB_SPIN_CAP) { atomicAdd(&(bar)[XB_TMO], 1u); break; } } } } while (0)

struct XcdBarrier {
    unsigned* bar; unsigned x;
    volatile LAS unsigned* st;
};

__device__ __forceinline__ XcdBarrier xcd_barrier_post(unsigned* bar, volatile LAS unsigned* st) {
    XcdBarrier b; b.bar = bar; b.x = xb_xcc_id(); b.st = st;
    if (threadIdx.x == 0) (void)xb_add(&bar[XB_XCNT(b.x)], 1u);
    return b;
}
__device__ __forceinline__ void xcd_barrier_complete(unsigned* bar, unsigned x, unsigned& nloc, unsigned& nx) {
    const unsigned G = gridDim.x * gridDim.y * gridDim.z;
    unsigned sum, cnt, mine, sp = 0u;
    for (;;) {
        sum = 0u; cnt = 0u; mine = 0u;
#pragma unroll
        for (unsigned j = 0; j < 16; ++j) { const unsigned c = xb_ld(&bar[XB_XCNT(j)]); sum += c; cnt += (c > 0u) ? 1u : 0u; mine = (j == x) ? c : mine; }
        if (sum == G) break;
        __builtin_amdgcn_s_sleep(1);
        if ((++sp & 255u) == 0u) { if (xb_ld(&bar[XB_TMO])) break; if (sp > XB_SPIN_CAP) { atomicAdd(&bar[XB_TMO], 1u); break; } }
    }
    nloc = mine > 0u ? mine : 1u; nx = cnt > 0u ? cnt : 1u;
}

__device__ __forceinline__ void xcd_barrier(const XcdBarrier& b) {
    asm volatile("s_waitcnt vmcnt(0)" ::: "memory");
    __syncthreads();
    if (threadIdx.x == 0) {
        unsigned* bar = b.bar;
        __builtin_amdgcn_s_waitcnt(0);
        unsigned nloc = b.st[0], nx = b.st[1];
        if (nloc == 0u) { xcd_barrier_complete(bar, b.x, nloc, nx); b.st[0] = nloc; b.st[1] = nx; }
        const unsigned old = xb_add(&bar[XB_XSUB(b.x)], 1u);
        const unsigned gen = old / nloc;
        if (old + 1u == (gen + 1u) * nloc) {
            __builtin_amdgcn_fence(__ATOMIC_RELEASE, "agent");
            asm volatile("s_waitcnt vmcnt(0)" ::: "memory");
            const unsigned og = xb_add(&bar[XB_TOP], 1u);
            const unsigned tg = og / nx;
            if (og + 1u == (tg + 1u) * nx) xb_add(&bar[XB_TOPGEN], 1u);
            else XB_SPIN(xb_ld(&bar[XB_TOPGEN]) == tg, bar);
            __builtin_amdgcn_fence(__ATOMIC_ACQUIRE, "agent");
            xb_add(&bar[XB_XGEN(b.x)], 1u);
            asm volatile("s_waitcnt vmcnt(0)" ::: "memory");
        } else {
            XB_SPIN(xb_ld(&bar[XB_XGEN(b.x)]) == gen, bar);
            __builtin_amdgcn_fence(__ATOMIC_ACQUIRE, "agent");
            asm volatile("s_waitcnt vmcnt(0)" ::: "memory");
        }
    }
    __syncthreads();
}

struct Args {
    const float *x_p, *x_s, *p_p, *p_s, *norm_pre, *w_in, *pool_w, *pool_scale, *w_a, *q_norm, *k_norm, *w_b, *w_out, *norm_post, *ple_norm, *w_gate, *w_ple;
    float* out; unsigned char* ws; int ph_lo, ph_hi;
};

__device__ __forceinline__ float wave_sum(float v) {
#pragma unroll
    for (int o = 1; o < 64; o <<= 1) v += __shfl_xor(v, o);
    return v;
}
__device__ __forceinline__ void p0_transpose_item(const float* W, int K, int N, bf16* WT, int row_off, int ldt, int koff, LAS float* scr, int item, int lane, const float* kscale = nullptr) {
    const int nblk = N / 32, kb = item / nblk, nb = item % nblk, k0 = 64 * kb, n0 = 32 * nb;
#pragma unroll 8
    for (int i = 0; i < 32; ++i) { const int kk = 2 * i + (lane >> 5); float wv = W[(size_t)(k0 + kk) * N + n0 + (lane & 31)]; if (kscale) wv *= kscale[k0 + kk]; scr[kk * 33 + (lane & 31)] = wv; }
    LDS_WAIT(); asm volatile("" ::: "memory");
    const int c = lane & 7;
#pragma unroll
    for (int j = 0; j < 4; ++j) { const int n = (lane >> 3) + 8 * j; const LAS float* s = scr + (8 * c) * 33 + n;
        v4u o; o.x = pk2(s[0 * 33], s[1 * 33]); o.y = pk2(s[2 * 33], s[3 * 33]); o.z = pk2(s[4 * 33], s[5 * 33]); o.w = pk2(s[6 * 33], s[7 * 33]);
        *(GAS v4u*)(WT + (size_t)(row_off + n0 + n) * ldt + koff + k0 + 8 * c) = o; }
    LDS_WAIT(); asm volatile("" ::: "memory");
}
__device__ __forceinline__ const float* xrow_ptr(const Args& a, int m) { return m < MP ? a.x_p + (size_t)m * D : a.x_s + (size_t)(m - MP) * D; }

__device__ __forceinline__ void phase0(const Args& a, LAS unsigned char* lds, int vcu, int G) {
    int tid = threadIdx.x; asm volatile("" : "+v"(tid));
    const int lane = tid & 63, wave = __builtin_amdgcn_readfirstlane(tid >> 6);
    LAS float* scr = (LAS float*)(lds + wave * 16384);
    const int gw = vcu * NWAVES + wave, NGW = G * NWAVES;
    unsigned char* ws = a.ws;
    {
        LAS float* At = (LAS float*)lds; LAS float* Bt = (LAS float*)(lds + 64 * 257 * 4 + 64);
        bf16* WT = (bf16*)(ws + WS_WIN);
        for (int tile = vcu; tile < 256; tile += G) {
            const int kb = tile >> 4, g = (tile >> 2) & 3, db = tile & 3, k0 = 64 * kb, d0 = 64 * db;
#pragma unroll
            for (int i = 0; i < 8; ++i) { const int row = (tid >> 6) + 8 * i, c4 = tid & 63;
                const f32x4 v = *(const GAS f32x4*)(a.w_in + (size_t)(k0 + row) * INW + g * 256 + 4 * c4);
                LAS float* d = At + row * 257 + 4 * c4; d[0] = v.x; d[1] = v.y; d[2] = v.z; d[3] = v.w; }
#pragma unroll
            for (int i = 0; i < 8; ++i) { const int c = (tid >> 4) + 32 * i, c4 = tid & 15;
                *(LAS f32x4*)(Bt + c * 64 + 4 * c4) = *(const GAS f32x4*)(a.pool_w + (size_t)g * 65536 + (size_t)c * 256 + d0 + 4 * c4); }
            __syncthreads();
            float acc[8];
#pragma unroll
            for (int j = 0; j < 8; ++j) acc[j] = 0.f;
#pragma unroll 4
            for (int c = 0; c < 256; ++c) { const float av = At[lane * 257 + c]; const f32x4 b0 = *(const LAS f32x4*)(Bt + c * 64 + wave * 8), b1 = *(const LAS f32x4*)(Bt + c * 64 + wave * 8 + 4);
                acc[0] += av * b0.x; acc[1] += av * b0.y; acc[2] += av * b0.z; acc[3] += av * b0.w; acc[4] += av * b1.x; acc[5] += av * b1.y; acc[6] += av * b1.z; acc[7] += av * b1.w; }
#pragma unroll
            for (int j = 0; j < 8; ++j) WT[(size_t)(g * 256 + d0 + wave * 8 + j) * D + k0 + lane] = (bf16)(pk2(acc[j], 0.f) & 0xffffu);
            __syncthreads();
        }
    }
    constexpr int I_IN = (D / 64) * ((INW - 1024) / 32), I_SQ = (D / 64) * (D / 32), I_PLE = (PLE / 64) * (D / 32);
    constexpr int NITEMS = I_IN + 4 * I_SQ + I_PLE;
    for (int it = gw; it < NITEMS; it += NGW) {
        int r = it;
        if (r < I_IN) { const int kb = r / 176, nb = 32 + r % 176; p0_transpose_item(a.w_in, D, INW, (bf16*)(ws + WS_WIN), 0, D, 0, scr, kb * (INW / 32) + nb, lane); continue; } r -= I_IN;
        if (r < I_SQ) { p0_transpose_item(a.w_a, D, D, (bf16*)(ws + WS_WAB), 0, 2048, 0, scr, r, lane); continue; } r -= I_SQ;
        if (r < I_SQ) { p0_transpose_item(a.w_b, D, D, (bf16*)(ws + WS_WAB), 0, 2048, 1024, scr, r, lane); continue; } r -= I_SQ;
        if (r < I_SQ) { p0_transpose_item(a.w_out, D, D, (bf16*)(ws + WS_WO), 0, D, 0, scr, r, lane); continue; } r -= I_SQ;
        if (r < I_SQ) { p0_transpose_item(a.w_gate, D, D, (bf16*)(ws + WS_WG), 0, D, 0, scr, r, lane, a.ple_norm); continue; } r -= I_SQ;
        p0_transpose_item(a.w_ple, PLE, D, (bf16*)(ws + WS_WPLE), 0, PLE, 0, scr, r, lane);
    }
    f32x4 gpre[4];
#pragma unroll
    for (int j = 0; j < 4; ++j) gpre[j] = ((const GAS f32x4*)a.norm_pre)[lane + 64 * j];
    bf16* H = (bf16*)(ws + WS_RA); bf16* PB = (bf16*)(ws + WS_PBF);
    for (int m = gw; m < M; m += NGW) {
        const GAS f32x4* xr = (const GAS f32x4*)xrow_ptr(a, m) + lane;
        f32x4 v[4]; float s = 0.f;
#pragma unroll
        for (int j = 0; j < 4; ++j) { v[j] = xr[64 * j]; s += (v[j].x * v[j].x + v[j].y * v[j].y) + (v[j].z * v[j].z + v[j].w * v[j].w); }
        const float rstd = 1.0f / sqrtf(wave_sum(s) * (1.f / D) + EPS);
        GAS v2u* o8 = (GAS v2u*)(H + (size_t)m * D) + lane;
#pragma unroll
        for (int j = 0; j < 4; ++j) { const f32x4 y = v[j] * rstd * gpre[j]; o8[64 * j] = (v2u){pk2(y.x, y.y), pk2(y.z, y.w)}; }
        const float* prow = m < MP ? a.p_p + (size_t)m * PLE : a.p_s + (size_t)(m - MP) * PLE;
        const f32x4 pv = ((const GAS f32x4*)prow)[lane];
        ((GAS v2u*)(PB + (size_t)m * PLE))[lane] = (v2u){pk2(pv.x, pv.y), pk2(pv.z, pv.w)};
    }
}

__device__ __forceinline__ void normrope16(bf16* ptr, int t, int qd, const float* gain, float scale) {
    const v4u w0 = ((const GAS v4u*)ptr)[0], w1 = ((const GAS v4u*)ptr)[1];
    float av[16];
    av[0] = blo(w0.x); av[1] = bhi(w0.x); av[2] = blo(w0.y); av[3] = bhi(w0.y); av[4] = blo(w0.z); av[5] = bhi(w0.z); av[6] = blo(w0.w); av[7] = bhi(w0.w);
    av[8] = blo(w1.x); av[9] = bhi(w1.x); av[10] = blo(w1.y); av[11] = bhi(w1.y); av[12] = blo(w1.z); av[13] = bhi(w1.z); av[14] = blo(w1.w); av[15] = bhi(w1.w);
    float ss = 0.f;
#pragma unroll
    for (int i = 0; i < 16; ++i) ss += av[i] * av[i];
    ss += __shfl_xor(ss, 1); ss += __shfl_xor(ss, 2);
    const float rstd = 1.0f / sqrtf(ss * (1.f / 64.f) + EPS);
    const float pos = (qd < 2) ? (float)(t >> 6) : (float)(t & 63);
    const float sgn = (qd & 1) ? 1.f : -1.f;
    float o[16];
#pragma unroll
    for (int i4 = 0; i4 < 4; ++i4) { const f32x4 g = ((const GAS f32x4*)(gain + qd * 16))[i4];
        av[4 * i4 + 0] *= rstd * g.x; av[4 * i4 + 1] *= rstd * g.y; av[4 * i4 + 2] *= rstd * g.z; av[4 * i4 + 3] *= rstd * g.w; }
#pragma unroll
    for (int i = 0; i < 16; ++i) {
        const float pr = __shfl_xor(av[i], 1);
        const float freq = __builtin_amdgcn_exp2f(-(float)i * 0.83048202372184058696f);
        float rev = pos * freq * 0.15915494309189533577f; rev = __builtin_amdgcn_fractf(rev);
        const float sn = __builtin_amdgcn_sinf(rev), cs = __builtin_amdgcn_cosf(rev);
        o[i] = (av[i] * cs + sgn * pr * sn) * scale;
    }
    v4u r0, r1;
    r0.x = pk2(o[0], o[1]); r0.y = pk2(o[2], o[3]); r0.z = pk2(o[4], o[5]); r0.w = pk2(o[6], o[7]);
    r1.x = pk2(o[8], o[9]); r1.y = pk2(o[10], o[11]); r1.z = pk2(o[12], o[13]); r1.w = pk2(o[14], o[15]);
    ((GAS v4u*)ptr)[0] = r0; ((GAS v4u*)ptr)[1] = r1;
}
__device__ __forceinline__ int tok_of_row(int m) { return m < MP ? (m & (TP - 1)) : (m & (TS - 1)); }
__device__ __forceinline__ void phase2(const Args& a, int vcu, int G) {
    int tid = threadIdx.x; asm volatile("" : "+v"(tid));
    const int lane = tid & 63, wave = __builtin_amdgcn_readfirstlane(tid >> 6);
    bf16* K = (bf16*)(a.ws + WS_RK);
    const int gw = vcu * NWAVES + wave, NGW = G * NWAVES;
    for (int m4 = gw; m4 < M / 4; m4 += NGW) { const int m = m4 * 4 + (lane >> 4); normrope16(K + (size_t)m * 256 + (lane & 15) * 16, tok_of_row(m), lane & 3, a.k_norm, 1.0f); }
}
template <int W> __device__ __forceinline__ void pool_item(const bf16* Z, const bf16* SZA, bf16* AO, const float* pscale, int g, int rb, int cc, int rsub) {
    const f32x4 ps0 = *(const GAS f32x4*)(pscale + g * 256 + cc * 8), ps1 = *(const GAS f32x4*)(pscale + g * 256 + cc * 8 + 4);
    constexpr int half = W / 2;
#pragma unroll 1
    for (int rr = 0; rr < 4; ++rr) {
        const int m = rb * 64 + rr * 16 + rsub;
        const int T = m < MP ? TP : TS, s0 = m < MP ? (m & ~(TP - 1)) : (m & ~(TS - 1)), t = m - s0;
        const bf16* colp = Z + (size_t)s0 * D + g * 256 + cc * 8;
        v4u wv[W];
#pragma unroll
        for (int i = 0; i < W; ++i) { const int sidx = t - half + i; const int sc = min(max(sidx, 0), T - 1); wv[i] = *(const GAS v4u*)(colp + (size_t)sc * D); }
        const v4u gz = *(const GAS v4u*)(SZA + (size_t)m * D + g * 256 + cc * 8);
        float acc[8];
#pragma unroll
        for (int e = 0; e < 8; ++e) acc[e] = 0.f;
#pragma unroll
        for (int i = 0; i < W; ++i) { const int sidx = t - half + i; const float wgt = (sidx >= 0 && sidx < T) ? 1.f : 0.f; const v4u w = wv[i];
            acc[0] += wgt * blo(w.x); acc[1] += wgt * bhi(w.x); acc[2] += wgt * blo(w.y); acc[3] += wgt * bhi(w.y); acc[4] += wgt * blo(w.z); acc[5] += wgt * bhi(w.z); acc[6] += wgt * blo(w.w); acc[7] += wgt * bhi(w.w); }
        const v4u own = wv[half];
        const int lo = max(t - half, 0), hi = min(t + half, T);
        const float inv = 1.0f / (float)(hi - lo);
        v4u o; o.x = pk2((acc[0] * inv - blo(own.x)) * ps0.x * blo(gz.x), (acc[1] * inv - bhi(own.x)) * ps0.y * bhi(gz.x));
        o.y = pk2((acc[2] * inv - blo(own.y)) * ps0.z * blo(gz.y), (acc[3] * inv - bhi(own.y)) * ps0.w * bhi(gz.y));
        o.z = pk2((acc[4] * inv - blo(own.z)) * ps1.x * blo(gz.z), (acc[5] * inv - bhi(own.z)) * ps1.y * bhi(gz.z));
        o.w = pk2((acc[6] * inv - blo(own.w)) * ps1.z * blo(gz.w), (acc[7] * inv - bhi(own.w)) * ps1.w * bhi(gz.w));
        *(GAS v4u*)(AO + (size_t)m * D + g * 256 + cc * 8) = o;
    }
}
__device__ __forceinline__ void pool_tail(const Args& a, int vcu, int G) {
    int tid = threadIdx.x; asm volatile("" : "+v"(tid));
    unsigned char* ws = a.ws;
    const bf16* Z = (const bf16*)(ws + WS_RB); const bf16* SZA = (const bf16*)(ws + WS_RC); bf16* AO = (bf16*)(ws + WS_RA);
    const int cc = tid & 31, rsub = tid >> 5;
    for (int it = vcu; it < (M / 64) * 4; it += G) {
        const int g = it & 3, rb = it >> 2;
        if (g == 0) pool_item<2>(Z, SZA, AO, a.pool_scale, g, rb, cc, rsub);
        else if (g == 1) pool_item<4>(Z, SZA, AO, a.pool_scale, g, rb, cc, rsub);
        else if (g == 2) pool_item<8>(Z, SZA, AO, a.pool_scale, g, rb, cc, rsub);
        else pool_item<16>(Z, SZA, AO, a.pool_scale, g, rb, cc, rsub);
    }
}

__device__ __forceinline__ void phase6(const Args& a, int vcu, int G) {
    int tid = threadIdx.x; asm volatile("" : "+v"(tid));
    const int lane = tid & 63, wave = __builtin_amdgcn_readfirstlane(tid >> 6);
    unsigned char* ws = a.ws;
    const bf16* Y = (const bf16*)(ws + WS_RA); bf16* X1 = (bf16*)(ws + WS_RB); float* R2 = (float*)(ws + WS_R2);
    const int gw = vcu * NWAVES + wave, NGW = G * NWAVES;
    f32x4 gpost[4];
#pragma unroll
    for (int j = 0; j < 4; ++j) gpost[j] = ((const GAS f32x4*)a.norm_post)[lane + 64 * j];
    for (int m = gw; m < M; m += NGW) {
        const GAS f32x4* xr = (const GAS f32x4*)xrow_ptr(a, m) + lane;
        const GAS v2u* yr = (const GAS v2u*)(Y + (size_t)m * D) + lane;
        f32x4 xv[4], yv[4]; float s = 0.f;
#pragma unroll
        for (int j = 0; j < 4; ++j) { xv[j] = xr[64 * j]; const v2u w = yr[64 * j]; yv[j] = (f32x4){blo(w.x), bhi(w.x), blo(w.y), bhi(w.y)};
            s += (yv[j].x * yv[j].x + yv[j].y * yv[j].y) + (yv[j].z * yv[j].z + yv[j].w * yv[j].w); }
        const float rstd = 1.0f / sqrtf(wave_sum(s) * (1.f / D) + EPS);
        float s2 = 0.f;
        GAS v2u* o8 = (GAS v2u*)(X1 + (size_t)m * D) + lane;
#pragma unroll
        for (int j = 0; j < 4; ++j) { xv[j] = xv[j] + yv[j] * rstd * gpost[j]; o8[64 * j] = (v2u){pk2(xv[j].x, xv[j].y), pk2(xv[j].z, xv[j].w)};
            s2 += (xv[j].x * xv[j].x + xv[j].y * xv[j].y) + (xv[j].z * xv[j].z + xv[j].w * xv[j].w); }
        const float rstd2 = 1.0f / sqrtf(wave_sum(s2) * (1.f / D) + EPS);
        if (lane == 0) R2[m] = rstd2;
    }
}

__device__ __forceinline__ bool attn_next(int i, int vcu, int G, long& qrow0, long& kvrow0, int& NT, int& h) {
    int samp, b, qb;
    if (G == 256) {
        if (i >= 20) return false;
        const int x = vcu >> 5, j = vcu & 31; b = x;
        if (i < 16) { samp = 0; h = (i >> 2) * 4 + (i & 3); qb = j; }
        else { samp = 1; h = (i - 16) * 4 + (j >> 3); qb = j & 7; }
    } else {
        const int uid = vcu + i * G; if (uid >= 5120) return false;
        if (uid < 4096) { samp = 0; b = uid >> 9; h = (uid >> 5) & 15; qb = uid & 31; }
        else { const int r = uid - 4096; samp = 1; b = r >> 7; h = (r >> 3) & 15; qb = r & 7; }
    }
    if (!samp) { kvrow0 = (long)b * TP; NT = TP / 64; } else { kvrow0 = (long)MP + (long)b * TS; NT = TS / 64; }
    qrow0 = kvrow0 + qb * 256;
    return true;
}

__global__ void __launch_bounds__(NWAVES * 64, 2) fwd_megakernel(Args args) {
    extern __shared__ __attribute__((aligned(16))) unsigned char lds_raw[];
    LAS unsigned char* lds = (LAS unsigned char*)lds_raw;
    const int G = gridDim.x; const int bx = blockIdx.x; const int vcu = (G % 8 == 0) ? (bx % 8) * (G / 8) + bx / 8 : bx;
    cg::grid_group grid = cg::this_grid();
    unsigned char* ws = args.ws;
    const int lo = args.ph_lo, hi = args.ph_hi;
#ifndef PH_MASK
#define PH_MASK 0xFF
#endif
#define IN(k) ((((PH_MASK) >> (k)) & 1) && lo <= (k) && (k) < hi)
#ifndef DUP_MASK
#define DUP_MASK 0
#endif
#define REPS(k) ((((DUP_MASK) >> (k)) & 1) ? 2 : 1)
#define SEAM(k) do { if (IN(k) && IN((k) + 1)) { if ((k) == 0) { VM_WAIT(); grid.sync(); VM_WAIT(); } else { xcd_barrier(bar); } } } while (0)
    volatile LAS unsigned* MISC = (volatile LAS unsigned*)(lds + MISC_OFF);
    if (threadIdx.x < 32) MISC[threadIdx.x] = 0u;
    __syncthreads();
    XcdBarrier bar = xcd_barrier_post((unsigned*)(ws + WS_CTL), MISC);
    bf16* RA = (bf16*)(ws + WS_RA); bf16* RB = (bf16*)(ws + WS_RB); bf16* RC = (bf16*)(ws + WS_RC); bf16* RD = (bf16*)(ws + WS_RD); bf16* RE = (bf16*)(ws + WS_RE);
    bf16* RK = (bf16*)(ws + WS_RK); bf16* RV = (bf16*)(ws + WS_RV);
    bf16* MA = (bf16*)args.out; bf16* MB = (bf16*)args.out + (size_t)M * D;

    if (IN(0)) { for (int rep = 0; rep < REPS(0); ++rep) phase0(args, lds, vcu, G); }
    SEAM(0);
    if (IN(1)) for (int rep = 0; rep < REPS(1); ++rep) {
        pg8::Gemm g{RA, RA, (const bf16*)(ws + WS_WIN), D, D, D, D, 0};
        pg8::StaticOrder S; S.init(M, INW, G, bx);
        pg8::EpiIn E{RB, RC, RD, RK, RV, RE, MA, MB};
        pg8::gemm_phase<pg8::EpiIn, pg8::StaticOrder, true, true>(lds, g, S, E);
    }
    SEAM(1);
    if (IN(2)) { phase2(args, vcu, G); }
    SEAM(2);
    if (IN(3)) {
        long qrow0, kvrow0; int NT, h;
        bool track;
        { const int ln = threadIdx.x & 63; float mq = fabsf(args.q_norm[ln]), mk = fabsf(args.k_norm[ln]);
#pragma unroll
          for (int o = 1; o < 64; o <<= 1) { mq = fmaxf(mq, __shfl_xor(mq, o)); mk = fmaxf(mk, __shfl_xor(mk, o)); }
          track = __builtin_amdgcn_readfirstlane((mq * mk <= 2.6f) ? 0 : 1) != 0; }
        for (int rep = 0; rep < REPS(3); ++rep)
        for (int i = 0; attn_next(i, vcu, G, qrow0, kvrow0, NT, h); ++i)
            attn_body::attn_unit<8>(qrow0, kvrow0, NT, h, (const attn_body::bf16*)RD, (const attn_body::bf16*)RK, (const attn_body::bf16*)RV, (attn_body::bf16*)((REPS(3) == 2 && rep == 0) ? RB : RD), (const attn_body::bf16*)RE, args.q_norm, track, (char*)lds_raw);
        for (int rep = 0; rep < REPS(8); ++rep) pool_tail(args, vcu, G);
    }
    SEAM(3);
    if (IN(4)) {
        pg8::Gemm g{RA, RD, (const bf16*)(ws + WS_WAB), D, 2048, 2048, 1024, 0};
        pg8::DupOrder S; S.init(M, D, G, bx, REPS(4));
        pg8::EpiMerge E{RC, MA, MB};
        pg8::gemm_phase<pg8::EpiMerge, pg8::DupOrder, true, true>(lds, g, S, E);
    }
    SEAM(4);
    if (IN(5)) {
        { pg8::Gemm g{RC, RC, (const bf16*)(ws + WS_WO), D, D, D, D, 0};
          pg8::DupOrder S; S.init(M, D, G, bx, REPS(5));
          pg8::EpiPlain E{RA, D};
          pg8::gemm_phase<pg8::EpiPlain, pg8::DupOrder, true, true>(lds, g, S, E); }
        { pg8::Gemm g{(const bf16*)(ws + WS_PBF), (const bf16*)(ws + WS_PBF), (const bf16*)(ws + WS_WPLE), PLE, PLE, PLE, PLE, 0};
          pg8::DupOrder S; S.init(M, D, G, bx, REPS(9));
          pg8::EpiPlain E{RD, D};
          pg8::gemm_phase<pg8::EpiPlain, pg8::DupOrder, true, true>(lds, g, S, E); }
    }
    SEAM(5);
    if (IN(6)) { for (int rep = 0; rep < REPS(6); ++rep) phase6(args, vcu, G); }
    SEAM(6);
    if (IN(7)) {
        pg8::Gemm g{RB, RB, (const bf16*)(ws + WS_WG), D, D, D, D, 0};
        pg8::StaticOrder S; S.init(M, D, G, bx);
        pg8::EpiFinal E{args.out, RB, RD, (const float*)(ws + WS_R2)};
        pg8::gemm_phase<pg8::EpiFinal, pg8::StaticOrder, true, true>(lds, g, S, E);
    }
#undef IN
#undef SEAM
}

extern "C" void kernel_launch(void* const* d_in, const int* in_sizes, int n_in, void* d_out, int out_size, void* d_ws, size_t ws_size, hipStream_t stream) {
    static int grid = 0;
    if (grid == 0) {
        if (n_in != 17 || in_sizes[0] != MP * D || in_sizes[1] != MS * D || out_size != M * D || ws_size < WS_END) {
            fprintf(stderr, "kernel_launch: unexpected shapes (n_in %d, in0 %d, out %d, ws %zu); nothing launched\n", n_in, n_in > 0 ? in_sizes[0] : -1, out_size, ws_size); grid = -1; return; }
        int dev = 0, cus = 0, per_cu = 0;
        if (hipGetDevice(&dev) != hipSuccess || hipDeviceGetAttribute(&cus, hipDeviceAttributeMultiprocessorCount, dev) != hipSuccess) { fprintf(stderr, "kernel_launch: device query failed\n"); grid = -1; return; }
        if (hipFuncSetAttribute((const void*)fwd_megakernel, hipFuncAttributeMaxDynamicSharedMemorySize, LDS_BYTES) != hipSuccess) { fprintf(stderr, "kernel_launch: hipFuncSetAttribute failed\n"); grid = -1; return; }
        if (hipOccupancyMaxActiveBlocksPerMultiprocessor(&per_cu, (const void*)fwd_megakernel, NWAVES * 64, LDS_BYTES) != hipSuccess || per_cu < 1) { fprintf(stderr, "kernel_launch: occupancy query says %d\n", per_cu); per_cu = 1; }
        (void)hipGetLastError();
        grid = cus * 1;
        (void)per_cu;
    }
    if (grid < 0) return;
    if (hipMemsetAsync((char*)d_ws + WS_CTL, 0, CTL_ZERO_BYTES, stream) != hipSuccess) { fprintf(stderr, "kernel_launch: memset of control words failed\n"); return; }
    Args a{};
    a.x_p = (const float*)d_in[0]; a.x_s = (const float*)d_in[1]; a.p_p = (const float*)d_in[2]; a.p_s = (const float*)d_in[3]; a.norm_pre = (const float*)d_in[4];
    a.w_in = (const float*)d_in[5]; a.pool_w = (const float*)d_in[6]; a.pool_scale = (const float*)d_in[7]; a.w_a = (const float*)d_in[8]; a.q_norm = (const float*)d_in[9];
    a.k_norm = (const float*)d_in[10]; a.w_b = (const float*)d_in[11]; a.w_out = (const float*)d_in[12]; a.norm_post = (const float*)d_in[13]; a.ple_norm = (const float*)d_in[14];
    a.w_gate = (const float*)d_in[15]; a.w_ple = (const float*)d_in[16];
    a.out = (float*)d_out; a.ws = (unsigned char*)d_ws;
    if (N_LAUNCHES == 1) {
        a.ph_lo = 0; a.ph_hi = N_PHASES;
        void* kargs[] = {&a};
        hipError_t e = hipLaunchCooperativeKernel((const void*)fwd_megakernel, dim3(grid), dim3(NWAVES * 64), kargs, LDS_BYTES, stream);
        if (e != hipSuccess) fprintf(stderr, "kernel_launch: cooperative launch failed: %s (grid %d)\n", hipGetErrorString(e), grid);
    } else {
        for (int ph = 0; ph < N_PHASES; ++ph) {
            a.ph_lo = ph; a.ph_hi = ph + 1;
            hipLaunchKernelGGL(fwd_megakernel, dim3(grid), dim3(NWAVES * 64), LDS_BYTES, stream, a);
        }
    }
}
```

```cpp
#include <hip/hip_runtime.h>
#include <hip/hip_cooperative_groups.h>
#include <hip/hip_bf16.h>
#include <cstdio>
#include <cstdint>
#include <cmath>
namespace cg = cooperative_groups;

namespace pg8 {
#define PG8_LAS __attribute__((address_space(3)))
typedef unsigned short bf16_t;
typedef short bf16x8 __attribute__((ext_vector_type(8)));
typedef float f32x4 __attribute__((ext_vector_type(4)));
typedef unsigned u32x4 __attribute__((ext_vector_type(4)));
constexpr int BM = 256, BK = 64, HALF = 128, HTB = HALF * BK * 2  , STAGE_BYTES = 8 * HTB, NXCD = 8, WGM = 8;

__host__ __device__ __forceinline__ int lds_byte(int r, int c) { const int st = (r >> 4) * 2 + (c >> 5), rr = r & 15, cc = c & 31, ob = rr * 64 + cc * 2; return st * 1024 + (ob ^ (((ob >> 9) & 1) << 5)); }
__host__ __device__ __forceinline__ void stage_rc(int b, int& R, int& C) { const int st = b / 1024, sb = b % 1024, swz = sb ^ (((sb >> 9) & 1) << 5); R = (st >> 1) * 16 + swz / 64; C = (st & 1) * 32 + (swz % 64) / 2; }
__host__ __device__ __forceinline__ int perm32(int rho) { const int n = rho >> 4, i = rho & 15; return 8 * (i >> 2) + 4 * n + (i & 3); }

struct Unit { int pm, pn; };
struct Gemm { const bf16_t* A; const bf16_t* A2; const bf16_t* Bt; int lda, ldb, K, K1; size_t a_pn_off; };

struct StaticOrder {
    int nM, nN, nwg, G, c;
    __host__ __device__ void init(int M, int N, int G_, int c_) { nM = M / BM; nN = N / BM; nwg = nM * nN; G = G_; c = c_; }
    __host__ __device__ bool next(int i, Unit& u) const {
        const long L = (long)i * G + c; if (L >= nwg) return false;
        int wgid = (int)L; { const int q = nwg / NXCD, r = nwg % NXCD, xcd = wgid % NXCD, off = wgid / NXCD; wgid = (xcd < r ? xcd * (q + 1) : r * (q + 1) + (xcd - r) * q) + off; }
        const int nig = WGM * nN, gid = wgid / nig, fm = gid * WGM, gsz = (nM - fm) < WGM ? (nM - fm) : WGM;
        u.pm = fm + ((wgid % nig) % gsz); u.pn = (wgid % nig) / gsz; return true;
    }
    __device__ __forceinline__ void a_ready(const Unit&) const {}
    __device__ __forceinline__ void done(const Unit&) const {}
};

__device__ __forceinline__ unsigned cvt_pk_bf16(float lo, float hi) { unsigned r; asm volatile("v_cvt_pk_bf16_f32 %0, %1, %2" : "=v"(r) : "v"(lo), "v"(hi)); return r; }
__device__ __forceinline__ float bf_lo(unsigned w) { return __uint_as_float(w << 16); }
__device__ __forceinline__ float bf_hi(unsigned w) { return __uint_as_float(w & 0xffff0000u); }
__device__ __forceinline__ float fsigmoid(float x) { return __builtin_amdgcn_rcpf(1.0f + __builtin_amdgcn_exp2f(-1.4426950408889634f * x)); }
__device__ __forceinline__ float fsilu(float x) { return x * fsigmoid(x); }
__device__ __forceinline__ u32x4 pack8(const f32x4& v0, const f32x4& v1) { u32x4 w; w.x = cvt_pk_bf16(v0[0], v0[1]); w.y = cvt_pk_bf16(v0[2], v0[3]); w.z = cvt_pk_bf16(v1[0], v1[1]); w.w = cvt_pk_bf16(v1[2], v1[3]); return w; }
__device__ __forceinline__ void unpack8(const u32x4& w, f32x4& v0, f32x4& v1) { v0 = (f32x4){bf_lo(w.x), bf_hi(w.x), bf_lo(w.y), bf_hi(w.y)}; v1 = (f32x4){bf_lo(w.z), bf_hi(w.z), bf_lo(w.w), bf_hi(w.w)}; }

struct EpiIn {
    static constexpr bool PERM = true, AFTER_DRAIN = false, MID = false;
    bf16_t *ua, *sza, *q, *k, *v, *szb, *ma, *mb;
    __device__ __forceinline__ void operator()(const f32x4 (&acc)[2][2][4][2], const Unit& u, int wr, int wc, int fr, int fq) const {
        const int pn = u.pn; bf16_t* base; int ldc = 1024, ct; bool act = false;
        if (pn < 4) { base = ua; ct = pn; }
        else if (pn < 8) { base = sza; ct = pn - 4; act = true; }
        else if (pn < 12) { base = q; ct = pn - 8; }
        else if (pn == 12) { base = k; ct = 0; ldc = 256; }
        else if (pn == 13) { base = v; ct = 0; ldc = 256; }
        else if (pn < 18) { base = szb; ct = pn - 14; act = true; }
        else {
            int row0 = u.pm * BM + wr * 64 + fr, col0 = (pn - 18) * HALF + wc * 32 + 8 * fq; asm volatile("" : "+v"(row0), "+v"(col0));
#pragma unroll
            for (int ai = 0; ai < 2; ++ai)
#pragma unroll
                for (int m = 0; m < 4; ++m) { const size_t off = (size_t)(row0 + ai * HALF + m * 16) * 1024 + col0; f32x4 r0, r1, s0, s1;
#pragma unroll
                    for (int e = 0; e < 4; ++e) {
                        const float ea0 = __builtin_amdgcn_exp2f(-1.4426950408889634f * acc[ai][0][m][0][e]), ea1 = __builtin_amdgcn_exp2f(-1.4426950408889634f * acc[ai][0][m][1][e]);
                        const float eb0 = __builtin_amdgcn_exp2f(-1.4426950408889634f * fmaxf(acc[ai][1][m][0][e], -60.f)), eb1 = __builtin_amdgcn_exp2f(-1.4426950408889634f * fmaxf(acc[ai][1][m][1][e], -60.f));
                        s0[e] = __builtin_amdgcn_rcpf(1.0f + eb0); s1[e] = __builtin_amdgcn_rcpf(1.0f + eb1);
                        r0[e] = (1.0f + eb0) * __builtin_amdgcn_rcpf(1.0f + ea0); r1[e] = (1.0f + eb1) * __builtin_amdgcn_rcpf(1.0f + ea1); }
                    *(u32x4*)(ma + off) = pack8(r0, r1); *(u32x4*)(mb + off) = pack8(s0, s1); }
            return; }
        int row0 = u.pm * BM + wr * 64 + fr, col0 = ct * BM + wc * 32 + 8 * fq; asm volatile("" : "+v"(row0), "+v"(col0));
#pragma unroll
        for (int ai = 0; ai < 2; ++ai)
#pragma unroll
            for (int m = 0; m < 4; ++m) { bf16_t* rowp = base + (size_t)(row0 + ai * HALF + m * 16) * ldc + col0;
#pragma unroll
                for (int bj = 0; bj < 2; ++bj) { f32x4 v0 = acc[ai][bj][m][0], v1 = acc[ai][bj][m][1];
                    if (act) {
#pragma unroll
                        for (int e = 0; e < 4; ++e) { v0[e] = fsilu(v0[e]); v1[e] = fsilu(v1[e]); } }
                    *(u32x4*)(rowp + bj * HALF) = pack8(v0, v1); } }
    }
};
struct EpiPlain {
    static constexpr bool PERM = true, AFTER_DRAIN = false, MID = false;
    bf16_t* O; int ldc;
    __device__ __forceinline__ void operator()(const f32x4 (&acc)[2][2][4][2], const Unit& u, int wr, int wc, int fr, int fq) const {
        int row0 = u.pm * BM + wr * 64 + fr, col0 = u.pn * BM + wc * 32 + 8 * fq; asm volatile("" : "+v"(row0), "+v"(col0));
#pragma unroll
        for (int ai = 0; ai < 2; ++ai)
#pragma unroll
            for (int m = 0; m < 4; ++m) { bf16_t* rowp = O + (size_t)(row0 + ai * HALF + m * 16) * ldc + col0;
#pragma unroll
                for (int bj = 0; bj < 2; ++bj) *(u32x4*)(rowp + bj * HALF) = pack8(acc[ai][bj][m][0], acc[ai][bj][m][1]); }
    }
};
struct EpiMerge {
    static constexpr bool PERM = true, AFTER_DRAIN = false, MID = true;
    bf16_t* O; const bf16_t* rt; const bf16_t* sb;
    __device__ __forceinline__ void mid(f32x4 (&acc)[2][2][4][2], const Unit& u, int wr, int wc, int fr, int fq) const {
        int row0 = u.pm * BM + wr * 64 + fr, col0 = u.pn * BM + wc * 32 + 8 * fq;
        asm volatile("" : "+v"(row0), "+v"(col0));
#pragma unroll
        for (int ai = 0; ai < 2; ++ai) {
            u32x4 rw[4][2];
#pragma unroll
            for (int m = 0; m < 4; ++m) { const size_t off = (size_t)(row0 + ai * HALF + m * 16) * 1024 + col0;
#pragma unroll
                for (int bj = 0; bj < 2; ++bj) rw[m][bj] = *(const u32x4*)(rt + off + bj * HALF); }
#pragma unroll
            for (int m = 0; m < 4; ++m)
#pragma unroll
                for (int bj = 0; bj < 2; ++bj) { f32x4 r0, r1; unpack8(rw[m][bj], r0, r1); acc[ai][bj][m][0] *= r0; acc[ai][bj][m][1] *= r1; }
#pragma unroll
            for (int m = 0; m < 4; ++m) asm volatile("" : "+v"(acc[ai][0][m][0]), "+v"(acc[ai][0][m][1]), "+v"(acc[ai][1][m][0]), "+v"(acc[ai][1][m][1]) :: "memory");
        }
    }
    __device__ __forceinline__ void operator()(const f32x4 (&acc)[2][2][4][2], const Unit& u, int wr, int wc, int fr, int fq) const {
        int row0 = u.pm * BM + wr * 64 + fr, col0 = u.pn * BM + wc * 32 + 8 * fq; asm volatile("" : "+v"(row0), "+v"(col0));
#pragma unroll
        for (int ai = 0; ai < 2; ++ai)
#pragma unroll
            for (int m = 0; m < 4; ++m) { const size_t off = (size_t)(row0 + ai * HALF + m * 16) * 1024 + col0;
#pragma unroll
                for (int bj = 0; bj < 2; ++bj) { const u32x4 bw = *(const u32x4*)(sb + off + bj * HALF); f32x4 b0, b1; unpack8(bw, b0, b1);
                    *(u32x4*)(O + off + bj * HALF) = pack8(acc[ai][bj][m][0] * b0, acc[ai][bj][m][1] * b1); } }
    }
};
struct EpiFinal {
    static constexpr bool PERM = true, AFTER_DRAIN = false, MID = false;
    float* out; const bf16_t* x1b; const bf16_t* pe; const float* r2;
    __device__ __forceinline__ void operator()(const f32x4 (&acc)[2][2][4][2], const Unit& u, int wr, int wc, int fr, int fq) const {
        int row0 = u.pm * BM + wr * 64 + fr, col0 = u.pn * BM + wc * 32 + 8 * fq; asm volatile("" : "+v"(row0), "+v"(col0));
#pragma unroll
        for (int ai = 0; ai < 2; ++ai)
#pragma unroll
            for (int m = 0; m < 4; ++m) { const int row = row0 + ai * HALF + m * 16; const size_t off = (size_t)row * 1024 + col0; const float rs = r2[row];
#pragma unroll
                for (int bj = 0; bj < 2; ++bj) { const u32x4 pw = *(const u32x4*)(pe + off + bj * HALF), xw = *(const u32x4*)(x1b + off + bj * HALF);
                    f32x4 p0, p1, x0, x1; unpack8(pw, p0, p1); unpack8(xw, x0, x1);
                    float* op = out + off + bj * HALF;
                    f32x4 g0 = acc[ai][bj][m][0], g1 = acc[ai][bj][m][1];
#pragma unroll
                    for (int e = 0; e < 4; ++e) { g0[e] = x0[e] + fsigmoid(rs * g0[e]) * p0[e]; g1[e] = x1[e] + fsigmoid(rs * g1[e]) * p1[e]; }
                    *(f32x4*)op = g0; *(f32x4*)(op + 4) = g1; } }
    }
};
struct DupOrder {
    StaticOrder S; int dup;
    __device__ void init(int M_, int N_, int G_, int c_, int dup_) { S.init(M_, N_, G_, c_); dup = dup_; }
    __device__ bool next(int i, Unit& u) const { if (dup > 1) { const int rounds = S.nwg / S.G; if (i >= dup * rounds) return false; i %= rounds; } return S.next(i, u); }
    __device__ __forceinline__ void a_ready(const Unit&) const {}
    __device__ __forceinline__ void done(const Unit&) const {}
};
template <class Epi, class Sched, bool ALIGN_EPI = false, bool SP2 = false>
__device__ __forceinline__ void gemm_phase(PG8_LAS unsigned char* lds, const Gemm g, const Sched& S, const Epi& E) {
    const int tid = threadIdx.x, wid = __builtin_amdgcn_readfirstlane(tid >> 6), lane = tid & 63, wr = wid >> 2, wc = wid & 3, fr = lane & 15, fq = lane >> 4;
    const int nt = g.K / BK, nth = g.K1 / BK;
    unsigned voffA[2], voffB[2];
#pragma unroll
    for (int i = 0; i < 2; ++i) { int R, C; stage_rc(tid * 16 + i * 8192, R, C); const int Rb = Epi::PERM ? ((R & ~31) + perm32(R & 31)) : R;
        voffA[i] = (unsigned)(R * g.lda + C) * 2u; voffB[i] = (unsigned)(Rb * g.ldb + C) * 2u; }
    const size_t kstep = (size_t)(BK * 2);
    const size_t hstepA = (size_t)HALF * g.lda * 2, hstepB = (size_t)HALF * g.ldb * 2;
    const size_t tstepA = 2 * hstepA, tstepB = 2 * hstepB;
    const unsigned ldsw = (unsigned)wid * 1024u;
    const int aoff = lds_byte(wr * 64 + fr, fq * 8), boff = lds_byte(wc * 32 + fr, fq * 8);
#define PG8_SA(b, h) (((b) * 2 + (h)) * HTB)
#define PG8_SB(b, h) ((4 + (b) * 2 + (h)) * HTB)
#define PG8_STAGE(bufoff, gbase, voff) do { _Pragma("unroll") for (int _i = 0; _i < 2; ++_i) \
        __builtin_amdgcn_global_load_lds((const unsigned*)((const char*)(gbase) + (voff)[_i]), (PG8_LAS unsigned*)(lds + (bufoff) + ldsw + _i * 8192), 16, 0, 0); } while (0)
#define PG8_LDA(dst, b, h) do { _Pragma("unroll") for (int m = 0; m < 4; ++m) _Pragma("unroll") for (int k = 0; k < 2; ++k) dst[m][k] = *(const PG8_LAS bf16x8*)(lds + PG8_SA(b, h) + aoff + m * 2048 + k * 1024); } while (0)
#define PG8_LDB(dst, b, h) do { _Pragma("unroll") for (int n = 0; n < 2; ++n) _Pragma("unroll") for (int k = 0; k < 2; ++k) dst[n][k] = *(const PG8_LAS bf16x8*)(lds + PG8_SB(b, h) + boff + n * 2048 + k * 1024); } while (0)
#define PG8_MMA(ai, bj, At, Bt) do { __builtin_amdgcn_s_setprio(1); _Pragma("unroll") for (int m = 0; m < 4; ++m) _Pragma("unroll") for (int n = 0; n < 2; ++n) _Pragma("unroll") for (int k = 0; k < 2; ++k) \
        acc[ai][bj][m][n] = __builtin_amdgcn_mfma_f32_16x16x32_bf16(Bt[n][k], At[m][k], acc[ai][bj][m][n], 0, 0, 0); __builtin_amdgcn_s_setprio(0); } while (0)
#define PG8_WAIT_V(n) asm volatile("s_waitcnt vmcnt(" #n ")" ::: "memory")
#define PG8_WAIT_L(n) asm volatile("s_waitcnt lgkmcnt(" #n ")" ::: "memory")
#define PG8_BAR __builtin_amdgcn_s_barrier()
#define PG8_SCHED __builtin_amdgcn_sched_barrier(0)
    Unit cur, nxt; int ui = 0;
    if (!S.next(0, cur)) return;
    f32x4 acc[2][2][4][2];
#pragma unroll
    for (int a = 0; a < 2; ++a)
#pragma unroll
        for (int b = 0; b < 2; ++b)
#pragma unroll
            for (int m = 0; m < 4; ++m)
#pragma unroll
                for (int n = 0; n < 2; ++n) acc[a][b][m][n] = (f32x4){0.f, 0.f, 0.f, 0.f};
    bf16x8 At[4][2], B0[2][2], B1[2][2];
    const char* cA = (const char*)g.A + (size_t)cur.pm * tstepA + (size_t)cur.pn * g.a_pn_off; const char* cA2 = (const char*)g.A2 + (size_t)cur.pm * tstepA; const char* cB = (const char*)g.Bt + (size_t)cur.pn * tstepB;
    S.a_ready(cur);
    if constexpr (SP2) {
        PG8_STAGE(PG8_SB(0, 0), cB, voffB); PG8_STAGE(PG8_SB(0, 1), cB + hstepB, voffB); PG8_STAGE(PG8_SA(0, 0), cA, voffA); PG8_STAGE(PG8_SA(0, 1), cA + hstepA, voffA);
        if (wr == 1) PG8_BAR;
        PG8_WAIT_V(2); PG8_BAR;
        PG8_STAGE(PG8_SB(1, 0), cB + kstep, voffB); PG8_STAGE(PG8_SA(1, 0), cA + kstep, voffA); PG8_STAGE(PG8_SB(1, 1), cB + hstepB + kstep, voffB);
        PG8_WAIT_V(6); PG8_BAR;
    } else {
        PG8_STAGE(PG8_SB(0, 0), cB, voffB); PG8_STAGE(PG8_SA(0, 0), cA, voffA); PG8_STAGE(PG8_SB(0, 1), cB + hstepB, voffB); PG8_STAGE(PG8_SA(0, 1), cA + hstepA, voffA);
        if (wr == 1) PG8_BAR;
        PG8_WAIT_V(4); PG8_BAR;
        PG8_STAGE(PG8_SB(1, 0), cB + kstep, voffB); PG8_STAGE(PG8_SA(1, 0), cA + kstep, voffA); PG8_STAGE(PG8_SB(1, 1), cB + hstepB + kstep, voffB);
        PG8_WAIT_V(6); PG8_BAR;
    }
    for (;;) {
        const bool has_next = S.next(ui + 1, nxt);
        const char* nA = has_next ? (const char*)g.A + (size_t)nxt.pm * tstepA + (size_t)nxt.pn * g.a_pn_off : cA; const char* nA2 = has_next ? (const char*)g.A2 + (size_t)nxt.pm * tstepA : cA2; const char* nB = has_next ? (const char*)g.Bt + (size_t)nxt.pn * tstepB : cB;
        for (int t = 0; t < nt; t += 2) {
            const bool last = (t == nt - 2);
            if constexpr (Epi::MID) { if (t == nth) E.mid(acc, cur, wr, wc, fr, fq); }
            const char* a1 = (t + 1 < nth) ? cA + (size_t)(t + 1) * kstep : cA2 + (size_t)(t + 1 - nth) * kstep;
            const char* a2 = last ? nA : ((t + 2 < nth) ? cA + (size_t)(t + 2) * kstep : cA2 + (size_t)(t + 2 - nth) * kstep); const char* b2 = last ? nB : cB + (size_t)(t + 2) * kstep;
            const char* a3 = a2 + kstep; const char* b3 = b2 + kstep;
            if (last && has_next) S.a_ready(nxt);
            if constexpr (SP2) {
            PG8_LDB(B0, 0, 0); PG8_LDB(B1, 0, 1); PG8_SCHED; PG8_LDA(At, 0, 0); PG8_STAGE(PG8_SA(1, 1), a1 + hstepA, voffA);
            PG8_WAIT_V(8); PG8_WAIT_L(0); PG8_BAR; PG8_MMA(0, 0, At, B0); PG8_MMA(0, 1, At, B1); PG8_BAR; PG8_SCHED;
            PG8_LDA(At, 0, 1); PG8_STAGE(PG8_SB(0, 0), b2, voffB); PG8_STAGE(PG8_SB(0, 1), b2 + hstepB, voffB); PG8_STAGE(PG8_SA(0, 0), a2, voffA);
            PG8_WAIT_V(8); PG8_WAIT_L(0); PG8_BAR; PG8_MMA(1, 0, At, B0); PG8_MMA(1, 1, At, B1); PG8_BAR; PG8_SCHED;
            PG8_LDB(B0, 1, 0); PG8_LDB(B1, 1, 1); PG8_SCHED; PG8_LDA(At, 1, 0); PG8_STAGE(PG8_SA(0, 1), a2 + hstepA, voffA);
            PG8_WAIT_V(8); PG8_WAIT_L(0); PG8_BAR; PG8_MMA(0, 0, At, B0); PG8_MMA(0, 1, At, B1); PG8_BAR; PG8_SCHED;
            PG8_LDA(At, 1, 1); PG8_STAGE(PG8_SB(1, 0), b3, voffB); PG8_STAGE(PG8_SB(1, 1), b3 + hstepB, voffB); PG8_STAGE(PG8_SA(1, 0), a3, voffA);
            PG8_WAIT_V(8); PG8_WAIT_L(0); PG8_BAR; PG8_MMA(1, 0, At, B0); PG8_MMA(1, 1, At, B1); PG8_BAR; PG8_SCHED;
            } else {
            PG8_LDB(B0, 0, 0); PG8_SCHED; PG8_LDA(At, 0, 0); PG8_STAGE(PG8_SA(1, 1), a1 + hstepA, voffA);
            PG8_WAIT_L(8); PG8_BAR; PG8_WAIT_L(0); PG8_MMA(0, 0, At, B0); PG8_BAR; PG8_SCHED;
            PG8_LDB(B1, 0, 1); PG8_STAGE(PG8_SB(0, 0), b2, voffB);
            PG8_BAR; PG8_WAIT_L(0); PG8_MMA(0, 1, At, B1); PG8_BAR;
            PG8_LDA(At, 0, 1); PG8_STAGE(PG8_SA(0, 0), a2, voffA);
            PG8_BAR; PG8_WAIT_L(0); PG8_MMA(1, 0, At, B0); PG8_BAR; PG8_SCHED;
            PG8_STAGE(PG8_SB(0, 1), b2 + hstepB, voffB);
            PG8_WAIT_V(6); PG8_BAR; PG8_MMA(1, 1, At, B1); PG8_BAR;
            PG8_LDB(B0, 1, 0); PG8_SCHED; PG8_LDA(At, 1, 0); PG8_STAGE(PG8_SA(0, 1), a2 + hstepA, voffA);
            PG8_WAIT_L(8); PG8_BAR; PG8_WAIT_L(0); PG8_MMA(0, 0, At, B0); PG8_BAR; PG8_SCHED;
            PG8_LDB(B1, 1, 1); PG8_STAGE(PG8_SB(1, 0), b3, voffB);
            PG8_BAR; PG8_WAIT_L(0); PG8_MMA(0, 1, At, B1); PG8_BAR;
            PG8_LDA(At, 1, 1); PG8_STAGE(PG8_SA(1, 0), a3, voffA);
            PG8_BAR; PG8_WAIT_L(0); PG8_MMA(1, 0, At, B0); PG8_BAR; PG8_SCHED;
            PG8_STAGE(PG8_SB(1, 1), b3 + hstepB, voffB);
            PG8_WAIT_V(6); PG8_BAR; PG8_MMA(1, 1, At, B1); PG8_BAR;
            }
        }
        if constexpr (ALIGN_EPI) { if (wr == 0) PG8_BAR; }
        if constexpr (!Epi::AFTER_DRAIN) { E(acc, cur, wr, wc, fr, fq); S.done(cur); }
        if (!has_next) break;
#pragma unroll
        for (int a = 0; a < 2; ++a)
#pragma unroll
            for (int b = 0; b < 2; ++b)
#pragma unroll
                for (int m = 0; m < 4; ++m)
#pragma unroll
                    for (int n = 0; n < 2; ++n) acc[a][b][m][n] = (f32x4){0.f, 0.f, 0.f, 0.f};
        cur = nxt; cA = nA; cA2 = nA2; cB = nB; ++ui;
        if constexpr (ALIGN_EPI) { if (wr == 1) PG8_BAR; }
    }
    PG8_WAIT_V(0);
    if constexpr (!ALIGN_EPI) { if (wr == 0) PG8_BAR; }
    PG8_BAR;
    if constexpr (Epi::AFTER_DRAIN) { E.fused(acc, cur, wr, wc, fr, fq, lds, wid, lane); S.done(cur); }
#undef PG8_SA
#undef PG8_SB
#undef PG8_STAGE
#undef PG8_LDA
#undef PG8_LDB
#undef PG8_MMA
#undef PG8_WAIT_V
#undef PG8_WAIT_L
#undef PG8_BAR
#undef PG8_SCHED
}
}

namespace attn_body {
using bf16=__hip_bfloat16;
using bf16x8=__attribute__((ext_vector_type(8)))short;
using s16x4=__attribute__((ext_vector_type(4)))short;
using f32x16=__attribute__((ext_vector_type(16)))float;
using u32x4=__attribute__((ext_vector_type(4)))unsigned;
constexpr int D=64,QP=1024,KP=256;
constexpr int NW=8,QBLK=32,QB=QBLK*NW,KVBLK=64;

__device__ __forceinline__ int crow(int r,int hi){return (r&3)+8*(r>>2)+4*hi;}
#define SBAR() __builtin_amdgcn_sched_barrier(0)
__device__ __forceinline__ void cmask(f32x16&p0,f32x16&p1,int jb,int qrel,int hi){
  const float NEG=-INFINITY; int kb=64*jb+4*hi;
  #pragma unroll
  for(int r=0;r<16;++r){int kv=kb+(r&3)+8*(r>>2); if(kv>qrel)p0[r]=NEG; if(kv+32>qrel)p1[r]=NEG;}
}

constexpr int NSLOT=3, SLOTB=8192;
constexpr int LDS_K=0, LDS_V=NSLOT*SLOTB, LDS_WS=2*NSLOT*SLOTB, LDS_OST=LDS_WS+NW*64*4, LDS_BYTES=LDS_OST+NW*4096;
constexpr float C2=0.125f*1.4426950408889634f;
__device__ __forceinline__ void glds16(const void*gsrc,unsigned lds_dst){unsigned keep;
  asm volatile("s_mov_b32 %0, m0\n\ts_mov_b32 m0, %2\n\ts_nop 0\n\tglobal_load_lds_dwordx4 %1, off\n\ts_mov_b32 m0, %0":"=&s"(keep):"v"(gsrc),"s"(lds_dst):"memory");}
__device__ __forceinline__ float max3f(float a,float b,float c){float r;asm("v_max3_f32 %0, %1, %2, %3":"=v"(r):"v"(a),"v"(b),"v"(c));return r;}
__device__ __forceinline__ float max2f(float a,float b){float r;asm("v_max_f32_e32 %0, %1, %2":"=v"(r):"v"(a),"v"(b));return r;}
__device__ __forceinline__ float fadd_s(float a,float b){float r;asm("v_add_f32_e32 %0, %1, %2":"=v"(r):"v"(a),"v"(b));return r;}
__device__ __forceinline__ float fsub_s(float a,float b){float r;asm("v_sub_f32_e32 %0, %1, %2":"=v"(r):"v"(a),"v"(b));return r;}
typedef float f32x2_t __attribute__((ext_vector_type(2))); typedef __bf16 bf16x2_t __attribute__((ext_vector_type(2)));
__device__ __forceinline__ unsigned cvtpk_s(float lo,float hi){f32x2_t v={lo,hi};bf16x2_t b=__builtin_convertvector(v,bf16x2_t);return __builtin_bit_cast(unsigned,b);}
#define WAIT_BAR(N) asm volatile("s_waitcnt vmcnt(" #N ") lgkmcnt(0)\n\ts_barrier":::"memory")

__device__ __forceinline__ void qkt(f32x16&p0,f32x16&p1,const char*Kslot,const bf16x8*qr,const f32x16&negm,int r32,int hi){
  const char*kb=Kslot+hi*1024+r32*16;
  #pragma unroll
  for(int d0=0;d0<4;++d0){
    const bf16x8 b0=*reinterpret_cast<const bf16x8*>(kb+d0*2048);
    const bf16x8 b1=*reinterpret_cast<const bf16x8*>(kb+d0*2048+512);
    if(d0==0){p0=__builtin_amdgcn_mfma_f32_32x32x16_bf16(b0,qr[0],negm,0,0,0);p1=__builtin_amdgcn_mfma_f32_32x32x16_bf16(b1,qr[0],negm,0,0,0);}
    else{p0=__builtin_amdgcn_mfma_f32_32x32x16_bf16(b0,qr[d0],p0,0,0,0);p1=__builtin_amdgcn_mfma_f32_32x32x16_bf16(b1,qr[d0],p1,0,0,0);}}
}
typedef __attribute__((address_space(3))) const char* lds_cptr;
typedef short v4i16_t __attribute__((ext_vector_type(4)));
__device__ __forceinline__ void kload8(bf16x8*kf,lds_cptr kp){
  kf[0]=*(const __attribute__((address_space(3))) bf16x8*)(kp);      kf[1]=*(const __attribute__((address_space(3))) bf16x8*)(kp+512);
  kf[2]=*(const __attribute__((address_space(3))) bf16x8*)(kp+2048); kf[3]=*(const __attribute__((address_space(3))) bf16x8*)(kp+2560);
  kf[4]=*(const __attribute__((address_space(3))) bf16x8*)(kp+4096); kf[5]=*(const __attribute__((address_space(3))) bf16x8*)(kp+4608);
  kf[6]=*(const __attribute__((address_space(3))) bf16x8*)(kp+6144); kf[7]=*(const __attribute__((address_space(3))) bf16x8*)(kp+6656);
}
__device__ __forceinline__ void kload2(bf16x8*kf,lds_cptr kp,int j){ kf[2*j]=*(const __attribute__((address_space(3))) bf16x8*)(kp+j*2048); kf[2*j+1]=*(const __attribute__((address_space(3))) bf16x8*)(kp+j*2048+512); }
__device__ __forceinline__ s16x4 vtr(lds_cptr p){ return __builtin_bit_cast(s16x4,__builtin_amdgcn_ds_read_tr16_b64_v4i16((__attribute__((address_space(3))) v4i16_t*)p)); }
__device__ __forceinline__ float rowmax(const f32x16&p0,const f32x16&p1){
  float a=max3f(p0[0],p0[1],p1[0]),b=max3f(p0[2],p0[3],p1[1]);a=max3f(a,p1[2],p1[3]);
  #pragma unroll
  for(int r=4;r<16;r+=4){a=max3f(a,p0[r],p0[r+1]);b=max3f(b,p0[r+2],p0[r+3]);a=max3f(a,p1[r],p1[r+1]);b=max3f(b,p1[r+2],p1[r+3]);}
  const float m=max2f(a,b);
  auto rr=__builtin_amdgcn_permlane32_swap(__float_as_uint(m),__float_as_uint(m),false,false);
  return max2f(__uint_as_float(rr[0]),__uint_as_float(rr[1]));
}
__device__ __forceinline__ void pv(f32x16*o,int vb,bf16x8 pa0,bf16x8 pa1,bf16x8 pa2,bf16x8 pa3){
  #pragma unroll
  for(int d0=0;d0<2;++d0){s16x4 lo[4],hi[4];
    #pragma unroll
    for(int ks=0;ks<4;++ks){
      asm volatile("ds_read_b64_tr_b16 %0,%1 offset:%c2":"=&v"(lo[ks]):"v"(vb),"i"(d0*4096+ks*1024):"memory");
      asm volatile("ds_read_b64_tr_b16 %0,%1 offset:%c2":"=&v"(hi[ks]):"v"(vb),"i"(d0*4096+ks*1024+512):"memory");}
    asm volatile("s_waitcnt lgkmcnt(0)":::"memory");SBAR();
    #define PK(k) (bf16x8){lo[k][0],lo[k][1],lo[k][2],lo[k][3],hi[k][0],hi[k][1],hi[k][2],hi[k][3]}
    o[d0]=__builtin_amdgcn_mfma_f32_32x32x16_bf16(pa0,PK(0),o[d0],0,0,0);
    o[d0]=__builtin_amdgcn_mfma_f32_32x32x16_bf16(pa1,PK(1),o[d0],0,0,0);
    o[d0]=__builtin_amdgcn_mfma_f32_32x32x16_bf16(pa2,PK(2),o[d0],0,0,0);
    o[d0]=__builtin_amdgcn_mfma_f32_32x32x16_bf16(pa3,PK(3),o[d0],0,0,0);
    #undef PK
  }
}
#define ATTN_STORE16(p,v) (*(u32x4*)(p)=(v))
__device__ __forceinline__ float abf_lo(unsigned w){return __uint_as_float(w<<16);}
__device__ __forceinline__ float abf_hi(unsigned w){return __uint_as_float(w&0xffff0000u);}
__device__ __forceinline__ u32x4 mulgate(const u32x4&v,const u32x4&g){u32x4 r;
  r.x=cvtpk_s(abf_lo(v.x)*abf_lo(g.x),abf_hi(v.x)*abf_hi(g.x)); r.y=cvtpk_s(abf_lo(v.y)*abf_lo(g.y),abf_hi(v.y)*abf_hi(g.y));
  r.z=cvtpk_s(abf_lo(v.z)*abf_lo(g.z),abf_hi(v.z)*abf_hi(g.z)); r.w=cvtpk_s(abf_lo(v.w)*abf_lo(g.w),abf_hi(v.w)*abf_hi(g.w)); return r;}
__device__ __forceinline__ void qnormrope(bf16x8*qr,const float*__restrict__ qn,int t,int hi){
  typedef float f4_t __attribute__((ext_vector_type(4)));
  float y[4][8]; float ss=0.f;
  #pragma unroll
  for(int d0=0;d0<4;++d0){ const u32x4 w=__builtin_bit_cast(u32x4,qr[d0]);
    #pragma unroll
    for(int i=0;i<4;++i){ y[d0][2*i]=__uint_as_float(w[i]<<16); y[d0][2*i+1]=__uint_as_float(w[i]&0xffff0000u); ss+=y[d0][2*i]*y[d0][2*i]+y[d0][2*i+1]*y[d0][2*i+1]; } }
  ss+=__shfl_xor(ss,32);
  const float rstd=1.0f/sqrtf(ss*(1.0f/64.0f)+1e-6f);
  #pragma unroll
  for(int d0=0;d0<4;++d0){ const f4_t g0=*(const f4_t*)(qn+16*d0+8*hi), g1=*(const f4_t*)(qn+16*d0+8*hi+4);
    #pragma unroll
    for(int i=0;i<4;++i){ y[d0][i]*=rstd*g0[i]; y[d0][4+i]*=rstd*g1[i]; } }
  const float prow=(float)(t>>6), pcol=(float)(t&63);
  #pragma unroll
  for(int j=0;j<8;++j){
    const float freq=__builtin_amdgcn_exp2f(-(float)(8*hi+j)*0.83048202372184058696f)*0.15915494309189533577f;
    const float rr=__builtin_amdgcn_fractf(prow*freq), rc=__builtin_amdgcn_fractf(pcol*freq);
    const float sr=__builtin_amdgcn_sinf(rr), cr=__builtin_amdgcn_cosf(rr), sc=__builtin_amdgcn_sinf(rc), cc=__builtin_amdgcn_cosf(rc);
    const float a0=y[0][j], b0=y[1][j], a1=y[2][j], b1=y[3][j];
    y[0][j]=(a0*cr-b0*sr)*C2; y[1][j]=(b0*cr+a0*sr)*C2; y[2][j]=(a1*cc-b1*sc)*C2; y[3][j]=(b1*cc+a1*sc)*C2; }
  #pragma unroll
  for(int d0=0;d0<4;++d0){ u32x4 w; w.x=cvtpk_s(y[d0][0],y[d0][1]); w.y=cvtpk_s(y[d0][2],y[d0][3]); w.z=cvtpk_s(y[d0][4],y[d0][5]); w.w=cvtpk_s(y[d0][6],y[d0][7]); qr[d0]=__builtin_bit_cast(bf16x8,w); }
}
template<int THRL> __device__ __forceinline__ void attn_unit(long qrow0,long kvrow0,int NT,int h,const bf16*Q,const bf16*__restrict__ K,const bf16*__restrict__ V,bf16*O,const bf16*__restrict__ Gt,const float*__restrict__ qn,bool track,char*shm){
  const int tid=threadIdx.x,lane=tid&63,r32=lane&31,hi=lane>>5; const int wid=__builtin_amdgcn_readfirstlane(tid>>6);
  const bf16*Qw=Q+(qrow0+wid*QBLK)*QP+h*D;
  const bf16*Kh=K+kvrow0*KP+(h>>2)*D,*Vh=V+kvrow0*KP+(h>>2)*D;
  const unsigned lds0=(unsigned)(uintptr_t)shm;
  float*wsf=(float*)(shm+LDS_WS)+wid*64;
  const bf16*ksrc=Kh+(long)lane*KP+wid*8;
  const bf16*vsrc=Vh+(long)(16*(wid&3)+(lane>>2))*KP+(wid>>2)*32+(lane&3)*8;
  const unsigned kdst=lds0+LDS_K+wid*1024, vdst=lds0+LDS_V+wid*1024;
  #define DMA_K(t,slot) glds16(ksrc+(long)(t)*KVBLK*KP,(unsigned)__builtin_amdgcn_readfirstlane(kdst+(slot)))
  #define DMA_V(t,slot) glds16(vsrc+(long)(t)*KVBLK*KP,(unsigned)__builtin_amdgcn_readfirstlane(vdst+(slot)))
  const int vb0=(int)(lds0+LDS_V)+((lane>>4)&1)*32+(lane&3)*8+(4*hi+((lane&15)>>2))*64;
  const char*Kbase=shm+LDS_K; bf16x8 kf[8];
  const lds_cptr shm3=(lds_cptr)shm; const lds_cptr kp0=shm3+LDS_K+hi*1024+r32*16; const lds_cptr vp0=shm3+LDS_V+((lane>>4)&1)*32+(lane&3)*8+(4*hi+((lane&15)>>2))*64;
  DMA_K(0,0);DMA_V(0,0);DMA_K(1,SLOTB);
  bf16x8 qr[4];
  #pragma unroll
  for(int d0=0;d0<4;++d0)qr[d0]=*reinterpret_cast<const bf16x8*>(&Qw[(long)r32*QP+d0*16+hi*8]);
  qnormrope(qr,qn,(int)(qrow0-kvrow0)+wid*QBLK+r32,hi);
  float mhat=0.f,l_reg=0.f;f32x16 o[2];o[0]=f32x16{};o[1]=f32x16{};f32x16 negm=f32x16{};asm volatile("":"+v"(negm));
  #define CMASK(P0,P1,t) do{}while(0)
  bool resc=false;
  #define START(P0,P1) do{ const float rm=rowmax(P0,P1); resc=false; \
    { const float dl=rm; mhat=fadd_s(mhat,dl); \
      _Pragma("unroll") for(int r=0;r<16;++r){P0[r]=fsub_s(P0[r],dl);P1[r]=fsub_s(P1[r],dl);} \
      _Pragma("unroll") for(int r=0;r<16;++r)negm[r]=-mhat; asm volatile("":"+v"(negm)); } \
    _Pragma("unroll") for(int r=0;r<16;++r)P0[r]=__builtin_amdgcn_exp2f(P0[r]); }while(0)
  #define RESC() do{ if(resc){ asm volatile("s_waitcnt lgkmcnt(0)":::"memory"); \
      _Pragma("unroll") for(int d_=0;d_<2;++d_) _Pragma("unroll") for(int r=0;r<16;++r)o[d_][r]*=wsf[crow(r,hi)]; } }while(0)
  f32x16 pA0,pA1,pB0,pB1;
  int sl_prev=0,sl_cur=0,sl_next=SLOTB;
  #define ROT() do{sl_prev=sl_cur;sl_cur=sl_next;sl_next=(sl_next==(NSLOT-1)*SLOTB)?0:sl_next+SLOTB;}while(0)
  DMA_K(2,2*SLOTB);
  WAIT_BAR(3);
  qkt(pA0,pA1,Kbase,qr,negm,r32,hi);asm volatile("s_nop 15\n\ts_nop 7":"+v"(pA0),"+v"(pA1));CMASK(pA0,pA1,0);
  START(pA0,pA1);
  _Pragma("unroll") for(int r=0;r<16;++r)pA1[r]=__builtin_amdgcn_exp2f(pA1[r]);
  WAIT_BAR(0);
  DMA_K(3,0);DMA_V(1,SLOTB);
  ROT();
  kload8(kf,kp0+sl_cur);
  WAIT_BAR(2);
  s16x4 vlo[8],vhi[8]; u32x4 pw0,pw1,pw2,pw3;
  #define PKW(P,B) cvtpk_s(P[B],P[B+1])
  #define PAF(k) __builtin_bit_cast(bf16x8,pw##k)
  #define VFR(i) (bf16x8){vlo[i][0],vlo[i][1],vlo[i][2],vlo[i][3],vhi[i][0],vhi[i][1],vhi[i][2],vhi[i][3]}
  #define PIN(x) asm volatile("":"+v"(x))
  #define MX3(a,b,c) __builtin_fmaxf(__builtin_fmaxf((a),(b)),(c))
  #define GAPA(MF,A0,A1,A2,A3,W0,W1,PW) do{ MF; sacc+=A0; sacc+=A1; sacc+=A2; sacc+=A3; PIN(sacc); W0; W1; PIN(PW); SBAR(); }while(0)
  #define EX(v) __builtin_amdgcn_exp2f(v)
  #define GAPB(MF,X,B) do{ MF; X[B]=EX(X[B]); X[B+1]=EX(X[B+1]); X[B+2]=EX(X[B+2]); X[B+3]=EX(X[B+3]); PIN(X); SBAR(); }while(0)
  #define VRD(i) do{ vlo[i]=vtr(vp_+(((i)>>2)*4096+((i)&3)*1024)); vhi[i]=vtr(vp_+(((i)>>2)*4096+((i)&3)*1024+512)); }while(0)
  #define KRD(G,j) do{ if(G){ kload2(kf,kp0+sl_next,j); SBAR(); } }while(0)
  #define STEP(C0,C1,P0,P1,t,GK,GV,GL) do{ SBAR(); \
    const lds_cptr vp_=vp0+sl_prev; \
    VRD(0); SBAR(); float sacc=(P0[0]+P0[1]); \
    GAPA(C0=__builtin_amdgcn_mfma_f32_32x32x16_bf16(kf[0],qr[0],negm,0,0,0), P0[2],P0[3],P0[4],P0[5],     pw0[0]=PKW(P0,0), pw0[1]=PKW(P0,2), pw0); \
    VRD(4); SBAR(); GAPA(C1=__builtin_amdgcn_mfma_f32_32x32x16_bf16(kf[1],qr[0],negm,0,0,0), P0[6],P0[7],P0[8],P0[9],     pw0[2]=PKW(P0,4), pw0[3]=PKW(P0,6), pw0); \
    VRD(1); SBAR(); GAPA(C0=__builtin_amdgcn_mfma_f32_32x32x16_bf16(kf[2],qr[1],C0,0,0,0),   P0[10],P0[11],P0[12],P0[13], pw1[0]=PKW(P0,8), pw1[1]=PKW(P0,10), pw1); \
    VRD(5); SBAR(); GAPA(C1=__builtin_amdgcn_mfma_f32_32x32x16_bf16(kf[3],qr[1],C1,0,0,0),   P0[14],P0[15],P1[0],P1[1],   pw1[2]=PKW(P0,12),pw1[3]=PKW(P0,14), pw1); \
    VRD(2); SBAR(); GAPA(C0=__builtin_amdgcn_mfma_f32_32x32x16_bf16(kf[4],qr[2],C0,0,0,0),   P1[2],P1[3],P1[4],P1[5],     pw2[0]=PKW(P1,0), pw2[1]=PKW(P1,2), pw2); \
    VRD(6); SBAR(); GAPA(C1=__builtin_amdgcn_mfma_f32_32x32x16_bf16(kf[5],qr[2],C1,0,0,0),   P1[6],P1[7],P1[8],P1[9],     pw2[2]=PKW(P1,4), pw2[3]=PKW(P1,6), pw2); \
    VRD(3); SBAR(); GAPA(C0=__builtin_amdgcn_mfma_f32_32x32x16_bf16(kf[6],qr[3],C0,0,0,0),   P1[10],P1[11],P1[12],P1[13], pw3[0]=PKW(P1,8), pw3[1]=PKW(P1,10), pw3); \
    VRD(7); SBAR(); GAPA(C1=__builtin_amdgcn_mfma_f32_32x32x16_bf16(kf[7],qr[3],C1,0,0,0),   P1[14],P1[15],0.f,0.f,       pw3[2]=PKW(P1,12),pw3[3]=PKW(P1,14), pw3); \
    l_reg+=sacc; \
    if(GK){DMA_K((t)+3,sl_cur);} if(GV){DMA_V((t)+1,sl_next);} \
    CMASK(C0,C1,t); \
    if(track){ float a=MX3(C0[0],C0[1],C1[0]),b=MX3(C0[2],C0[3],C1[1]); a=MX3(a,C1[2],C1[3]); \
      _Pragma("unroll") for(int r=4;r<16;r+=4){a=MX3(a,C0[r],C0[r+1]);b=MX3(b,C0[r+2],C0[r+3]);a=MX3(a,C1[r],C1[r+1]);b=MX3(b,C1[r+2],C1[r+3]);} \
      float rm=__builtin_fmaxf(a,b); { auto rr=__builtin_amdgcn_permlane32_swap(__float_as_uint(rm),__float_as_uint(rm),false,false); rm=__builtin_fmaxf(__uint_as_float(rr[0]),__uint_as_float(rr[1])); } \
      resc=false; \
      if(__builtin_expect(__any(rm>(float)THRL),0)){ const float dl=__builtin_fmaxf(rm,0.f); mhat+=dl; \
        _Pragma("unroll") for(int r=0;r<16;++r){C0[r]-=dl;C1[r]-=dl;} \
        _Pragma("unroll") for(int r=0;r<16;++r)negm[r]=-mhat; asm volatile("":"+v"(negm)); \
        const float f=__builtin_amdgcn_exp2f(-dl); l_reg*=f; if(hi==0)wsf[r32]=f; resc=true; } } \
    SBAR(); \
    GAPB(o[0]=__builtin_amdgcn_mfma_f32_32x32x16_bf16(PAF(0),VFR(0),o[0],0,0,0), C0,0); \
    GAPB(o[1]=__builtin_amdgcn_mfma_f32_32x32x16_bf16(PAF(0),VFR(4),o[1],0,0,0), C0,4); \
    KRD(GL,0); GAPB(o[0]=__builtin_amdgcn_mfma_f32_32x32x16_bf16(PAF(1),VFR(1),o[0],0,0,0), C0,8); \
    KRD(GL,1); GAPB(o[1]=__builtin_amdgcn_mfma_f32_32x32x16_bf16(PAF(1),VFR(5),o[1],0,0,0), C0,12); \
    KRD(GL,2); GAPB(o[0]=__builtin_amdgcn_mfma_f32_32x32x16_bf16(PAF(2),VFR(2),o[0],0,0,0), C1,0); \
    KRD(GL,3); GAPB(o[1]=__builtin_amdgcn_mfma_f32_32x32x16_bf16(PAF(2),VFR(6),o[1],0,0,0), C1,4); \
    GAPB(o[0]=__builtin_amdgcn_mfma_f32_32x32x16_bf16(PAF(3),VFR(3),o[0],0,0,0), C1,8); \
    GAPB(o[1]=__builtin_amdgcn_mfma_f32_32x32x16_bf16(PAF(3),VFR(7),o[1],0,0,0), C1,12); \
    }while(0)
  int t=1;
  #undef CMASK
  #define CMASK(P0,P1,t) do{}while(0)
  for(;t+5<NT;t+=2){
    STEP(pB0,pB1,pA0,pA1,t,true,true,true);     WAIT_BAR(2); RESC(); ROT();
    STEP(pA0,pA1,pB0,pB1,t+1,true,true,true);   WAIT_BAR(2); RESC(); ROT();
  }
  #undef CMASK
  #define CMASK(P0,P1,t) do{}while(0)
  #define ENDW(tt) do{ if((tt)+3<NT){WAIT_BAR(2);} else if((tt)+2<NT){WAIT_BAR(1);} else {WAIT_BAR(0);} }while(0)
  for(;t+1<NT;t+=2){
    STEP(pB0,pB1,pA0,pA1,t,(t+3<NT),(t+1<NT),(t+1<NT));       ENDW(t);   RESC(); ROT();
    STEP(pA0,pA1,pB0,pB1,t+1,(t+4<NT),(t+2<NT),(t+2<NT));     ENDW(t+1); RESC(); ROT();
  }
  STEP(pB0,pB1,pA0,pA1,NT-1,false,false,false); RESC();
  { float sacc=pB0[0]+pB0[1]; _Pragma("unroll") for(int r=2;r<16;++r)sacc+=pB0[r]; _Pragma("unroll") for(int r=0;r<16;++r)sacc+=pB1[r]; l_reg+=sacc;
    pw0=(u32x4){PKW(pB0,0),PKW(pB0,2),PKW(pB0,4),PKW(pB0,6)};pw1=(u32x4){PKW(pB0,8),PKW(pB0,10),PKW(pB0,12),PKW(pB0,14)};pw2=(u32x4){PKW(pB1,0),PKW(pB1,2),PKW(pB1,4),PKW(pB1,6)};pw3=(u32x4){PKW(pB1,8),PKW(pB1,10),PKW(pB1,12),PKW(pB1,14)};
    SBAR(); pv(o,vb0+sl_cur,PAF(0),PAF(1),PAF(2),PAF(3)); }
  #undef PKW
  #undef PAF
  #undef VFR
  #undef PIN
  #undef MX3
  #undef GAPA
  #undef GAPB
  #undef EX
  #undef VRD
  #undef KRD
  #undef STEP
  #undef ENDW
  {auto rr=__builtin_amdgcn_permlane32_swap(__float_as_uint(l_reg),__float_as_uint(l_reg),false,false);l_reg=__uint_as_float(rr[0])+__uint_as_float(rr[1]);}
  if(hi==0)wsf[32+r32]=l_reg;asm volatile("s_waitcnt lgkmcnt(0)":::"memory");
  float rli[16];
  #pragma unroll
  for(int r=0;r<16;++r)rli[r]=__builtin_amdgcn_rcpf(wsf[32+crow(r,hi)]);
  bf16*Ow=O+(qrow0+wid*QBLK)*QP+h*D; const bf16*Gw=Gt+(qrow0+wid*QBLK)*QP+h*D;
  { bf16*stg=(bf16*)(shm+LDS_OST)+wid*2048;
    #pragma unroll
    for(int r=0;r<16;++r){const int orow=crow(r,hi);
      #pragma unroll
      for(int d0=0;d0<2;++d0)stg[orow*64+d0*32+r32]=__float2bfloat16(o[d0][r]*rli[r]);}
    asm volatile("s_waitcnt lgkmcnt(0)":::"memory");
    #pragma unroll
    for(int i=0;i<4;++i){const int row=i*8+(lane>>3),ch=lane&7; const u32x4 v=*(const u32x4*)(stg+row*64+ch*8); const u32x4 gv=*(const u32x4*)(Gw+(long)row*QP+ch*8); ATTN_STORE16(Ow+(long)row*QP+ch*8,mulgate(v,gv));} }
  asm volatile("s_waitcnt lgkmcnt(0)\n\ts_barrier":::"memory");
  #undef DMA_K
  #undef DMA_V
  #undef CMASK
  #undef START
  #undef RESC
  #undef ROT
}
constexpr int ATTN_LDS_BYTES=LDS_BYTES;
#undef SBAR
#undef WAIT_BAR
}

constexpr int NWAVES = 8;
constexpr int D = 1024, TP = 8192, TS = 2048, NB = 8;
constexpr int MP = NB * TP, MS = NB * TS, M = MP + MS;
constexpr int INW = 6656, PLE = 256;
constexpr float EPS = 1e-6f;
#ifndef MK_N_LAUNCHES
#define MK_N_LAUNCHES 1
#endif
constexpr int N_LAUNCHES = MK_N_LAUNCHES;
constexpr int N_PHASES = 8;

constexpr size_t MiB = 1u << 20;
constexpr size_t WS_CTL = 0, CTL_ZERO_BYTES = 64 * 1024;
constexpr size_t WS_R2 = 1 * MiB;
constexpr size_t WS_WIN = 2 * MiB;
constexpr size_t WS_WAB = 16 * MiB;
constexpr size_t WS_WO = 20 * MiB;
constexpr size_t WS_WG = 22 * MiB;
constexpr size_t WS_WPLE = 24 * MiB;
constexpr size_t WS_PBF = 26 * MiB;
constexpr size_t WS_RA = 80 * MiB;
constexpr size_t WS_RB = 240 * MiB;
constexpr size_t WS_RC = 400 * MiB;
constexpr size_t WS_RD = 560 * MiB;
constexpr size_t WS_RE = 720 * MiB;
constexpr size_t WS_RK = 880 * MiB;
constexpr size_t WS_RV = 920 * MiB;
constexpr size_t WS_END = 960 * MiB;

constexpr int RING_BYTES = 131072;
constexpr int LDS_BYTES = 147456;
constexpr int MISC_OFF = LDS_BYTES - 256;

#define GAS __attribute__((address_space(1)))
#define LAS __attribute__((address_space(3)))
typedef unsigned short bf16;
typedef unsigned v4u __attribute__((ext_vector_type(4)));
typedef unsigned v2u __attribute__((ext_vector_type(2)));
typedef float f32x4 __attribute__((ext_vector_type(4)));
#define LDS_WAIT() asm volatile("s_waitcnt lgkmcnt(0)" ::: "memory")
#define VM_WAIT() asm volatile("s_waitcnt vmcnt(0)" ::: "memory")
__device__ __forceinline__ unsigned pk2(float lo, float hi) { return pg8::cvt_pk_bf16(lo, hi); }
__device__ __forceinline__ float blo(unsigned w) { return __uint_as_float(w << 16); }
__device__ __forceinline__ float bhi(unsigned w) { return __uint_as_float(w & 0xffff0000u); }

#define XB_TMO      128
#define XB_XCNT(j)  (256  + 64 * (j))
#define XB_XSUB(j)  (1280 + 64 * (j))
#define XB_XGEN(j)  (2304 + 64 * (j))
#define XB_TOP      3328
#define XB_TOPGEN   3392
#define XCD_BAR_WORDS 3456
#define XB_SPIN_CAP (1u << 18)

__device__ __forceinline__ unsigned xb_ld(unsigned* p)              { return __hip_atomic_load(p, __ATOMIC_RELAXED, __HIP_MEMORY_SCOPE_AGENT); }
__device__ __forceinline__ unsigned xb_add(unsigned* p, unsigned v) { return __hip_atomic_fetch_add(p, v, __ATOMIC_RELAXED, __HIP_MEMORY_SCOPE_AGENT); }
__device__ __forceinline__ unsigned xb_xcc_id() { return (unsigned)__builtin_amdgcn_s_getreg((3 << 11) | 20) & 0xFu; }
#define XB_SPIN(cond, bar) do { unsigned _sp = 0; while (cond) { __builtin_amdgcn_s_sleep(1); \
    if ((++_sp & 255u) == 0u) { if (xb_ld(&(bar)[XB_TMO])) break; if (_sp > XB_SPIN_CAP) { atomicAdd(&(bar)[XB_TMO], 1u); break; } } } } while (0)

struct XcdBarrier {
    unsigned* bar; unsigned x;
    volatile LAS unsigned* st;
};

__device__ __forceinline__ XcdBarrier xcd_barrier_post(unsigned* bar, volatile LAS unsigned* st) {
    XcdBarrier b; b.bar = bar; b.x = xb_xcc_id(); b.st = st;
    if (threadIdx.x == 0) (void)xb_add(&bar[XB_XCNT(b.x)], 1u);
    return b;
}
__device__ __forceinline__ void xcd_barrier_complete(unsigned* bar, unsigned x, unsigned& nloc, unsigned& nx) {
    const unsigned G = gridDim.x * gridDim.y * gridDim.z;
    unsigned sum, cnt, mine, sp = 0u;
    for (;;) {
        sum = 0u; cnt = 0u; mine = 0u;
#pragma unroll
        for (unsigned j = 0; j < 16; ++j) { const unsigned c = xb_ld(&bar[XB_XCNT(j)]); sum += c; cnt += (c > 0u) ? 1u : 0u; mine = (j == x) ? c : mine; }
        if (sum == G) break;
        __builtin_amdgcn_s_sleep(1);
        if ((++sp & 255u) == 0u) { if (xb_ld(&bar[XB_TMO])) break; if (sp > XB_SPIN_CAP) { atomicAdd(&bar[XB_TMO], 1u); break; } }
    }
    nloc = mine > 0u ? mine : 1u; nx = cnt > 0u ? cnt : 1u;
}

__device__ __forceinline__ void xcd_barrier(const XcdBarrier& b) {
    asm volatile("s_waitcnt vmcnt(0)" ::: "memory");
    __syncthreads();
    if (threadIdx.x == 0) {
        unsigned* bar = b.bar;
        __builtin_amdgcn_s_waitcnt(0);
        unsigned nloc = b.st[0], nx = b.st[1];
        if (nloc == 0u) { xcd_barrier_complete(bar, b.x, nloc, nx); b.st[0] = nloc; b.st[1] = nx; }
        const unsigned old = xb_add(&bar[XB_XSUB(b.x)], 1u);
        const unsigned gen = old / nloc;
        if (old + 1u == (gen + 1u) * nloc) {
            __builtin_amdgcn_fence(__ATOMIC_RELEASE, "agent");
            asm volatile("s_waitcnt vmcnt(0)" ::: "memory");
            const unsigned og = xb_add(&bar[XB_TOP], 1u);
            const unsigned tg = og / nx;
            if (og + 1u == (tg + 1u) * nx) xb_add(&bar[XB_TOPGEN], 1u);
            else XB_SPIN(xb_ld(&bar[XB_TOPGEN]) == tg, bar);
            __builtin_amdgcn_fence(__ATOMIC_ACQUIRE, "agent");
            xb_add(&bar[XB_XGEN(b.x)], 1u);
            asm volatile("s_waitcnt vmcnt(0)" ::: "memory");
        } else {
            XB_SPIN(xb_ld(&bar[XB_XGEN(b.x)]) == gen, bar);
            __builtin_amdgcn_fence(__ATOMIC_ACQUIRE, "agent");
            asm volatile("s_waitcnt vmcnt(0)" ::: "memory");
        }
    }
    __syncthreads();
}

struct Args {
    const float *x_p, *x_s, *p_p, *p_s, *norm_pre, *w_in, *pool_w, *pool_scale, *w_a, *q_norm, *k_norm, *w_b, *w_out, *norm_post, *ple_norm, *w_gate, *w_ple;
    float* out; unsigned char* ws; int ph_lo, ph_hi;
};

__device__ __forceinline__ float wave_sum(float v) {
#pragma unroll
    for (int o = 1; o < 64; o <<= 1) v += __shfl_xor(v, o);
    return v;
}
__device__ __forceinline__ void p0_transpose_item(const float* W, int K, int N, bf16* WT, int row_off, int ldt, int koff, LAS float* scr, int item, int lane, const float* kscale = nullptr) {
    const int nblk = N / 32, kb = item / nblk, nb = item % nblk, k0 = 64 * kb, n0 = 32 * nb;
#pragma unroll 8
    for (int i = 0; i < 32; ++i) { const int kk = 2 * i + (lane >> 5); float wv = W[(size_t)(k0 + kk) * N + n0 + (lane & 31)]; if (kscale) wv *= kscale[k0 + kk]; scr[kk * 33 + (lane & 31)] = wv; }
    LDS_WAIT(); asm volatile("" ::: "memory");
    const int c = lane & 7;
#pragma unroll
    for (int j = 0; j < 4; ++j) { const int n = (lane >> 3) + 8 * j; const LAS float* s = scr + (8 * c) * 33 + n;
        v4u o; o.x = pk2(s[0 * 33], s[1 * 33]); o.y = pk2(s[2 * 33], s[3 * 33]); o.z = pk2(s[4 * 33], s[5 * 33]); o.w = pk2(s[6 * 33], s[7 * 33]);
        *(GAS v4u*)(WT + (size_t)(row_off + n0 + n) * ldt + koff + k0 + 8 * c) = o; }
    LDS_WAIT(); asm volatile("" ::: "memory");
}
__device__ __forceinline__ const float* xrow_ptr(const Args& a, int m) { return m < MP ? a.x_p + (size_t)m * D : a.x_s + (size_t)(m - MP) * D; }

__device__ __forceinline__ void phase0(const Args& a, LAS unsigned char* lds, int vcu, int G) {
    int tid = threadIdx.x; asm volatile("" : "+v"(tid));
    const int lane = tid & 63, wave = __builtin_amdgcn_readfirstlane(tid >> 6);
    LAS float* scr = (LAS float*)(lds + wave * 16384);
    const int gw = vcu * NWAVES + wave, NGW = G * NWAVES;
    unsigned char* ws = a.ws;
    {
        LAS float* At = (LAS float*)lds; LAS float* Bt = (LAS float*)(lds + 64 * 257 * 4 + 64);
        bf16* WT = (bf16*)(ws + WS_WIN);
        for (int tile = vcu; tile < 256; tile += G) {
            const int kb = tile >> 4, g = (tile >> 2) & 3, db = tile & 3, k0 = 64 * kb, d0 = 64 * db;
#pragma unroll
            for (int i = 0; i < 8; ++i) { const int row = (tid >> 6) + 8 * i, c4 = tid & 63;
                const f32x4 v = *(const GAS f32x4*)(a.w_in + (size_t)(k0 + row) * INW + g * 256 + 4 * c4);
                LAS float* d = At + row * 257 + 4 * c4; d[0] = v.x; d[1] = v.y; d[2] = v.z; d[3] = v.w; }
#pragma unroll
            for (int i = 0; i < 8; ++i) { const int c = (tid >> 4) + 32 * i, c4 = tid & 15;
                *(LAS f32x4*)(Bt + c * 64 + 4 * c4) = *(const GAS f32x4*)(a.pool_w + (size_t)g * 65536 + (size_t)c * 256 + d0 + 4 * c4); }
            __syncthreads();
            float acc[8];
#pragma unroll
            for (int j = 0; j < 8; ++j) acc[j] = 0.f;
#pragma unroll 4
            for (int c = 0; c < 256; ++c) { const float av = At[lane * 257 + c]; const f32x4 b0 = *(const LAS f32x4*)(Bt + c * 64 + wave * 8), b1 = *(const LAS f32x4*)(Bt + c * 64 + wave * 8 + 4);
                acc[0] += av * b0.x; acc[1] += av * b0.y; acc[2] += av * b0.z; acc[3] += av * b0.w; acc[4] += av * b1.x; acc[5] += av * b1.y; acc[6] += av * b1.z; acc[7] += av * b1.w; }
#pragma unroll
            for (int j = 0; j < 8; ++j) WT[(size_t)(g * 256 + d0 + wave * 8 + j) * D + k0 + lane] = (bf16)(pk2(acc[j], 0.f) & 0xffffu);
            __syncthreads();
        }
    }
    constexpr int I_IN = (D / 64) * ((INW - 1024) / 32), I_SQ = (D / 64) * (D / 32), I_PLE = (PLE / 64) * (D / 32);
    constexpr int NITEMS = I_IN + 4 * I_SQ + I_PLE;
    for (int it = gw; it < NITEMS; it += NGW) {
        int r = it;
        if (r < I_IN) { const int kb = r / 176, nb = 32 + r % 176; const int n0 = 32 * nb; int roff = 0;
            if (n0 >= 4608) { const int c = (n0 - 4608) & 1023, isb = (n0 - 4608) >> 10; roff = 4608 + 256 * (c >> 7) + 128 * isb + (c & 127) - n0; }
            p0_transpose_item(a.w_in, D, INW, (bf16*)(ws + WS_WIN), roff, D, 0, scr, kb * (INW / 32) + nb, lane); continue; } r -= I_IN;
        if (r < I_SQ) { p0_transpose_item(a.w_a, D, D, (bf16*)(ws + WS_WAB), 0, 2048, 0, scr, r, lane); continue; } r -= I_SQ;
        if (r < I_SQ) { p0_transpose_item(a.w_b, D, D, (bf16*)(ws + WS_WAB), 0, 2048, 1024, scr, r, lane); continue; } r -= I_SQ;
        if (r < I_SQ) { p0_transpose_item(a.w_out, D, D, (bf16*)(ws + WS_WO), 0, D, 0, scr, r, lane); continue; } r -= I_SQ;
        if (r < I_SQ) { p0_transpose_item(a.w_gate, D, D, (bf16*)(ws + WS_WG), 0, D, 0, scr, r, lane, a.ple_norm); continue; } r -= I_SQ;
        p0_transpose_item(a.w_ple, PLE, D, (bf16*)(ws + WS_WPLE), 0, PLE, 0, scr, r, lane);
    }
    f32x4 gpre[4];
#pragma unroll
    for (int j = 0; j < 4; ++j) gpre[j] = ((const GAS f32x4*)a.norm_pre)[lane + 64 * j];
    bf16* H = (bf16*)(ws + WS_RA); bf16* PB = (bf16*)(ws + WS_PBF);
    for (int m = gw; m < M; m += NGW) {
        const GAS f32x4* xr = (const GAS f32x4*)xrow_ptr(a, m) + lane;
        f32x4 v[4]; float s = 0.f;
#pragma unroll
        for (int j = 0; j < 4; ++j) { v[j] = xr[64 * j]; s += (v[j].x * v[j].x + v[j].y * v[j].y) + (v[j].z * v[j].z + v[j].w * v[j].w); }
        const float rstd = 1.0f / sqrtf(wave_sum(s) * (1.f / D) + EPS);
        GAS v2u* o8 = (GAS v2u*)(H + (size_t)m * D) + lane;
#pragma unroll
        for (int j = 0; j < 4; ++j) { const f32x4 y = v[j] * rstd * gpre[j]; o8[64 * j] = (v2u){pk2(y.x, y.y), pk2(y.z, y.w)}; }
        const float* prow = m < MP ? a.p_p + (size_t)m * PLE : a.p_s + (size_t)(m - MP) * PLE;
        const f32x4 pv = ((const GAS f32x4*)prow)[lane];
        ((GAS v2u*)(PB + (size_t)m * PLE))[lane] = (v2u){pk2(pv.x, pv.y), pk2(pv.z, pv.w)};
    }
}

__device__ __forceinline__ void normrope16(bf16* ptr, int t, int qd, const float* gain, float scale) {
    const v4u w0 = ((const GAS v4u*)ptr)[0], w1 = ((const GAS v4u*)ptr)[1];
    float av[16];
    av[0] = blo(w0.x); av[1] = bhi(w0.x); av[2] = blo(w0.y); av[3] = bhi(w0.y); av[4] = blo(w0.z); av[5] = bhi(w0.z); av[6] = blo(w0.w); av[7] = bhi(w0.w);
    av[8] = blo(w1.x); av[9] = bhi(w1.x); av[10] = blo(w1.y); av[11] = bhi(w1.y); av[12] = blo(w1.z); av[13] = bhi(w1.z); av[14] = blo(w1.w); av[15] = bhi(w1.w);
    float ss = 0.f;
#pragma unroll
    for (int i = 0; i < 16; ++i) ss += av[i] * av[i];
    ss += __shfl_xor(ss, 1); ss += __shfl_xor(ss, 2);
    const float rstd = 1.0f / sqrtf(ss * (1.f / 64.f) + EPS);
    const float pos = (qd < 2) ? (float)(t >> 6) : (float)(t & 63);
    const float sgn = (qd & 1) ? 1.f : -1.f;
    float o[16];
#pragma unroll
    for (int i4 = 0; i4 < 4; ++i4) { const f32x4 g = ((const GAS f32x4*)(gain + qd * 16))[i4];
        av[4 * i4 + 0] *= rstd * g.x; av[4 * i4 + 1] *= rstd * g.y; av[4 * i4 + 2] *= rstd * g.z; av[4 * i4 + 3] *= rstd * g.w; }
#pragma unroll
    for (int i = 0; i < 16; ++i) {
        const float pr = __shfl_xor(av[i], 1);
        const float freq = __builtin_amdgcn_exp2f(-(float)i * 0.83048202372184058696f);
        float rev = pos * freq * 0.15915494309189533577f; rev = __builtin_amdgcn_fractf(rev);
        const float sn = __builtin_amdgcn_sinf(rev), cs = __builtin_amdgcn_cosf(rev);
        o[i] = (av[i] * cs + sgn * pr * sn) * scale;
    }
    v4u r0, r1;
    r0.x = pk2(o[0], o[1]); r0.y = pk2(o[2], o[3]); r0.z = pk2(o[4], o[5]); r0.w = pk2(o[6], o[7]);
    r1.x = pk2(o[8], o[9]); r1.y = pk2(o[10], o[11]); r1.z = pk2(o[12], o[13]); r1.w = pk2(o[14], o[15]);
    ((GAS v4u*)ptr)[0] = r0; ((GAS v4u*)ptr)[1] = r1;
}
__device__ __forceinline__ int tok_of_row(int m) { return m < MP ? (m & (TP - 1)) : (m & (TS - 1)); }
__device__ __forceinline__ void phase2(const Args& a, int vcu, int G) {
    int tid = threadIdx.x; asm volatile("" : "+v"(tid));
    const int lane = tid & 63, wave = __builtin_amdgcn_readfirstlane(tid >> 6);
    bf16* K = (bf16*)(a.ws + WS_RK);
    const int gw = vcu * NWAVES + wave, NGW = G * NWAVES;
    for (int m4 = gw; m4 < M / 4; m4 += NGW) { const int m = m4 * 4 + (lane >> 4); normrope16(K + (size_t)m * 256 + (lane & 15) * 16, tok_of_row(m), lane & 3, a.k_norm, 1.0f); }
}
template <int W> __device__ __forceinline__ void pool_item(const bf16* Z, const bf16* SZA, bf16* AO, const float* pscale, int g, int rb, int cc, int rsub) {
    const f32x4 ps0 = *(const GAS f32x4*)(pscale + g * 256 + cc * 8), ps1 = *(const GAS f32x4*)(pscale + g * 256 + cc * 8 + 4);
    constexpr int half = W / 2;
#pragma unroll 1
    for (int rr = 0; rr < 4; ++rr) {
        const int m = rb * 64 + rr * 16 + rsub;
        const int T = m < MP ? TP : TS, s0 = m < MP ? (m & ~(TP - 1)) : (m & ~(TS - 1)), t = m - s0;
        const bf16* colp = Z + (size_t)s0 * D + g * 256 + cc * 8;
        v4u wv[W];
#pragma unroll
        for (int i = 0; i < W; ++i) { const int sidx = t - half + i; const int sc = min(max(sidx, 0), T - 1); wv[i] = *(const GAS v4u*)(colp + (size_t)sc * D); }
        const v4u gz = *(const GAS v4u*)(SZA + (size_t)m * D + g * 256 + cc * 8);
        float acc[8];
#pragma unroll
        for (int e = 0; e < 8; ++e) acc[e] = 0.f;
#pragma unroll
        for (int i = 0; i < W; ++i) { const int sidx = t - half + i; const float wgt = (sidx >= 0 && sidx < T) ? 1.f : 0.f; const v4u w = wv[i];
            acc[0] += wgt * blo(w.x); acc[1] += wgt * bhi(w.x); acc[2] += wgt * blo(w.y); acc[3] += wgt * bhi(w.y); acc[4] += wgt * blo(w.z); acc[5] += wgt * bhi(w.z); acc[6] += wgt * blo(w.w); acc[7] += wgt * bhi(w.w); }
        const v4u own = wv[half];
        const int lo = max(t - half, 0), hi = min(t + half, T);
        const float inv = 1.0f / (float)(hi - lo);
        v4u o; o.x = pk2((acc[0] * inv - blo(own.x)) * ps0.x * blo(gz.x), (acc[1] * inv - bhi(own.x)) * ps0.y * bhi(gz.x));
        o.y = pk2((acc[2] * inv - blo(own.y)) * ps0.z * blo(gz.y), (acc[3] * inv - bhi(own.y)) * ps0.w * bhi(gz.y));
        o.z = pk2((acc[4] * inv - blo(own.z)) * ps1.x * blo(gz.z), (acc[5] * inv - bhi(own.z)) * ps1.y * bhi(gz.z));
        o.w = pk2((acc[6] * inv - blo(own.w)) * ps1.z * blo(gz.w), (acc[7] * inv - bhi(own.w)) * ps1.w * bhi(gz.w));
        *(GAS v4u*)(AO + (size_t)m * D + g * 256 + cc * 8) = o;
    }
}
__device__ __forceinline__ void pool_tail(const Args& a, int vcu, int G) {
    int tid = threadIdx.x; asm volatile("" : "+v"(tid));
    unsigned char* ws = a.ws;
    const bf16* Z = (const bf16*)(ws + WS_RB); const bf16* SZA = (const bf16*)(ws + WS_RC); bf16* AO = (bf16*)(ws + WS_RA);
    const int cc = tid & 31, rsub = tid >> 5;
    for (int it = vcu; it < (M / 64) * 4; it += G) {
        const int g = it & 3, rb = it >> 2;
        if (g == 0) pool_item<2>(Z, SZA, AO, a.pool_scale, g, rb, cc, rsub);
        else if (g == 1) pool_item<4>(Z, SZA, AO, a.pool_scale, g, rb, cc, rsub);
        else if (g == 2) pool_item<8>(Z, SZA, AO, a.pool_scale, g, rb, cc, rsub);
        else pool_item<16>(Z, SZA, AO, a.pool_scale, g, rb, cc, rsub);
    }
}

__device__ __forceinline__ void phase6(const Args& a, int vcu, int G) {
    int tid = threadIdx.x; asm volatile("" : "+v"(tid));
    const int lane = tid & 63, wave = __builtin_amdgcn_readfirstlane(tid >> 6);
    unsigned char* ws = a.ws;
    const bf16* Y = (const bf16*)(ws + WS_RA); bf16* X1 = (bf16*)(ws + WS_RB); float* R2 = (float*)(ws + WS_R2);
    const int gw = vcu * NWAVES + wave, NGW = G * NWAVES;
    f32x4 gpost[4];
#pragma unroll
    for (int j = 0; j < 4; ++j) gpost[j] = ((const GAS f32x4*)a.norm_post)[lane + 64 * j];
    for (int m = gw; m < M; m += NGW) {
        const GAS f32x4* xr = (const GAS f32x4*)xrow_ptr(a, m) + lane;
        const GAS v2u* yr = (const GAS v2u*)(Y + (size_t)m * D) + lane;
        f32x4 xv[4], yv[4]; float s = 0.f;
#pragma unroll
        for (int j = 0; j < 4; ++j) { xv[j] = xr[64 * j]; const v2u w = yr[64 * j]; yv[j] = (f32x4){blo(w.x), bhi(w.x), blo(w.y), bhi(w.y)};
            s += (yv[j].x * yv[j].x + yv[j].y * yv[j].y) + (yv[j].z * yv[j].z + yv[j].w * yv[j].w); }
        const float rstd = 1.0f / sqrtf(wave_sum(s) * (1.f / D) + EPS);
        float s2 = 0.f;
        GAS v2u* o8 = (GAS v2u*)(X1 + (size_t)m * D) + lane;
#pragma unroll
        for (int j = 0; j < 4; ++j) { xv[j] = xv[j] + yv[j] * rstd * gpost[j]; o8[64 * j] = (v2u){pk2(xv[j].x, xv[j].y), pk2(xv[j].z, xv[j].w)};
            s2 += (xv[j].x * xv[j].x + xv[j].y * xv[j].y) + (xv[j].z * xv[j].z + xv[j].w * xv[j].w); }
        const float rstd2 = 1.0f / sqrtf(wave_sum(s2) * (1.f / D) + EPS);
        if (lane == 0) R2[m] = rstd2;
    }
}

__device__ __forceinline__ bool attn_next(int i, int vcu, int G, long& qrow0, long& kvrow0, int& NT, int& h) {
    int samp, b, qb;
    if (G == 256) {
        if (i >= 20) return false;
        const int x = vcu >> 5, j = vcu & 31; b = x;
        if (i < 16) { samp = 0; h = (i >> 2) * 4 + (i & 3); qb = j; }
        else { samp = 1; h = (i - 16) * 4 + (j >> 3); qb = j & 7; }
    } else {
        const int uid = vcu + i * G; if (uid >= 5120) return false;
        if (uid < 4096) { samp = 0; b = uid >> 9; h = (uid >> 5) & 15; qb = uid & 31; }
        else { const int r = uid - 4096; samp = 1; b = r >> 7; h = (r >> 3) & 15; qb = r & 7; }
    }
    if (!samp) { kvrow0 = (long)b * TP; NT = TP / 64; } else { kvrow0 = (long)MP + (long)b * TS; NT = TS / 64; }
    qrow0 = kvrow0 + qb * 256;
    return true;
}

__global__ void __launch_bounds__(NWAVES * 64, 2) fwd_megakernel(Args args) {
    extern __shared__ __attribute__((aligned(16))) unsigned char lds_raw[];
    LAS unsigned char* lds = (LAS unsigned char*)lds_raw;
    const int G = gridDim.x; const int bx = blockIdx.x; const int vcu = (G % 8 == 0) ? (bx % 8) * (G / 8) + bx / 8 : bx;
    cg::grid_group grid = cg::this_grid();
    unsigned char* ws = args.ws;
    const int lo = args.ph_lo, hi = args.ph_hi;
#ifndef PH_MASK
#define PH_MASK 0xFF
#endif
#define IN(k) ((((PH_MASK) >> (k)) & 1) && lo <= (k) && (k) < hi)
#ifndef DUP_MASK
#define DUP_MASK 0
#endif
#define REPS(k) ((((DUP_MASK) >> (k)) & 1) ? 2 : 1)
#define SEAM(k) do { if (IN(k) && IN((k) + 1)) { if ((k) == 0) { VM_WAIT(); grid.sync(); VM_WAIT(); } else { xcd_barrier(bar); } } } while (0)
    volatile LAS unsigned* MISC = (volatile LAS unsigned*)(lds + MISC_OFF);
    if (threadIdx.x < 32) MISC[threadIdx.x] = 0u;
    __syncthreads();
    XcdBarrier bar = xcd_barrier_post((unsigned*)(ws + WS_CTL), MISC);
    bf16* RA = (bf16*)(ws + WS_RA); bf16* RB = (bf16*)(ws + WS_RB); bf16* RC = (bf16*)(ws + WS_RC); bf16* RD = (bf16*)(ws + WS_RD); bf16* RE = (bf16*)(ws + WS_RE);
    bf16* RK = (bf16*)(ws + WS_RK); bf16* RV = (bf16*)(ws + WS_RV);
    bf16* MA = (bf16*)args.out; bf16* MB = (bf16*)args.out + (size_t)M * D;

    if (IN(0)) { for (int rep = 0; rep < REPS(0); ++rep) phase0(args, lds, vcu, G); }
    SEAM(0);
    if (IN(1)) for (int rep = 0; rep < REPS(1); ++rep) {
        pg8::Gemm g{RA, RA, (const bf16*)(ws + WS_WIN), D, D, D, D, 0};
        pg8::StaticOrder S; S.init(M, INW, G, bx);
        pg8::EpiIn E{RB, RC, RD, RK, RV, RE, MA, MB};
        pg8::gemm_phase<pg8::EpiIn, pg8::StaticOrder, true, true>(lds, g, S, E);
    }
    SEAM(1);
    if (IN(2)) { phase2(args, vcu, G); }
    SEAM(2);
    if (IN(3)) {
        long qrow0, kvrow0; int NT, h;
        bool track;
        { const int ln = threadIdx.x & 63; float mq = fabsf(args.q_norm[ln]), mk = fabsf(args.k_norm[ln]);
#pragma unroll
          for (int o = 1; o < 64; o <<= 1) { mq = fmaxf(mq, __shfl_xor(mq, o)); mk = fmaxf(mk, __shfl_xor(mk, o)); }
          track = __builtin_amdgcn_readfirstlane((mq * mk <= 2.6f) ? 0 : 1) != 0; }
        for (int rep = 0; rep < REPS(3); ++rep)
        for (int i = 0; attn_next(i, vcu, G, qrow0, kvrow0, NT, h); ++i)
            attn_body::attn_unit<8>(qrow0, kvrow0, NT, h, (const attn_body::bf16*)RD, (const attn_body::bf16*)RK, (const attn_body::bf16*)RV, (attn_body::bf16*)((REPS(3) == 2 && rep == 0) ? RB : RD), (const attn_body::bf16*)RE, args.q_norm, track, (char*)lds_raw);
        for (int rep = 0; rep < REPS(8); ++rep) pool_tail(args, vcu, G);
    }
    SEAM(3);
    if (IN(4)) {
        pg8::Gemm g{RA, RD, (const bf16*)(ws + WS_WAB), D, 2048, 2048, 1024, 0};
        pg8::DupOrder S; S.init(M, D, G, bx, REPS(4));
        pg8::EpiMerge E{RC, MA, MB};
        pg8::gemm_phase<pg8::EpiMerge, pg8::DupOrder, true, true>(lds, g, S, E);
    }
    SEAM(4);
    if (IN(5)) {
        { pg8::Gemm g{RC, RC, (const bf16*)(ws + WS_WO), D, D, D, D, 0};
          pg8::DupOrder S; S.init(M, D, G, bx, REPS(5));
          pg8::EpiPlain E{RA, D};
          pg8::gemm_phase<pg8::EpiPlain, pg8::DupOrder, true, true>(lds, g, S, E); }
        { pg8::Gemm g{(const bf16*)(ws + WS_PBF), (const bf16*)(ws + WS_PBF), (const bf16*)(ws + WS_WPLE), PLE, PLE, PLE, PLE, 0};
          pg8::DupOrder S; S.init(M, D, G, bx, REPS(9));
          pg8::EpiPlain E{RD, D};
          pg8::gemm_phase<pg8::EpiPlain, pg8::DupOrder, true, true>(lds, g, S, E); }
    }
    SEAM(5);
    if (IN(6)) { for (int rep = 0; rep < REPS(6); ++rep) phase6(args, vcu, G); }
    SEAM(6);
    if (IN(7)) {
        pg8::Gemm g{RB, RB, (const bf16*)(ws + WS_WG), D, D, D, D, 0};
        pg8::StaticOrder S; S.init(M, D, G, bx);
        pg8::EpiFinal E{args.out, RB, RD, (const float*)(ws + WS_R2)};
        pg8::gemm_phase<pg8::EpiFinal, pg8::StaticOrder, true, true>(lds, g, S, E);
    }
#undef IN
#undef SEAM
}

extern "C" void kernel_launch(void* const* d_in, const int* in_sizes, int n_in, void* d_out, int out_size, void* d_ws, size_t ws_size, hipStream_t stream) {
    static int grid = 0;
    if (grid == 0) {
        if (n_in != 17 || in_sizes[0] != MP * D || in_sizes[1] != MS * D || out_size != M * D || ws_size < WS_END) {
            fprintf(stderr, "kernel_launch: unexpected shapes (n_in %d, in0 %d, out %d, ws %zu); nothing launched\n", n_in, n_in > 0 ? in_sizes[0] : -1, out_size, ws_size); grid = -1; return; }
        int dev = 0, cus = 0, per_cu = 0;
        if (hipGetDevice(&dev) != hipSuccess || hipDeviceGetAttribute(&cus, hipDeviceAttributeMultiprocessorCount, dev) != hipSuccess) { fprintf(stderr, "kernel_launch: device query failed\n"); grid = -1; return; }
        if (hipFuncSetAttribute((const void*)fwd_megakernel, hipFuncAttributeMaxDynamicSharedMemorySize, LDS_BYTES) != hipSuccess) { fprintf(stderr, "kernel_launch: hipFuncSetAttribute failed\n"); grid = -1; return; }
        if (hipOccupancyMaxActiveBlocksPerMultiprocessor(&per_cu, (const void*)fwd_megakernel, NWAVES * 64, LDS_BYTES) != hipSuccess || per_cu < 1) { fprintf(stderr, "kernel_launch: occupancy query says %d\n", per_cu); per_cu = 1; }
        (void)hipGetLastError();
        grid = cus * 1;
        (void)per_cu;
    }
    if (grid < 0) return;
    if (hipMemsetAsync((char*)d_ws + WS_CTL, 0, CTL_ZERO_BYTES, stream) != hipSuccess) { fprintf(stderr, "kernel_launch: memset of control words failed\n"); return; }
    Args a{};
    a.x_p = (const float*)d_in[0]; a.x_s = (const float*)d_in[1]; a.p_p = (const float*)d_in[2]; a.p_s = (const float*)d_in[3]; a.norm_pre = (const float*)d_in[4];
    a.w_in = (const float*)d_in[5]; a.pool_w = (const float*)d_in[6]; a.pool_scale = (const float*)d_in[7]; a.w_a = (const float*)d_in[8]; a.q_norm = (const float*)d_in[9];
    a.k_norm = (const float*)d_in[10]; a.w_b = (const float*)d_in[11]; a.w_out = (const float*)d_in[12]; a.norm_post = (const float*)d_in[13]; a.ple_norm = (const float*)d_in[14];
    a.w_gate = (const float*)d_in[15]; a.w_ple = (const float*)d_in[16];
    a.out = (float*)d_out; a.ws = (unsigned char*)d_ws;
    if (N_LAUNCHES == 1) {
        a.ph_lo = 0; a.ph_hi = N_PHASES;
        void* kargs[] = {&a};
        hipError_t e = hipLaunchCooperativeKernel((const void*)fwd_megakernel, dim3(grid), dim3(NWAVES * 64), kargs, LDS_BYTES, stream);
        if (e != hipSuccess) fprintf(stderr, "kernel_launch: cooperative launch failed: %s (grid %d)\n", hipGetErrorString(e), grid);
    } else {
        for (int ph = 0; ph < N_PHASES; ++ph) {
            a.ph_lo = ph; a.ph_hi = ph + 1;
            hipLaunchKernelGGL(fwd_megakernel, dim3(grid), dim3(NWAVES * 64), LDS_BYTES, stream, a);
        }
    }
}
```

```cpp
#include <hip/hip_runtime.h>
#include <hip/hip_cooperative_groups.h>
#include <hip/hip_bf16.h>
#include <cstdio>
#include <cstdint>
#include <cmath>
namespace cg = cooperative_groups;

namespace pg8 {
#define PG8_LAS __attribute__((address_space(3)))
typedef unsigned short bf16_t;
typedef short bf16x8 __attribute__((ext_vector_type(8)));
typedef float f32x4 __attribute__((ext_vector_type(4)));
typedef unsigned u32x4 __attribute__((ext_vector_type(4)));
constexpr int BM = 256, BK = 64, HALF = 128, HTB = HALF * BK * 2  , STAGE_BYTES = 8 * HTB, NXCD = 8, WGM = 8;

__host__ __device__ __forceinline__ int lds_byte(int r, int c) { const int st = (r >> 4) * 2 + (c >> 5), rr = r & 15, cc = c & 31, ob = rr * 64 + cc * 2; return st * 1024 + (ob ^ (((ob >> 9) & 1) << 5)); }
__host__ __device__ __forceinline__ void stage_rc(int b, int& R, int& C) { const int st = b / 1024, sb = b % 1024, swz = sb ^ (((sb >> 9) & 1) << 5); R = (st >> 1) * 16 + swz / 64; C = (st & 1) * 32 + (swz % 64) / 2; }
__host__ __device__ __forceinline__ int perm32(int rho) { const int n = rho >> 4, i = rho & 15; return 8 * (i >> 2) + 4 * n + (i & 3); }

struct Unit { int pm, pn; };
struct Gemm { const bf16_t* A; const bf16_t* A2; const bf16_t* Bt; int lda, ldb, K, K1; size_t a_pn_off; };

struct StaticOrder {
    int nM, nN, nwg, G, c;
    __host__ __device__ void init(int M, int N, int G_, int c_) { nM = M / BM; nN = N / BM; nwg = nM * nN; G = G_; c = c_; }
    __host__ __device__ bool next(int i, Unit& u) const {
        const long L = (long)i * G + c; if (L >= nwg) return false;
        int wgid = (int)L; { const int q = nwg / NXCD, r = nwg % NXCD, xcd = wgid % NXCD, off = wgid / NXCD; wgid = (xcd < r ? xcd * (q + 1) : r * (q + 1) + (xcd - r) * q) + off; }
        const int nig = WGM * nN, gid = wgid / nig, fm = gid * WGM, gsz = (nM - fm) < WGM ? (nM - fm) : WGM;
        u.pm = fm + ((wgid % nig) % gsz); u.pn = (wgid % nig) / gsz; return true;
    }
    __device__ __forceinline__ void a_ready(const Unit&) const {}
    __device__ __forceinline__ void done(const Unit&) const {}
};

__device__ __forceinline__ unsigned cvt_pk_bf16(float lo, float hi) { unsigned r; asm volatile("v_cvt_pk_bf16_f32 %0, %1, %2" : "=v"(r) : "v"(lo), "v"(hi)); return r; }
__device__ __forceinline__ float bf_lo(unsigned w) { return __uint_as_float(w << 16); }
__device__ __forceinline__ float bf_hi(unsigned w) { return __uint_as_float(w & 0xffff0000u); }
__device__ __forceinline__ float fsigmoid(float x) { return __builtin_amdgcn_rcpf(1.0f + __builtin_amdgcn_exp2f(-1.4426950408889634f * x)); }
__device__ __forceinline__ float fsilu(float x) { return x * fsigmoid(x); }
__device__ __forceinline__ u32x4 pack8(const f32x4& v0, const f32x4& v1) { u32x4 w; w.x = cvt_pk_bf16(v0[0], v0[1]); w.y = cvt_pk_bf16(v0[2], v0[3]); w.z = cvt_pk_bf16(v1[0], v1[1]); w.w = cvt_pk_bf16(v1[2], v1[3]); return w; }
__device__ __forceinline__ void unpack8(const u32x4& w, f32x4& v0, f32x4& v1) { v0 = (f32x4){bf_lo(w.x), bf_hi(w.x), bf_lo(w.y), bf_hi(w.y)}; v1 = (f32x4){bf_lo(w.z), bf_hi(w.z), bf_lo(w.w), bf_hi(w.w)}; }

struct EpiIn {
    static constexpr bool PERM = true, AFTER_DRAIN = false, MID = false;
    bf16_t *ua, *sza, *q, *k, *v, *szb, *ma, *mb;
    __device__ __forceinline__ void operator()(const f32x4 (&acc)[2][2][4][2], const Unit& u, int wr, int wc, int fr, int fq) const {
        const int pn = u.pn; bf16_t* base; int ldc = 1024, ct; bool act = false;
        if (pn < 4) { base = ua; ct = pn; }
        else if (pn < 8) { base = sza; ct = pn - 4; act = true; }
        else if (pn < 12) { base = q; ct = pn - 8; }
        else if (pn == 12) { base = k; ct = 0; ldc = 256; }
        else if (pn == 13) { base = v; ct = 0; ldc = 256; }
        else if (pn < 18) { base = szb; ct = pn - 14; act = true; }
        else {
            int row0 = u.pm * BM + wr * 64 + fr, col0 = (pn - 18) * HALF + wc * 32 + 8 * fq; asm volatile("" : "+v"(row0), "+v"(col0));
#pragma unroll
            for (int ai = 0; ai < 2; ++ai)
#pragma unroll
                for (int m = 0; m < 4; ++m) { const size_t off = (size_t)(row0 + ai * HALF + m * 16) * 1024 + col0; f32x4 r0, r1, s0, s1;
#pragma unroll
                    for (int e = 0; e < 4; ++e) {
                        const float ea0 = __builtin_amdgcn_exp2f(-1.4426950408889634f * acc[ai][0][m][0][e]), ea1 = __builtin_amdgcn_exp2f(-1.4426950408889634f * acc[ai][0][m][1][e]);
                        const float eb0 = __builtin_amdgcn_exp2f(-1.4426950408889634f * fmaxf(acc[ai][1][m][0][e], -60.f)), eb1 = __builtin_amdgcn_exp2f(-1.4426950408889634f * fmaxf(acc[ai][1][m][1][e], -60.f));
                        s0[e] = __builtin_amdgcn_rcpf(1.0f + eb0); s1[e] = __builtin_amdgcn_rcpf(1.0f + eb1);
                        r0[e] = (1.0f + eb0) * __builtin_amdgcn_rcpf(1.0f + ea0); r1[e] = (1.0f + eb1) * __builtin_amdgcn_rcpf(1.0f + ea1); }
                    *(u32x4*)(ma + off) = pack8(r0, r1); *(u32x4*)(mb + off) = pack8(s0, s1); }
            return; }
        int row0 = u.pm * BM + wr * 64 + fr, col0 = ct * BM + wc * 32 + 8 * fq; asm volatile("" : "+v"(row0), "+v"(col0));
#pragma unroll
        for (int ai = 0; ai < 2; ++ai)
#pragma unroll
            for (int m = 0; m < 4; ++m) { bf16_t* rowp = base + (size_t)(row0 + ai * HALF + m * 16) * ldc + col0;
#pragma unroll
                for (int bj = 0; bj < 2; ++bj) { f32x4 v0 = acc[ai][bj][m][0], v1 = acc[ai][bj][m][1];
                    if (act) {
#pragma unroll
                        for (int e = 0; e < 4; ++e) { v0[e] = fsilu(v0[e]); v1[e] = fsilu(v1[e]); } }
                    *(u32x4*)(rowp + bj * HALF) = pack8(v0, v1); } }
    }
};
struct EpiPlain {
    static constexpr bool PERM = true, AFTER_DRAIN = false, MID = false;
    bf16_t* O; int ldc;
    __device__ __forceinline__ void operator()(const f32x4 (&acc)[2][2][4][2], const Unit& u, int wr, int wc, int fr, int fq) const {
        int row0 = u.pm * BM + wr * 64 + fr, col0 = u.pn * BM + wc * 32 + 8 * fq; asm volatile("" : "+v"(row0), "+v"(col0));
#pragma unroll
        for (int ai = 0; ai < 2; ++ai)
#pragma unroll
            for (int m = 0; m < 4; ++m) { bf16_t* rowp = O + (size_t)(row0 + ai * HALF + m * 16) * ldc + col0;
#pragma unroll
                for (int bj = 0; bj < 2; ++bj) *(u32x4*)(rowp + bj * HALF) = pack8(acc[ai][bj][m][0], acc[ai][bj][m][1]); }
    }
};
struct EpiMerge {
    static constexpr bool PERM = true, AFTER_DRAIN = false, MID = true;
    bf16_t* O; const bf16_t* rt; const bf16_t* sb;
    __device__ __forceinline__ void mid(f32x4 (&acc)[2][2][4][2], const Unit& u, int wr, int wc, int fr, int fq) const {
        int row0 = u.pm * BM + wr * 64 + fr, col0 = u.pn * BM + wc * 32 + 8 * fq;
        asm volatile("" : "+v"(row0), "+v"(col0));
#pragma unroll
        for (int ai = 0; ai < 2; ++ai) {
            u32x4 rw[4][2];
#pragma unroll
            for (int m = 0; m < 4; ++m) { const size_t off = (size_t)(row0 + ai * HALF + m * 16) * 1024 + col0;
#pragma unroll
                for (int bj = 0; bj < 2; ++bj) rw[m][bj] = *(const u32x4*)(rt + off + bj * HALF); }
#pragma unroll
            for (int m = 0; m < 4; ++m)
#pragma unroll
                for (int bj = 0; bj < 2; ++bj) { f32x4 r0, r1; unpack8(rw[m][bj], r0, r1); acc[ai][bj][m][0] *= r0; acc[ai][bj][m][1] *= r1; }
#pragma unroll
            for (int m = 0; m < 4; ++m) asm volatile("" : "+v"(acc[ai][0][m][0]), "+v"(acc[ai][0][m][1]), "+v"(acc[ai][1][m][0]), "+v"(acc[ai][1][m][1]) :: "memory");
        }
    }
    __device__ __forceinline__ void operator()(const f32x4 (&acc)[2][2][4][2], const Unit& u, int wr, int wc, int fr, int fq) const {
        int row0 = u.pm * BM + wr * 64 + fr, col0 = u.pn * BM + wc * 32 + 8 * fq; asm volatile("" : "+v"(row0), "+v"(col0));
#pragma unroll
        for (int ai = 0; ai < 2; ++ai)
#pragma unroll
            for (int m = 0; m < 4; ++m) { const size_t off = (size_t)(row0 + ai * HALF + m * 16) * 1024 + col0;
#pragma unroll
                for (int bj = 0; bj < 2; ++bj) { const u32x4 bw = *(const u32x4*)(sb + off + bj * HALF); f32x4 b0, b1; unpack8(bw, b0, b1);
                    *(u32x4*)(O + off + bj * HALF) = pack8(acc[ai][bj][m][0] * b0, acc[ai][bj][m][1] * b1); } }
    }
};
struct EpiFinal {
    static constexpr bool PERM = true, AFTER_DRAIN = false, MID = false;
    float* out; const bf16_t* x1b; const bf16_t* pe; const float* r2;
    __device__ __forceinline__ void operator()(const f32x4 (&acc)[2][2][4][2], const Unit& u, int wr, int wc, int fr, int fq) const {
        int row0 = u.pm * BM + wr * 64 + fr, col0 = u.pn * BM + wc * 32 + 8 * fq; asm volatile("" : "+v"(row0), "+v"(col0));
#pragma unroll
        for (int ai = 0; ai < 2; ++ai)
#pragma unroll
            for (int m = 0; m < 4; ++m) { const int row = row0 + ai * HALF + m * 16; const size_t off = (size_t)row * 1024 + col0; const float rs = r2[row];
#pragma unroll
                for (int bj = 0; bj < 2; ++bj) { const u32x4 pw = *(const u32x4*)(pe + off + bj * HALF), xw = *(const u32x4*)(x1b + off + bj * HALF);
                    f32x4 p0, p1, x0, x1; unpack8(pw, p0, p1); unpack8(xw, x0, x1);
                    float* op = out + off + bj * HALF;
                    f32x4 g0 = acc[ai][bj][m][0], g1 = acc[ai][bj][m][1];
#pragma unroll
                    for (int e = 0; e < 4; ++e) { g0[e] = x0[e] + fsigmoid(rs * g0[e]) * p0[e]; g1[e] = x1[e] + fsigmoid(rs * g1[e]) * p1[e]; }
                    *(f32x4*)op = g0; *(f32x4*)(op + 4) = g1; } }
    }
};
struct DupOrder {
    StaticOrder S; int dup;
    __device__ void init(int M_, int N_, int G_, int c_, int dup_) { S.init(M_, N_, G_, c_); dup = dup_; }
    __device__ bool next(int i, Unit& u) const { if (dup > 1) { const int rounds = S.nwg / S.G; if (i >= dup * rounds) return false; i %= rounds; } return S.next(i, u); }
    __device__ __forceinline__ void a_ready(const Unit&) const {}
    __device__ __forceinline__ void done(const Unit&) const {}
};
template <class Epi, class Sched, bool ALIGN_EPI = false, bool SP2 = false>
__device__ __forceinline__ void gemm_phase(PG8_LAS unsigned char* lds, const Gemm g, const Sched& S, const Epi& E) {
    const int tid = threadIdx.x, wid = __builtin_amdgcn_readfirstlane(tid >> 6), lane = tid & 63, wr = wid >> 2, wc = wid & 3, fr = lane & 15, fq = lane >> 4;
    const int nt = g.K / BK, nth = g.K1 / BK;
    unsigned voffA[2], voffB[2];
#pragma unroll
    for (int i = 0; i < 2; ++i) { int R, C; stage_rc(tid * 16 + i * 8192, R, C); const int Rb = Epi::PERM ? ((R & ~31) + perm32(R & 31)) : R;
        voffA[i] = (unsigned)(R * g.lda + C) * 2u; voffB[i] = (unsigned)(Rb * g.ldb + C) * 2u; }
    const size_t kstep = (size_t)(BK * 2);
    const size_t hstepA = (size_t)HALF * g.lda * 2, hstepB = (size_t)HALF * g.ldb * 2;
    const size_t tstepA = 2 * hstepA, tstepB = 2 * hstepB;
    const unsigned ldsw = (unsigned)wid * 1024u;
    const int aoff = lds_byte(wr * 64 + fr, fq * 8), boff = lds_byte(wc * 32 + fr, fq * 8);
#define PG8_SA(b, h) (((b) * 2 + (h)) * HTB)
#define PG8_SB(b, h) ((4 + (b) * 2 + (h)) * HTB)
#define PG8_STAGE(bufoff, gbase, voff) do { _Pragma("unroll") for (int _i = 0; _i < 2; ++_i) \
        __builtin_amdgcn_global_load_lds((const unsigned*)((const char*)(gbase) + (voff)[_i]), (PG8_LAS unsigned*)(lds + (bufoff) + ldsw + _i * 8192), 16, 0, 0); } while (0)
#define PG8_LDA(dst, b, h) do { _Pragma("unroll") for (int m = 0; m < 4; ++m) _Pragma("unroll") for (int k = 0; k < 2; ++k) dst[m][k] = *(const PG8_LAS bf16x8*)(lds + PG8_SA(b, h) + aoff + m * 2048 + k * 1024); } while (0)
#define PG8_LDB(dst, b, h) do { _Pragma("unroll") for (int n = 0; n < 2; ++n) _Pragma("unroll") for (int k = 0; k < 2; ++k) dst[n][k] = *(const PG8_LAS bf16x8*)(lds + PG8_SB(b, h) + boff + n * 2048 + k * 1024); } while (0)
#define PG8_MMA(ai, bj, At, Bt) do { __builtin_amdgcn_s_setprio(1); _Pragma("unroll") for (int m = 0; m < 4; ++m) _Pragma("unroll") for (int n = 0; n < 2; ++n) _Pragma("unroll") for (int k = 0; k < 2; ++k) \
        acc[ai][bj][m][n] = __builtin_amdgcn_mfma_f32_16x16x32_bf16(Bt[n][k], At[m][k], acc[ai][bj][m][n], 0, 0, 0); __builtin_amdgcn_s_setprio(0); } while (0)
#define PG8_WAIT_V(n) asm volatile("s_waitcnt vmcnt(" #n ")" ::: "memory")
#define PG8_WAIT_L(n) asm volatile("s_waitcnt lgkmcnt(" #n ")" ::: "memory")
#define PG8_BAR __builtin_amdgcn_s_barrier()
#define PG8_SCHED __builtin_amdgcn_sched_barrier(0)
    Unit cur, nxt; int ui = 0;
    if (!S.next(0, cur)) return;
    f32x4 acc[2][2][4][2];
#pragma unroll
    for (int a = 0; a < 2; ++a)
#pragma unroll
        for (int b = 0; b < 2; ++b)
#pragma unroll
            for (int m = 0; m < 4; ++m)
#pragma unroll
                for (int n = 0; n < 2; ++n) acc[a][b][m][n] = (f32x4){0.f, 0.f, 0.f, 0.f};
    bf16x8 At[4][2], B0[2][2], B1[2][2];
    const char* cA = (const char*)g.A + (size_t)cur.pm * tstepA + (size_t)cur.pn * g.a_pn_off; const char* cA2 = (const char*)g.A2 + (size_t)cur.pm * tstepA; const char* cB = (const char*)g.Bt + (size_t)cur.pn * tstepB;
    S.a_ready(cur);
    if constexpr (SP2) {
        PG8_STAGE(PG8_SB(0, 0), cB, voffB); PG8_STAGE(PG8_SB(0, 1), cB + hstepB, voffB); PG8_STAGE(PG8_SA(0, 0), cA, voffA); PG8_STAGE(PG8_SA(0, 1), cA + hstepA, voffA);
        if (wr == 1) PG8_BAR;
        PG8_WAIT_V(2); PG8_BAR;
        PG8_STAGE(PG8_SB(1, 0), cB + kstep, voffB); PG8_STAGE(PG8_SA(1, 0), cA + kstep, voffA); PG8_STAGE(PG8_SB(1, 1), cB + hstepB + kstep, voffB);
        PG8_WAIT_V(6); PG8_BAR;
    } else {
        PG8_STAGE(PG8_SB(0, 0), cB, voffB); PG8_STAGE(PG8_SA(0, 0), cA, voffA); PG8_STAGE(PG8_SB(0, 1), cB + hstepB, voffB); PG8_STAGE(PG8_SA(0, 1), cA + hstepA, voffA);
        if (wr == 1) PG8_BAR;
        PG8_WAIT_V(4); PG8_BAR;
        PG8_STAGE(PG8_SB(1, 0), cB + kstep, voffB); PG8_STAGE(PG8_SA(1, 0), cA + kstep, voffA); PG8_STAGE(PG8_SB(1, 1), cB + hstepB + kstep, voffB);
        PG8_WAIT_V(6); PG8_BAR;
    }
    for (;;) {
        const bool has_next = S.next(ui + 1, nxt);
        const char* nA = has_next ? (const char*)g.A + (size_t)nxt.pm * tstepA + (size_t)nxt.pn * g.a_pn_off : cA; const char* nA2 = has_next ? (const char*)g.A2 + (size_t)nxt.pm * tstepA : cA2; const char* nB = has_next ? (const char*)g.Bt + (size_t)nxt.pn * tstepB : cB;
        for (int t = 0; t < nt; t += 2) {
            const bool last = (t == nt - 2);
            if constexpr (Epi::MID) { if (t == nth) E.mid(acc, cur, wr, wc, fr, fq); }
            const char* a1 = (t + 1 < nth) ? cA + (size_t)(t + 1) * kstep : cA2 + (size_t)(t + 1 - nth) * kstep;
            const char* a2 = last ? nA : ((t + 2 < nth) ? cA + (size_t)(t + 2) * kstep : cA2 + (size_t)(t + 2 - nth) * kstep); const char* b2 = last ? nB : cB + (size_t)(t + 2) * kstep;
            const char* a3 = a2 + kstep; const char* b3 = b2 + kstep;
            if (last && has_next) S.a_ready(nxt);
            if constexpr (SP2) {
            PG8_LDB(B0, 0, 0); PG8_LDB(B1, 0, 1); PG8_SCHED; PG8_LDA(At, 0, 0); PG8_STAGE(PG8_SA(1, 1), a1 + hstepA, voffA);
            PG8_WAIT_V(8); PG8_WAIT_L(0); PG8_BAR; PG8_MMA(0, 0, At, B0); PG8_MMA(0, 1, At, B1); PG8_BAR; PG8_SCHED;
            PG8_LDA(At, 0, 1); PG8_STAGE(PG8_SB(0, 0), b2, voffB); PG8_STAGE(PG8_SB(0, 1), b2 + hstepB, voffB); PG8_STAGE(PG8_SA(0, 0), a2, voffA);
            PG8_WAIT_V(8); PG8_WAIT_L(0); PG8_BAR; PG8_MMA(1, 0, At, B0); PG8_MMA(1, 1, At, B1); PG8_BAR; PG8_SCHED;
            PG8_LDB(B0, 1, 0); PG8_LDB(B1, 1, 1); PG8_SCHED; PG8_LDA(At, 1, 0); PG8_STAGE(PG8_SA(0, 1), a2 + hstepA, voffA);
            PG8_WAIT_V(8); PG8_WAIT_L(0); PG8_BAR; PG8_MMA(0, 0, At, B0); PG8_MMA(0, 1, At, B1); PG8_BAR; PG8_SCHED;
            PG8_LDA(At, 1, 1); PG8_STAGE(PG8_SB(1, 0), b3, voffB); PG8_STAGE(PG8_SB(1, 1), b3 + hstepB, voffB); PG8_STAGE(PG8_SA(1, 0), a3, voffA);
            PG8_WAIT_V(8); PG8_WAIT_L(0); PG8_BAR; PG8_MMA(1, 0, At, B0); PG8_MMA(1, 1, At, B1); PG8_BAR; PG8_SCHED;
            } else {
            PG8_LDB(B0, 0, 0); PG8_SCHED; PG8_LDA(At, 0, 0); PG8_STAGE(PG8_SA(1, 1), a1 + hstepA, voffA);
            PG8_WAIT_L(8); PG8_BAR; PG8_WAIT_L(0); PG8_MMA(0, 0, At, B0); PG8_BAR; PG8_SCHED;
            PG8_LDB(B1, 0, 1); PG8_STAGE(PG8_SB(0, 0), b2, voffB);
            PG8_BAR; PG8_WAIT_L(0); PG8_MMA(0, 1, At, B1); PG8_BAR;
            PG8_LDA(At, 0, 1); PG8_STAGE(PG8_SA(0, 0), a2, voffA);
            PG8_BAR; PG8_WAIT_L(0); PG8_MMA(1, 0, At, B0); PG8_BAR; PG8_SCHED;
            PG8_STAGE(PG8_SB(0, 1), b2 + hstepB, voffB);
            PG8_WAIT_V(6); PG8_BAR; PG8_MMA(1, 1, At, B1); PG8_BAR;
            PG8_LDB(B0, 1, 0); PG8_SCHED; PG8_LDA(At, 1, 0); PG8_STAGE(PG8_SA(0, 1), a2 + hstepA, voffA);
            PG8_WAIT_L(8); PG8_BAR; PG8_WAIT_L(0); PG8_MMA(0, 0, At, B0); PG8_BAR; PG8_SCHED;
            PG8_LDB(B1, 1, 1); PG8_STAGE(PG8_SB(1, 0), b3, voffB);
            PG8_BAR; PG8_WAIT_L(0); PG8_MMA(0, 1, At, B1); PG8_BAR;
            PG8_LDA(At, 1, 1); PG8_STAGE(PG8_SA(1, 0), a3, voffA);
            PG8_BAR; PG8_WAIT_L(0); PG8_MMA(1, 0, At, B0); PG8_BAR; PG8_SCHED;
            PG8_STAGE(PG8_SB(1, 1), b3 + hstepB, voffB);
            PG8_WAIT_V(6); PG8_BAR; PG8_MMA(1, 1, At, B1); PG8_BAR;
            }
        }
        if constexpr (ALIGN_EPI) { if (wr == 0) PG8_BAR; }
        if constexpr (!Epi::AFTER_DRAIN) { E(acc, cur, wr, wc, fr, fq); S.done(cur); }
        if (!has_next) break;
#pragma unroll
        for (int a = 0; a < 2; ++a)
#pragma unroll
            for (int b = 0; b < 2; ++b)
#pragma unroll
                for (int m = 0; m < 4; ++m)
#pragma unroll
                    for (int n = 0; n < 2; ++n) acc[a][b][m][n] = (f32x4){0.f, 0.f, 0.f, 0.f};
        cur = nxt; cA = nA; cA2 = nA2; cB = nB; ++ui;
        if constexpr (ALIGN_EPI) { if (wr == 1) PG8_BAR; }
    }
    PG8_WAIT_V(0);
    if constexpr (!ALIGN_EPI) { if (wr == 0) PG8_BAR; }
    PG8_BAR;
    if constexpr (Epi::AFTER_DRAIN) { E.fused(acc, cur, wr, wc, fr, fq, lds, wid, lane); S.done(cur); }
#undef PG8_SA
#undef PG8_SB
#undef PG8_STAGE
#undef PG8_LDA
#undef PG8_LDB
#undef PG8_MMA
#undef PG8_WAIT_V
#undef PG8_WAIT_L
#undef PG8_BAR
#undef PG8_SCHED
}
}

namespace attn_body {
using bf16=__hip_bfloat16;
using bf16x8=__attribute__((ext_vector_type(8)))short;
using s16x4=__attribute__((ext_vector_type(4)))short;
using f32x16=__attribute__((ext_vector_type(16)))float;
using u32x4=__attribute__((ext_vector_type(4)))unsigned;
constexpr int D=64,QP=1024,KP=256;
constexpr int NW=8,QBLK=32,QB=QBLK*NW,KVBLK=64;

__device__ __forceinline__ int crow(int r,int hi){return (r&3)+8*(r>>2)+4*hi;}
#define SBAR() __builtin_amdgcn_sched_barrier(0)
__device__ __forceinline__ void cmask(f32x16&p0,f32x16&p1,int jb,int qrel,int hi){
  const float NEG=-INFINITY; int kb=64*jb+4*hi;
  #pragma unroll
  for(int r=0;r<16;++r){int kv=kb+(r&3)+8*(r>>2); if(kv>qrel)p0[r]=NEG; if(kv+32>qrel)p1[r]=NEG;}
}

constexpr int NSLOT=3, SLOTB=8192;
constexpr int LDS_K=0, LDS_V=NSLOT*SLOTB, LDS_WS=2*NSLOT*SLOTB, LDS_OST=LDS_WS+NW*64*4, LDS_BYTES=LDS_OST+NW*4096;
constexpr float C2=0.125f*1.4426950408889634f;
__device__ __forceinline__ void glds16(const void*gsrc,unsigned lds_dst){unsigned keep;
  asm volatile("s_mov_b32 %0, m0\n\ts_mov_b32 m0, %2\n\ts_nop 0\n\tglobal_load_lds_dwordx4 %1, off\n\ts_mov_b32 m0, %0":"=&s"(keep):"v"(gsrc),"s"(lds_dst):"memory");}
__device__ __forceinline__ float max3f(float a,float b,float c){float r;asm("v_max3_f32 %0, %1, %2, %3":"=v"(r):"v"(a),"v"(b),"v"(c));return r;}
__device__ __forceinline__ float max2f(float a,float b){float r;asm("v_max_f32_e32 %0, %1, %2":"=v"(r):"v"(a),"v"(b));return r;}
__device__ __forceinline__ float fadd_s(float a,float b){float r;asm("v_add_f32_e32 %0, %1, %2":"=v"(r):"v"(a),"v"(b));return r;}
__device__ __forceinline__ float fsub_s(float a,float b){float r;asm("v_sub_f32_e32 %0, %1, %2":"=v"(r):"v"(a),"v"(b));return r;}
typedef float f32x2_t __attribute__((ext_vector_type(2))); typedef __bf16 bf16x2_t __attribute__((ext_vector_type(2)));
__device__ __forceinline__ unsigned cvtpk_s(float lo,float hi){f32x2_t v={lo,hi};bf16x2_t b=__builtin_convertvector(v,bf16x2_t);return __builtin_bit_cast(unsigned,b);}
#define WAIT_BAR(N) asm volatile("s_waitcnt vmcnt(" #N ") lgkmcnt(0)\n\ts_barrier":::"memory")

__device__ __forceinline__ void qkt(f32x16&p0,f32x16&p1,const char*Kslot,const bf16x8*qr,const f32x16&negm,int r32,int hi){
  const char*kb=Kslot+hi*1024+r32*16;
  #pragma unroll
  for(int d0=0;d0<4;++d0){
    const bf16x8 b0=*reinterpret_cast<const bf16x8*>(kb+d0*2048);
    const bf16x8 b1=*reinterpret_cast<const bf16x8*>(kb+d0*2048+512);
    if(d0==0){p0=__builtin_amdgcn_mfma_f32_32x32x16_bf16(b0,qr[0],negm,0,0,0);p1=__builtin_amdgcn_mfma_f32_32x32x16_bf16(b1,qr[0],negm,0,0,0);}
    else{p0=__builtin_amdgcn_mfma_f32_32x32x16_bf16(b0,qr[d0],p0,0,0,0);p1=__builtin_amdgcn_mfma_f32_32x32x16_bf16(b1,qr[d0],p1,0,0,0);}}
}
typedef __attribute__((address_space(3))) const char* lds_cptr;
typedef short v4i16_t __attribute__((ext_vector_type(4)));
__device__ __forceinline__ void kload8(bf16x8*kf,lds_cptr kp){
  kf[0]=*(const __attribute__((address_space(3))) bf16x8*)(kp);      kf[1]=*(const __attribute__((address_space(3))) bf16x8*)(kp+512);
  kf[2]=*(const __attribute__((address_space(3))) bf16x8*)(kp+2048); kf[3]=*(const __attribute__((address_space(3))) bf16x8*)(kp+2560);
  kf[4]=*(const __attribute__((address_space(3))) bf16x8*)(kp+4096); kf[5]=*(const __attribute__((address_space(3))) bf16x8*)(kp+4608);
  kf[6]=*(const __attribute__((address_space(3))) bf16x8*)(kp+6144); kf[7]=*(const __attribute__((address_space(3))) bf16x8*)(kp+6656);
}
__device__ __forceinline__ void kload2(bf16x8*kf,lds_cptr kp,int j){ kf[2*j]=*(const __attribute__((address_space(3))) bf16x8*)(kp+j*2048); kf[2*j+1]=*(const __attribute__((address_space(3))) bf16x8*)(kp+j*2048+512); }
__device__ __forceinline__ s16x4 vtr(lds_cptr p){ return __builtin_bit_cast(s16x4,__builtin_amdgcn_ds_read_tr16_b64_v4i16((__attribute__((address_space(3))) v4i16_t*)p)); }
__device__ __forceinline__ float rowmax(const f32x16&p0,const f32x16&p1){
  float a=max3f(p0[0],p0[1],p1[0]),b=max3f(p0[2],p0[3],p1[1]);a=max3f(a,p1[2],p1[3]);
  #pragma unroll
  for(int r=4;r<16;r+=4){a=max3f(a,p0[r],p0[r+1]);b=max3f(b,p0[r+2],p0[r+3]);a=max3f(a,p1[r],p1[r+1]);b=max3f(b,p1[r+2],p1[r+3]);}
  const float m=max2f(a,b);
  auto rr=__builtin_amdgcn_permlane32_swap(__float_as_uint(m),__float_as_uint(m),false,false);
  return max2f(__uint_as_float(rr[0]),__uint_as_float(rr[1]));
}
__device__ __forceinline__ void pv(f32x16*o,int vb,bf16x8 pa0,bf16x8 pa1,bf16x8 pa2,bf16x8 pa3){
  #pragma unroll
  for(int d0=0;d0<2;++d0){s16x4 lo[4],hi[4];
    #pragma unroll
    for(int ks=0;ks<4;++ks){
      asm volatile("ds_read_b64_tr_b16 %0,%1 offset:%c2":"=&v"(lo[ks]):"v"(vb),"i"(d0*4096+ks*1024):"memory");
      asm volatile("ds_read_b64_tr_b16 %0,%1 offset:%c2":"=&v"(hi[ks]):"v"(vb),"i"(d0*4096+ks*1024+512):"memory");}
    asm volatile("s_waitcnt lgkmcnt(0)":::"memory");SBAR();
    #define PK(k) (bf16x8){lo[k][0],lo[k][1],lo[k][2],lo[k][3],hi[k][0],hi[k][1],hi[k][2],hi[k][3]}
    o[d0]=__builtin_amdgcn_mfma_f32_32x32x16_bf16(pa0,PK(0),o[d0],0,0,0);
    o[d0]=__builtin_amdgcn_mfma_f32_32x32x16_bf16(pa1,PK(1),o[d0],0,0,0);
    o[d0]=__builtin_amdgcn_mfma_f32_32x32x16_bf16(pa2,PK(2),o[d0],0,0,0);
    o[d0]=__builtin_amdgcn_mfma_f32_32x32x16_bf16(pa3,PK(3),o[d0],0,0,0);
    #undef PK
  }
}
#define ATTN_STORE16(p,v) (*(u32x4*)(p)=(v))
__device__ __forceinline__ float abf_lo(unsigned w){return __uint_as_float(w<<16);}
__device__ __forceinline__ float abf_hi(unsigned w){return __uint_as_float(w&0xffff0000u);}
__device__ __forceinline__ u32x4 mulgate(const u32x4&v,const u32x4&g){u32x4 r;
  r.x=cvtpk_s(abf_lo(v.x)*abf_lo(g.x),abf_hi(v.x)*abf_hi(g.x)); r.y=cvtpk_s(abf_lo(v.y)*abf_lo(g.y),abf_hi(v.y)*abf_hi(g.y));
  r.z=cvtpk_s(abf_lo(v.z)*abf_lo(g.z),abf_hi(v.z)*abf_hi(g.z)); r.w=cvtpk_s(abf_lo(v.w)*abf_lo(g.w),abf_hi(v.w)*abf_hi(g.w)); return r;}
__device__ __forceinline__ void qnormrope(bf16x8*qr,const float*__restrict__ qn,int t,int hi){
  typedef float f4_t __attribute__((ext_vector_type(4)));
  float y[4][8]; float ss=0.f;
  #pragma unroll
  for(int d0=0;d0<4;++d0){ const u32x4 w=__builtin_bit_cast(u32x4,qr[d0]);
    #pragma unroll
    for(int i=0;i<4;++i){ y[d0][2*i]=__uint_as_float(w[i]<<16); y[d0][2*i+1]=__uint_as_float(w[i]&0xffff0000u); ss+=y[d0][2*i]*y[d0][2*i]+y[d0][2*i+1]*y[d0][2*i+1]; } }
  ss+=__shfl_xor(ss,32);
  const float rstd=1.0f/sqrtf(ss*(1.0f/64.0f)+1e-6f);
  #pragma unroll
  for(int d0=0;d0<4;++d0){ const f4_t g0=*(const f4_t*)(qn+16*d0+8*hi), g1=*(const f4_t*)(qn+16*d0+8*hi+4);
    #pragma unroll
    for(int i=0;i<4;++i){ y[d0][i]*=rstd*g0[i]; y[d0][4+i]*=rstd*g1[i]; } }
  const float prow=(float)(t>>6), pcol=(float)(t&63);
  #pragma unroll
  for(int j=0;j<8;++j){
    const float freq=__builtin_amdgcn_exp2f(-(float)(8*hi+j)*0.83048202372184058696f)*0.15915494309189533577f;
    const float rr=__builtin_amdgcn_fractf(prow*freq), rc=__builtin_amdgcn_fractf(pcol*freq);
    const float sr=__builtin_amdgcn_sinf(rr), cr=__builtin_amdgcn_cosf(rr), sc=__builtin_amdgcn_sinf(rc), cc=__builtin_amdgcn_cosf(rc);
    const float a0=y[0][j], b0=y[1][j], a1=y[2][j], b1=y[3][j];
    y[0][j]=(a0*cr-b0*sr)*C2; y[1][j]=(b0*cr+a0*sr)*C2; y[2][j]=(a1*cc-b1*sc)*C2; y[3][j]=(b1*cc+a1*sc)*C2; }
  #pragma unroll
  for(int d0=0;d0<4;++d0){ u32x4 w; w.x=cvtpk_s(y[d0][0],y[d0][1]); w.y=cvtpk_s(y[d0][2],y[d0][3]); w.z=cvtpk_s(y[d0][4],y[d0][5]); w.w=cvtpk_s(y[d0][6],y[d0][7]); qr[d0]=__builtin_bit_cast(bf16x8,w); }
}
template<int THRL> __device__ __forceinline__ void attn_unit(long qrow0,long kvrow0,int NT,int h,const bf16*Q,const bf16*__restrict__ K,const bf16*__restrict__ V,bf16*O,const bf16*__restrict__ Gt,const float*__restrict__ qn,bool track,char*shm){
  const int tid=threadIdx.x,lane=tid&63,r32=lane&31,hi=lane>>5; const int wid=__builtin_amdgcn_readfirstlane(tid>>6);
  const bf16*Qw=Q+(qrow0+wid*QBLK)*QP+h*D;
  const bf16*Kh=K+kvrow0*KP+(h>>2)*D,*Vh=V+kvrow0*KP+(h>>2)*D;
  const unsigned lds0=(unsigned)(uintptr_t)shm;
  float*wsf=(float*)(shm+LDS_WS)+wid*64;
  const bf16*ksrc=Kh+(long)lane*KP+wid*8;
  const bf16*vsrc=Vh+(long)(16*(wid&3)+(lane>>2))*KP+(wid>>2)*32+(lane&3)*8;
  const unsigned kdst=lds0+LDS_K+wid*1024, vdst=lds0+LDS_V+wid*1024;
  #define DMA_K(t,slot) glds16(ksrc+(long)(t)*KVBLK*KP,(unsigned)__builtin_amdgcn_readfirstlane(kdst+(slot)))
  #define DMA_V(t,slot) glds16(vsrc+(long)(t)*KVBLK*KP,(unsigned)__builtin_amdgcn_readfirstlane(vdst+(slot)))
  const int vb0=(int)(lds0+LDS_V)+((lane>>4)&1)*32+(lane&3)*8+(4*hi+((lane&15)>>2))*64;
  const char*Kbase=shm+LDS_K; bf16x8 kf[8];
  const lds_cptr shm3=(lds_cptr)shm; const lds_cptr kp0=shm3+LDS_K+hi*1024+r32*16; const lds_cptr vp0=shm3+LDS_V+((lane>>4)&1)*32+(lane&3)*8+(4*hi+((lane&15)>>2))*64;
  DMA_K(0,0);DMA_V(0,0);DMA_K(1,SLOTB);
  bf16x8 qr[4];
  #pragma unroll
  for(int d0=0;d0<4;++d0)qr[d0]=*reinterpret_cast<const bf16x8*>(&Qw[(long)r32*QP+d0*16+hi*8]);
  qnormrope(qr,qn,(int)(qrow0-kvrow0)+wid*QBLK+r32,hi);
  float mhat=0.f,l_reg=0.f;f32x16 o[2];o[0]=f32x16{};o[1]=f32x16{};f32x16 negm=f32x16{};asm volatile("":"+v"(negm));
  #define CMASK(P0,P1,t) do{}while(0)
  bool resc=false;
  #define START(P0,P1) do{ const float rm=rowmax(P0,P1); resc=false; \
    { const float dl=rm; mhat=fadd_s(mhat,dl); \
      _Pragma("unroll") for(int r=0;r<16;++r){P0[r]=fsub_s(P0[r],dl);P1[r]=fsub_s(P1[r],dl);} \
      _Pragma("unroll") for(int r=0;r<16;++r)negm[r]=-mhat; asm volatile("":"+v"(negm)); } \
    _Pragma("unroll") for(int r=0;r<16;++r)P0[r]=__builtin_amdgcn_exp2f(P0[r]); }while(0)
  #define RESC() do{ if(resc){ asm volatile("s_waitcnt lgkmcnt(0)":::"memory"); \
      _Pragma("unroll") for(int d_=0;d_<2;++d_) _Pragma("unroll") for(int r=0;r<16;++r)o[d_][r]*=wsf[crow(r,hi)]; } }while(0)
  f32x16 pA0,pA1,pB0,pB1;
  int sl_prev=0,sl_cur=0,sl_next=SLOTB;
  #define ROT() do{sl_prev=sl_cur;sl_cur=sl_next;sl_next=(sl_next==(NSLOT-1)*SLOTB)?0:sl_next+SLOTB;}while(0)
  DMA_K(2,2*SLOTB);
  WAIT_BAR(3);
  qkt(pA0,pA1,Kbase,qr,negm,r32,hi);asm volatile("s_nop 15\n\ts_nop 7":"+v"(pA0),"+v"(pA1));CMASK(pA0,pA1,0);
  START(pA0,pA1);
  _Pragma("unroll") for(int r=0;r<16;++r)pA1[r]=__builtin_amdgcn_exp2f(pA1[r]);
  WAIT_BAR(0);
  DMA_K(3,0);DMA_V(1,SLOTB);
  ROT();
  kload8(kf,kp0+sl_cur);
  WAIT_BAR(2);
  s16x4 vlo[8],vhi[8]; u32x4 pw0,pw1,pw2,pw3;
  #define PKW(P,B) cvtpk_s(P[B],P[B+1])
  #define PAF(k) __builtin_bit_cast(bf16x8,pw##k)
  #define VFR(i) (bf16x8){vlo[i][0],vlo[i][1],vlo[i][2],vlo[i][3],vhi[i][0],vhi[i][1],vhi[i][2],vhi[i][3]}
  #define PIN(x) asm volatile("":"+v"(x))
  #define MX3(a,b,c) __builtin_fmaxf(__builtin_fmaxf((a),(b)),(c))
  #define GAPA(MF,A0,A1,A2,A3,W0,W1,PW) do{ MF; sacc+=A0; sacc+=A1; sacc+=A2; sacc+=A3; PIN(sacc); W0; W1; PIN(PW); SBAR(); }while(0)
  #define EX(v) __builtin_amdgcn_exp2f(v)
  #define GAPB(MF,X,B) do{ MF; X[B]=EX(X[B]); X[B+1]=EX(X[B+1]); X[B+2]=EX(X[B+2]); X[B+3]=EX(X[B+3]); PIN(X); SBAR(); }while(0)
  #define VRD(i) do{ vlo[i]=vtr(vp_+(((i)>>2)*4096+((i)&3)*1024)); vhi[i]=vtr(vp_+(((i)>>2)*4096+((i)&3)*1024+512)); }while(0)
  #define KRD(G,j) do{ if(G){ kload2(kf,kp0+sl_next,j); SBAR(); } }while(0)
  #define STEP(C0,C1,P0,P1,t,GK,GV,GL) do{ SBAR(); \
    const lds_cptr vp_=vp0+sl_prev; \
    VRD(0); SBAR(); float sacc=(P0[0]+P0[1]); \
    GAPA(C0=__builtin_amdgcn_mfma_f32_32x32x16_bf16(kf[0],qr[0],negm,0,0,0), P0[2],P0[3],P0[4],P0[5],     pw0[0]=PKW(P0,0), pw0[1]=PKW(P0,2), pw0); \
    VRD(4); SBAR(); GAPA(C1=__builtin_amdgcn_mfma_f32_32x32x16_bf16(kf[1],qr[0],negm,0,0,0), P0[6],P0[7],P0[8],P0[9],     pw0[2]=PKW(P0,4), pw0[3]=PKW(P0,6), pw0); \
    VRD(1); SBAR(); GAPA(C0=__builtin_amdgcn_mfma_f32_32x32x16_bf16(kf[2],qr[1],C0,0,0,0),   P0[10],P0[11],P0[12],P0[13], pw1[0]=PKW(P0,8), pw1[1]=PKW(P0,10), pw1); \
    VRD(5); SBAR(); GAPA(C1=__builtin_amdgcn_mfma_f32_32x32x16_bf16(kf[3],qr[1],C1,0,0,0),   P0[14],P0[15],P1[0],P1[1],   pw1[2]=PKW(P0,12),pw1[3]=PKW(P0,14), pw1); \
    VRD(2); SBAR(); GAPA(C0=__builtin_amdgcn_mfma_f32_32x32x16_bf16(kf[4],qr[2],C0,0,0,0),   P1[2],P1[3],P1[4],P1[5],     pw2[0]=PKW(P1,0), pw2[1]=PKW(P1,2), pw2); \
    VRD(6); SBAR(); GAPA(C1=__builtin_amdgcn_mfma_f32_32x32x16_bf16(kf[5],qr[2],C1,0,0,0),   P1[6],P1[7],P1[8],P1[9],     pw2[2]=PKW(P1,4), pw2[3]=PKW(P1,6), pw2); \
    VRD(3); SBAR(); GAPA(C0=__builtin_amdgcn_mfma_f32_32x32x16_bf16(kf[6],qr[3],C0,0,0,0),   P1[10],P1[11],P1[12],P1[13], pw3[0]=PKW(P1,8), pw3[1]=PKW(P1,10), pw3); \
    VRD(7); SBAR(); GAPA(C1=__builtin_amdgcn_mfma_f32_32x32x16_bf16(kf[7],qr[3],C1,0,0,0),   P1[14],P1[15],0.f,0.f,       pw3[2]=PKW(P1,12),pw3[3]=PKW(P1,14), pw3); \
    l_reg+=sacc; \
    if(GK){DMA_K((t)+3,sl_cur);} if(GV){DMA_V((t)+1,sl_next);} \
    CMASK(C0,C1,t); \
    if(track){ float a=MX3(C0[0],C0[1],C1[0]),b=MX3(C0[2],C0[3],C1[1]); a=MX3(a,C1[2],C1[3]); \
      _Pragma("unroll") for(int r=4;r<16;r+=4){a=MX3(a,C0[r],C0[r+1]);b=MX3(b,C0[r+2],C0[r+3]);a=MX3(a,C1[r],C1[r+1]);b=MX3(b,C1[r+2],C1[r+3]);} \
      float rm=__builtin_fmaxf(a,b); { auto rr=__builtin_amdgcn_permlane32_swap(__float_as_uint(rm),__float_as_uint(rm),false,false); rm=__builtin_fmaxf(__uint_as_float(rr[0]),__uint_as_float(rr[1])); } \
      resc=false; \
      if(__builtin_expect(__any(rm>(float)THRL),0)){ const float dl=__builtin_fmaxf(rm,0.f); mhat+=dl; \
        _Pragma("unroll") for(int r=0;r<16;++r){C0[r]-=dl;C1[r]-=dl;} \
        _Pragma("unroll") for(int r=0;r<16;++r)negm[r]=-mhat; asm volatile("":"+v"(negm)); \
        const float f=__builtin_amdgcn_exp2f(-dl); l_reg*=f; if(hi==0)wsf[r32]=f; resc=true; } } \
    SBAR(); \
    GAPB(o[0]=__builtin_amdgcn_mfma_f32_32x32x16_bf16(PAF(0),VFR(0),o[0],0,0,0), C0,0); \
    GAPB(o[1]=__builtin_amdgcn_mfma_f32_32x32x16_bf16(PAF(0),VFR(4),o[1],0,0,0), C0,4); \
    KRD(GL,0); GAPB(o[0]=__builtin_amdgcn_mfma_f32_32x32x16_bf16(PAF(1),VFR(1),o[0],0,0,0), C0,8); \
    KRD(GL,1); GAPB(o[1]=__builtin_amdgcn_mfma_f32_32x32x16_bf16(PAF(1),VFR(5),o[1],0,0,0), C0,12); \
    KRD(GL,2); GAPB(o[0]=__builtin_amdgcn_mfma_f32_32x32x16_bf16(PAF(2),VFR(2),o[0],0,0,0), C1,0); \
    KRD(GL,3); GAPB(o[1]=__builtin_amdgcn_mfma_f32_32x32x16_bf16(PAF(2),VFR(6),o[1],0,0,0), C1,4); \
    GAPB(o[0]=__builtin_amdgcn_mfma_f32_32x32x16_bf16(PAF(3),VFR(3),o[0],0,0,0), C1,8); \
    GAPB(o[1]=__builtin_amdgcn_mfma_f32_32x32x16_bf16(PAF(3),VFR(7),o[1],0,0,0), C1,12); \
    }while(0)
  int t=1;
  #undef CMASK
  #define CMASK(P0,P1,t) do{}while(0)
  for(;t+5<NT;t+=2){
    STEP(pB0,pB1,pA0,pA1,t,true,true,true);     WAIT_BAR(2); RESC(); ROT();
    STEP(pA0,pA1,pB0,pB1,t+1,true,true,true);   WAIT_BAR(2); RESC(); ROT();
  }
  #undef CMASK
  #define CMASK(P0,P1,t) do{}while(0)
  #define ENDW(tt) do{ if((tt)+3<NT){WAIT_BAR(2);} else if((tt)+2<NT){WAIT_BAR(1);} else {WAIT_BAR(0);} }while(0)
  for(;t+1<NT;t+=2){
    STEP(pB0,pB1,pA0,pA1,t,(t+3<NT),(t+1<NT),(t+1<NT));       ENDW(t);   RESC(); ROT();
    STEP(pA0,pA1,pB0,pB1,t+1,(t+4<NT),(t+2<NT),(t+2<NT));     ENDW(t+1); RESC(); ROT();
  }
  STEP(pB0,pB1,pA0,pA1,NT-1,false,false,false); RESC();
  const bf16*Gw=Gt+(qrow0+wid*QBLK)*QP+h*D; u32x4 gvv[4];
  _Pragma("unroll") for(int i=0;i<4;++i) gvv[i]=*(const u32x4*)(Gw+(long)(i*8+(lane>>3))*QP+(lane&7)*8);
  { float sacc=pB0[0]+pB0[1]; _Pragma("unroll") for(int r=2;r<16;++r)sacc+=pB0[r]; _Pragma("unroll") for(int r=0;r<16;++r)sacc+=pB1[r]; l_reg+=sacc;
    pw0=(u32x4){PKW(pB0,0),PKW(pB0,2),PKW(pB0,4),PKW(pB0,6)};pw1=(u32x4){PKW(pB0,8),PKW(pB0,10),PKW(pB0,12),PKW(pB0,14)};pw2=(u32x4){PKW(pB1,0),PKW(pB1,2),PKW(pB1,4),PKW(pB1,6)};pw3=(u32x4){PKW(pB1,8),PKW(pB1,10),PKW(pB1,12),PKW(pB1,14)};
    SBAR(); pv(o,vb0+sl_cur,PAF(0),PAF(1),PAF(2),PAF(3)); }
  #undef PKW
  #undef PAF
  #undef VFR
  #undef PIN
  #undef MX3
  #undef GAPA
  #undef GAPB
  #undef EX
  #undef VRD
  #undef KRD
  #undef STEP
  #undef ENDW
  {auto rr=__builtin_amdgcn_permlane32_swap(__float_as_uint(l_reg),__float_as_uint(l_reg),false,false);l_reg=__uint_as_float(rr[0])+__uint_as_float(rr[1]);}
  if(hi==0)wsf[32+r32]=l_reg;asm volatile("s_waitcnt lgkmcnt(0)":::"memory");
  float rli[16];
  #pragma unroll
  for(int r=0;r<16;++r)rli[r]=__builtin_amdgcn_rcpf(wsf[32+crow(r,hi)]);
  bf16*Ow=O+(qrow0+wid*QBLK)*QP+h*D;
  { bf16*stg=(bf16*)(shm+LDS_OST)+wid*2048;
    #pragma unroll
    for(int r=0;r<16;++r){const int orow=crow(r,hi);
      #pragma unroll
      for(int d0=0;d0<2;++d0)stg[orow*64+d0*32+r32]=__float2bfloat16(o[d0][r]*rli[r]);}
    asm volatile("s_waitcnt lgkmcnt(0)":::"memory");
    #pragma unroll
    for(int i=0;i<4;++i){const int row=i*8+(lane>>3),ch=lane&7; const u32x4 v=*(const u32x4*)(stg+row*64+ch*8); ATTN_STORE16(Ow+(long)row*QP+ch*8,mulgate(v,gvv[i]));} }
  asm volatile("s_waitcnt lgkmcnt(0)\n\ts_barrier":::"memory");
  #undef DMA_K
  #undef DMA_V
  #undef CMASK
  #undef START
  #undef RESC
  #undef ROT
}
constexpr int ATTN_LDS_BYTES=LDS_BYTES;
#undef SBAR
#undef WAIT_BAR
}

constexpr int NWAVES = 8;
constexpr int D = 1024, TP = 8192, TS = 2048, NB = 8;
constexpr int MP = NB * TP, MS = NB * TS, M = MP + MS;
constexpr int INW = 6656, PLE = 256;
constexpr float EPS = 1e-6f;
#ifndef MK_N_LAUNCHES
#define MK_N_LAUNCHES 1
#endif
constexpr int N_LAUNCHES = MK_N_LAUNCHES;
constexpr int N_PHASES = 8;

constexpr size_t MiB = 1u << 20;
constexpr size_t WS_CTL = 0, CTL_ZERO_BYTES = 64 * 1024;
constexpr size_t WS_R2 = 1 * MiB;
constexpr size_t WS_WIN = 2 * MiB;
constexpr size_t WS_WAB = 16 * MiB;
constexpr size_t WS_WO = 20 * MiB;
constexpr size_t WS_WG = 22 * MiB;
constexpr size_t WS_WPLE = 24 * MiB;
constexpr size_t WS_PBF = 26 * MiB;
constexpr size_t WS_RA = 80 * MiB;
constexpr size_t WS_RB = 240 * MiB;
constexpr size_t WS_RC = 400 * MiB;
constexpr size_t WS_RD = 560 * MiB;
constexpr size_t WS_RE = 720 * MiB;
constexpr size_t WS_RK = 880 * MiB;
constexpr size_t WS_RV = 920 * MiB;
constexpr size_t WS_END = 960 * MiB;

constexpr int RING_BYTES = 131072;
constexpr int LDS_BYTES = 147456;
constexpr int MISC_OFF = LDS_BYTES - 256;

#define GAS __attribute__((address_space(1)))
#define LAS __attribute__((address_space(3)))
typedef unsigned short bf16;
typedef unsigned v4u __attribute__((ext_vector_type(4)));
typedef unsigned v2u __attribute__((ext_vector_type(2)));
typedef float f32x4 __attribute__((ext_vector_type(4)));
#define LDS_WAIT() asm volatile("s_waitcnt lgkmcnt(0)" ::: "memory")
#define VM_WAIT() asm volatile("s_waitcnt vmcnt(0)" ::: "memory")
__device__ __forceinline__ unsigned pk2(float lo, float hi) { return pg8::cvt_pk_bf16(lo, hi); }
__device__ __forceinline__ float blo(unsigned w) { return __uint_as_float(w << 16); }
__device__ __forceinline__ float bhi(unsigned w) { return __uint_as_float(w & 0xffff0000u); }

#define XB_TMO      128
#define XB_XCNT(j)  (256  + 64 * (j))
#define XB_XSUB(j)  (1280 + 64 * (j))
#define XB_XGEN(j)  (2304 + 64 * (j))
#define XB_TOP      3328
#define XB_TOPGEN   3392
#define XCD_BAR_WORDS 3456
#define XB_SPIN_CAP (1u << 18)

__device__ __forceinline__ unsigned xb_ld(unsigned* p)              { return __hip_atomic_load(p, __ATOMIC_RELAXED, __HIP_MEMORY_SCOPE_AGENT); }
__device__ __forceinline__ unsigned xb_add(unsigned* p, unsigned v) { return __hip_atomic_fetch_add(p, v, __ATOMIC_RELAXED, __HIP_MEMORY_SCOPE_AGENT); }
__device__ __forceinline__ unsigned xb_xcc_id() { return (unsigned)__builtin_amdgcn_s_getreg((3 << 11) | 20) & 0xFu; }
#define XB_SPIN(cond, bar) do { unsigned _sp = 0; while (cond) { __builtin_amdgcn_s_sleep(1); \
    if ((++_sp & 255u) == 0u) { if (xb_ld(&(bar)[XB_TMO])) break; if (_sp > XB_SPIN_CAP) { atomicAdd(&(bar)[XB_TMO], 1u); break; } } } } while (0)

struct XcdBarrier {
    unsigned* bar; unsigned x;
    volatile LAS unsigned* st;
};

__device__ __forceinline__ XcdBarrier xcd_barrier_post(unsigned* bar, volatile LAS unsigned* st) {
    XcdBarrier b; b.bar = bar; b.x = xb_xcc_id(); b.st = st;
    if (threadIdx.x == 0) (void)xb_add(&bar[XB_XCNT(b.x)], 1u);
    return b;
}
__device__ __forceinline__ void xcd_barrier_complete(unsigned* bar, unsigned x, unsigned& nloc, unsigned& nx) {
    const unsigned G = gridDim.x * gridDim.y * gridDim.z;
    unsigned sum, cnt, mine, sp = 0u;
    for (;;) {
        sum = 0u; cnt = 0u; mine = 0u;
#pragma unroll
        for (unsigned j = 0; j < 16; ++j) { const unsigned c = xb_ld(&bar[XB_XCNT(j)]); sum += c; cnt += (c > 0u) ? 1u : 0u; mine = (j == x) ? c : mine; }
        if (sum == G) break;
        __builtin_amdgcn_s_sleep(1);
        if ((++sp & 255u) == 0u) { if (xb_ld(&bar[XB_TMO])) break; if (sp > XB_SPIN_CAP) { atomicAdd(&bar[XB_TMO], 1u); break; } }
    }
    nloc = mine > 0u ? mine : 1u; nx = cnt > 0u ? cnt : 1u;
}

__device__ __forceinline__ void xcd_barrier(const XcdBarrier& b) {
    asm volatile("s_waitcnt vmcnt(0)" ::: "memory");
    __syncthreads();
    if (threadIdx.x == 0) {
        unsigned* bar = b.bar;
        __builtin_amdgcn_s_waitcnt(0);
        unsigned nloc = b.st[0], nx = b.st[1];
        if (nloc == 0u) { xcd_barrier_complete(bar, b.x, nloc, nx); b.st[0] = nloc; b.st[1] = nx; }
        const unsigned old = xb_add(&bar[XB_XSUB(b.x)], 1u);
        const unsigned gen = old / nloc;
        if (old + 1u == (gen + 1u) * nloc) {
            __builtin_amdgcn_fence(__ATOMIC_RELEASE, "agent");
            asm volatile("s_waitcnt vmcnt(0)" ::: "memory");
            const unsigned og = xb_add(&bar[XB_TOP], 1u);
            const unsigned tg = og / nx;
            if (og + 1u == (tg + 1u) * nx) xb_add(&bar[XB_TOPGEN], 1u);
            else XB_SPIN(xb_ld(&bar[XB_TOPGEN]) == tg, bar);
            __builtin_amdgcn_fence(__ATOMIC_ACQUIRE, "agent");
            xb_add(&bar[XB_XGEN(b.x)], 1u);
            asm volatile("s_waitcnt vmcnt(0)" ::: "memory");
        } else {
            XB_SPIN(xb_ld(&bar[XB_XGEN(b.x)]) == gen, bar);
            __builtin_amdgcn_fence(__ATOMIC_ACQUIRE, "agent");
            asm volatile("s_waitcnt vmcnt(0)" ::: "memory");
        }
    }
    __syncthreads();
}

struct Args {
    const float *x_p, *x_s, *p_p, *p_s, *norm_pre, *w_in, *pool_w, *pool_scale, *w_a, *q_norm, *k_norm, *w_b, *w_out, *norm_post, *ple_norm, *w_gate, *w_ple;
    float* out; unsigned char* ws; int ph_lo, ph_hi;
};

__device__ __forceinline__ float wave_sum(float v) {
#pragma unroll
    for (int o = 1; o < 64; o <<= 1) v += __shfl_xor(v, o);
    return v;
}
__device__ __forceinline__ void p0_transpose_item(const float* W, int K, int N, bf16* WT, int row_off, int ldt, int koff, LAS float* scr, int item, int lane, const float* kscale = nullptr) {
    const int nblk = N / 32, kb = item / nblk, nb = item % nblk, k0 = 64 * kb, n0 = 32 * nb;
#pragma unroll 8
    for (int i = 0; i < 32; ++i) { const int kk = 2 * i + (lane >> 5); float wv = W[(size_t)(k0 + kk) * N + n0 + (lane & 31)]; if (kscale) wv *= kscale[k0 + kk]; scr[kk * 33 + (lane & 31)] = wv; }
    LDS_WAIT(); asm volatile("" ::: "memory");
    const int c = lane & 7;
#pragma unroll
    for (int j = 0; j < 4; ++j) { const int n = (lane >> 3) + 8 * j; const LAS float* s = scr + (8 * c) * 33 + n;
        v4u o; o.x = pk2(s[0 * 33], s[1 * 33]); o.y = pk2(s[2 * 33], s[3 * 33]); o.z = pk2(s[4 * 33], s[5 * 33]); o.w = pk2(s[6 * 33], s[7 * 33]);
        *(GAS v4u*)(WT + (size_t)(row_off + n0 + n) * ldt + koff + k0 + 8 * c) = o; }
    LDS_WAIT(); asm volatile("" ::: "memory");
}
__device__ __forceinline__ const float* xrow_ptr(const Args& a, int m) { return m < MP ? a.x_p + (size_t)m * D : a.x_s + (size_t)(m - MP) * D; }

__device__ __forceinline__ void phase0(const Args& a, LAS unsigned char* lds, int vcu, int G) {
    int tid = threadIdx.x; asm volatile("" : "+v"(tid));
    const int lane = tid & 63, wave = __builtin_amdgcn_readfirstlane(tid >> 6);
    LAS float* scr = (LAS float*)(lds + wave * 16384);
    const int gw = vcu * NWAVES + wave, NGW = G * NWAVES;
    unsigned char* ws = a.ws;
    {
        LAS float* At = (LAS float*)lds; LAS float* Bt = (LAS float*)(lds + 64 * 257 * 4 + 64);
        bf16* WT = (bf16*)(ws + WS_WIN);
        for (int tile = vcu; tile < 256; tile += G) {
            const int kb = tile >> 4, g = (tile >> 2) & 3, db = tile & 3, k0 = 64 * kb, d0 = 64 * db;
#pragma unroll
            for (int i = 0; i < 8; ++i) { const int row = (tid >> 6) + 8 * i, c4 = tid & 63;
                const f32x4 v = *(const GAS f32x4*)(a.w_in + (size_t)(k0 + row) * INW + g * 256 + 4 * c4);
                LAS float* d = At + row * 257 + 4 * c4; d[0] = v.x; d[1] = v.y; d[2] = v.z; d[3] = v.w; }
#pragma unroll
            for (int i = 0; i < 8; ++i) { const int c = (tid >> 4) + 32 * i, c4 = tid & 15;
                *(LAS f32x4*)(Bt + c * 64 + 4 * c4) = *(const GAS f32x4*)(a.pool_w + (size_t)g * 65536 + (size_t)c * 256 + d0 + 4 * c4); }
            __syncthreads();
            float acc[8];
#pragma unroll
            for (int j = 0; j < 8; ++j) acc[j] = 0.f;
#pragma unroll 4
            for (int c = 0; c < 256; ++c) { const float av = At[lane * 257 + c]; const f32x4 b0 = *(const LAS f32x4*)(Bt + c * 64 + wave * 8), b1 = *(const LAS f32x4*)(Bt + c * 64 + wave * 8 + 4);
                acc[0] += av * b0.x; acc[1] += av * b0.y; acc[2] += av * b0.z; acc[3] += av * b0.w; acc[4] += av * b1.x; acc[5] += av * b1.y; acc[6] += av * b1.z; acc[7] += av * b1.w; }
#pragma unroll
            for (int j = 0; j < 8; ++j) WT[(size_t)(g * 256 + d0 + wave * 8 + j) * D + k0 + lane] = (bf16)(pk2(acc[j], 0.f) & 0xffffu);
            __syncthreads();
        }
    }
    constexpr int I_IN = (D / 64) * ((INW - 1024) / 32), I_SQ = (D / 64) * (D / 32), I_PLE = (PLE / 64) * (D / 32);
    constexpr int NITEMS = I_IN + 4 * I_SQ + I_PLE;
    for (int it = gw; it < NITEMS; it += NGW) {
        int r = it;
        if (r < I_IN) { const int kb = r / 176, nb = 32 + r % 176; const int n0 = 32 * nb; int roff = 0;
            if (n0 >= 4608) { const int c = (n0 - 4608) & 1023, isb = (n0 - 4608) >> 10; roff = 4608 + 256 * (c >> 7) + 128 * isb + (c & 127) - n0; }
            p0_transpose_item(a.w_in, D, INW, (bf16*)(ws + WS_WIN), roff, D, 0, scr, kb * (INW / 32) + nb, lane); continue; } r -= I_IN;
        if (r < I_SQ) { p0_transpose_item(a.w_a, D, D, (bf16*)(ws + WS_WAB), 0, 2048, 0, scr, r, lane); continue; } r -= I_SQ;
        if (r < I_SQ) { p0_transpose_item(a.w_b, D, D, (bf16*)(ws + WS_WAB), 0, 2048, 1024, scr, r, lane); continue; } r -= I_SQ;
        if (r < I_SQ) { p0_transpose_item(a.w_out, D, D, (bf16*)(ws + WS_WO), 0, D, 0, scr, r, lane); continue; } r -= I_SQ;
        if (r < I_SQ) { p0_transpose_item(a.w_gate, D, D, (bf16*)(ws + WS_WG), 0, D, 0, scr, r, lane, a.ple_norm); continue; } r -= I_SQ;
        p0_transpose_item(a.w_ple, PLE, D, (bf16*)(ws + WS_WPLE), 0, PLE, 0, scr, r, lane);
    }
    f32x4 gpre[4];
#pragma unroll
    for (int j = 0; j < 4; ++j) gpre[j] = ((const GAS f32x4*)a.norm_pre)[lane + 64 * j];
    bf16* H = (bf16*)(ws + WS_RA); bf16* PB = (bf16*)(ws + WS_PBF);
    for (int m = gw; m < M; m += NGW) {
        const GAS f32x4* xr = (const GAS f32x4*)xrow_ptr(a, m) + lane;
        f32x4 v[4]; float s = 0.f;
#pragma unroll
        for (int j = 0; j < 4; ++j) { v[j] = xr[64 * j]; s += (v[j].x * v[j].x + v[j].y * v[j].y) + (v[j].z * v[j].z + v[j].w * v[j].w); }
        const float rstd = 1.0f / sqrtf(wave_sum(s) * (1.f / D) + EPS);
        GAS v2u* o8 = (GAS v2u*)(H + (size_t)m * D) + lane;
#pragma unroll
        for (int j = 0; j < 4; ++j) { const f32x4 y = v[j] * rstd * gpre[j]; o8[64 * j] = (v2u){pk2(y.x, y.y), pk2(y.z, y.w)}; }
        const float* prow = m < MP ? a.p_p + (size_t)m * PLE : a.p_s + (size_t)(m - MP) * PLE;
        const f32x4 pv = ((const GAS f32x4*)prow)[lane];
        ((GAS v2u*)(PB + (size_t)m * PLE))[lane] = (v2u){pk2(pv.x, pv.y), pk2(pv.z, pv.w)};
    }
}

__device__ __forceinline__ void normrope16(bf16* ptr, int t, int qd, const float* gain, float scale) {
    const v4u w0 = ((const GAS v4u*)ptr)[0], w1 = ((const GAS v4u*)ptr)[1];
    float av[16];
    av[0] = blo(w0.x); av[1] = bhi(w0.x); av[2] = blo(w0.y); av[3] = bhi(w0.y); av[4] = blo(w0.z); av[5] = bhi(w0.z); av[6] = blo(w0.w); av[7] = bhi(w0.w);
    av[8] = blo(w1.x); av[9] = bhi(w1.x); av[10] = blo(w1.y); av[11] = bhi(w1.y); av[12] = blo(w1.z); av[13] = bhi(w1.z); av[14] = blo(w1.w); av[15] = bhi(w1.w);
    float ss = 0.f;
#pragma unroll
    for (int i = 0; i < 16; ++i) ss += av[i] * av[i];
    ss += __shfl_xor(ss, 1); ss += __shfl_xor(ss, 2);
    const float rstd = 1.0f / sqrtf(ss * (1.f / 64.f) + EPS);
    const float pos = (qd < 2) ? (float)(t >> 6) : (float)(t & 63);
    const float sgn = (qd & 1) ? 1.f : -1.f;
    float o[16];
#pragma unroll
    for (int i4 = 0; i4 < 4; ++i4) { const f32x4 g = ((const GAS f32x4*)(gain + qd * 16))[i4];
        av[4 * i4 + 0] *= rstd * g.x; av[4 * i4 + 1] *= rstd * g.y; av[4 * i4 + 2] *= rstd * g.z; av[4 * i4 + 3] *= rstd * g.w; }
#pragma unroll
    for (int i = 0; i < 16; ++i) {
        const float pr = __shfl_xor(av[i], 1);
        const float freq = __builtin_amdgcn_exp2f(-(float)i * 0.83048202372184058696f);
        float rev = pos * freq * 0.15915494309189533577f; rev = __builtin_amdgcn_fractf(rev);
        const float sn = __builtin_amdgcn_sinf(rev), cs = __builtin_amdgcn_cosf(rev);
        o[i] = (av[i] * cs + sgn * pr * sn) * scale;
    }
    v4u r0, r1;
    r0.x = pk2(o[0], o[1]); r0.y = pk2(o[2], o[3]); r0.z = pk2(o[4], o[5]); r0.w = pk2(o[6], o[7]);
    r1.x = pk2(o[8], o[9]); r1.y = pk2(o[10], o[11]); r1.z = pk2(o[12], o[13]); r1.w = pk2(o[14], o[15]);
    ((GAS v4u*)ptr)[0] = r0; ((GAS v4u*)ptr)[1] = r1;
}
__device__ __forceinline__ int tok_of_row(int m) { return m < MP ? (m & (TP - 1)) : (m & (TS - 1)); }
__device__ __forceinline__ void phase2(const Args& a, int vcu, int G) {
    int tid = threadIdx.x; asm volatile("" : "+v"(tid));
    const int lane = tid & 63, wave = __builtin_amdgcn_readfirstlane(tid >> 6);
    bf16* K = (bf16*)(a.ws + WS_RK);
    const int gw = vcu * NWAVES + wave, NGW = G * NWAVES;
    for (int m4 = gw; m4 < M / 4; m4 += NGW) { const int m = m4 * 4 + (lane >> 4); normrope16(K + (size_t)m * 256 + (lane & 15) * 16, tok_of_row(m), lane & 3, a.k_norm, 1.0f); }
}
template <int W> __device__ __forceinline__ void pool_item(const bf16* Z, const bf16* SZA, bf16* AO, const float* pscale, int g, int rb, int cc, int rsub) {
    const f32x4 ps0 = *(const GAS f32x4*)(pscale + g * 256 + cc * 8), ps1 = *(const GAS f32x4*)(pscale + g * 256 + cc * 8 + 4);
    constexpr int half = W / 2;
#pragma unroll 1
    for (int rr = 0; rr < 4; ++rr) {
        const int m = rb * 64 + rr * 16 + rsub;
        const int T = m < MP ? TP : TS, s0 = m < MP ? (m & ~(TP - 1)) : (m & ~(TS - 1)), t = m - s0;
        const bf16* colp = Z + (size_t)s0 * D + g * 256 + cc * 8;
        v4u wv[W];
#pragma unroll
        for (int i = 0; i < W; ++i) { const int sidx = t - half + i; const int sc = min(max(sidx, 0), T - 1); wv[i] = *(const GAS v4u*)(colp + (size_t)sc * D); }
        const v4u gz = *(const GAS v4u*)(SZA + (size_t)m * D + g * 256 + cc * 8);
        float acc[8];
#pragma unroll
        for (int e = 0; e < 8; ++e) acc[e] = 0.f;
#pragma unroll
        for (int i = 0; i < W; ++i) { const int sidx = t - half + i; const float wgt = (sidx >= 0 && sidx < T) ? 1.f : 0.f; const v4u w = wv[i];
            acc[0] += wgt * blo(w.x); acc[1] += wgt * bhi(w.x); acc[2] += wgt * blo(w.y); acc[3] += wgt * bhi(w.y); acc[4] += wgt * blo(w.z); acc[5] += wgt * bhi(w.z); acc[6] += wgt * blo(w.w); acc[7] += wgt * bhi(w.w); }
        const v4u own = wv[half];
        const int lo = max(t - half, 0), hi = min(t + half, T);
        const float inv = 1.0f / (float)(hi - lo);
        v4u o; o.x = pk2((acc[0] * inv - blo(own.x)) * ps0.x * blo(gz.x), (acc[1] * inv - bhi(own.x)) * ps0.y * bhi(gz.x));
        o.y = pk2((acc[2] * inv - blo(own.y)) * ps0.z * blo(gz.y), (acc[3] * inv - bhi(own.y)) * ps0.w * bhi(gz.y));
        o.z = pk2((acc[4] * inv - blo(own.z)) * ps1.x * blo(gz.z), (acc[5] * inv - bhi(own.z)) * ps1.y * bhi(gz.z));
        o.w = pk2((acc[6] * inv - blo(own.w)) * ps1.z * blo(gz.w), (acc[7] * inv - bhi(own.w)) * ps1.w * bhi(gz.w));
        *(GAS v4u*)(AO + (size_t)m * D + g * 256 + cc * 8) = o;
    }
}
__device__ __forceinline__ void pool_tail(const Args& a, int vcu, int G) {
    int tid = threadIdx.x; asm volatile("" : "+v"(tid));
    unsigned char* ws = a.ws;
    const bf16* Z = (const bf16*)(ws + WS_RB); const bf16* SZA = (const bf16*)(ws + WS_RC); bf16* AO = (bf16*)(ws + WS_RA);
    const int cc = tid & 31, rsub = tid >> 5;
    for (int it = vcu; it < (M / 64) * 4; it += G) {
        const int g = it & 3, rb = it >> 2;
        if (g == 0) pool_item<2>(Z, SZA, AO, a.pool_scale, g, rb, cc, rsub);
        else if (g == 1) pool_item<4>(Z, SZA, AO, a.pool_scale, g, rb, cc, rsub);
        else if (g == 2) pool_item<8>(Z, SZA, AO, a.pool_scale, g, rb, cc, rsub);
        else pool_item<16>(Z, SZA, AO, a.pool_scale, g, rb, cc, rsub);
    }
}

__device__ __forceinline__ void phase6(const Args& a, int vcu, int G) {
    int tid = threadIdx.x; asm volatile("" : "+v"(tid));
    const int lane = tid & 63, wave = __builtin_amdgcn_readfirstlane(tid >> 6);
    unsigned char* ws = a.ws;
    const bf16* Y = (const bf16*)(ws + WS_RA); bf16* X1 = (bf16*)(ws + WS_RB); float* R2 = (float*)(ws + WS_R2);
    const int gw = vcu * NWAVES + wave, NGW = G * NWAVES;
    f32x4 gpost[4];
#pragma unroll
    for (int j = 0; j < 4; ++j) gpost[j] = ((const GAS f32x4*)a.norm_post)[lane + 64 * j];
    for (int m = gw; m < M; m += NGW) {
        const GAS f32x4* xr = (const GAS f32x4*)xrow_ptr(a, m) + lane;
        const GAS v2u* yr = (const GAS v2u*)(Y + (size_t)m * D) + lane;
        f32x4 xv[4], yv[4]; float s = 0.f;
#pragma unroll
        for (int j = 0; j < 4; ++j) { xv[j] = xr[64 * j]; const v2u w = yr[64 * j]; yv[j] = (f32x4){blo(w.x), bhi(w.x), blo(w.y), bhi(w.y)};
            s += (yv[j].x * yv[j].x + yv[j].y * yv[j].y) + (yv[j].z * yv[j].z + yv[j].w * yv[j].w); }
        const float rstd = 1.0f / sqrtf(wave_sum(s) * (1.f / D) + EPS);
        float s2 = 0.f;
        GAS v2u* o8 = (GAS v2u*)(X1 + (size_t)m * D) + lane;
#pragma unroll
        for (int j = 0; j < 4; ++j) { xv[j] = xv[j] + yv[j] * rstd * gpost[j]; o8[64 * j] = (v2u){pk2(xv[j].x, xv[j].y), pk2(xv[j].z, xv[j].w)};
            s2 += (xv[j].x * xv[j].x + xv[j].y * xv[j].y) + (xv[j].z * xv[j].z + xv[j].w * xv[j].w); }
        const float rstd2 = 1.0f / sqrtf(wave_sum(s2) * (1.f / D) + EPS);
        if (lane == 0) R2[m] = rstd2;
    }
}

__device__ __forceinline__ bool attn_next(int i, int vcu, int G, long& qrow0, long& kvrow0, int& NT, int& h) {
    int samp, b, qb;
    if (G == 256) {
        if (i >= 20) return false;
        const int x = vcu >> 5, j = vcu & 31; b = x;
        if (i < 16) { samp = 0; h = (i >> 2) * 4 + (i & 3); qb = j; }
        else { samp = 1; h = (i - 16) * 4 + (j >> 3); qb = j & 7; }
    } else {
        const int uid = vcu + i * G; if (uid >= 5120) return false;
        if (uid < 4096) { samp = 0; b = uid >> 9; h = (uid >> 5) & 15; qb = uid & 31; }
        else { const int r = uid - 4096; samp = 1; b = r >> 7; h = (r >> 3) & 15; qb = r & 7; }
    }
    if (!samp) { kvrow0 = (long)b * TP; NT = TP / 64; } else { kvrow0 = (long)MP + (long)b * TS; NT = TS / 64; }
    qrow0 = kvrow0 + qb * 256;
    return true;
}

__global__ void __launch_bounds__(NWAVES * 64, 2) fwd_megakernel(Args args) {
    extern __shared__ __attribute__((aligned(16))) unsigned char lds_raw[];
    LAS unsigned char* lds = (LAS unsigned char*)lds_raw;
    const int G = gridDim.x; const int bx = blockIdx.x; const int vcu = (G % 8 == 0) ? (bx % 8) * (G / 8) + bx / 8 : bx;
    cg::grid_group grid = cg::this_grid();
    unsigned char* ws = args.ws;
    const int lo = args.ph_lo, hi = args.ph_hi;
#ifndef PH_MASK
#define PH_MASK 0xFF
#endif
#define IN(k) ((((PH_MASK) >> (k)) & 1) && lo <= (k) && (k) < hi)
#ifndef DUP_MASK
#define DUP_MASK 0
#endif
#define REPS(k) ((((DUP_MASK) >> (k)) & 1) ? 2 : 1)
#define SEAM(k) do { if (IN(k) && IN((k) + 1)) { if ((k) == 0) { VM_WAIT(); grid.sync(); VM_WAIT(); } else { xcd_barrier(bar); } } } while (0)
    volatile LAS unsigned* MISC = (volatile LAS unsigned*)(lds + MISC_OFF);
    if (threadIdx.x < 32) MISC[threadIdx.x] = 0u;
    __syncthreads();
    XcdBarrier bar = xcd_barrier_post((unsigned*)(ws + WS_CTL), MISC);
    bf16* RA = (bf16*)(ws + WS_RA); bf16* RB = (bf16*)(ws + WS_RB); bf16* RC = (bf16*)(ws + WS_RC); bf16* RD = (bf16*)(ws + WS_RD); bf16* RE = (bf16*)(ws + WS_RE);
    bf16* RK = (bf16*)(ws + WS_RK); bf16* RV = (bf16*)(ws + WS_RV);
    bf16* MA = (bf16*)args.out; bf16* MB = (bf16*)args.out + (size_t)M * D;

    if (IN(0)) { for (int rep = 0; rep < REPS(0); ++rep) phase0(args, lds, vcu, G); }
    SEAM(0);
    if (IN(1)) for (int rep = 0; rep < REPS(1); ++rep) {
        pg8::Gemm g{RA, RA, (const bf16*)(ws + WS_WIN), D, D, D, D, 0};
        pg8::StaticOrder S; S.init(M, INW, G, bx);
        pg8::EpiIn E{RB, RC, RD, RK, RV, RE, MA, MB};
        pg8::gemm_phase<pg8::EpiIn, pg8::StaticOrder, true, true>(lds, g, S, E);
    }
    SEAM(1);
    if (IN(2)) { phase2(args, vcu, G); }
    SEAM(2);
    if (IN(3)) {
        long qrow0, kvrow0; int NT, h;
        bool track;
        { const int ln = threadIdx.x & 63; float mq = fabsf(args.q_norm[ln]), mk = fabsf(args.k_norm[ln]);
#pragma unroll
          for (int o = 1; o < 64; o <<= 1) { mq = fmaxf(mq, __shfl_xor(mq, o)); mk = fmaxf(mk, __shfl_xor(mk, o)); }
          track = __builtin_amdgcn_readfirstlane((mq * mk <= 2.6f) ? 0 : 1) != 0; }
        for (int rep = 0; rep < REPS(3); ++rep)
        for (int i = 0; attn_next(i, vcu, G, qrow0, kvrow0, NT, h); ++i)
            attn_body::attn_unit<8>(qrow0, kvrow0, NT, h, (const attn_body::bf16*)RD, (const attn_body::bf16*)RK, (const attn_body::bf16*)RV, (attn_body::bf16*)((REPS(3) == 2 && rep == 0) ? RB : RD), (const attn_body::bf16*)RE, args.q_norm, track, (char*)lds_raw);
        for (int rep = 0; rep < REPS(8); ++rep) pool_tail(args, vcu, G);
    }
    SEAM(3);
    if (IN(4)) {
        pg8::Gemm g{RA, RD, (const bf16*)(ws + WS_WAB), D, 2048, 2048, 1024, 0};
        pg8::DupOrder S; S.init(M, D, G, bx, REPS(4));
        pg8::EpiMerge E{RC, MA, MB};
        pg8::gemm_phase<pg8::EpiMerge, pg8::DupOrder, true, true>(lds, g, S, E);
    }
    SEAM(4);
    if (IN(5)) {
        { pg8::Gemm g{RC, RC, (const bf16*)(ws + WS_WO), D, D, D, D, 0};
          pg8::DupOrder S; S.init(M, D, G, bx, REPS(5));
          pg8::EpiPlain E{RA, D};
          pg8::gemm_phase<pg8::EpiPlain, pg8::DupOrder, true, true>(lds, g, S, E); }
        { pg8::Gemm g{(const bf16*)(ws + WS_PBF), (const bf16*)(ws + WS_PBF), (const bf16*)(ws + WS_WPLE), PLE, PLE, PLE, PLE, 0};
          pg8::DupOrder S; S.init(M, D, G, bx, REPS(9));
          pg8::EpiPlain E{RD, D};
          pg8::gemm_phase<pg8::EpiPlain, pg8::DupOrder, true, true>(lds, g, S, E); }
    }
    SEAM(5);
    if (IN(6)) { for (int rep = 0; rep < REPS(6); ++rep) phase6(args, vcu, G); }
    SEAM(6);
    if (IN(7)) {
        pg8::Gemm g{RB, RB, (const bf16*)(ws + WS_WG), D, D, D, D, 0};
        pg8::StaticOrder S; S.init(M, D, G, bx);
        pg8::EpiFinal E{args.out, RB, RD, (const float*)(ws + WS_R2)};
        pg8::gemm_phase<pg8::EpiFinal, pg8::StaticOrder, true, true>(lds, g, S, E);
    }
#undef IN
#undef SEAM
}

extern "C" void kernel_launch(void* const* d_in, const int* in_sizes, int n_in, void* d_out, int out_size, void* d_ws, size_t ws_size, hipStream_t stream) {
    static int grid = 0;
    if (grid == 0) {
        if (n_in != 17 || in_sizes[0] != MP * D || in_sizes[1] != MS * D || out_size != M * D || ws_size < WS_END) {
            fprintf(stderr, "kernel_launch: unexpected shapes (n_in %d, in0 %d, out %d, ws %zu); nothing launched\n", n_in, n_in > 0 ? in_sizes[0] : -1, out_size, ws_size); grid = -1; return; }
        int dev = 0, cus = 0, per_cu = 0;
        if (hipGetDevice(&dev) != hipSuccess || hipDeviceGetAttribute(&cus, hipDeviceAttributeMultiprocessorCount, dev) != hipSuccess) { fprintf(stderr, "kernel_launch: device query failed\n"); grid = -1; return; }
        if (hipFuncSetAttribute((const void*)fwd_megakernel, hipFuncAttributeMaxDynamicSharedMemorySize, LDS_BYTES) != hipSuccess) { fprintf(stderr, "kernel_launch: hipFuncSetAttribute failed\n"); grid = -1; return; }
        if (hipOccupancyMaxActiveBlocksPerMultiprocessor(&per_cu, (const void*)fwd_megakernel, NWAVES * 64, LDS_BYTES) != hipSuccess || per_cu < 1) { fprintf(stderr, "kernel_launch: occupancy query says %d\n", per_cu); per_cu = 1; }
        (void)hipGetLastError();
        grid = cus * 1;
        (void)per_cu;
    }
    if (grid < 0) return;
    if (hipMemsetAsync((char*)d_ws + WS_CTL, 0, CTL_ZERO_BYTES, stream) != hipSuccess) { fprintf(stderr, "kernel_launch: memset of control words failed\n"); return; }
    Args a{};
    a.x_p = (const float*)d_in[0]; a.x_s = (const float*)d_in[1]; a.p_p = (const float*)d_in[2]; a.p_s = (const float*)d_in[3]; a.norm_pre = (const float*)d_in[4];
    a.w_in = (const float*)d_in[5]; a.pool_w = (const float*)d_in[6]; a.pool_scale = (const float*)d_in[7]; a.w_a = (const float*)d_in[8]; a.q_norm = (const float*)d_in[9];
    a.k_norm = (const float*)d_in[10]; a.w_b = (const float*)d_in[11]; a.w_out = (const float*)d_in[12]; a.norm_post = (const float*)d_in[13]; a.ple_norm = (const float*)d_in[14];
    a.w_gate = (const float*)d_in[15]; a.w_ple = (const float*)d_in[16];
    a.out = (float*)d_out; a.ws = (unsigned char*)d_ws;
    if (N_LAUNCHES == 1) {
        a.ph_lo = 0; a.ph_hi = N_PHASES;
        void* kargs[] = {&a};
        hipError_t e = hipLaunchCooperativeKernel((const void*)fwd_megakernel, dim3(grid), dim3(NWAVES * 64), kargs, LDS_BYTES, stream);
        if (e != hipSuccess) fprintf(stderr, "kernel_launch: cooperative launch failed: %s (grid %d)\n", hipGetErrorString(e), grid);
    } else {
        for (int ph = 0; ph < N_PHASES; ++ph) {
            a.ph_lo = ph; a.ph_hi = ph + 1;
            hipLaunchKernelGGL(fwd_megakernel, dim3(grid), dim3(NWAVES * 64), LDS_BYTES, stream, a);
        }
    }
}
```

```cpp
#include <hip/hip_runtime.h>
#include <hip/hip_cooperative_groups.h>
#include <hip/hip_bf16.h>
#include <cstdio>
#include <cstdint>
#include <cmath>
namespace cg = cooperative_groups;

namespace pg8 {
#define PG8_LAS __attribute__((address_space(3)))
typedef unsigned short bf16_t;
typedef short bf16x8 __attribute__((ext_vector_type(8)));
typedef float f32x4 __attribute__((ext_vector_type(4)));
typedef unsigned u32x4 __attribute__((ext_vector_type(4)));
constexpr int BM = 256, BK = 64, HALF = 128, HTB = HALF * BK * 2  , STAGE_BYTES = 8 * HTB, NXCD = 8, WGM = 8;

__host__ __device__ __forceinline__ int lds_byte(int r, int c) { const int st = (r >> 4) * 2 + (c >> 5), rr = r & 15, cc = c & 31, ob = rr * 64 + cc * 2; return st * 1024 + (ob ^ (((ob >> 9) & 1) << 5)); }
__host__ __device__ __forceinline__ void stage_rc(int b, int& R, int& C) { const int st = b / 1024, sb = b % 1024, swz = sb ^ (((sb >> 9) & 1) << 5); R = (st >> 1) * 16 + swz / 64; C = (st & 1) * 32 + (swz % 64) / 2; }
__host__ __device__ __forceinline__ int perm32(int rho) { const int n = rho >> 4, i = rho & 15; return 8 * (i >> 2) + 4 * n + (i & 3); }

struct Unit { int pm, pn; };
struct Gemm { const bf16_t* A; const bf16_t* A2; const bf16_t* Bt; int lda, ldb, K, K1; size_t a_pn_off; };

struct StaticOrder {
    int nM, nN, nwg, G, c;
    __host__ __device__ void init(int M, int N, int G_, int c_) { nM = M / BM; nN = N / BM; nwg = nM * nN; G = G_; c = c_; }
    __host__ __device__ bool next(int i, Unit& u) const {
        const long L = (long)i * G + c; if (L >= nwg) return false;
        int wgid = (int)L; { const int q = nwg / NXCD, r = nwg % NXCD, xcd = wgid % NXCD, off = wgid / NXCD; wgid = (xcd < r ? xcd * (q + 1) : r * (q + 1) + (xcd - r) * q) + off; }
        const int nig = WGM * nN, gid = wgid / nig, fm = gid * WGM, gsz = (nM - fm) < WGM ? (nM - fm) : WGM;
        u.pm = fm + ((wgid % nig) % gsz); u.pn = (wgid % nig) / gsz; return true;
    }
    __device__ __forceinline__ void a_ready(const Unit&) const {}
    __device__ __forceinline__ void done(const Unit&) const {}
};

__device__ __forceinline__ unsigned cvt_pk_bf16(float lo, float hi) { unsigned r; asm volatile("v_cvt_pk_bf16_f32 %0, %1, %2" : "=v"(r) : "v"(lo), "v"(hi)); return r; }
__device__ __forceinline__ float bf_lo(unsigned w) { return __uint_as_float(w << 16); }
__device__ __forceinline__ float bf_hi(unsigned w) { return __uint_as_float(w & 0xffff0000u); }
__device__ __forceinline__ float fsigmoid(float x) { return __builtin_amdgcn_rcpf(1.0f + __builtin_amdgcn_exp2f(-1.4426950408889634f * x)); }
__device__ __forceinline__ float fsilu(float x) { return x * fsigmoid(x); }
__device__ __forceinline__ u32x4 pack8(const f32x4& v0, const f32x4& v1) { u32x4 w; w.x = cvt_pk_bf16(v0[0], v0[1]); w.y = cvt_pk_bf16(v0[2], v0[3]); w.z = cvt_pk_bf16(v1[0], v1[1]); w.w = cvt_pk_bf16(v1[2], v1[3]); return w; }
__device__ __forceinline__ void unpack8(const u32x4& w, f32x4& v0, f32x4& v1) { v0 = (f32x4){bf_lo(w.x), bf_hi(w.x), bf_lo(w.y), bf_hi(w.y)}; v1 = (f32x4){bf_lo(w.z), bf_hi(w.z), bf_lo(w.w), bf_hi(w.w)}; }

struct EpiIn {
    static constexpr bool PERM = true, AFTER_DRAIN = false, MID = false;
    bf16_t *ua, *sza, *q, *k, *v, *szb, *ma, *mb;
    __device__ __forceinline__ void operator()(const f32x4 (&acc)[2][2][4][2], const Unit& u, int wr, int wc, int fr, int fq) const {
        const int pn = u.pn; bf16_t* base; int ldc = 1024, ct; bool act = false;
        if (pn < 4) { base = ua; ct = pn; }
        else if (pn < 8) { base = sza; ct = pn - 4; act = true; }
        else if (pn < 12) { base = q; ct = pn - 8; }
        else if (pn == 12) { base = k; ct = 0; ldc = 256; }
        else if (pn == 13) { base = v; ct = 0; ldc = 256; }
        else if (pn < 18) { base = szb; ct = pn - 14; act = true; }
        else {
            int row0 = u.pm * BM + wr * 64 + fr, col0 = (pn - 18) * HALF + wc * 32 + 8 * fq; asm volatile("" : "+v"(row0), "+v"(col0));
#pragma unroll
            for (int ai = 0; ai < 2; ++ai)
#pragma unroll
                for (int m = 0; m < 4; ++m) { const size_t off = (size_t)(row0 + ai * HALF + m * 16) * 1024 + col0; f32x4 r0, r1, s0, s1;
#pragma unroll
                    for (int e = 0; e < 4; ++e) {
                        const float ea0 = __builtin_amdgcn_exp2f(-1.4426950408889634f * acc[ai][0][m][0][e]), ea1 = __builtin_amdgcn_exp2f(-1.4426950408889634f * acc[ai][0][m][1][e]);
                        const float eb0 = __builtin_amdgcn_exp2f(-1.4426950408889634f * fmaxf(acc[ai][1][m][0][e], -60.f)), eb1 = __builtin_amdgcn_exp2f(-1.4426950408889634f * fmaxf(acc[ai][1][m][1][e], -60.f));
                        s0[e] = __builtin_amdgcn_rcpf(1.0f + eb0); s1[e] = __builtin_amdgcn_rcpf(1.0f + eb1);
                        r0[e] = (1.0f + eb0) * __builtin_amdgcn_rcpf(1.0f + ea0); r1[e] = (1.0f + eb1) * __builtin_amdgcn_rcpf(1.0f + ea1); }
                    *(u32x4*)(ma + off) = pack8(r0, r1); *(u32x4*)(mb + off) = pack8(s0, s1); }
            return; }
        int row0 = u.pm * BM + wr * 64 + fr, col0 = ct * BM + wc * 32 + 8 * fq; asm volatile("" : "+v"(row0), "+v"(col0));
#pragma unroll
        for (int ai = 0; ai < 2; ++ai)
#pragma unroll
            for (int m = 0; m < 4; ++m) { bf16_t* rowp = base + (size_t)(row0 + ai * HALF + m * 16) * ldc + col0;
#pragma unroll
                for (int bj = 0; bj < 2; ++bj) { f32x4 v0 = acc[ai][bj][m][0], v1 = acc[ai][bj][m][1];
                    if (act) {
#pragma unroll
                        for (int e = 0; e < 4; ++e) { v0[e] = fsilu(v0[e]); v1[e] = fsilu(v1[e]); } }
                    *(u32x4*)(rowp + bj * HALF) = pack8(v0, v1); } }
    }
};
struct EpiPlain {
    static constexpr bool PERM = true, AFTER_DRAIN = false, MID = false;
    bf16_t* O; int ldc;
    __device__ __forceinline__ void operator()(const f32x4 (&acc)[2][2][4][2], const Unit& u, int wr, int wc, int fr, int fq) const {
        int row0 = u.pm * BM + wr * 64 + fr, col0 = u.pn * BM + wc * 32 + 8 * fq; asm volatile("" : "+v"(row0), "+v"(col0));
#pragma unroll
        for (int ai = 0; ai < 2; ++ai)
#pragma unroll
            for (int m = 0; m < 4; ++m) { bf16_t* rowp = O + (size_t)(row0 + ai * HALF + m * 16) * ldc + col0;
#pragma unroll
                for (int bj = 0; bj < 2; ++bj) *(u32x4*)(rowp + bj * HALF) = pack8(acc[ai][bj][m][0], acc[ai][bj][m][1]); }
    }
};
struct EpiMerge {
    static constexpr bool PERM = true, AFTER_DRAIN = false, MID = true;
    bf16_t* O; const bf16_t* rt; const bf16_t* sb;
    __device__ __forceinline__ void mid(f32x4 (&acc)[2][2][4][2], const Unit& u, int wr, int wc, int fr, int fq) const {
        int row0 = u.pm * BM + wr * 64 + fr, col0 = u.pn * BM + wc * 32 + 8 * fq;
        asm volatile("" : "+v"(row0), "+v"(col0));
#pragma unroll
        for (int ai = 0; ai < 2; ++ai) {
            u32x4 rw[4][2];
#pragma unroll
            for (int m = 0; m < 4; ++m) { const size_t off = (size_t)(row0 + ai * HALF + m * 16) * 1024 + col0;
#pragma unroll
                for (int bj = 0; bj < 2; ++bj) rw[m][bj] = *(const u32x4*)(rt + off + bj * HALF); }
#pragma unroll
            for (int m = 0; m < 4; ++m)
#pragma unroll
                for (int bj = 0; bj < 2; ++bj) { f32x4 r0, r1; unpack8(rw[m][bj], r0, r1); acc[ai][bj][m][0] *= r0; acc[ai][bj][m][1] *= r1; }
#pragma unroll
            for (int m = 0; m < 4; ++m) asm volatile("" : "+v"(acc[ai][0][m][0]), "+v"(acc[ai][0][m][1]), "+v"(acc[ai][1][m][0]), "+v"(acc[ai][1][m][1]) :: "memory");
        }
    }
    __device__ __forceinline__ void operator()(const f32x4 (&acc)[2][2][4][2], const Unit& u, int wr, int wc, int fr, int fq) const {
        int row0 = u.pm * BM + wr * 64 + fr, col0 = u.pn * BM + wc * 32 + 8 * fq; asm volatile("" : "+v"(row0), "+v"(col0));
#pragma unroll
        for (int ai = 0; ai < 2; ++ai)
#pragma unroll
            for (int m = 0; m < 4; ++m) { const size_t off = (size_t)(row0 + ai * HALF + m * 16) * 1024 + col0;
#pragma unroll
                for (int bj = 0; bj < 2; ++bj) { const u32x4 bw = *(const u32x4*)(sb + off + bj * HALF); f32x4 b0, b1; unpack8(bw, b0, b1);
                    *(u32x4*)(O + off + bj * HALF) = pack8(acc[ai][bj][m][0] * b0, acc[ai][bj][m][1] * b1); } }
    }
};
struct EpiFinal {
    static constexpr bool PERM = true, AFTER_DRAIN = false, MID = false;
    float* out; const bf16_t* x1b; const bf16_t* pe; const float* r2;
    __device__ __forceinline__ void operator()(const f32x4 (&acc)[2][2][4][2], const Unit& u, int wr, int wc, int fr, int fq) const {
        int row0 = u.pm * BM + wr * 64 + fr, col0 = u.pn * BM + wc * 32 + 8 * fq; asm volatile("" : "+v"(row0), "+v"(col0));
#pragma unroll
        for (int ai = 0; ai < 2; ++ai)
#pragma unroll
            for (int m = 0; m < 4; ++m) { const int row = row0 + ai * HALF + m * 16; const size_t off = (size_t)row * 1024 + col0; const float rs = r2[row];
#pragma unroll
                for (int bj = 0; bj < 2; ++bj) { const u32x4 pw = *(const u32x4*)(pe + off + bj * HALF), xw = *(const u32x4*)(x1b + off + bj * HALF);
                    f32x4 p0, p1, x0, x1; unpack8(pw, p0, p1); unpack8(xw, x0, x1);
                    float* op = out + off + bj * HALF;
                    f32x4 g0 = acc[ai][bj][m][0], g1 = acc[ai][bj][m][1];
#pragma unroll
                    for (int e = 0; e < 4; ++e) { g0[e] = x0[e] + fsigmoid(rs * g0[e]) * p0[e]; g1[e] = x1[e] + fsigmoid(rs * g1[e]) * p1[e]; }
                    *(f32x4*)op = g0; *(f32x4*)(op + 4) = g1; } }
    }
};
struct DupOrder {
    StaticOrder S; int dup;
    __device__ void init(int M_, int N_, int G_, int c_, int dup_) { S.init(M_, N_, G_, c_); dup = dup_; }
    __device__ bool next(int i, Unit& u) const { if (dup > 1) { const int rounds = S.nwg / S.G; if (i >= dup * rounds) return false; i %= rounds; } return S.next(i, u); }
    __device__ __forceinline__ void a_ready(const Unit&) const {}
    __device__ __forceinline__ void done(const Unit&) const {}
};
template <class Epi, class Sched, bool ALIGN_EPI = false, bool SP2 = false>
__device__ __forceinline__ void gemm_phase(PG8_LAS unsigned char* lds, const Gemm g, const Sched& S, const Epi& E) {
    const int tid = threadIdx.x, wid = __builtin_amdgcn_readfirstlane(tid >> 6), lane = tid & 63, wr = wid >> 2, wc = wid & 3, fr = lane & 15, fq = lane >> 4;
    const int nt = g.K / BK, nth = g.K1 / BK;
    unsigned voffA[2], voffB[2];
#pragma unroll
    for (int i = 0; i < 2; ++i) { int R, C; stage_rc(tid * 16 + i * 8192, R, C); const int Rb = Epi::PERM ? ((R & ~31) + perm32(R & 31)) : R;
        voffA[i] = (unsigned)(R * g.lda + C) * 2u; voffB[i] = (unsigned)(Rb * g.ldb + C) * 2u; }
    const size_t kstep = (size_t)(BK * 2);
    const size_t hstepA = (size_t)HALF * g.lda * 2, hstepB = (size_t)HALF * g.ldb * 2;
    const size_t tstepA = 2 * hstepA, tstepB = 2 * hstepB;
    const unsigned ldsw = (unsigned)wid * 1024u;
    const int aoff = lds_byte(wr * 64 + fr, fq * 8), boff = lds_byte(wc * 32 + fr, fq * 8);
#define PG8_SA(b, h) (((b) * 2 + (h)) * HTB)
#define PG8_SB(b, h) ((4 + (b) * 2 + (h)) * HTB)
#define PG8_STAGE(bufoff, gbase, voff) do { _Pragma("unroll") for (int _i = 0; _i < 2; ++_i) \
        __builtin_amdgcn_global_load_lds((const unsigned*)((const char*)(gbase) + (voff)[_i]), (PG8_LAS unsigned*)(lds + (bufoff) + ldsw + _i * 8192), 16, 0, 0); } while (0)
#define PG8_LDA(dst, b, h) do { _Pragma("unroll") for (int m = 0; m < 4; ++m) _Pragma("unroll") for (int k = 0; k < 2; ++k) dst[m][k] = *(const PG8_LAS bf16x8*)(lds + PG8_SA(b, h) + aoff + m * 2048 + k * 1024); } while (0)
#define PG8_LDB(dst, b, h) do { _Pragma("unroll") for (int n = 0; n < 2; ++n) _Pragma("unroll") for (int k = 0; k < 2; ++k) dst[n][k] = *(const PG8_LAS bf16x8*)(lds + PG8_SB(b, h) + boff + n * 2048 + k * 1024); } while (0)
#define PG8_MMA(ai, bj, At, Bt) do { __builtin_amdgcn_s_setprio(1); _Pragma("unroll") for (int m = 0; m < 4; ++m) _Pragma("unroll") for (int n = 0; n < 2; ++n) _Pragma("unroll") for (int k = 0; k < 2; ++k) \
        acc[ai][bj][m][n] = __builtin_amdgcn_mfma_f32_16x16x32_bf16(Bt[n][k], At[m][k], acc[ai][bj][m][n], 0, 0, 0); __builtin_amdgcn_s_setprio(0); } while (0)
#define PG8_WAIT_V(n) asm volatile("s_waitcnt vmcnt(" #n ")" ::: "memory")
#define PG8_WAIT_L(n) asm volatile("s_waitcnt lgkmcnt(" #n ")" ::: "memory")
#define PG8_BAR __builtin_amdgcn_s_barrier()
#define PG8_SCHED __builtin_amdgcn_sched_barrier(0)
    Unit cur, nxt; int ui = 0;
    if (!S.next(0, cur)) return;
    f32x4 acc[2][2][4][2];
#pragma unroll
    for (int a = 0; a < 2; ++a)
#pragma unroll
        for (int b = 0; b < 2; ++b)
#pragma unroll
            for (int m = 0; m < 4; ++m)
#pragma unroll
                for (int n = 0; n < 2; ++n) acc[a][b][m][n] = (f32x4){0.f, 0.f, 0.f, 0.f};
    bf16x8 At[4][2], B0[2][2], B1[2][2];
    const char* cA = (const char*)g.A + (size_t)cur.pm * tstepA + (size_t)cur.pn * g.a_pn_off; const char* cA2 = (const char*)g.A2 + (size_t)cur.pm * tstepA; const char* cB = (const char*)g.Bt + (size_t)cur.pn * tstepB;
    S.a_ready(cur);
    if constexpr (SP2) {
        PG8_STAGE(PG8_SB(0, 0), cB, voffB); PG8_STAGE(PG8_SB(0, 1), cB + hstepB, voffB); PG8_STAGE(PG8_SA(0, 0), cA, voffA); PG8_STAGE(PG8_SA(0, 1), cA + hstepA, voffA);
        if (wr == 1) PG8_BAR;
        PG8_WAIT_V(2); PG8_BAR;
        PG8_STAGE(PG8_SB(1, 0), cB + kstep, voffB); PG8_STAGE(PG8_SA(1, 0), cA + kstep, voffA); PG8_STAGE(PG8_SB(1, 1), cB + hstepB + kstep, voffB);
        PG8_WAIT_V(6); PG8_BAR;
    } else {
        PG8_STAGE(PG8_SB(0, 0), cB, voffB); PG8_STAGE(PG8_SA(0, 0), cA, voffA); PG8_STAGE(PG8_SB(0, 1), cB + hstepB, voffB); PG8_STAGE(PG8_SA(0, 1), cA + hstepA, voffA);
        if (wr == 1) PG8_BAR;
        PG8_WAIT_V(4); PG8_BAR;
        PG8_STAGE(PG8_SB(1, 0), cB + kstep, voffB); PG8_STAGE(PG8_SA(1, 0), cA + kstep, voffA); PG8_STAGE(PG8_SB(1, 1), cB + hstepB + kstep, voffB);
        PG8_WAIT_V(6); PG8_BAR;
    }
    for (;;) {
        const bool has_next = S.next(ui + 1, nxt);
        const char* nA = has_next ? (const char*)g.A + (size_t)nxt.pm * tstepA + (size_t)nxt.pn * g.a_pn_off : cA; const char* nA2 = has_next ? (const char*)g.A2 + (size_t)nxt.pm * tstepA : cA2; const char* nB = has_next ? (const char*)g.Bt + (size_t)nxt.pn * tstepB : cB;
        for (int t = 0; t < nt; t += 2) {
            const bool last = (t == nt - 2);
            if constexpr (Epi::MID) { if (t == nth) E.mid(acc, cur, wr, wc, fr, fq); }
            const char* a1 = (t + 1 < nth) ? cA + (size_t)(t + 1) * kstep : cA2 + (size_t)(t + 1 - nth) * kstep;
            const char* a2 = last ? nA : ((t + 2 < nth) ? cA + (size_t)(t + 2) * kstep : cA2 + (size_t)(t + 2 - nth) * kstep); const char* b2 = last ? nB : cB + (size_t)(t + 2) * kstep;
            const char* a3 = a2 + kstep; const char* b3 = b2 + kstep;
            if (last && has_next) S.a_ready(nxt);
            if constexpr (SP2) {
            PG8_LDB(B0, 0, 0); PG8_LDB(B1, 0, 1); PG8_SCHED; PG8_LDA(At, 0, 0); PG8_STAGE(PG8_SA(1, 1), a1 + hstepA, voffA);
            PG8_WAIT_V(8); PG8_WAIT_L(0); PG8_BAR; PG8_MMA(0, 0, At, B0); PG8_MMA(0, 1, At, B1); PG8_BAR; PG8_SCHED;
            PG8_LDA(At, 0, 1); PG8_STAGE(PG8_SB(0, 0), b2, voffB); PG8_STAGE(PG8_SB(0, 1), b2 + hstepB, voffB); PG8_STAGE(PG8_SA(0, 0), a2, voffA);
            PG8_WAIT_V(8); PG8_WAIT_L(0); PG8_BAR; PG8_MMA(1, 0, At, B0); PG8_MMA(1, 1, At, B1); PG8_BAR; PG8_SCHED;
            PG8_LDB(B0, 1, 0); PG8_LDB(B1, 1, 1); PG8_SCHED; PG8_LDA(At, 1, 0); PG8_STAGE(PG8_SA(0, 1), a2 + hstepA, voffA);
            PG8_WAIT_V(8); PG8_WAIT_L(0); PG8_BAR; PG8_MMA(0, 0, At, B0); PG8_MMA(0, 1, At, B1); PG8_BAR; PG8_SCHED;
            PG8_LDA(At, 1, 1); PG8_STAGE(PG8_SB(1, 0), b3, voffB); PG8_STAGE(PG8_SB(1, 1), b3 + hstepB, voffB); PG8_STAGE(PG8_SA(1, 0), a3, voffA);
            PG8_WAIT_V(8); PG8_WAIT_L(0); PG8_BAR; PG8_MMA(1, 0, At, B0); PG8_MMA(1, 1, At, B1); PG8_BAR; PG8_SCHED;
            } else {
            PG8_LDB(B0, 0, 0); PG8_SCHED; PG8_LDA(At, 0, 0); PG8_STAGE(PG8_SA(1, 1), a1 + hstepA, voffA);
            PG8_WAIT_L(8); PG8_BAR; PG8_WAIT_L(0); PG8_MMA(0, 0, At, B0); PG8_BAR; PG8_SCHED;
            PG8_LDB(B1, 0, 1); PG8_STAGE(PG8_SB(0, 0), b2, voffB);
            PG8_BAR; PG8_WAIT_L(0); PG8_MMA(0, 1, At, B1); PG8_BAR;
            PG8_LDA(At, 0, 1); PG8_STAGE(PG8_SA(0, 0), a2, voffA);
            PG8_BAR; PG8_WAIT_L(0); PG8_MMA(1, 0, At, B0); PG8_BAR; PG8_SCHED;
            PG8_STAGE(PG8_SB(0, 1), b2 + hstepB, voffB);
            PG8_WAIT_V(6); PG8_BAR; PG8_MMA(1, 1, At, B1); PG8_BAR;
            PG8_LDB(B0, 1, 0); PG8_SCHED; PG8_LDA(At, 1, 0); PG8_STAGE(PG8_SA(0, 1), a2 + hstepA, voffA);
            PG8_WAIT_L(8); PG8_BAR; PG8_WAIT_L(0); PG8_MMA(0, 0, At, B0); PG8_BAR; PG8_SCHED;
            PG8_LDB(B1, 1, 1); PG8_STAGE(PG8_SB(1, 0), b3, voffB);
            PG8_BAR; PG8_WAIT_L(0); PG8_MMA(0, 1, At, B1); PG8_BAR;
            PG8_LDA(At, 1, 1); PG8_STAGE(PG8_SA(1, 0), a3, voffA);
            PG8_BAR; PG8_WAIT_L(0); PG8_MMA(1, 0, At, B0); PG8_BAR; PG8_SCHED;
            PG8_STAGE(PG8_SB(1, 1), b3 + hstepB, voffB);
            PG8_WAIT_V(6); PG8_BAR; PG8_MMA(1, 1, At, B1); PG8_BAR;
            }
        }
        if constexpr (ALIGN_EPI) { if (wr == 0) PG8_BAR; }
        if constexpr (!Epi::AFTER_DRAIN) { E(acc, cur, wr, wc, fr, fq); S.done(cur); }
        if (!has_next) break;
#pragma unroll
        for (int a = 0; a < 2; ++a)
#pragma unroll
            for (int b = 0; b < 2; ++b)
#pragma unroll
                for (int m = 0; m < 4; ++m)
#pragma unroll
                    for (int n = 0; n < 2; ++n) acc[a][b][m][n] = (f32x4){0.f, 0.f, 0.f, 0.f};
        cur = nxt; cA = nA; cA2 = nA2; cB = nB; ++ui;
        if constexpr (ALIGN_EPI) { if (wr == 1) PG8_BAR; }
    }
    PG8_WAIT_V(0);
    if constexpr (!ALIGN_EPI) { if (wr == 0) PG8_BAR; }
    PG8_BAR;
    if constexpr (Epi::AFTER_DRAIN) { E.fused(acc, cur, wr, wc, fr, fq, lds, wid, lane); S.done(cur); }
#undef PG8_SA
#undef PG8_SB
#undef PG8_STAGE
#undef PG8_LDA
#undef PG8_LDB
#undef PG8_MMA
#undef PG8_WAIT_V
#undef PG8_WAIT_L
#undef PG8_BAR
#undef PG8_SCHED
}
}

namespace attn_body {
using bf16=__hip_bfloat16;
using bf16x8=__attribute__((ext_vector_type(8)))short;
using s16x4=__attribute__((ext_vector_type(4)))short;
using f32x16=__attribute__((ext_vector_type(16)))float;
using u32x4=__attribute__((ext_vector_type(4)))unsigned;
constexpr int D=64,QP=1024,KP=256;
constexpr int NW=8,QBLK=32,QB=QBLK*NW,KVBLK=64;

__device__ __forceinline__ int crow(int r,int hi){return (r&3)+8*(r>>2)+4*hi;}
#define SBAR() __builtin_amdgcn_sched_barrier(0)
__device__ __forceinline__ void cmask(f32x16&p0,f32x16&p1,int jb,int qrel,int hi){
  const float NEG=-INFINITY; int kb=64*jb+4*hi;
  #pragma unroll
  for(int r=0;r<16;++r){int kv=kb+(r&3)+8*(r>>2); if(kv>qrel)p0[r]=NEG; if(kv+32>qrel)p1[r]=NEG;}
}

constexpr int NSLOT=3, SLOTB=8192;
constexpr int LDS_K=0, LDS_V=NSLOT*SLOTB, LDS_WS=2*NSLOT*SLOTB, LDS_OST=LDS_WS+NW*64*4, LDS_BYTES=LDS_OST+NW*4096;
constexpr float C2=0.125f*1.4426950408889634f;
__device__ __forceinline__ void glds16(const void*gsrc,unsigned lds_dst){unsigned keep;
  asm volatile("s_mov_b32 %0, m0\n\ts_mov_b32 m0, %2\n\ts_nop 0\n\tglobal_load_lds_dwordx4 %1, off\n\ts_mov_b32 m0, %0":"=&s"(keep):"v"(gsrc),"s"(lds_dst):"memory");}
__device__ __forceinline__ float max3f(float a,float b,float c){float r;asm("v_max3_f32 %0, %1, %2, %3":"=v"(r):"v"(a),"v"(b),"v"(c));return r;}
__device__ __forceinline__ float max2f(float a,float b){float r;asm("v_max_f32_e32 %0, %1, %2":"=v"(r):"v"(a),"v"(b));return r;}
__device__ __forceinline__ float fadd_s(float a,float b){float r;asm("v_add_f32_e32 %0, %1, %2":"=v"(r):"v"(a),"v"(b));return r;}
__device__ __forceinline__ float fsub_s(float a,float b){float r;asm("v_sub_f32_e32 %0, %1, %2":"=v"(r):"v"(a),"v"(b));return r;}
typedef float f32x2_t __attribute__((ext_vector_type(2))); typedef __bf16 bf16x2_t __attribute__((ext_vector_type(2)));
__device__ __forceinline__ unsigned cvtpk_s(float lo,float hi){f32x2_t v={lo,hi};bf16x2_t b=__builtin_convertvector(v,bf16x2_t);return __builtin_bit_cast(unsigned,b);}
#define WAIT_BAR(N) asm volatile("s_waitcnt vmcnt(" #N ") lgkmcnt(0)\n\ts_barrier":::"memory")

__device__ __forceinline__ void qkt(f32x16&p0,f32x16&p1,const char*Kslot,const bf16x8*qr,const f32x16&negm,int r32,int hi){
  const char*kb=Kslot+hi*1024+r32*16;
  #pragma unroll
  for(int d0=0;d0<4;++d0){
    const bf16x8 b0=*reinterpret_cast<const bf16x8*>(kb+d0*2048);
    const bf16x8 b1=*reinterpret_cast<const bf16x8*>(kb+d0*2048+512);
    if(d0==0){p0=__builtin_amdgcn_mfma_f32_32x32x16_bf16(b0,qr[0],negm,0,0,0);p1=__builtin_amdgcn_mfma_f32_32x32x16_bf16(b1,qr[0],negm,0,0,0);}
    else{p0=__builtin_amdgcn_mfma_f32_32x32x16_bf16(b0,qr[d0],p0,0,0,0);p1=__builtin_amdgcn_mfma_f32_32x32x16_bf16(b1,qr[d0],p1,0,0,0);}}
}
typedef __attribute__((address_space(3))) const char* lds_cptr;
typedef short v4i16_t __attribute__((ext_vector_type(4)));
__device__ __forceinline__ void kload8(bf16x8*kf,lds_cptr kp){
  kf[0]=*(const __attribute__((address_space(3))) bf16x8*)(kp);      kf[1]=*(const __attribute__((address_space(3))) bf16x8*)(kp+512);
  kf[2]=*(const __attribute__((address_space(3))) bf16x8*)(kp+2048); kf[3]=*(const __attribute__((address_space(3))) bf16x8*)(kp+2560);
  kf[4]=*(const __attribute__((address_space(3))) bf16x8*)(kp+4096); kf[5]=*(const __attribute__((address_space(3))) bf16x8*)(kp+4608);
  kf[6]=*(const __attribute__((address_space(3))) bf16x8*)(kp+6144); kf[7]=*(const __attribute__((address_space(3))) bf16x8*)(kp+6656);
}
__device__ __forceinline__ void kload2(bf16x8*kf,lds_cptr kp,int j){ kf[2*j]=*(const __attribute__((address_space(3))) bf16x8*)(kp+j*2048); kf[2*j+1]=*(const __attribute__((address_space(3))) bf16x8*)(kp+j*2048+512); }
__device__ __forceinline__ s16x4 vtr(lds_cptr p){ return __builtin_bit_cast(s16x4,__builtin_amdgcn_ds_read_tr16_b64_v4i16((__attribute__((address_space(3))) v4i16_t*)p)); }
__device__ __forceinline__ float rowmax(const f32x16&p0,const f32x16&p1){
  float a=max3f(p0[0],p0[1],p1[0]),b=max3f(p0[2],p0[3],p1[1]);a=max3f(a,p1[2],p1[3]);
  #pragma unroll
  for(int r=4;r<16;r+=4){a=max3f(a,p0[r],p0[r+1]);b=max3f(b,p0[r+2],p0[r+3]);a=max3f(a,p1[r],p1[r+1]);b=max3f(b,p1[r+2],p1[r+3]);}
  const float m=max2f(a,b);
  auto rr=__builtin_amdgcn_permlane32_swap(__float_as_uint(m),__float_as_uint(m),false,false);
  return max2f(__uint_as_float(rr[0]),__uint_as_float(rr[1]));
}
__device__ __forceinline__ void pv(f32x16*o,int vb,bf16x8 pa0,bf16x8 pa1,bf16x8 pa2,bf16x8 pa3){
  #pragma unroll
  for(int d0=0;d0<2;++d0){s16x4 lo[4],hi[4];
    #pragma unroll
    for(int ks=0;ks<4;++ks){
      asm volatile("ds_read_b64_tr_b16 %0,%1 offset:%c2":"=&v"(lo[ks]):"v"(vb),"i"(d0*4096+ks*1024):"memory");
      asm volatile("ds_read_b64_tr_b16 %0,%1 offset:%c2":"=&v"(hi[ks]):"v"(vb),"i"(d0*4096+ks*1024+512):"memory");}
    asm volatile("s_waitcnt lgkmcnt(0)":::"memory");SBAR();
    #define PK(k) (bf16x8){lo[k][0],lo[k][1],lo[k][2],lo[k][3],hi[k][0],hi[k][1],hi[k][2],hi[k][3]}
    o[d0]=__builtin_amdgcn_mfma_f32_32x32x16_bf16(pa0,PK(0),o[d0],0,0,0);
    o[d0]=__builtin_amdgcn_mfma_f32_32x32x16_bf16(pa1,PK(1),o[d0],0,0,0);
    o[d0]=__builtin_amdgcn_mfma_f32_32x32x16_bf16(pa2,PK(2),o[d0],0,0,0);
    o[d0]=__builtin_amdgcn_mfma_f32_32x32x16_bf16(pa3,PK(3),o[d0],0,0,0);
    #undef PK
  }
}
#define ATTN_STORE16(p,v) (*(u32x4*)(p)=(v))
__device__ __forceinline__ float abf_lo(unsigned w){return __uint_as_float(w<<16);}
__device__ __forceinline__ float abf_hi(unsigned w){return __uint_as_float(w&0xffff0000u);}
__device__ __forceinline__ u32x4 mulgate(const u32x4&v,const u32x4&g){u32x4 r;
  r.x=cvtpk_s(abf_lo(v.x)*abf_lo(g.x),abf_hi(v.x)*abf_hi(g.x)); r.y=cvtpk_s(abf_lo(v.y)*abf_lo(g.y),abf_hi(v.y)*abf_hi(g.y));
  r.z=cvtpk_s(abf_lo(v.z)*abf_lo(g.z),abf_hi(v.z)*abf_hi(g.z)); r.w=cvtpk_s(abf_lo(v.w)*abf_lo(g.w),abf_hi(v.w)*abf_hi(g.w)); return r;}
__device__ __forceinline__ void qnormrope(bf16x8*qr,const float*__restrict__ qn,int t,int hi){
  typedef float f4_t __attribute__((ext_vector_type(4)));
  float y[4][8]; float ss=0.f;
  #pragma unroll
  for(int d0=0;d0<4;++d0){ const u32x4 w=__builtin_bit_cast(u32x4,qr[d0]);
    #pragma unroll
    for(int i=0;i<4;++i){ y[d0][2*i]=__uint_as_float(w[i]<<16); y[d0][2*i+1]=__uint_as_float(w[i]&0xffff0000u); ss+=y[d0][2*i]*y[d0][2*i]+y[d0][2*i+1]*y[d0][2*i+1]; } }
  ss+=__shfl_xor(ss,32);
  const float rstd=1.0f/sqrtf(ss*(1.0f/64.0f)+1e-6f);
  #pragma unroll
  for(int d0=0;d0<4;++d0){ const f4_t g0=*(const f4_t*)(qn+16*d0+8*hi), g1=*(const f4_t*)(qn+16*d0+8*hi+4);
    #pragma unroll
    for(int i=0;i<4;++i){ y[d0][i]*=rstd*g0[i]; y[d0][4+i]*=rstd*g1[i]; } }
  const float prow=(float)(t>>6), pcol=(float)(t&63);
  #pragma unroll
  for(int j=0;j<8;++j){
    const float freq=__builtin_amdgcn_exp2f(-(float)(8*hi+j)*0.83048202372184058696f)*0.15915494309189533577f;
    const float rr=__builtin_amdgcn_fractf(prow*freq), rc=__builtin_amdgcn_fractf(pcol*freq);
    const float sr=__builtin_amdgcn_sinf(rr), cr=__builtin_amdgcn_cosf(rr), sc=__builtin_amdgcn_sinf(rc), cc=__builtin_amdgcn_cosf(rc);
    const float a0=y[0][j], b0=y[1][j], a1=y[2][j], b1=y[3][j];
    y[0][j]=(a0*cr-b0*sr)*C2; y[1][j]=(b0*cr+a0*sr)*C2; y[2][j]=(a1*cc-b1*sc)*C2; y[3][j]=(b1*cc+a1*sc)*C2; }
  #pragma unroll
  for(int d0=0;d0<4;++d0){ u32x4 w; w.x=cvtpk_s(y[d0][0],y[d0][1]); w.y=cvtpk_s(y[d0][2],y[d0][3]); w.z=cvtpk_s(y[d0][4],y[d0][5]); w.w=cvtpk_s(y[d0][6],y[d0][7]); qr[d0]=__builtin_bit_cast(bf16x8,w); }
}
template<int THRL,bool track> __device__ __forceinline__ void attn_unit(long qrow0,long kvrow0,int NT,int h,const bf16*Q,const bf16*__restrict__ K,const bf16*__restrict__ V,bf16*O,const bf16*__restrict__ Gt,const float*__restrict__ qn,char*shm){
  const int tid=threadIdx.x,lane=tid&63,r32=lane&31,hi=lane>>5; const int wid=__builtin_amdgcn_readfirstlane(tid>>6);
  const bf16*Qw=Q+(qrow0+wid*QBLK)*QP+h*D;
  const bf16*Kh=K+kvrow0*KP+(h>>2)*D,*Vh=V+kvrow0*KP+(h>>2)*D;
  const unsigned lds0=(unsigned)(uintptr_t)shm;
  float*wsf=(float*)(shm+LDS_WS)+wid*64;
  const bf16*ksrc=Kh+(long)lane*KP+wid*8;
  const bf16*vsrc=Vh+(long)(16*(wid&3)+(lane>>2))*KP+(wid>>2)*32+(lane&3)*8;
  const unsigned kdst=lds0+LDS_K+wid*1024, vdst=lds0+LDS_V+wid*1024;
  #define DMA_K(t,slot) glds16(ksrc+(long)(t)*KVBLK*KP,(unsigned)__builtin_amdgcn_readfirstlane(kdst+(slot)))
  #define DMA_V(t,slot) glds16(vsrc+(long)(t)*KVBLK*KP,(unsigned)__builtin_amdgcn_readfirstlane(vdst+(slot)))
  const int vb0=(int)(lds0+LDS_V)+((lane>>4)&1)*32+(lane&3)*8+(4*hi+((lane&15)>>2))*64;
  const char*Kbase=shm+LDS_K; bf16x8 kf[8];
  const lds_cptr shm3=(lds_cptr)shm; const lds_cptr kp0=shm3+LDS_K+hi*1024+r32*16; const lds_cptr vp0=shm3+LDS_V+((lane>>4)&1)*32+(lane&3)*8+(4*hi+((lane&15)>>2))*64;
  DMA_K(0,0);DMA_V(0,0);DMA_K(1,SLOTB);
  bf16x8 qr[4];
  #pragma unroll
  for(int d0=0;d0<4;++d0)qr[d0]=*reinterpret_cast<const bf16x8*>(&Qw[(long)r32*QP+d0*16+hi*8]);
  qnormrope(qr,qn,(int)(qrow0-kvrow0)+wid*QBLK+r32,hi);
  float mhat=0.f,l_reg=0.f;f32x16 o[2];o[0]=f32x16{};o[1]=f32x16{};f32x16 negm=f32x16{};asm volatile("":"+v"(negm));
  #define CMASK(P0,P1,t) do{}while(0)
  bool resc=false;
  #define START(P0,P1) do{ const float rm=rowmax(P0,P1); resc=false; \
    { const float dl=rm; mhat=fadd_s(mhat,dl); \
      _Pragma("unroll") for(int r=0;r<16;++r){P0[r]=fsub_s(P0[r],dl);P1[r]=fsub_s(P1[r],dl);} \
      _Pragma("unroll") for(int r=0;r<16;++r)negm[r]=-mhat; asm volatile("":"+v"(negm)); } \
    _Pragma("unroll") for(int r=0;r<16;++r)P0[r]=__builtin_amdgcn_exp2f(P0[r]); }while(0)
  #define RESC() do{ if(resc){ asm volatile("s_waitcnt lgkmcnt(0)":::"memory"); \
      _Pragma("unroll") for(int d_=0;d_<2;++d_) _Pragma("unroll") for(int r=0;r<16;++r)o[d_][r]*=wsf[crow(r,hi)]; } }while(0)
  f32x16 pA0,pA1,pB0,pB1;
  int sl_prev=0,sl_cur=0,sl_next=SLOTB;
  #define ROT() do{sl_prev=sl_cur;sl_cur=sl_next;sl_next=(sl_next==(NSLOT-1)*SLOTB)?0:sl_next+SLOTB;}while(0)
  DMA_K(2,2*SLOTB);
  WAIT_BAR(3);
  qkt(pA0,pA1,Kbase,qr,negm,r32,hi);asm volatile("s_nop 15\n\ts_nop 7":"+v"(pA0),"+v"(pA1));CMASK(pA0,pA1,0);
  START(pA0,pA1);
  _Pragma("unroll") for(int r=0;r<16;++r)pA1[r]=__builtin_amdgcn_exp2f(pA1[r]);
  WAIT_BAR(0);
  DMA_K(3,0);DMA_V(1,SLOTB);
  ROT();
  kload8(kf,kp0+sl_cur);
  WAIT_BAR(2);
  s16x4 vlo[8],vhi[8]; u32x4 pw0,pw1,pw2,pw3;
  #define PKW(P,B) cvtpk_s(P[B],P[B+1])
  #define PAF(k) __builtin_bit_cast(bf16x8,pw##k)
  #define VFR(i) (bf16x8){vlo[i][0],vlo[i][1],vlo[i][2],vlo[i][3],vhi[i][0],vhi[i][1],vhi[i][2],vhi[i][3]}
  #define PIN(x) asm volatile("":"+v"(x))
  #define MX3(a,b,c) __builtin_fmaxf(__builtin_fmaxf((a),(b)),(c))
  #define GAPA(MF,A0,A1,A2,A3,W0,W1,PW) do{ MF; sacc+=A0; sacc+=A1; sacc+=A2; sacc+=A3; PIN(sacc); W0; W1; PIN(PW); SBAR(); }while(0)
  #define EX(v) __builtin_amdgcn_exp2f(v)
  #define GAPB(MF,X,B) do{ MF; X[B]=EX(X[B]); X[B+1]=EX(X[B+1]); X[B+2]=EX(X[B+2]); X[B+3]=EX(X[B+3]); PIN(X); SBAR(); }while(0)
  #define VRD(i) do{ vlo[i]=vtr(vp_+(((i)>>2)*4096+((i)&3)*1024)); vhi[i]=vtr(vp_+(((i)>>2)*4096+((i)&3)*1024+512)); }while(0)
  #define KRD(G,j) do{ if(G){ kload2(kf,kp0+sl_next,j); SBAR(); } }while(0)
  #define STEP(C0,C1,P0,P1,t,GK,GV,GL) do{ SBAR(); \
    const lds_cptr vp_=vp0+sl_prev; \
    VRD(0); SBAR(); float sacc=(P0[0]+P0[1]); \
    GAPA(C0=__builtin_amdgcn_mfma_f32_32x32x16_bf16(kf[0],qr[0],negm,0,0,0), P0[2],P0[3],P0[4],P0[5],     pw0[0]=PKW(P0,0), pw0[1]=PKW(P0,2), pw0); \
    VRD(4); SBAR(); GAPA(C1=__builtin_amdgcn_mfma_f32_32x32x16_bf16(kf[1],qr[0],negm,0,0,0), P0[6],P0[7],P0[8],P0[9],     pw0[2]=PKW(P0,4), pw0[3]=PKW(P0,6), pw0); \
    VRD(1); SBAR(); GAPA(C0=__builtin_amdgcn_mfma_f32_32x32x16_bf16(kf[2],qr[1],C0,0,0,0),   P0[10],P0[11],P0[12],P0[13], pw1[0]=PKW(P0,8), pw1[1]=PKW(P0,10), pw1); \
    VRD(5); SBAR(); GAPA(C1=__builtin_amdgcn_mfma_f32_32x32x16_bf16(kf[3],qr[1],C1,0,0,0),   P0[14],P0[15],P1[0],P1[1],   pw1[2]=PKW(P0,12),pw1[3]=PKW(P0,14), pw1); \
    VRD(2); SBAR(); GAPA(C0=__builtin_amdgcn_mfma_f32_32x32x16_bf16(kf[4],qr[2],C0,0,0,0),   P1[2],P1[3],P1[4],P1[5],     pw2[0]=PKW(P1,0), pw2[1]=PKW(P1,2), pw2); \
    VRD(6); SBAR(); GAPA(C1=__builtin_amdgcn_mfma_f32_32x32x16_bf16(kf[5],qr[2],C1,0,0,0),   P1[6],P1[7],P1[8],P1[9],     pw2[2]=PKW(P1,4), pw2[3]=PKW(P1,6), pw2); \
    VRD(3); SBAR(); GAPA(C0=__builtin_amdgcn_mfma_f32_32x32x16_bf16(kf[6],qr[3],C0,0,0,0),   P1[10],P1[11],P1[12],P1[13], pw3[0]=PKW(P1,8), pw3[1]=PKW(P1,10), pw3); \
    VRD(7); SBAR(); GAPA(C1=__builtin_amdgcn_mfma_f32_32x32x16_bf16(kf[7],qr[3],C1,0,0,0),   P1[14],P1[15],0.f,0.f,       pw3[2]=PKW(P1,12),pw3[3]=PKW(P1,14), pw3); \
    l_reg+=sacc; \
    if(GK){DMA_K((t)+3,sl_cur);} if(GV){DMA_V((t)+1,sl_next);} \
    CMASK(C0,C1,t); \
    if(track){ float a=MX3(C0[0],C0[1],C1[0]),b=MX3(C0[2],C0[3],C1[1]); a=MX3(a,C1[2],C1[3]); \
      _Pragma("unroll") for(int r=4;r<16;r+=4){a=MX3(a,C0[r],C0[r+1]);b=MX3(b,C0[r+2],C0[r+3]);a=MX3(a,C1[r],C1[r+1]);b=MX3(b,C1[r+2],C1[r+3]);} \
      float rm=__builtin_fmaxf(a,b); { auto rr=__builtin_amdgcn_permlane32_swap(__float_as_uint(rm),__float_as_uint(rm),false,false); rm=__builtin_fmaxf(__uint_as_float(rr[0]),__uint_as_float(rr[1])); } \
      resc=false; \
      if(__builtin_expect(__any(rm>(float)THRL),0)){ const float dl=__builtin_fmaxf(rm,0.f); mhat+=dl; \
        _Pragma("unroll") for(int r=0;r<16;++r){C0[r]-=dl;C1[r]-=dl;} \
        _Pragma("unroll") for(int r=0;r<16;++r)negm[r]=-mhat; asm volatile("":"+v"(negm)); \
        const float f=__builtin_amdgcn_exp2f(-dl); l_reg*=f; if(hi==0)wsf[r32]=f; resc=true; } } \
    SBAR(); \
    GAPB(o[0]=__builtin_amdgcn_mfma_f32_32x32x16_bf16(PAF(0),VFR(0),o[0],0,0,0), C0,0); \
    GAPB(o[1]=__builtin_amdgcn_mfma_f32_32x32x16_bf16(PAF(0),VFR(4),o[1],0,0,0), C0,4); \
    KRD(GL,0); GAPB(o[0]=__builtin_amdgcn_mfma_f32_32x32x16_bf16(PAF(1),VFR(1),o[0],0,0,0), C0,8); \
    KRD(GL,1); GAPB(o[1]=__builtin_amdgcn_mfma_f32_32x32x16_bf16(PAF(1),VFR(5),o[1],0,0,0), C0,12); \
    KRD(GL,2); GAPB(o[0]=__builtin_amdgcn_mfma_f32_32x32x16_bf16(PAF(2),VFR(2),o[0],0,0,0), C1,0); \
    KRD(GL,3); GAPB(o[1]=__builtin_amdgcn_mfma_f32_32x32x16_bf16(PAF(2),VFR(6),o[1],0,0,0), C1,4); \
    GAPB(o[0]=__builtin_amdgcn_mfma_f32_32x32x16_bf16(PAF(3),VFR(3),o[0],0,0,0), C1,8); \
    GAPB(o[1]=__builtin_amdgcn_mfma_f32_32x32x16_bf16(PAF(3),VFR(7),o[1],0,0,0), C1,12); \
    }while(0)
  int t=1;
  #undef CMASK
  #define CMASK(P0,P1,t) do{}while(0)
  for(;t+5<NT;t+=2){
    STEP(pB0,pB1,pA0,pA1,t,true,true,true);     WAIT_BAR(2); RESC(); ROT();
    STEP(pA0,pA1,pB0,pB1,t+1,true,true,true);   WAIT_BAR(2); RESC(); ROT();
  }
  #undef CMASK
  #define CMASK(P0,P1,t) do{}while(0)
  #define ENDW(tt) do{ if((tt)+3<NT){WAIT_BAR(2);} else if((tt)+2<NT){WAIT_BAR(1);} else {WAIT_BAR(0);} }while(0)
  for(;t+1<NT;t+=2){
    STEP(pB0,pB1,pA0,pA1,t,(t+3<NT),(t+1<NT),(t+1<NT));       ENDW(t);   RESC(); ROT();
    STEP(pA0,pA1,pB0,pB1,t+1,(t+4<NT),(t+2<NT),(t+2<NT));     ENDW(t+1); RESC(); ROT();
  }
  STEP(pB0,pB1,pA0,pA1,NT-1,false,false,false); RESC();
  const bf16*Gw=Gt+(qrow0+wid*QBLK)*QP+h*D; u32x4 gvv[4];
  _Pragma("unroll") for(int i=0;i<4;++i) gvv[i]=*(const u32x4*)(Gw+(long)(i*8+(lane>>3))*QP+(lane&7)*8);
  { float sacc=pB0[0]+pB0[1]; _Pragma("unroll") for(int r=2;r<16;++r)sacc+=pB0[r]; _Pragma("unroll") for(int r=0;r<16;++r)sacc+=pB1[r]; l_reg+=sacc;
    pw0=(u32x4){PKW(pB0,0),PKW(pB0,2),PKW(pB0,4),PKW(pB0,6)};pw1=(u32x4){PKW(pB0,8),PKW(pB0,10),PKW(pB0,12),PKW(pB0,14)};pw2=(u32x4){PKW(pB1,0),PKW(pB1,2),PKW(pB1,4),PKW(pB1,6)};pw3=(u32x4){PKW(pB1,8),PKW(pB1,10),PKW(pB1,12),PKW(pB1,14)};
    SBAR(); pv(o,vb0+sl_cur,PAF(0),PAF(1),PAF(2),PAF(3)); }
  #undef PKW
  #undef PAF
  #undef VFR
  #undef PIN
  #undef MX3
  #undef GAPA
  #undef GAPB
  #undef EX
  #undef VRD
  #undef KRD
  #undef STEP
  #undef ENDW
  {auto rr=__builtin_amdgcn_permlane32_swap(__float_as_uint(l_reg),__float_as_uint(l_reg),false,false);l_reg=__uint_as_float(rr[0])+__uint_as_float(rr[1]);}
  if(hi==0)wsf[32+r32]=l_reg;asm volatile("s_waitcnt lgkmcnt(0)":::"memory");
  float rli[16];
  #pragma unroll
  for(int r=0;r<16;++r)rli[r]=__builtin_amdgcn_rcpf(wsf[32+crow(r,hi)]);
  bf16*Ow=O+(qrow0+wid*QBLK)*QP+h*D;
  { bf16*stg=(bf16*)(shm+LDS_OST)+wid*2048;
    #pragma unroll
    for(int r=0;r<16;++r){const int orow=crow(r,hi);
      #pragma unroll
      for(int d0=0;d0<2;++d0)stg[orow*64+d0*32+r32]=__float2bfloat16(o[d0][r]*rli[r]);}
    asm volatile("s_waitcnt lgkmcnt(0)":::"memory");
    #pragma unroll
    for(int i=0;i<4;++i){const int row=i*8+(lane>>3),ch=lane&7; const u32x4 v=*(const u32x4*)(stg+row*64+ch*8); ATTN_STORE16(Ow+(long)row*QP+ch*8,mulgate(v,gvv[i]));} }
  asm volatile("s_waitcnt lgkmcnt(0)\n\ts_barrier":::"memory");
  #undef DMA_K
  #undef DMA_V
  #undef CMASK
  #undef START
  #undef RESC
  #undef ROT
}
constexpr int ATTN_LDS_BYTES=LDS_BYTES;
#undef SBAR
#undef WAIT_BAR
}

constexpr int NWAVES = 8;
constexpr int D = 1024, TP = 8192, TS = 2048, NB = 8;
constexpr int MP = NB * TP, MS = NB * TS, M = MP + MS;
constexpr int INW = 6656, PLE = 256;
constexpr float EPS = 1e-6f;
#ifndef MK_N_LAUNCHES
#define MK_N_LAUNCHES 1
#endif
constexpr int N_LAUNCHES = MK_N_LAUNCHES;
constexpr int N_PHASES = 8;

constexpr size_t MiB = 1u << 20;
constexpr size_t WS_CTL = 0, CTL_ZERO_BYTES = 64 * 1024;
constexpr size_t WS_R2 = 1 * MiB;
constexpr size_t WS_WIN = 2 * MiB;
constexpr size_t WS_WAB = 16 * MiB;
constexpr size_t WS_WO = 20 * MiB;
constexpr size_t WS_WG = 22 * MiB;
constexpr size_t WS_WPLE = 24 * MiB;
constexpr size_t WS_PBF = 26 * MiB;
constexpr size_t WS_RA = 80 * MiB;
constexpr size_t WS_RB = 240 * MiB;
constexpr size_t WS_RC = 400 * MiB;
constexpr size_t WS_RD = 560 * MiB;
constexpr size_t WS_RE = 720 * MiB;
constexpr size_t WS_RK = 880 * MiB;
constexpr size_t WS_RV = 920 * MiB;
constexpr size_t WS_END = 960 * MiB;

constexpr int RING_BYTES = 131072;
constexpr int LDS_BYTES = 147456;
constexpr int MISC_OFF = LDS_BYTES - 256;

#define GAS __attribute__((address_space(1)))
#define LAS __attribute__((address_space(3)))
typedef unsigned short bf16;
typedef unsigned v4u __attribute__((ext_vector_type(4)));
typedef unsigned v2u __attribute__((ext_vector_type(2)));
typedef float f32x4 __attribute__((ext_vector_type(4)));
#define LDS_WAIT() asm volatile("s_waitcnt lgkmcnt(0)" ::: "memory")
#define VM_WAIT() asm volatile("s_waitcnt vmcnt(0)" ::: "memory")
__device__ __forceinline__ unsigned pk2(float lo, float hi) { return pg8::cvt_pk_bf16(lo, hi); }
__device__ __forceinline__ float blo(unsigned w) { return __uint_as_float(w << 16); }
__device__ __forceinline__ float bhi(unsigned w) { return __uint_as_float(w & 0xffff0000u); }

#define XB_TMO      128
#define XB_XCNT(j)  (256  + 64 * (j))
#define XB_XSUB(j)  (1280 + 64 * (j))
#define XB_XGEN(j)  (2304 + 64 * (j))
#define XB_TOP      3328
#define XB_TOPGEN   3392
#define XCD_BAR_WORDS 3456
#define XB_SPIN_CAP (1u << 18)

__device__ __forceinline__ unsigned xb_ld(unsigned* p)              { return __hip_atomic_load(p, __ATOMIC_RELAXED, __HIP_MEMORY_SCOPE_AGENT); }
__device__ __forceinline__ unsigned xb_add(unsigned* p, unsigned v) { return __hip_atomic_fetch_add(p, v, __ATOMIC_RELAXED, __HIP_MEMORY_SCOPE_AGENT); }
__device__ __forceinline__ unsigned xb_xcc_id() { return (unsigned)__builtin_amdgcn_s_getreg((3 << 11) | 20) & 0xFu; }
#define XB_SPIN(cond, bar) do { unsigned _sp = 0; while (cond) { __builtin_amdgcn_s_sleep(1); \
    if ((++_sp & 255u) == 0u) { if (xb_ld(&(bar)[XB_TMO])) break; if (_sp > XB_SPIN_CAP) { atomicAdd(&(bar)[XB_TMO], 1u); break; } } } } while (0)

struct XcdBarrier {
    unsigned* bar; unsigned x;
    volatile LAS unsigned* st;
};

__device__ __forceinline__ XcdBarrier xcd_barrier_post(unsigned* bar, volatile LAS unsigned* st) {
    XcdBarrier b; b.bar = bar; b.x = xb_xcc_id(); b.st = st;
    if (threadIdx.x == 0) (void)xb_add(&bar[XB_XCNT(b.x)], 1u);
    return b;
}
__device__ __forceinline__ void xcd_barrier_complete(unsigned* bar, unsigned x, unsigned& nloc, unsigned& nx) {
    const unsigned G = gridDim.x * gridDim.y * gridDim.z;
    unsigned sum, cnt, mine, sp = 0u;
    for (;;) {
        sum = 0u; cnt = 0u; mine = 0u;
#pragma unroll
        for (unsigned j = 0; j < 16; ++j) { const unsigned c = xb_ld(&bar[XB_XCNT(j)]); sum += c; cnt += (c > 0u) ? 1u : 0u; mine = (j == x) ? c : mine; }
        if (sum == G) break;
        __builtin_amdgcn_s_sleep(1);
        if ((++sp & 255u) == 0u) { if (xb_ld(&bar[XB_TMO])) break; if (sp > XB_SPIN_CAP) { atomicAdd(&bar[XB_TMO], 1u); break; } }
    }
    nloc = mine > 0u ? mine : 1u; nx = cnt > 0u ? cnt : 1u;
}

__device__ __forceinline__ void xcd_barrier(const XcdBarrier& b) {
    asm volatile("s_waitcnt vmcnt(0)" ::: "memory");
    __syncthreads();
    if (threadIdx.x == 0) {
        unsigned* bar = b.bar;
        __builtin_amdgcn_s_waitcnt(0);
        unsigned nloc = b.st[0], nx = b.st[1];
        if (nloc == 0u) { xcd_barrier_complete(bar, b.x, nloc, nx); b.st[0] = nloc; b.st[1] = nx; }
        const unsigned old = xb_add(&bar[XB_XSUB(b.x)], 1u);
        const unsigned gen = old / nloc;
        if (old + 1u == (gen + 1u) * nloc) {
            __builtin_amdgcn_fence(__ATOMIC_RELEASE, "agent");
            asm volatile("s_waitcnt vmcnt(0)" ::: "memory");
            const unsigned og = xb_add(&bar[XB_TOP], 1u);
            const unsigned tg = og / nx;
            if (og + 1u == (tg + 1u) * nx) xb_add(&bar[XB_TOPGEN], 1u);
            else XB_SPIN(xb_ld(&bar[XB_TOPGEN]) == tg, bar);
            __builtin_amdgcn_fence(__ATOMIC_ACQUIRE, "agent");
            xb_add(&bar[XB_XGEN(b.x)], 1u);
            asm volatile("s_waitcnt vmcnt(0)" ::: "memory");
        } else {
            XB_SPIN(xb_ld(&bar[XB_XGEN(b.x)]) == gen, bar);
            __builtin_amdgcn_fence(__ATOMIC_ACQUIRE, "agent");
            asm volatile("s_waitcnt vmcnt(0)" ::: "memory");
        }
    }
    __syncthreads();
}

struct Args {
    const float *x_p, *x_s, *p_p, *p_s, *norm_pre, *w_in, *pool_w, *pool_scale, *w_a, *q_norm, *k_norm, *w_b, *w_out, *norm_post, *ple_norm, *w_gate, *w_ple;
    float* out; unsigned char* ws; int ph_lo, ph_hi;
};

__device__ __forceinline__ float wave_sum(float v) {
#pragma unroll
    for (int o = 1; o < 64; o <<= 1) v += __shfl_xor(v, o);
    return v;
}
__device__ __forceinline__ void p0_transpose_item(const float* W, int K, int N, bf16* WT, int row_off, int ldt, int koff, LAS float* scr, int item, int lane, const float* kscale = nullptr) {
    const int nblk = N / 32, kb = item / nblk, nb = item % nblk, k0 = 64 * kb, n0 = 32 * nb;
#pragma unroll 8
    for (int i = 0; i < 32; ++i) { const int kk = 2 * i + (lane >> 5); float wv = W[(size_t)(k0 + kk) * N + n0 + (lane & 31)]; if (kscale) wv *= kscale[k0 + kk]; scr[kk * 33 + (lane & 31)] = wv; }
    LDS_WAIT(); asm volatile("" ::: "memory");
    const int c = lane & 7;
#pragma unroll
    for (int j = 0; j < 4; ++j) { const int n = (lane >> 3) + 8 * j; const LAS float* s = scr + (8 * c) * 33 + n;
        v4u o; o.x = pk2(s[0 * 33], s[1 * 33]); o.y = pk2(s[2 * 33], s[3 * 33]); o.z = pk2(s[4 * 33], s[5 * 33]); o.w = pk2(s[6 * 33], s[7 * 33]);
        *(GAS v4u*)(WT + (size_t)(row_off + n0 + n) * ldt + koff + k0 + 8 * c) = o; }
    LDS_WAIT(); asm volatile("" ::: "memory");
}
__device__ __forceinline__ const float* xrow_ptr(const Args& a, int m) { return m < MP ? a.x_p + (size_t)m * D : a.x_s + (size_t)(m - MP) * D; }

__device__ __forceinline__ void phase0(const Args& a, LAS unsigned char* lds, int vcu, int G) {
    int tid = threadIdx.x; asm volatile("" : "+v"(tid));
    const int lane = tid & 63, wave = __builtin_amdgcn_readfirstlane(tid >> 6);
    LAS float* scr = (LAS float*)(lds + wave * 16384);
    const int gw = vcu * NWAVES + wave, NGW = G * NWAVES;
    unsigned char* ws = a.ws;
    {
        LAS float* At = (LAS float*)lds; LAS float* Bt = (LAS float*)(lds + 64 * 257 * 4 + 64);
        bf16* WT = (bf16*)(ws + WS_WIN);
        for (int tile = vcu; tile < 256; tile += G) {
            const int kb = tile >> 4, g = (tile >> 2) & 3, db = tile & 3, k0 = 64 * kb, d0 = 64 * db;
#pragma unroll
            for (int i = 0; i < 8; ++i) { const int row = (tid >> 6) + 8 * i, c4 = tid & 63;
                const f32x4 v = *(const GAS f32x4*)(a.w_in + (size_t)(k0 + row) * INW + g * 256 + 4 * c4);
                LAS float* d = At + row * 257 + 4 * c4; d[0] = v.x; d[1] = v.y; d[2] = v.z; d[3] = v.w; }
#pragma unroll
            for (int i = 0; i < 8; ++i) { const int c = (tid >> 4) + 32 * i, c4 = tid & 15;
                *(LAS f32x4*)(Bt + c * 64 + 4 * c4) = *(const GAS f32x4*)(a.pool_w + (size_t)g * 65536 + (size_t)c * 256 + d0 + 4 * c4); }
            __syncthreads();
            float acc[8];
#pragma unroll
            for (int j = 0; j < 8; ++j) acc[j] = 0.f;
#pragma unroll 4
            for (int c = 0; c < 256; ++c) { const float av = At[lane * 257 + c]; const f32x4 b0 = *(const LAS f32x4*)(Bt + c * 64 + wave * 8), b1 = *(const LAS f32x4*)(Bt + c * 64 + wave * 8 + 4);
                acc[0] += av * b0.x; acc[1] += av * b0.y; acc[2] += av * b0.z; acc[3] += av * b0.w; acc[4] += av * b1.x; acc[5] += av * b1.y; acc[6] += av * b1.z; acc[7] += av * b1.w; }
#pragma unroll
            for (int j = 0; j < 8; ++j) WT[(size_t)(g * 256 + d0 + wave * 8 + j) * D + k0 + lane] = (bf16)(pk2(acc[j], 0.f) & 0xffffu);
            __syncthreads();
        }
    }
    constexpr int I_IN = (D / 64) * ((INW - 1024) / 32), I_SQ = (D / 64) * (D / 32), I_PLE = (PLE / 64) * (D / 32);
    constexpr int NITEMS = I_IN + 4 * I_SQ + I_PLE;
    for (int it = gw; it < NITEMS; it += NGW) {
        int r = it;
        if (r < I_IN) { const int kb = r / 176, nb = 32 + r % 176; const int n0 = 32 * nb; int roff = 0;
            if (n0 >= 4608) { const int c = (n0 - 4608) & 1023, isb = (n0 - 4608) >> 10; roff = 4608 + 256 * (c >> 7) + 128 * isb + (c & 127) - n0; }
            p0_transpose_item(a.w_in, D, INW, (bf16*)(ws + WS_WIN), roff, D, 0, scr, kb * (INW / 32) + nb, lane); continue; } r -= I_IN;
        if (r < I_SQ) { p0_transpose_item(a.w_a, D, D, (bf16*)(ws + WS_WAB), 0, 2048, 0, scr, r, lane); continue; } r -= I_SQ;
        if (r < I_SQ) { p0_transpose_item(a.w_b, D, D, (bf16*)(ws + WS_WAB), 0, 2048, 1024, scr, r, lane); continue; } r -= I_SQ;
        if (r < I_SQ) { p0_transpose_item(a.w_out, D, D, (bf16*)(ws + WS_WO), 0, D, 0, scr, r, lane); continue; } r -= I_SQ;
        if (r < I_SQ) { p0_transpose_item(a.w_gate, D, D, (bf16*)(ws + WS_WG), 0, D, 0, scr, r, lane, a.ple_norm); continue; } r -= I_SQ;
        p0_transpose_item(a.w_ple, PLE, D, (bf16*)(ws + WS_WPLE), 0, PLE, 0, scr, r, lane);
    }
    f32x4 gpre[4];
#pragma unroll
    for (int j = 0; j < 4; ++j) gpre[j] = ((const GAS f32x4*)a.norm_pre)[lane + 64 * j];
    bf16* H = (bf16*)(ws + WS_RA); bf16* PB = (bf16*)(ws + WS_PBF);
    for (int m = gw; m < M; m += NGW) {
        const GAS f32x4* xr = (const GAS f32x4*)xrow_ptr(a, m) + lane;
        f32x4 v[4]; float s = 0.f;
#pragma unroll
        for (int j = 0; j < 4; ++j) { v[j] = xr[64 * j]; s += (v[j].x * v[j].x + v[j].y * v[j].y) + (v[j].z * v[j].z + v[j].w * v[j].w); }
        const float rstd = 1.0f / sqrtf(wave_sum(s) * (1.f / D) + EPS);
        GAS v2u* o8 = (GAS v2u*)(H + (size_t)m * D) + lane;
#pragma unroll
        for (int j = 0; j < 4; ++j) { const f32x4 y = v[j] * rstd * gpre[j]; o8[64 * j] = (v2u){pk2(y.x, y.y), pk2(y.z, y.w)}; }
        const float* prow = m < MP ? a.p_p + (size_t)m * PLE : a.p_s + (size_t)(m - MP) * PLE;
        const f32x4 pv = ((const GAS f32x4*)prow)[lane];
        ((GAS v2u*)(PB + (size_t)m * PLE))[lane] = (v2u){pk2(pv.x, pv.y), pk2(pv.z, pv.w)};
    }
}

__device__ __forceinline__ void normrope16(bf16* ptr, int t, int qd, const float* gain, float scale) {
    const v4u w0 = ((const GAS v4u*)ptr)[0], w1 = ((const GAS v4u*)ptr)[1];
    float av[16];
    av[0] = blo(w0.x); av[1] = bhi(w0.x); av[2] = blo(w0.y); av[3] = bhi(w0.y); av[4] = blo(w0.z); av[5] = bhi(w0.z); av[6] = blo(w0.w); av[7] = bhi(w0.w);
    av[8] = blo(w1.x); av[9] = bhi(w1.x); av[10] = blo(w1.y); av[11] = bhi(w1.y); av[12] = blo(w1.z); av[13] = bhi(w1.z); av[14] = blo(w1.w); av[15] = bhi(w1.w);
    float ss = 0.f;
#pragma unroll
    for (int i = 0; i < 16; ++i) ss += av[i] * av[i];
    ss += __shfl_xor(ss, 1); ss += __shfl_xor(ss, 2);
    const float rstd = 1.0f / sqrtf(ss * (1.f / 64.f) + EPS);
    const float pos = (qd < 2) ? (float)(t >> 6) : (float)(t & 63);
    const float sgn = (qd & 1) ? 1.f : -1.f;
    float o[16];
#pragma unroll
    for (int i4 = 0; i4 < 4; ++i4) { const f32x4 g = ((const GAS f32x4*)(gain + qd * 16))[i4];
        av[4 * i4 + 0] *= rstd * g.x; av[4 * i4 + 1] *= rstd * g.y; av[4 * i4 + 2] *= rstd * g.z; av[4 * i4 + 3] *= rstd * g.w; }
#pragma unroll
    for (int i = 0; i < 16; ++i) {
        const float pr = __shfl_xor(av[i], 1);
        const float freq = __builtin_amdgcn_exp2f(-(float)i * 0.83048202372184058696f);
        float rev = pos * freq * 0.15915494309189533577f; rev = __builtin_amdgcn_fractf(rev);
        const float sn = __builtin_amdgcn_sinf(rev), cs = __builtin_amdgcn_cosf(rev);
        o[i] = (av[i] * cs + sgn * pr * sn) * scale;
    }
    v4u r0, r1;
    r0.x = pk2(o[0], o[1]); r0.y = pk2(o[2], o[3]); r0.z = pk2(o[4], o[5]); r0.w = pk2(o[6], o[7]);
    r1.x = pk2(o[8], o[9]); r1.y = pk2(o[10], o[11]); r1.z = pk2(o[12], o[13]); r1.w = pk2(o[14], o[15]);
    ((GAS v4u*)ptr)[0] = r0; ((GAS v4u*)ptr)[1] = r1;
}
__device__ __forceinline__ int tok_of_row(int m) { return m < MP ? (m & (TP - 1)) : (m & (TS - 1)); }
__device__ __forceinline__ void phase2(const Args& a, int vcu, int G) {
    int tid = threadIdx.x; asm volatile("" : "+v"(tid));
    const int lane = tid & 63, wave = __builtin_amdgcn_readfirstlane(tid >> 6);
    bf16* K = (bf16*)(a.ws + WS_RK);
    const int gw = vcu * NWAVES + wave, NGW = G * NWAVES;
    for (int m4 = gw; m4 < M / 4; m4 += NGW) { const int m = m4 * 4 + (lane >> 4); normrope16(K + (size_t)m * 256 + (lane & 15) * 16, tok_of_row(m), lane & 3, a.k_norm, 1.0f); }
}
template <int W> __device__ __forceinline__ void pool_item(const bf16* Z, const bf16* SZA, bf16* AO, const float* pscale, int g, int rb, int cc, int rsub) {
    const f32x4 ps0 = *(const GAS f32x4*)(pscale + g * 256 + cc * 8), ps1 = *(const GAS f32x4*)(pscale + g * 256 + cc * 8 + 4);
    constexpr int half = W / 2;
#pragma unroll 1
    for (int rr = 0; rr < 4; ++rr) {
        const int m = rb * 64 + rr * 16 + rsub;
        const int T = m < MP ? TP : TS, s0 = m < MP ? (m & ~(TP - 1)) : (m & ~(TS - 1)), t = m - s0;
        const bf16* colp = Z + (size_t)s0 * D + g * 256 + cc * 8;
        v4u wv[W];
#pragma unroll
        for (int i = 0; i < W; ++i) { const int sidx = t - half + i; const int sc = min(max(sidx, 0), T - 1); wv[i] = *(const GAS v4u*)(colp + (size_t)sc * D); }
        const v4u gz = *(const GAS v4u*)(SZA + (size_t)m * D + g * 256 + cc * 8);
        float acc[8];
#pragma unroll
        for (int e = 0; e < 8; ++e) acc[e] = 0.f;
#pragma unroll
        for (int i = 0; i < W; ++i) { const int sidx = t - half + i; const float wgt = (sidx >= 0 && sidx < T) ? 1.f : 0.f; const v4u w = wv[i];
            acc[0] += wgt * blo(w.x); acc[1] += wgt * bhi(w.x); acc[2] += wgt * blo(w.y); acc[3] += wgt * bhi(w.y); acc[4] += wgt * blo(w.z); acc[5] += wgt * bhi(w.z); acc[6] += wgt * blo(w.w); acc[7] += wgt * bhi(w.w); }
        const v4u own = wv[half];
        const int lo = max(t - half, 0), hi = min(t + half, T);
        const float inv = 1.0f / (float)(hi - lo);
        v4u o; o.x = pk2((acc[0] * inv - blo(own.x)) * ps0.x * blo(gz.x), (acc[1] * inv - bhi(own.x)) * ps0.y * bhi(gz.x));
        o.y = pk2((acc[2] * inv - blo(own.y)) * ps0.z * blo(gz.y), (acc[3] * inv - bhi(own.y)) * ps0.w * bhi(gz.y));
        o.z = pk2((acc[4] * inv - blo(own.z)) * ps1.x * blo(gz.z), (acc[5] * inv - bhi(own.z)) * ps1.y * bhi(gz.z));
        o.w = pk2((acc[6] * inv - blo(own.w)) * ps1.z * blo(gz.w), (acc[7] * inv - bhi(own.w)) * ps1.w * bhi(gz.w));
        *(GAS v4u*)(AO + (size_t)m * D + g * 256 + cc * 8) = o;
    }
}
__device__ __forceinline__ void pool_tail(const Args& a, int vcu, int G) {
    int tid = threadIdx.x; asm volatile("" : "+v"(tid));
    unsigned char* ws = a.ws;
    const bf16* Z = (const bf16*)(ws + WS_RB); const bf16* SZA = (const bf16*)(ws + WS_RC); bf16* AO = (bf16*)(ws + WS_RA);
    const int cc = tid & 31, rsub = tid >> 5;
    for (int it = vcu; it < (M / 64) * 4; it += G) {
        const int g = it & 3, rb = it >> 2;
        if (g == 0) pool_item<2>(Z, SZA, AO, a.pool_scale, g, rb, cc, rsub);
        else if (g == 1) pool_item<4>(Z, SZA, AO, a.pool_scale, g, rb, cc, rsub);
        else if (g == 2) pool_item<8>(Z, SZA, AO, a.pool_scale, g, rb, cc, rsub);
        else pool_item<16>(Z, SZA, AO, a.pool_scale, g, rb, cc, rsub);
    }
}

__device__ __forceinline__ void phase6(const Args& a, int vcu, int G) {
    int tid = threadIdx.x; asm volatile("" : "+v"(tid));
    const int lane = tid & 63, wave = __builtin_amdgcn_readfirstlane(tid >> 6);
    unsigned char* ws = a.ws;
    const bf16* Y = (const bf16*)(ws + WS_RA); bf16* X1 = (bf16*)(ws + WS_RB); float* R2 = (float*)(ws + WS_R2);
    const int gw = vcu * NWAVES + wave, NGW = G * NWAVES;
    f32x4 gpost[4];
#pragma unroll
    for (int j = 0; j < 4; ++j) gpost[j] = ((const GAS f32x4*)a.norm_post)[lane + 64 * j];
    for (int m = gw; m < M; m += NGW) {
        const GAS f32x4* xr = (const GAS f32x4*)xrow_ptr(a, m) + lane;
        const GAS v2u* yr = (const GAS v2u*)(Y + (size_t)m * D) + lane;
        f32x4 xv[4], yv[4]; float s = 0.f;
#pragma unroll
        for (int j = 0; j < 4; ++j) { xv[j] = xr[64 * j]; const v2u w = yr[64 * j]; yv[j] = (f32x4){blo(w.x), bhi(w.x), blo(w.y), bhi(w.y)};
            s += (yv[j].x * yv[j].x + yv[j].y * yv[j].y) + (yv[j].z * yv[j].z + yv[j].w * yv[j].w); }
        const float rstd = 1.0f / sqrtf(wave_sum(s) * (1.f / D) + EPS);
        float s2 = 0.f;
        GAS v2u* o8 = (GAS v2u*)(X1 + (size_t)m * D) + lane;
#pragma unroll
        for (int j = 0; j < 4; ++j) { xv[j] = xv[j] + yv[j] * rstd * gpost[j]; o8[64 * j] = (v2u){pk2(xv[j].x, xv[j].y), pk2(xv[j].z, xv[j].w)};
            s2 += (xv[j].x * xv[j].x + xv[j].y * xv[j].y) + (xv[j].z * xv[j].z + xv[j].w * xv[j].w); }
        const float rstd2 = 1.0f / sqrtf(wave_sum(s2) * (1.f / D) + EPS);
        if (lane == 0) R2[m] = rstd2;
    }
}

__device__ __forceinline__ bool attn_next(int i, int vcu, int G, long& qrow0, long& kvrow0, int& NT, int& h) {
    int samp, b, qb;
    if (G == 256) {
        if (i >= 20) return false;
        const int x = vcu >> 5, j = vcu & 31; b = x;
        if (i < 16) { samp = 0; h = (i >> 2) * 4 + (i & 3); qb = j; }
        else { samp = 1; h = (i - 16) * 4 + (j >> 3); qb = j & 7; }
    } else {
        const int uid = vcu + i * G; if (uid >= 5120) return false;
        if (uid < 4096) { samp = 0; b = uid >> 9; h = (uid >> 5) & 15; qb = uid & 31; }
        else { const int r = uid - 4096; samp = 1; b = r >> 7; h = (r >> 3) & 15; qb = r & 7; }
    }
    if (!samp) { kvrow0 = (long)b * TP; NT = TP / 64; } else { kvrow0 = (long)MP + (long)b * TS; NT = TS / 64; }
    qrow0 = kvrow0 + qb * 256;
    return true;
}

__global__ void __launch_bounds__(NWAVES * 64, 2) fwd_megakernel(Args args) {
    extern __shared__ __attribute__((aligned(16))) unsigned char lds_raw[];
    LAS unsigned char* lds = (LAS unsigned char*)lds_raw;
    const int G = gridDim.x; const int bx = blockIdx.x; const int vcu = (G % 8 == 0) ? (bx % 8) * (G / 8) + bx / 8 : bx;
    cg::grid_group grid = cg::this_grid();
    unsigned char* ws = args.ws;
    const int lo = args.ph_lo, hi = args.ph_hi;
#ifndef PH_MASK
#define PH_MASK 0xFF
#endif
#define IN(k) ((((PH_MASK) >> (k)) & 1) && lo <= (k) && (k) < hi)
#ifndef DUP_MASK
#define DUP_MASK 0
#endif
#define REPS(k) ((((DUP_MASK) >> (k)) & 1) ? 2 : 1)
#define SEAM(k) do { if (IN(k) && IN((k) + 1)) { if ((k) == 0) { VM_WAIT(); grid.sync(); VM_WAIT(); } else { xcd_barrier(bar); } } } while (0)
    volatile LAS unsigned* MISC = (volatile LAS unsigned*)(lds + MISC_OFF);
    if (threadIdx.x < 32) MISC[threadIdx.x] = 0u;
    __syncthreads();
    XcdBarrier bar = xcd_barrier_post((unsigned*)(ws + WS_CTL), MISC);
    bf16* RA = (bf16*)(ws + WS_RA); bf16* RB = (bf16*)(ws + WS_RB); bf16* RC = (bf16*)(ws + WS_RC); bf16* RD = (bf16*)(ws + WS_RD); bf16* RE = (bf16*)(ws + WS_RE);
    bf16* RK = (bf16*)(ws + WS_RK); bf16* RV = (bf16*)(ws + WS_RV);
    bf16* MA = (bf16*)args.out; bf16* MB = (bf16*)args.out + (size_t)M * D;

    if (IN(0)) { for (int rep = 0; rep < REPS(0); ++rep) phase0(args, lds, vcu, G); }
    SEAM(0);
    if (IN(1)) for (int rep = 0; rep < REPS(1); ++rep) {
        pg8::Gemm g{RA, RA, (const bf16*)(ws + WS_WIN), D, D, D, D, 0};
        pg8::StaticOrder S; S.init(M, INW, G, bx);
        pg8::EpiIn E{RB, RC, RD, RK, RV, RE, MA, MB};
        pg8::gemm_phase<pg8::EpiIn, pg8::StaticOrder, true, true>(lds, g, S, E);
    }
    SEAM(1);
    if (IN(2)) { phase2(args, vcu, G); }
    SEAM(2);
    if (IN(3)) {
        long qrow0, kvrow0; int NT, h;
        bool track;
        { const int ln = threadIdx.x & 63; float mq = fabsf(args.q_norm[ln]), mk = fabsf(args.k_norm[ln]);
#pragma unroll
          for (int o = 1; o < 64; o <<= 1) { mq = fmaxf(mq, __shfl_xor(mq, o)); mk = fmaxf(mk, __shfl_xor(mk, o)); }
          track = __builtin_amdgcn_readfirstlane((mq * mk <= 2.6f) ? 0 : 1) != 0; }
        for (int rep = 0; rep < REPS(3); ++rep)
        for (int i = 0; attn_next(i, vcu, G, qrow0, kvrow0, NT, h); ++i)
            { if (track) attn_body::attn_unit<8, true>(qrow0, kvrow0, NT, h, (const attn_body::bf16*)RD, (const attn_body::bf16*)RK, (const attn_body::bf16*)RV, (attn_body::bf16*)RD, (const attn_body::bf16*)RE, args.q_norm, (char*)lds_raw);
              else attn_body::attn_unit<8, false>(qrow0, kvrow0, NT, h, (const attn_body::bf16*)RD, (const attn_body::bf16*)RK, (const attn_body::bf16*)RV, (attn_body::bf16*)RD, (const attn_body::bf16*)RE, args.q_norm, (char*)lds_raw); }
        for (int rep = 0; rep < REPS(8); ++rep) pool_tail(args, vcu, G);
    }
    SEAM(3);
    if (IN(4)) {
        pg8::Gemm g{RA, RD, (const bf16*)(ws + WS_WAB), D, 2048, 2048, 1024, 0};
        pg8::DupOrder S; S.init(M, D, G, bx, REPS(4));
        pg8::EpiMerge E{RC, MA, MB};
        pg8::gemm_phase<pg8::EpiMerge, pg8::DupOrder, true, true>(lds, g, S, E);
    }
    SEAM(4);
    if (IN(5)) {
        { pg8::Gemm g{RC, RC, (const bf16*)(ws + WS_WO), D, D, D, D, 0};
          pg8::DupOrder S; S.init(M, D, G, bx, REPS(5));
          pg8::EpiPlain E{RA, D};
          pg8::gemm_phase<pg8::EpiPlain, pg8::DupOrder, true, true>(lds, g, S, E); }
        { pg8::Gemm g{(const bf16*)(ws + WS_PBF), (const bf16*)(ws + WS_PBF), (const bf16*)(ws + WS_WPLE), PLE, PLE, PLE, PLE, 0};
          pg8::DupOrder S; S.init(M, D, G, bx, REPS(9));
          pg8::EpiPlain E{RD, D};
          pg8::gemm_phase<pg8::EpiPlain, pg8::DupOrder, true, true>(lds, g, S, E); }
    }
    SEAM(5);
    if (IN(6)) { for (int rep = 0; rep < REPS(6); ++rep) phase6(args, vcu, G); }
    SEAM(6);
    if (IN(7)) {
        pg8::Gemm g{RB, RB, (const bf16*)(ws + WS_WG), D, D, D, D, 0};
        pg8::StaticOrder S; S.init(M, D, G, bx);
        pg8::EpiFinal E{args.out, RB, RD, (const float*)(ws + WS_R2)};
        pg8::gemm_phase<pg8::EpiFinal, pg8::StaticOrder, true, true>(lds, g, S, E);
    }
#undef IN
#undef SEAM
}

extern "C" void kernel_launch(void* const* d_in, const int* in_sizes, int n_in, void* d_out, int out_size, void* d_ws, size_t ws_size, hipStream_t stream) {
    static int grid = 0;
    if (grid == 0) {
        if (n_in != 17 || in_sizes[0] != MP * D || in_sizes[1] != MS * D || out_size != M * D || ws_size < WS_END) {
            fprintf(stderr, "kernel_launch: unexpected shapes (n_in %d, in0 %d, out %d, ws %zu); nothing launched\n", n_in, n_in > 0 ? in_sizes[0] : -1, out_size, ws_size); grid = -1; return; }
        int dev = 0, cus = 0, per_cu = 0;
        if (hipGetDevice(&dev) != hipSuccess || hipDeviceGetAttribute(&cus, hipDeviceAttributeMultiprocessorCount, dev) != hipSuccess) { fprintf(stderr, "kernel_launch: device query failed\n"); grid = -1; return; }
        if (hipFuncSetAttribute((const void*)fwd_megakernel, hipFuncAttributeMaxDynamicSharedMemorySize, LDS_BYTES) != hipSuccess) { fprintf(stderr, "kernel_launch: hipFuncSetAttribute failed\n"); grid = -1; return; }
        if (hipOccupancyMaxActiveBlocksPerMultiprocessor(&per_cu, (const void*)fwd_megakernel, NWAVES * 64, LDS_BYTES) != hipSuccess || per_cu < 1) { fprintf(stderr, "kernel_launch: occupancy query says %d\n", per_cu); per_cu = 1; }
        (void)hipGetLastError();
        grid = cus * 1;
        (void)per_cu;
    }
    if (grid < 0) return;
    if (hipMemsetAsync((char*)d_ws + WS_CTL, 0, CTL_ZERO_BYTES, stream) != hipSuccess) { fprintf(stderr, "kernel_launch: memset of control words failed\n"); return; }
    Args a{};
    a.x_p = (const float*)d_in[0]; a.x_s = (const float*)d_in[1]; a.p_p = (const float*)d_in[2]; a.p_s = (const float*)d_in[3]; a.norm_pre = (const float*)d_in[4];
    a.w_in = (const float*)d_in[5]; a.pool_w = (const float*)d_in[6]; a.pool_scale = (const float*)d_in[7]; a.w_a = (const float*)d_in[8]; a.q_norm = (const float*)d_in[9];
    a.k_norm = (const float*)d_in[10]; a.w_b = (const float*)d_in[11]; a.w_out = (const float*)d_in[12]; a.norm_post = (const float*)d_in[13]; a.ple_norm = (const float*)d_in[14];
    a.w_gate = (const float*)d_in[15]; a.w_ple = (const float*)d_in[16];
    a.out = (float*)d_out; a.ws = (unsigned char*)d_ws;
    if (N_LAUNCHES == 1) {
        a.ph_lo = 0; a.ph_hi = N_PHASES;
        void* kargs[] = {&a};
        hipError_t e = hipLaunchCooperativeKernel((const void*)fwd_megakernel, dim3(grid), dim3(NWAVES * 64), kargs, LDS_BYTES, stream);
        if (e != hipSuccess) fprintf(stderr, "kernel_launch: cooperative launch failed: %s (grid %d)\n", hipGetErrorString(e), grid);
    } else {
        for (int ph = 0; ph < N_PHASES; ++ph) {
            a.ph_lo = ph; a.ph_hi = ph + 1;
            hipLaunchKernelGGL(fwd_megakernel, dim3(grid), dim3(NWAVES * 64), LDS_BYTES, stream, a);
        }
    }
}
```

```cpp
#include <hip/hip_runtime.h>
#include <hip/hip_cooperative_groups.h>
#include <hip/hip_bf16.h>
#include <cstdio>
#include <cstdint>
#include <cmath>
namespace cg = cooperative_groups;

namespace pg8 {
#define PG8_LAS __attribute__((address_space(3)))
typedef unsigned short bf16_t;
typedef short bf16x8 __attribute__((ext_vector_type(8)));
typedef float f32x4 __attribute__((ext_vector_type(4)));
typedef unsigned u32x4 __attribute__((ext_vector_type(4)));
constexpr int BM = 256, BK = 64, HALF = 128, HTB = HALF * BK * 2  , STAGE_BYTES = 8 * HTB, NXCD = 8, WGM = 8;

__host__ __device__ __forceinline__ int lds_byte(int r, int c) { const int st = (r >> 4) * 2 + (c >> 5), rr = r & 15, cc = c & 31, ob = rr * 64 + cc * 2; return st * 1024 + (ob ^ (((ob >> 9) & 1) << 5)); }
__host__ __device__ __forceinline__ void stage_rc(int b, int& R, int& C) { const int st = b / 1024, sb = b % 1024, swz = sb ^ (((sb >> 9) & 1) << 5); R = (st >> 1) * 16 + swz / 64; C = (st & 1) * 32 + (swz % 64) / 2; }
__host__ __device__ __forceinline__ int perm32(int rho) { const int n = rho >> 4, i = rho & 15; return 8 * (i >> 2) + 4 * n + (i & 3); }

struct Unit { int pm, pn; };
struct Gemm { const bf16_t* A; const bf16_t* A2; const bf16_t* Bt; int lda, ldb, K, K1; size_t a_pn_off; };

struct StaticOrder {
    int nM, nN, nwg, G, c;
    __host__ __device__ void init(int M, int N, int G_, int c_) { nM = M / BM; nN = N / BM; nwg = nM * nN; G = G_; c = c_; }
    __host__ __device__ bool next(int i, Unit& u) const {
        const long L = (long)i * G + c; if (L >= nwg) return false;
        int wgid = (int)L; { const int q = nwg / NXCD, r = nwg % NXCD, xcd = wgid % NXCD, off = wgid / NXCD; wgid = (xcd < r ? xcd * (q + 1) : r * (q + 1) + (xcd - r) * q) + off; }
        const int nig = WGM * nN, gid = wgid / nig, fm = gid * WGM, gsz = (nM - fm) < WGM ? (nM - fm) : WGM;
        u.pm = fm + ((wgid % nig) % gsz); u.pn = (wgid % nig) / gsz; return true;
    }
    __device__ __forceinline__ void a_ready(const Unit&) const {}
    __device__ __forceinline__ void done(const Unit&) const {}
};

__device__ __forceinline__ unsigned cvt_pk_bf16(float lo, float hi) { unsigned r; asm volatile("v_cvt_pk_bf16_f32 %0, %1, %2" : "=v"(r) : "v"(lo), "v"(hi)); return r; }
__device__ __forceinline__ float bf_lo(unsigned w) { return __uint_as_float(w << 16); }
__device__ __forceinline__ float bf_hi(unsigned w) { return __uint_as_float(w & 0xffff0000u); }
__device__ __forceinline__ float fsigmoid(float x) { return __builtin_amdgcn_rcpf(1.0f + __builtin_amdgcn_exp2f(-1.4426950408889634f * x)); }
__device__ __forceinline__ float fsilu(float x) { return x * fsigmoid(x); }
__device__ __forceinline__ u32x4 pack8(const f32x4& v0, const f32x4& v1) { u32x4 w; w.x = cvt_pk_bf16(v0[0], v0[1]); w.y = cvt_pk_bf16(v0[2], v0[3]); w.z = cvt_pk_bf16(v1[0], v1[1]); w.w = cvt_pk_bf16(v1[2], v1[3]); return w; }
__device__ __forceinline__ void unpack8(const u32x4& w, f32x4& v0, f32x4& v1) { v0 = (f32x4){bf_lo(w.x), bf_hi(w.x), bf_lo(w.y), bf_hi(w.y)}; v1 = (f32x4){bf_lo(w.z), bf_hi(w.z), bf_lo(w.w), bf_hi(w.w)}; }

struct EpiIn {
    static constexpr bool PERM = true, AFTER_DRAIN = false, MID = false;
    bf16_t *ua, *sza, *q, *k, *v, *szb, *ma, *mb;
    __device__ __forceinline__ void operator()(const f32x4 (&acc)[2][2][4][2], const Unit& u, int wr, int wc, int fr, int fq) const {
        const int pn = u.pn; bf16_t* base; int ldc = 1024, ct; bool act = false;
        if (pn < 4) { base = ua; ct = pn; }
        else if (pn < 8) { base = sza; ct = pn - 4; act = true; }
        else if (pn < 12) { base = q; ct = pn - 8; }
        else if (pn == 12) { base = k; ct = 0; ldc = 256; }
        else if (pn == 13) { base = v; ct = 0; ldc = 256; }
        else if (pn < 18) { base = szb; ct = pn - 14; act = true; }
        else {
            int row0 = u.pm * BM + wr * 64 + fr, col0 = (pn - 18) * HALF + wc * 32 + 8 * fq; asm volatile("" : "+v"(row0), "+v"(col0));
#pragma unroll
            for (int ai = 0; ai < 2; ++ai)
#pragma unroll
                for (int m = 0; m < 4; ++m) { const size_t off = (size_t)(row0 + ai * HALF + m * 16) * 1024 + col0; f32x4 r0, r1, s0, s1;
#pragma unroll
                    for (int e = 0; e < 4; ++e) {
                        const float ea0 = __builtin_amdgcn_exp2f(-1.4426950408889634f * acc[ai][0][m][0][e]), ea1 = __builtin_amdgcn_exp2f(-1.4426950408889634f * acc[ai][0][m][1][e]);
                        const float eb0 = __builtin_amdgcn_exp2f(-1.4426950408889634f * fmaxf(acc[ai][1][m][0][e], -60.f)), eb1 = __builtin_amdgcn_exp2f(-1.4426950408889634f * fmaxf(acc[ai][1][m][1][e], -60.f));
                        s0[e] = __builtin_amdgcn_rcpf(1.0f + eb0); s1[e] = __builtin_amdgcn_rcpf(1.0f + eb1);
                        r0[e] = (1.0f + eb0) * __builtin_amdgcn_rcpf(1.0f + ea0); r1[e] = (1.0f + eb1) * __builtin_amdgcn_rcpf(1.0f + ea1); }
                    *(u32x4*)(ma + off) = pack8(r0, r1); *(u32x4*)(mb + off) = pack8(s0, s1); }
            return; }
        int row0 = u.pm * BM + wr * 64 + fr, col0 = ct * BM + wc * 32 + 8 * fq; asm volatile("" : "+v"(row0), "+v"(col0));
#pragma unroll
        for (int ai = 0; ai < 2; ++ai)
#pragma unroll
            for (int m = 0; m < 4; ++m) { bf16_t* rowp = base + (size_t)(row0 + ai * HALF + m * 16) * ldc + col0;
#pragma unroll
                for (int bj = 0; bj < 2; ++bj) { f32x4 v0 = acc[ai][bj][m][0], v1 = acc[ai][bj][m][1];
                    if (act) {
#pragma unroll
                        for (int e = 0; e < 4; ++e) { v0[e] = fsilu(v0[e]); v1[e] = fsilu(v1[e]); } }
                    *(u32x4*)(rowp + bj * HALF) = pack8(v0, v1); } }
    }
};
struct EpiPlain {
    static constexpr bool PERM = true, AFTER_DRAIN = false, MID = false;
    bf16_t* O; int ldc;
    __device__ __forceinline__ void operator()(const f32x4 (&acc)[2][2][4][2], const Unit& u, int wr, int wc, int fr, int fq) const {
        int row0 = u.pm * BM + wr * 64 + fr, col0 = u.pn * BM + wc * 32 + 8 * fq; asm volatile("" : "+v"(row0), "+v"(col0));
#pragma unroll
        for (int ai = 0; ai < 2; ++ai)
#pragma unroll
            for (int m = 0; m < 4; ++m) { bf16_t* rowp = O + (size_t)(row0 + ai * HALF + m * 16) * ldc + col0;
#pragma unroll
                for (int bj = 0; bj < 2; ++bj) *(u32x4*)(rowp + bj * HALF) = pack8(acc[ai][bj][m][0], acc[ai][bj][m][1]); }
    }
};
struct EpiMerge {
    static constexpr bool PERM = true, AFTER_DRAIN = false, MID = true;
    bf16_t* O; const bf16_t* rt; const bf16_t* sb;
    __device__ __forceinline__ void mid(f32x4 (&acc)[2][2][4][2], const Unit& u, int wr, int wc, int fr, int fq) const {
        int row0 = u.pm * BM + wr * 64 + fr, col0 = u.pn * BM + wc * 32 + 8 * fq;
        asm volatile("" : "+v"(row0), "+v"(col0));
#pragma unroll
        for (int ai = 0; ai < 2; ++ai) {
            u32x4 rw[4][2];
#pragma unroll
            for (int m = 0; m < 4; ++m) { const size_t off = (size_t)(row0 + ai * HALF + m * 16) * 1024 + col0;
#pragma unroll
                for (int bj = 0; bj < 2; ++bj) rw[m][bj] = *(const u32x4*)(rt + off + bj * HALF); }
#pragma unroll
            for (int m = 0; m < 4; ++m)
#pragma unroll
                for (int bj = 0; bj < 2; ++bj) { f32x4 r0, r1; unpack8(rw[m][bj], r0, r1); acc[ai][bj][m][0] *= r0; acc[ai][bj][m][1] *= r1; }
#pragma unroll
            for (int m = 0; m < 4; ++m) asm volatile("" : "+v"(acc[ai][0][m][0]), "+v"(acc[ai][0][m][1]), "+v"(acc[ai][1][m][0]), "+v"(acc[ai][1][m][1]) :: "memory");
        }
    }
    __device__ __forceinline__ void operator()(const f32x4 (&acc)[2][2][4][2], const Unit& u, int wr, int wc, int fr, int fq) const {
        int row0 = u.pm * BM + wr * 64 + fr, col0 = u.pn * BM + wc * 32 + 8 * fq; asm volatile("" : "+v"(row0), "+v"(col0));
#pragma unroll
        for (int ai = 0; ai < 2; ++ai)
#pragma unroll
            for (int m = 0; m < 4; ++m) { const size_t off = (size_t)(row0 + ai * HALF + m * 16) * 1024 + col0;
#pragma unroll
                for (int bj = 0; bj < 2; ++bj) { const u32x4 bw = *(const u32x4*)(sb + off + bj * HALF); f32x4 b0, b1; unpack8(bw, b0, b1);
                    *(u32x4*)(O + off + bj * HALF) = pack8(acc[ai][bj][m][0] * b0, acc[ai][bj][m][1] * b1); } }
    }
};
struct EpiFinal {
    static constexpr bool PERM = true, AFTER_DRAIN = false, MID = false;
    float* out; const bf16_t* x1b; const bf16_t* pe; const float* r2;
    __device__ __forceinline__ void operator()(const f32x4 (&acc)[2][2][4][2], const Unit& u, int wr, int wc, int fr, int fq) const {
        int row0 = u.pm * BM + wr * 64 + fr, col0 = u.pn * BM + wc * 32 + 8 * fq; asm volatile("" : "+v"(row0), "+v"(col0));
#pragma unroll
        for (int ai = 0; ai < 2; ++ai)
#pragma unroll
            for (int m = 0; m < 4; ++m) { const int row = row0 + ai * HALF + m * 16; const size_t off = (size_t)row * 1024 + col0; const float rs = r2[row];
#pragma unroll
                for (int bj = 0; bj < 2; ++bj) { const u32x4 pw = *(const u32x4*)(pe + off + bj * HALF), xw = *(const u32x4*)(x1b + off + bj * HALF);
                    f32x4 p0, p1, x0, x1; unpack8(pw, p0, p1); unpack8(xw, x0, x1);
                    float* op = out + off + bj * HALF;
                    f32x4 g0 = acc[ai][bj][m][0], g1 = acc[ai][bj][m][1];
#pragma unroll
                    for (int e = 0; e < 4; ++e) { g0[e] = x0[e] + fsigmoid(rs * g0[e]) * p0[e]; g1[e] = x1[e] + fsigmoid(rs * g1[e]) * p1[e]; }
                    *(f32x4*)op = g0; *(f32x4*)(op + 4) = g1; } }
    }
};
struct DupOrder {
    StaticOrder S; int dup;
    __device__ void init(int M_, int N_, int G_, int c_, int dup_) { S.init(M_, N_, G_, c_); dup = dup_; }
    __device__ bool next(int i, Unit& u) const { if (dup > 1) { const int rounds = S.nwg / S.G; if (i >= dup * rounds) return false; i %= rounds; } return S.next(i, u); }
    __device__ __forceinline__ void a_ready(const Unit&) const {}
    __device__ __forceinline__ void done(const Unit&) const {}
};
template <class Epi, class Sched, bool ALIGN_EPI = false, bool SP2 = false>
__device__ __forceinline__ void gemm_phase(PG8_LAS unsigned char* lds, const Gemm g, const Sched& S, const Epi& E) {
    const int tid = threadIdx.x, wid = __builtin_amdgcn_readfirstlane(tid >> 6), lane = tid & 63, wr = wid >> 2, wc = wid & 3, fr = lane & 15, fq = lane >> 4;
    const int nt = g.K / BK, nth = g.K1 / BK;
    unsigned voffA[2], voffB[2];
#pragma unroll
    for (int i = 0; i < 2; ++i) { int R, C; stage_rc(tid * 16 + i * 8192, R, C); const int Rb = Epi::PERM ? ((R & ~31) + perm32(R & 31)) : R;
        voffA[i] = (unsigned)(R * g.lda + C) * 2u; voffB[i] = (unsigned)(Rb * g.ldb + C) * 2u; }
    const size_t kstep = (size_t)(BK * 2);
    const size_t hstepA = (size_t)HALF * g.lda * 2, hstepB = (size_t)HALF * g.ldb * 2;
    const size_t tstepA = 2 * hstepA, tstepB = 2 * hstepB;
    const unsigned ldsw = (unsigned)wid * 1024u;
    const int aoff = lds_byte(wr * 64 + fr, fq * 8), boff = lds_byte(wc * 32 + fr, fq * 8);
#define PG8_SA(b, h) (((b) * 2 + (h)) * HTB)
#define PG8_SB(b, h) ((4 + (b) * 2 + (h)) * HTB)
#define PG8_STAGE(bufoff, gbase, voff) do { _Pragma("unroll") for (int _i = 0; _i < 2; ++_i) \
        __builtin_amdgcn_global_load_lds((const unsigned*)((const char*)(gbase) + (voff)[_i]), (PG8_LAS unsigned*)(lds + (bufoff) + ldsw + _i * 8192), 16, 0, 0); } while (0)
#define PG8_LDA(dst, b, h) do { _Pragma("unroll") for (int m = 0; m < 4; ++m) _Pragma("unroll") for (int k = 0; k < 2; ++k) dst[m][k] = *(const PG8_LAS bf16x8*)(lds + PG8_SA(b, h) + aoff + m * 2048 + k * 1024); } while (0)
#define PG8_LDB(dst, b, h) do { _Pragma("unroll") for (int n = 0; n < 2; ++n) _Pragma("unroll") for (int k = 0; k < 2; ++k) dst[n][k] = *(const PG8_LAS bf16x8*)(lds + PG8_SB(b, h) + boff + n * 2048 + k * 1024); } while (0)
#define PG8_MMA(ai, bj, At, Bt) do { __builtin_amdgcn_s_setprio(1); _Pragma("unroll") for (int m = 0; m < 4; ++m) _Pragma("unroll") for (int n = 0; n < 2; ++n) _Pragma("unroll") for (int k = 0; k < 2; ++k) \
        acc[ai][bj][m][n] = __builtin_amdgcn_mfma_f32_16x16x32_bf16(Bt[n][k], At[m][k], acc[ai][bj][m][n], 0, 0, 0); __builtin_amdgcn_s_setprio(0); } while (0)
#define PG8_WAIT_V(n) asm volatile("s_waitcnt vmcnt(" #n ")" ::: "memory")
#define PG8_WAIT_L(n) asm volatile("s_waitcnt lgkmcnt(" #n ")" ::: "memory")
#define PG8_BAR __builtin_amdgcn_s_barrier()
#define PG8_SCHED __builtin_amdgcn_sched_barrier(0)
    Unit cur, nxt; int ui = 0;
    if (!S.next(0, cur)) return;
    f32x4 acc[2][2][4][2];
#pragma unroll
    for (int a = 0; a < 2; ++a)
#pragma unroll
        for (int b = 0; b < 2; ++b)
#pragma unroll
            for (int m = 0; m < 4; ++m)
#pragma unroll
                for (int n = 0; n < 2; ++n) acc[a][b][m][n] = (f32x4){0.f, 0.f, 0.f, 0.f};
    bf16x8 At[4][2], B0[2][2], B1[2][2];
    const char* cA = (const char*)g.A + (size_t)cur.pm * tstepA + (size_t)cur.pn * g.a_pn_off; const char* cA2 = (const char*)g.A2 + (size_t)cur.pm * tstepA; const char* cB = (const char*)g.Bt + (size_t)cur.pn * tstepB;
    S.a_ready(cur);
    if constexpr (SP2) {
        PG8_STAGE(PG8_SB(0, 0), cB, voffB); PG8_STAGE(PG8_SB(0, 1), cB + hstepB, voffB); PG8_STAGE(PG8_SA(0, 0), cA, voffA); PG8_STAGE(PG8_SA(0, 1), cA + hstepA, voffA);
        if (wr == 1) PG8_BAR;
        PG8_WAIT_V(2); PG8_BAR;
        PG8_STAGE(PG8_SB(1, 0), cB + kstep, voffB); PG8_STAGE(PG8_SA(1, 0), cA + kstep, voffA); PG8_STAGE(PG8_SB(1, 1), cB + hstepB + kstep, voffB);
        PG8_WAIT_V(6); PG8_BAR;
    } else {
        PG8_STAGE(PG8_SB(0, 0), cB, voffB); PG8_STAGE(PG8_SA(0, 0), cA, voffA); PG8_STAGE(PG8_SB(0, 1), cB + hstepB, voffB); PG8_STAGE(PG8_SA(0, 1), cA + hstepA, voffA);
        if (wr == 1) PG8_BAR;
        PG8_WAIT_V(4); PG8_BAR;
        PG8_STAGE(PG8_SB(1, 0), cB + kstep, voffB); PG8_STAGE(PG8_SA(1, 0), cA + kstep, voffA); PG8_STAGE(PG8_SB(1, 1), cB + hstepB + kstep, voffB);
        PG8_WAIT_V(6); PG8_BAR;
    }
    for (;;) {
        const bool has_next = S.next(ui + 1, nxt);
        const char* nA = has_next ? (const char*)g.A + (size_t)nxt.pm * tstepA + (size_t)nxt.pn * g.a_pn_off : cA; const char* nA2 = has_next ? (const char*)g.A2 + (size_t)nxt.pm * tstepA : cA2; const char* nB = has_next ? (const char*)g.Bt + (size_t)nxt.pn * tstepB : cB;
        for (int t = 0; t < nt; t += 2) {
            const bool last = (t == nt - 2);
            if constexpr (Epi::MID) { if (t == nth) E.mid(acc, cur, wr, wc, fr, fq); }
            const char* a1 = (t + 1 < nth) ? cA + (size_t)(t + 1) * kstep : cA2 + (size_t)(t + 1 - nth) * kstep;
            const char* a2 = last ? nA : ((t + 2 < nth) ? cA + (size_t)(t + 2) * kstep : cA2 + (size_t)(t + 2 - nth) * kstep); const char* b2 = last ? nB : cB + (size_t)(t + 2) * kstep;
            const char* a3 = a2 + kstep; const char* b3 = b2 + kstep;
            if (last && has_next) S.a_ready(nxt);
            if constexpr (SP2) {
            PG8_LDB(B0, 0, 0); PG8_LDB(B1, 0, 1); PG8_SCHED; PG8_LDA(At, 0, 0); PG8_STAGE(PG8_SA(1, 1), a1 + hstepA, voffA);
            PG8_WAIT_V(8); PG8_WAIT_L(0); PG8_BAR; PG8_MMA(0, 0, At, B0); PG8_MMA(0, 1, At, B1); PG8_BAR; PG8_SCHED;
            PG8_LDA(At, 0, 1); PG8_STAGE(PG8_SB(0, 0), b2, voffB); PG8_STAGE(PG8_SB(0, 1), b2 + hstepB, voffB); PG8_STAGE(PG8_SA(0, 0), a2, voffA);
            PG8_WAIT_V(8); PG8_WAIT_L(0); PG8_BAR; PG8_MMA(1, 0, At, B0); PG8_MMA(1, 1, At, B1); PG8_BAR; PG8_SCHED;
            PG8_LDB(B0, 1, 0); PG8_LDB(B1, 1, 1); PG8_SCHED; PG8_LDA(At, 1, 0); PG8_STAGE(PG8_SA(0, 1), a2 + hstepA, voffA);
            PG8_WAIT_V(8); PG8_WAIT_L(0); PG8_BAR; PG8_MMA(0, 0, At, B0); PG8_MMA(0, 1, At, B1); PG8_BAR; PG8_SCHED;
            PG8_LDA(At, 1, 1); PG8_STAGE(PG8_SB(1, 0), b3, voffB); PG8_STAGE(PG8_SB(1, 1), b3 + hstepB, voffB); PG8_STAGE(PG8_SA(1, 0), a3, voffA);
            PG8_WAIT_V(8); PG8_WAIT_L(0); PG8_BAR; PG8_MMA(1, 0, At, B0); PG8_MMA(1, 1, At, B1); PG8_BAR; PG8_SCHED;
            } else {
            PG8_LDB(B0, 0, 0); PG8_SCHED; PG8_LDA(At, 0, 0); PG8_STAGE(PG8_SA(1, 1), a1 + hstepA, voffA);
            PG8_WAIT_L(8); PG8_BAR; PG8_WAIT_L(0); PG8_MMA(0, 0, At, B0); PG8_BAR; PG8_SCHED;
            PG8_LDB(B1, 0, 1); PG8_STAGE(PG8_SB(0, 0), b2, voffB);
            PG8_BAR; PG8_WAIT_L(0); PG8_MMA(0, 1, At, B1); PG8_BAR;
            PG8_LDA(At, 0, 1); PG8_STAGE(PG8_SA(0, 0), a2, voffA);
            PG8_BAR; PG8_WAIT_L(0); PG8_MMA(1, 0, At, B0); PG8_BAR; PG8_SCHED;
            PG8_STAGE(PG8_SB(0, 1), b2 + hstepB, voffB);
            PG8_WAIT_V(6); PG8_BAR; PG8_MMA(1, 1, At, B1); PG8_BAR;
            PG8_LDB(B0, 1, 0); PG8_SCHED; PG8_LDA(At, 1, 0); PG8_STAGE(PG8_SA(0, 1), a2 + hstepA, voffA);
            PG8_WAIT_L(8); PG8_BAR; PG8_WAIT_L(0); PG8_MMA(0, 0, At, B0); PG8_BAR; PG8_SCHED;
            PG8_LDB(B1, 1, 1); PG8_STAGE(PG8_SB(1, 0), b3, voffB);
            PG8_BAR; PG8_WAIT_L(0); PG8_MMA(0, 1, At, B1); PG8_BAR;
            PG8_LDA(At, 1, 1); PG8_STAGE(PG8_SA(1, 0), a3, voffA);
            PG8_BAR; PG8_WAIT_L(0); PG8_MMA(1, 0, At, B0); PG8_BAR; PG8_SCHED;
            PG8_STAGE(PG8_SB(1, 1), b3 + hstepB, voffB);
            PG8_WAIT_V(6); PG8_BAR; PG8_MMA(1, 1, At, B1); PG8_BAR;
            }
        }
        if constexpr (ALIGN_EPI) { if (wr == 0) PG8_BAR; }
        if constexpr (!Epi::AFTER_DRAIN) { E(acc, cur, wr, wc, fr, fq); S.done(cur); }
        if (!has_next) break;
#pragma unroll
        for (int a = 0; a < 2; ++a)
#pragma unroll
            for (int b = 0; b < 2; ++b)
#pragma unroll
                for (int m = 0; m < 4; ++m)
#pragma unroll
                    for (int n = 0; n < 2; ++n) acc[a][b][m][n] = (f32x4){0.f, 0.f, 0.f, 0.f};
        cur = nxt; cA = nA; cA2 = nA2; cB = nB; ++ui;
        if constexpr (ALIGN_EPI) { if (wr == 1) PG8_BAR; }
    }
    PG8_WAIT_V(0);
    if constexpr (!ALIGN_EPI) { if (wr == 0) PG8_BAR; }
    PG8_BAR;
    if constexpr (Epi::AFTER_DRAIN) { E.fused(acc, cur, wr, wc, fr, fq, lds, wid, lane); S.done(cur); }
#undef PG8_SA
#undef PG8_SB
#undef PG8_STAGE
#undef PG8_LDA
#undef PG8_LDB
#undef PG8_MMA
#undef PG8_WAIT_V
#undef PG8_WAIT_L
#undef PG8_BAR
#undef PG8_SCHED
}
}

namespace attn_body {
using bf16=__hip_bfloat16;
using bf16x8=__attribute__((ext_vector_type(8)))short;
using s16x4=__attribute__((ext_vector_type(4)))short;
using f32x16=__attribute__((ext_vector_type(16)))float;
using u32x4=__attribute__((ext_vector_type(4)))unsigned;
constexpr int D=64,QP=1024,KP=256;
constexpr int NW=8,QBLK=32,QB=QBLK*NW,KVBLK=64;

__device__ __forceinline__ int crow(int r,int hi){return (r&3)+8*(r>>2)+4*hi;}
#define SBAR() __builtin_amdgcn_sched_barrier(0)
__device__ __forceinline__ void cmask(f32x16&p0,f32x16&p1,int jb,int qrel,int hi){
  const float NEG=-INFINITY; int kb=64*jb+4*hi;
  #pragma unroll
  for(int r=0;r<16;++r){int kv=kb+(r&3)+8*(r>>2); if(kv>qrel)p0[r]=NEG; if(kv+32>qrel)p1[r]=NEG;}
}

constexpr int NSLOT=3, SLOTB=8192;
constexpr int LDS_K=0, LDS_V=NSLOT*SLOTB, LDS_WS=2*NSLOT*SLOTB, LDS_OST=LDS_WS+NW*64*4, LDS_BYTES=LDS_OST+NW*4096;
constexpr float C2=0.125f*1.4426950408889634f;
__device__ __forceinline__ void glds16(const void*gsrc,unsigned lds_dst){
  asm volatile("s_mov_b32 m0, %1\n\ts_nop 0\n\tglobal_load_lds_dwordx4 %0, off"::"v"(gsrc),"s"(lds_dst):"memory","m0");}
__device__ __forceinline__ float max3f(float a,float b,float c){float r;asm("v_max3_f32 %0, %1, %2, %3":"=v"(r):"v"(a),"v"(b),"v"(c));return r;}
__device__ __forceinline__ float max2f(float a,float b){float r;asm("v_max_f32_e32 %0, %1, %2":"=v"(r):"v"(a),"v"(b));return r;}
__device__ __forceinline__ float fadd_s(float a,float b){float r;asm("v_add_f32_e32 %0, %1, %2":"=v"(r):"v"(a),"v"(b));return r;}
__device__ __forceinline__ float fsub_s(float a,float b){float r;asm("v_sub_f32_e32 %0, %1, %2":"=v"(r):"v"(a),"v"(b));return r;}
typedef float f32x2_t __attribute__((ext_vector_type(2))); typedef __bf16 bf16x2_t __attribute__((ext_vector_type(2)));
__device__ __forceinline__ unsigned cvtpk_s(float lo,float hi){f32x2_t v={lo,hi};bf16x2_t b=__builtin_convertvector(v,bf16x2_t);return __builtin_bit_cast(unsigned,b);}
#define WAIT_BAR(N) asm volatile("s_waitcnt vmcnt(" #N ") lgkmcnt(0)\n\ts_barrier":::"memory")

__device__ __forceinline__ void qkt(f32x16&p0,f32x16&p1,const char*Kslot,const bf16x8*qr,const f32x16&negm,int r32,int hi){
  const char*kb=Kslot+hi*1024+r32*16;
  #pragma unroll
  for(int d0=0;d0<4;++d0){
    const bf16x8 b0=*reinterpret_cast<const bf16x8*>(kb+d0*2048);
    const bf16x8 b1=*reinterpret_cast<const bf16x8*>(kb+d0*2048+512);
    if(d0==0){p0=__builtin_amdgcn_mfma_f32_32x32x16_bf16(b0,qr[0],negm,0,0,0);p1=__builtin_amdgcn_mfma_f32_32x32x16_bf16(b1,qr[0],negm,0,0,0);}
    else{p0=__builtin_amdgcn_mfma_f32_32x32x16_bf16(b0,qr[d0],p0,0,0,0);p1=__builtin_amdgcn_mfma_f32_32x32x16_bf16(b1,qr[d0],p1,0,0,0);}}
}
typedef __attribute__((address_space(3))) const char* lds_cptr;
typedef short v4i16_t __attribute__((ext_vector_type(4)));
__device__ __forceinline__ void kload8(bf16x8*kf,lds_cptr kp){
  kf[0]=*(const __attribute__((address_space(3))) bf16x8*)(kp);      kf[1]=*(const __attribute__((address_space(3))) bf16x8*)(kp+512);
  kf[2]=*(const __attribute__((address_space(3))) bf16x8*)(kp+2048); kf[3]=*(const __attribute__((address_space(3))) bf16x8*)(kp+2560);
  kf[4]=*(const __attribute__((address_space(3))) bf16x8*)(kp+4096); kf[5]=*(const __attribute__((address_space(3))) bf16x8*)(kp+4608);
  kf[6]=*(const __attribute__((address_space(3))) bf16x8*)(kp+6144); kf[7]=*(const __attribute__((address_space(3))) bf16x8*)(kp+6656);
}
__device__ __forceinline__ void kload2(bf16x8*kf,lds_cptr kp,int j){ kf[2*j]=*(const __attribute__((address_space(3))) bf16x8*)(kp+j*2048); kf[2*j+1]=*(const __attribute__((address_space(3))) bf16x8*)(kp+j*2048+512); }
__device__ __forceinline__ s16x4 vtr(lds_cptr p){ return __builtin_bit_cast(s16x4,__builtin_amdgcn_ds_read_tr16_b64_v4i16((__attribute__((address_space(3))) v4i16_t*)p)); }
__device__ __forceinline__ float rowmax(const f32x16&p0,const f32x16&p1){
  float a=max3f(p0[0],p0[1],p1[0]),b=max3f(p0[2],p0[3],p1[1]);a=max3f(a,p1[2],p1[3]);
  #pragma unroll
  for(int r=4;r<16;r+=4){a=max3f(a,p0[r],p0[r+1]);b=max3f(b,p0[r+2],p0[r+3]);a=max3f(a,p1[r],p1[r+1]);b=max3f(b,p1[r+2],p1[r+3]);}
  const float m=max2f(a,b);
  auto rr=__builtin_amdgcn_permlane32_swap(__float_as_uint(m),__float_as_uint(m),false,false);
  return max2f(__uint_as_float(rr[0]),__uint_as_float(rr[1]));
}
__device__ __forceinline__ void pv(f32x16*o,int vb,bf16x8 pa0,bf16x8 pa1,bf16x8 pa2,bf16x8 pa3){
  #pragma unroll
  for(int d0=0;d0<2;++d0){s16x4 lo[4],hi[4];
    #pragma unroll
    for(int ks=0;ks<4;++ks){
      asm volatile("ds_read_b64_tr_b16 %0,%1 offset:%c2":"=&v"(lo[ks]):"v"(vb),"i"(d0*4096+ks*1024):"memory");
      asm volatile("ds_read_b64_tr_b16 %0,%1 offset:%c2":"=&v"(hi[ks]):"v"(vb),"i"(d0*4096+ks*1024+512):"memory");}
    asm volatile("s_waitcnt lgkmcnt(0)":::"memory");SBAR();
    #define PK(k) (bf16x8){lo[k][0],lo[k][1],lo[k][2],lo[k][3],hi[k][0],hi[k][1],hi[k][2],hi[k][3]}
    o[d0]=__builtin_amdgcn_mfma_f32_32x32x16_bf16(pa0,PK(0),o[d0],0,0,0);
    o[d0]=__builtin_amdgcn_mfma_f32_32x32x16_bf16(pa1,PK(1),o[d0],0,0,0);
    o[d0]=__builtin_amdgcn_mfma_f32_32x32x16_bf16(pa2,PK(2),o[d0],0,0,0);
    o[d0]=__builtin_amdgcn_mfma_f32_32x32x16_bf16(pa3,PK(3),o[d0],0,0,0);
    #undef PK
  }
}
#define ATTN_STORE16(p,v) (*(u32x4*)(p)=(v))
__device__ __forceinline__ float abf_lo(unsigned w){return __uint_as_float(w<<16);}
__device__ __forceinline__ float abf_hi(unsigned w){return __uint_as_float(w&0xffff0000u);}
__device__ __forceinline__ u32x4 mulgate(const u32x4&v,const u32x4&g){u32x4 r;
  r.x=cvtpk_s(abf_lo(v.x)*abf_lo(g.x),abf_hi(v.x)*abf_hi(g.x)); r.y=cvtpk_s(abf_lo(v.y)*abf_lo(g.y),abf_hi(v.y)*abf_hi(g.y));
  r.z=cvtpk_s(abf_lo(v.z)*abf_lo(g.z),abf_hi(v.z)*abf_hi(g.z)); r.w=cvtpk_s(abf_lo(v.w)*abf_lo(g.w),abf_hi(v.w)*abf_hi(g.w)); return r;}
__device__ __forceinline__ void qnormrope(bf16x8*qr,const float*__restrict__ qn,int t,int hi){
  typedef float f4_t __attribute__((ext_vector_type(4)));
  float y[4][8]; float ss=0.f;
  #pragma unroll
  for(int d0=0;d0<4;++d0){ const u32x4 w=__builtin_bit_cast(u32x4,qr[d0]);
    #pragma unroll
    for(int i=0;i<4;++i){ y[d0][2*i]=__uint_as_float(w[i]<<16); y[d0][2*i+1]=__uint_as_float(w[i]&0xffff0000u); ss+=y[d0][2*i]*y[d0][2*i]+y[d0][2*i+1]*y[d0][2*i+1]; } }
  ss+=__shfl_xor(ss,32);
  const float rstd=1.0f/sqrtf(ss*(1.0f/64.0f)+1e-6f);
  #pragma unroll
  for(int d0=0;d0<4;++d0){ const f4_t g0=*(const f4_t*)(qn+16*d0+8*hi), g1=*(const f4_t*)(qn+16*d0+8*hi+4);
    #pragma unroll
    for(int i=0;i<4;++i){ y[d0][i]*=rstd*g0[i]; y[d0][4+i]*=rstd*g1[i]; } }
  const float prow=(float)(t>>6), pcol=(float)(t&63);
  #pragma unroll
  for(int j=0;j<8;++j){
    const float freq=__builtin_amdgcn_exp2f(-(float)(8*hi+j)*0.83048202372184058696f)*0.15915494309189533577f;
    const float rr=__builtin_amdgcn_fractf(prow*freq), rc=__builtin_amdgcn_fractf(pcol*freq);
    const float sr=__builtin_amdgcn_sinf(rr), cr=__builtin_amdgcn_cosf(rr), sc=__builtin_amdgcn_sinf(rc), cc=__builtin_amdgcn_cosf(rc);
    const float a0=y[0][j], b0=y[1][j], a1=y[2][j], b1=y[3][j];
    y[0][j]=(a0*cr-b0*sr)*C2; y[1][j]=(b0*cr+a0*sr)*C2; y[2][j]=(a1*cc-b1*sc)*C2; y[3][j]=(b1*cc+a1*sc)*C2; }
  #pragma unroll
  for(int d0=0;d0<4;++d0){ u32x4 w; w.x=cvtpk_s(y[d0][0],y[d0][1]); w.y=cvtpk_s(y[d0][2],y[d0][3]); w.z=cvtpk_s(y[d0][4],y[d0][5]); w.w=cvtpk_s(y[d0][6],y[d0][7]); qr[d0]=__builtin_bit_cast(bf16x8,w); }
}
template<int THRL,bool track> __device__ __forceinline__ void attn_unit(long qrow0,long kvrow0,int NT,int h,const bf16*Q,const bf16*__restrict__ K,const bf16*__restrict__ V,bf16*O,const bf16*__restrict__ Gt,const float*__restrict__ qn,char*shm){
  const int tid=threadIdx.x,lane=tid&63,r32=lane&31,hi=lane>>5; const int wid=__builtin_amdgcn_readfirstlane(tid>>6);
  const bf16*Qw=Q+(qrow0+wid*QBLK)*QP+h*D;
  const bf16*Kh=K+kvrow0*KP+(h>>2)*D,*Vh=V+kvrow0*KP+(h>>2)*D;
  const unsigned lds0=(unsigned)(uintptr_t)shm;
  float*wsf=(float*)(shm+LDS_WS)+wid*64;
  const bf16*ksrc=Kh+(long)lane*KP+wid*8;
  const bf16*vsrc=Vh+(long)(16*(wid&3)+(lane>>2))*KP+(wid>>2)*32+(lane&3)*8;
  const unsigned kdst=lds0+LDS_K+wid*1024, vdst=lds0+LDS_V+wid*1024;
  #define DMA_K(t,slot) glds16(ksrc+(long)(t)*KVBLK*KP,(unsigned)__builtin_amdgcn_readfirstlane(kdst+(slot)))
  #define DMA_V(t,slot) glds16(vsrc+(long)(t)*KVBLK*KP,(unsigned)__builtin_amdgcn_readfirstlane(vdst+(slot)))
  const int vb0=(int)(lds0+LDS_V)+((lane>>4)&1)*32+(lane&3)*8+(4*hi+((lane&15)>>2))*64;
  const char*Kbase=shm+LDS_K; bf16x8 kf[8];
  const lds_cptr shm3=(lds_cptr)shm; const lds_cptr kp0=shm3+LDS_K+hi*1024+r32*16; const lds_cptr vp0=shm3+LDS_V+((lane>>4)&1)*32+(lane&3)*8+(4*hi+((lane&15)>>2))*64;
  DMA_K(0,0);DMA_V(0,0);DMA_K(1,SLOTB);
  bf16x8 qr[4];
  #pragma unroll
  for(int d0=0;d0<4;++d0)qr[d0]=*reinterpret_cast<const bf16x8*>(&Qw[(long)r32*QP+d0*16+hi*8]);
  qnormrope(qr,qn,(int)(qrow0-kvrow0)+wid*QBLK+r32,hi);
  float mhat=0.f,l_reg=0.f;f32x16 o[2];o[0]=f32x16{};o[1]=f32x16{};f32x16 negm=f32x16{};asm volatile("":"+v"(negm));
  #define CMASK(P0,P1,t) do{}while(0)
  bool resc=false;
  #define START(P0,P1) do{ const float rm=rowmax(P0,P1); resc=false; \
    { const float dl=rm; mhat=fadd_s(mhat,dl); \
      _Pragma("unroll") for(int r=0;r<16;++r){P0[r]=fsub_s(P0[r],dl);P1[r]=fsub_s(P1[r],dl);} \
      _Pragma("unroll") for(int r=0;r<16;++r)negm[r]=-mhat; asm volatile("":"+v"(negm)); } \
    _Pragma("unroll") for(int r=0;r<16;++r)P0[r]=__builtin_amdgcn_exp2f(P0[r]); }while(0)
  #define RESC() do{ if(resc){ asm volatile("s_waitcnt lgkmcnt(0)":::"memory"); \
      _Pragma("unroll") for(int d_=0;d_<2;++d_) _Pragma("unroll") for(int r=0;r<16;++r)o[d_][r]*=wsf[crow(r,hi)]; } }while(0)
  f32x16 pA0,pA1,pB0,pB1;
  int sl_prev=0,sl_cur=0,sl_next=SLOTB;
  #define ROT() do{sl_prev=sl_cur;sl_cur=sl_next;sl_next=(sl_next==(NSLOT-1)*SLOTB)?0:sl_next+SLOTB;}while(0)
  DMA_K(2,2*SLOTB);
  WAIT_BAR(3);
  qkt(pA0,pA1,Kbase,qr,negm,r32,hi);asm volatile("s_nop 15\n\ts_nop 7":"+v"(pA0),"+v"(pA1));CMASK(pA0,pA1,0);
  START(pA0,pA1);
  _Pragma("unroll") for(int r=0;r<16;++r)pA1[r]=__builtin_amdgcn_exp2f(pA1[r]);
  WAIT_BAR(0);
  DMA_K(3,0);DMA_V(1,SLOTB);
  ROT();
  kload8(kf,kp0+sl_cur);
  WAIT_BAR(2);
  s16x4 vlo[8],vhi[8]; u32x4 pw0,pw1,pw2,pw3;
  #define PKW(P,B) cvtpk_s(P[B],P[B+1])
  #define PAF(k) __builtin_bit_cast(bf16x8,pw##k)
  #define VFR(i) (bf16x8){vlo[i][0],vlo[i][1],vlo[i][2],vlo[i][3],vhi[i][0],vhi[i][1],vhi[i][2],vhi[i][3]}
  #define PIN(x) asm volatile("":"+v"(x))
  #define MX3(a,b,c) __builtin_fmaxf(__builtin_fmaxf((a),(b)),(c))
  #define GAPA(MF,A0,A1,A2,A3,W0,W1,PW) do{ MF; sacc+=A0; sacc+=A1; sacc+=A2; sacc+=A3; PIN(sacc); W0; W1; PIN(PW); SBAR(); }while(0)
  #define EX(v) __builtin_amdgcn_exp2f(v)
  #define GAPB(MF,X,B) do{ MF; X[B]=EX(X[B]); X[B+1]=EX(X[B+1]); X[B+2]=EX(X[B+2]); X[B+3]=EX(X[B+3]); PIN(X); SBAR(); }while(0)
  #define VRD(i) do{ vlo[i]=vtr(vp_+(((i)>>2)*4096+((i)&3)*1024)); vhi[i]=vtr(vp_+(((i)>>2)*4096+((i)&3)*1024+512)); }while(0)
  #define KRD(G,j) do{ if(G){ kload2(kf,kp0+sl_next,j); SBAR(); } }while(0)
  #define STEP(C0,C1,P0,P1,t,GK,GV,GL) do{ SBAR(); \
    const lds_cptr vp_=vp0+sl_prev; \
    VRD(0); SBAR(); float sacc=(P0[0]+P0[1]); \
    GAPA(C0=__builtin_amdgcn_mfma_f32_32x32x16_bf16(kf[0],qr[0],negm,0,0,0), P0[2],P0[3],P0[4],P0[5],     pw0[0]=PKW(P0,0), pw0[1]=PKW(P0,2), pw0); \
    VRD(4); SBAR(); GAPA(C1=__builtin_amdgcn_mfma_f32_32x32x16_bf16(kf[1],qr[0],negm,0,0,0), P0[6],P0[7],P0[8],P0[9],     pw0[2]=PKW(P0,4), pw0[3]=PKW(P0,6), pw0); \
    VRD(1); SBAR(); GAPA(C0=__builtin_amdgcn_mfma_f32_32x32x16_bf16(kf[2],qr[1],C0,0,0,0),   P0[10],P0[11],P0[12],P0[13], pw1[0]=PKW(P0,8), pw1[1]=PKW(P0,10), pw1); \
    VRD(5); SBAR(); GAPA(C1=__builtin_amdgcn_mfma_f32_32x32x16_bf16(kf[3],qr[1],C1,0,0,0),   P0[14],P0[15],P1[0],P1[1],   pw1[2]=PKW(P0,12),pw1[3]=PKW(P0,14), pw1); \
    VRD(2); SBAR(); GAPA(C0=__builtin_amdgcn_mfma_f32_32x32x16_bf16(kf[4],qr[2],C0,0,0,0),   P1[2],P1[3],P1[4],P1[5],     pw2[0]=PKW(P1,0), pw2[1]=PKW(P1,2), pw2); \
    VRD(6); SBAR(); GAPA(C1=__builtin_amdgcn_mfma_f32_32x32x16_bf16(kf[5],qr[2],C1,0,0,0),   P1[6],P1[7],P1[8],P1[9],     pw2[2]=PKW(P1,4), pw2[3]=PKW(P1,6), pw2); \
    VRD(3); SBAR(); GAPA(C0=__builtin_amdgcn_mfma_f32_32x32x16_bf16(kf[6],qr[3],C0,0,0,0),   P1[10],P1[11],P1[12],P1[13], pw3[0]=PKW(P1,8), pw3[1]=PKW(P1,10), pw3); \
    VRD(7); SBAR(); GAPA(C1=__builtin_amdgcn_mfma_f32_32x32x16_bf16(kf[7],qr[3],C1,0,0,0),   P1[14],P1[15],0.f,0.f,       pw3[2]=PKW(P1,12),pw3[3]=PKW(P1,14), pw3); \
    l_reg+=sacc; \
    if(GK){DMA_K((t)+3,sl_cur);} if(GV){DMA_V((t)+1,sl_next);} \
    CMASK(C0,C1,t); \
    if(track){ float a=MX3(C0[0],C0[1],C1[0]),b=MX3(C0[2],C0[3],C1[1]); a=MX3(a,C1[2],C1[3]); \
      _Pragma("unroll") for(int r=4;r<16;r+=4){a=MX3(a,C0[r],C0[r+1]);b=MX3(b,C0[r+2],C0[r+3]);a=MX3(a,C1[r],C1[r+1]);b=MX3(b,C1[r+2],C1[r+3]);} \
      float rm=__builtin_fmaxf(a,b); { auto rr=__builtin_amdgcn_permlane32_swap(__float_as_uint(rm),__float_as_uint(rm),false,false); rm=__builtin_fmaxf(__uint_as_float(rr[0]),__uint_as_float(rr[1])); } \
      resc=false; \
      if(__builtin_expect(__any(rm>(float)THRL),0)){ const float dl=__builtin_fmaxf(rm,0.f); mhat+=dl; \
        _Pragma("unroll") for(int r=0;r<16;++r){C0[r]-=dl;C1[r]-=dl;} \
        _Pragma("unroll") for(int r=0;r<16;++r)negm[r]=-mhat; asm volatile("":"+v"(negm)); \
        const float f=__builtin_amdgcn_exp2f(-dl); l_reg*=f; if(hi==0)wsf[r32]=f; resc=true; } } \
    SBAR(); \
    GAPB(o[0]=__builtin_amdgcn_mfma_f32_32x32x16_bf16(PAF(0),VFR(0),o[0],0,0,0), C0,0); \
    GAPB(o[1]=__builtin_amdgcn_mfma_f32_32x32x16_bf16(PAF(0),VFR(4),o[1],0,0,0), C0,4); \
    KRD(GL,0); GAPB(o[0]=__builtin_amdgcn_mfma_f32_32x32x16_bf16(PAF(1),VFR(1),o[0],0,0,0), C0,8); \
    KRD(GL,1); GAPB(o[1]=__builtin_amdgcn_mfma_f32_32x32x16_bf16(PAF(1),VFR(5),o[1],0,0,0), C0,12); \
    KRD(GL,2); GAPB(o[0]=__builtin_amdgcn_mfma_f32_32x32x16_bf16(PAF(2),VFR(2),o[0],0,0,0), C1,0); \
    KRD(GL,3); GAPB(o[1]=__builtin_amdgcn_mfma_f32_32x32x16_bf16(PAF(2),VFR(6),o[1],0,0,0), C1,4); \
    GAPB(o[0]=__builtin_amdgcn_mfma_f32_32x32x16_bf16(PAF(3),VFR(3),o[0],0,0,0), C1,8); \
    GAPB(o[1]=__builtin_amdgcn_mfma_f32_32x32x16_bf16(PAF(3),VFR(7),o[1],0,0,0), C1,12); \
    }while(0)
  int t=1;
  #undef CMASK
  #define CMASK(P0,P1,t) do{}while(0)
  for(;t+5<NT;t+=2){
    STEP(pB0,pB1,pA0,pA1,t,true,true,true);     WAIT_BAR(2); RESC(); ROT();
    STEP(pA0,pA1,pB0,pB1,t+1,true,true,true);   WAIT_BAR(2); RESC(); ROT();
  }
  #undef CMASK
  #define CMASK(P0,P1,t) do{}while(0)
  #define ENDW(tt) do{ if((tt)+3<NT){WAIT_BAR(2);} else if((tt)+2<NT){WAIT_BAR(1);} else {WAIT_BAR(0);} }while(0)
  for(;t+1<NT;t+=2){
    STEP(pB0,pB1,pA0,pA1,t,(t+3<NT),(t+1<NT),(t+1<NT));       ENDW(t);   RESC(); ROT();
    STEP(pA0,pA1,pB0,pB1,t+1,(t+4<NT),(t+2<NT),(t+2<NT));     ENDW(t+1); RESC(); ROT();
  }
  STEP(pB0,pB1,pA0,pA1,NT-1,false,false,false); RESC();
  const bf16*Gw=Gt+(qrow0+wid*QBLK)*QP+h*D; u32x4 gvv[4];
  _Pragma("unroll") for(int i=0;i<4;++i) gvv[i]=*(const u32x4*)(Gw+(long)(i*8+(lane>>3))*QP+(lane&7)*8);
  { float sacc=pB0[0]+pB0[1]; _Pragma("unroll") for(int r=2;r<16;++r)sacc+=pB0[r]; _Pragma("unroll") for(int r=0;r<16;++r)sacc+=pB1[r]; l_reg+=sacc;
    pw0=(u32x4){PKW(pB0,0),PKW(pB0,2),PKW(pB0,4),PKW(pB0,6)};pw1=(u32x4){PKW(pB0,8),PKW(pB0,10),PKW(pB0,12),PKW(pB0,14)};pw2=(u32x4){PKW(pB1,0),PKW(pB1,2),PKW(pB1,4),PKW(pB1,6)};pw3=(u32x4){PKW(pB1,8),PKW(pB1,10),PKW(pB1,12),PKW(pB1,14)};
    SBAR(); pv(o,vb0+sl_cur,PAF(0),PAF(1),PAF(2),PAF(3)); }
  #undef PKW
  #undef PAF
  #undef VFR
  #undef PIN
  #undef MX3
  #undef GAPA
  #undef GAPB
  #undef EX
  #undef VRD
  #undef KRD
  #undef STEP
  #undef ENDW
  {auto rr=__builtin_amdgcn_permlane32_swap(__float_as_uint(l_reg),__float_as_uint(l_reg),false,false);l_reg=__uint_as_float(rr[0])+__uint_as_float(rr[1]);}
  if(hi==0)wsf[32+r32]=l_reg;asm volatile("s_waitcnt lgkmcnt(0)":::"memory");
  float rli[16];
  #pragma unroll
  for(int r=0;r<16;++r)rli[r]=__builtin_amdgcn_rcpf(wsf[32+crow(r,hi)]);
  bf16*Ow=O+(qrow0+wid*QBLK)*QP+h*D;
  { bf16*stg=(bf16*)(shm+LDS_OST)+wid*2048;
    #pragma unroll
    for(int r=0;r<16;++r){const int orow=crow(r,hi);
      #pragma unroll
      for(int d0=0;d0<2;++d0)stg[orow*64+d0*32+r32]=__float2bfloat16(o[d0][r]*rli[r]);}
    asm volatile("s_waitcnt lgkmcnt(0)":::"memory");
    #pragma unroll
    for(int i=0;i<4;++i){const int row=i*8+(lane>>3),ch=lane&7; const u32x4 v=*(const u32x4*)(stg+row*64+ch*8); ATTN_STORE16(Ow+(long)row*QP+ch*8,mulgate(v,gvv[i]));} }
  asm volatile("s_waitcnt lgkmcnt(0)\n\ts_barrier":::"memory");
  #undef DMA_K
  #undef DMA_V
  #undef CMASK
  #undef START
  #undef RESC
  #undef ROT
}
constexpr int ATTN_LDS_BYTES=LDS_BYTES;
#undef SBAR
#undef WAIT_BAR
}

constexpr int NWAVES = 8;
constexpr int D = 1024, TP = 8192, TS = 2048, NB = 8;
constexpr int MP = NB * TP, MS = NB * TS, M = MP + MS;
constexpr int INW = 6656, PLE = 256;
constexpr float EPS = 1e-6f;
#ifndef MK_N_LAUNCHES
#define MK_N_LAUNCHES 1
#endif
constexpr int N_LAUNCHES = MK_N_LAUNCHES;
constexpr int N_PHASES = 8;

constexpr size_t MiB = 1u << 20;
constexpr size_t WS_CTL = 0, CTL_ZERO_BYTES = 64 * 1024;
constexpr size_t WS_R2 = 1 * MiB;
constexpr size_t WS_WIN = 2 * MiB;
constexpr size_t WS_WAB = 16 * MiB;
constexpr size_t WS_WO = 20 * MiB;
constexpr size_t WS_WG = 22 * MiB;
constexpr size_t WS_WPLE = 24 * MiB;
constexpr size_t WS_PBF = 26 * MiB;
constexpr size_t WS_RA = 80 * MiB;
constexpr size_t WS_RB = 240 * MiB;
constexpr size_t WS_RC = 400 * MiB;
constexpr size_t WS_RD = 560 * MiB;
constexpr size_t WS_RE = 720 * MiB;
constexpr size_t WS_RK = 880 * MiB;
constexpr size_t WS_RV = 920 * MiB;
constexpr size_t WS_END = 960 * MiB;

constexpr int RING_BYTES = 131072;
constexpr int LDS_BYTES = 147456;
constexpr int MISC_OFF = LDS_BYTES - 256;

#define GAS __attribute__((address_space(1)))
#define LAS __attribute__((address_space(3)))
typedef unsigned short bf16;
typedef unsigned v4u __attribute__((ext_vector_type(4)));
typedef unsigned v2u __attribute__((ext_vector_type(2)));
typedef float f32x4 __attribute__((ext_vector_type(4)));
#define LDS_WAIT() asm volatile("s_waitcnt lgkmcnt(0)" ::: "memory")
#define VM_WAIT() asm volatile("s_waitcnt vmcnt(0)" ::: "memory")
__device__ __forceinline__ unsigned pk2(float lo, float hi) { return pg8::cvt_pk_bf16(lo, hi); }
__device__ __forceinline__ float blo(unsigned w) { return __uint_as_float(w << 16); }
__device__ __forceinline__ float bhi(unsigned w) { return __uint_as_float(w & 0xffff0000u); }

#define XB_TMO      128
#define XB_XCNT(j)  (256  + 64 * (j))
#define XB_XSUB(j)  (1280 + 64 * (j))
#define XB_XGEN(j)  (2304 + 64 * (j))
#define XB_TOP      3328
#define XB_TOPGEN   3392
#define XCD_BAR_WORDS 3456
#define XB_SPIN_CAP (1u << 18)

__device__ __forceinline__ unsigned xb_ld(unsigned* p)              { return __hip_atomic_load(p, __ATOMIC_RELAXED, __HIP_MEMORY_SCOPE_AGENT); }
__device__ __forceinline__ unsigned xb_add(unsigned* p, unsigned v) { return __hip_atomic_fetch_add(p, v, __ATOMIC_RELAXED, __HIP_MEMORY_SCOPE_AGENT); }
__device__ __forceinline__ unsigned xb_xcc_id() { return (unsigned)__builtin_amdgcn_s_getreg((3 << 11) | 20) & 0xFu; }
#define XB_SPIN(cond, bar) do { unsigned _sp = 0; while (cond) { __builtin_amdgcn_s_sleep(1); \
    if ((++_sp & 255u) == 0u) { if (xb_ld(&(bar)[XB_TMO])) break; if (_sp > XB_SPIN_CAP) { atomicAdd(&(bar)[XB_TMO], 1u); break; } } } } while (0)

struct XcdBarrier {
    unsigned* bar; unsigned x;
    volatile LAS unsigned* st;
};

__device__ __forceinline__ XcdBarrier xcd_barrier_post(unsigned* bar, volatile LAS unsigned* st) {
    XcdBarrier b; b.bar = bar; b.x = xb_xcc_id(); b.st = st;
    if (threadIdx.x == 0) (void)xb_add(&bar[XB_XCNT(b.x)], 1u);
    return b;
}
__device__ __forceinline__ void xcd_barrier_complete(unsigned* bar, unsigned x, unsigned& nloc, unsigned& nx) {
    const unsigned G = gridDim.x * gridDim.y * gridDim.z;
    unsigned sum, cnt, mine, sp = 0u;
    for (;;) {
        sum = 0u; cnt = 0u; mine = 0u;
#pragma unroll
        for (unsigned j = 0; j < 16; ++j) { const unsigned c = xb_ld(&bar[XB_XCNT(j)]); sum += c; cnt += (c > 0u) ? 1u : 0u; mine = (j == x) ? c : mine; }
        if (sum == G) break;
        __builtin_amdgcn_s_sleep(1);
        if ((++sp & 255u) == 0u) { if (xb_ld(&bar[XB_TMO])) break; if (sp > XB_SPIN_CAP) { atomicAdd(&bar[XB_TMO], 1u); break; } }
    }
    nloc = mine > 0u ? mine : 1u; nx = cnt > 0u ? cnt : 1u;
}

__device__ __forceinline__ void xcd_barrier(const XcdBarrier& b) {
    asm volatile("s_waitcnt vmcnt(0)" ::: "memory");
    __syncthreads();
    if (threadIdx.x == 0) {
        unsigned* bar = b.bar;
        __builtin_amdgcn_s_waitcnt(0);
        unsigned nloc = b.st[0], nx = b.st[1];
        if (nloc == 0u) { xcd_barrier_complete(bar, b.x, nloc, nx); b.st[0] = nloc; b.st[1] = nx; }
        const unsigned old = xb_add(&bar[XB_XSUB(b.x)], 1u);
        const unsigned gen = old / nloc;
        if (old + 1u == (gen + 1u) * nloc) {
            __builtin_amdgcn_fence(__ATOMIC_RELEASE, "agent");
            asm volatile("s_waitcnt vmcnt(0)" ::: "memory");
            const unsigned og = xb_add(&bar[XB_TOP], 1u);
            const unsigned tg = og / nx;
            if (og + 1u == (tg + 1u) * nx) xb_add(&bar[XB_TOPGEN], 1u);
            else XB_SPIN(xb_ld(&bar[XB_TOPGEN]) == tg, bar);
            __builtin_amdgcn_fence(__ATOMIC_ACQUIRE, "agent");
            xb_add(&bar[XB_XGEN(b.x)], 1u);
            asm volatile("s_waitcnt vmcnt(0)" ::: "memory");
        } else {
            XB_SPIN(xb_ld(&bar[XB_XGEN(b.x)]) == gen, bar);
            __builtin_amdgcn_fence(__ATOMIC_ACQUIRE, "agent");
            asm volatile("s_waitcnt vmcnt(0)" ::: "memory");
        }
    }
    __syncthreads();
}

struct Args {
    const float *x_p, *x_s, *p_p, *p_s, *norm_pre, *w_in, *pool_w, *pool_scale, *w_a, *q_norm, *k_norm, *w_b, *w_out, *norm_post, *ple_norm, *w_gate, *w_ple;
    float* out; unsigned char* ws; int ph_lo, ph_hi;
};

__device__ __forceinline__ float wave_sum(float v) {
#pragma unroll
    for (int o = 1; o < 64; o <<= 1) v += __shfl_xor(v, o);
    return v;
}
__device__ __forceinline__ void p0_transpose_item(const float* W, int K, int N, bf16* WT, int row_off, int ldt, int koff, LAS float* scr, int item, int lane, const float* kscale = nullptr) {
    const int nblk = N / 32, kb = item / nblk, nb = item % nblk, k0 = 64 * kb, n0 = 32 * nb;
#pragma unroll 8
    for (int i = 0; i < 32; ++i) { const int kk = 2 * i + (lane >> 5); float wv = W[(size_t)(k0 + kk) * N + n0 + (lane & 31)]; if (kscale) wv *= kscale[k0 + kk]; scr[kk * 33 + (lane & 31)] = wv; }
    LDS_WAIT(); asm volatile("" ::: "memory");
    const int c = lane & 7;
#pragma unroll
    for (int j = 0; j < 4; ++j) { const int n = (lane >> 3) + 8 * j; const LAS float* s = scr + (8 * c) * 33 + n;
        v4u o; o.x = pk2(s[0 * 33], s[1 * 33]); o.y = pk2(s[2 * 33], s[3 * 33]); o.z = pk2(s[4 * 33], s[5 * 33]); o.w = pk2(s[6 * 33], s[7 * 33]);
        *(GAS v4u*)(WT + (size_t)(row_off + n0 + n) * ldt + koff + k0 + 8 * c) = o; }
    LDS_WAIT(); asm volatile("" ::: "memory");
}
__device__ __forceinline__ const float* xrow_ptr(const Args& a, int m) { return m < MP ? a.x_p + (size_t)m * D : a.x_s + (size_t)(m - MP) * D; }

__device__ __forceinline__ void phase0(const Args& a, LAS unsigned char* lds, int vcu, int G) {
    int tid = threadIdx.x; asm volatile("" : "+v"(tid));
    const int lane = tid & 63, wave = __builtin_amdgcn_readfirstlane(tid >> 6);
    LAS float* scr = (LAS float*)(lds + wave * 16384);
    const int gw = vcu * NWAVES + wave, NGW = G * NWAVES;
    unsigned char* ws = a.ws;
    {
        LAS float* At = (LAS float*)lds; LAS float* Bt = (LAS float*)(lds + 64 * 257 * 4 + 64);
        bf16* WT = (bf16*)(ws + WS_WIN);
        for (int tile = vcu; tile < 256; tile += G) {
            const int kb = tile >> 4, g = (tile >> 2) & 3, db = tile & 3, k0 = 64 * kb, d0 = 64 * db;
#pragma unroll
            for (int i = 0; i < 8; ++i) { const int row = (tid >> 6) + 8 * i, c4 = tid & 63;
                const f32x4 v = *(const GAS f32x4*)(a.w_in + (size_t)(k0 + row) * INW + g * 256 + 4 * c4);
                LAS float* d = At + row * 257 + 4 * c4; d[0] = v.x; d[1] = v.y; d[2] = v.z; d[3] = v.w; }
#pragma unroll
            for (int i = 0; i < 8; ++i) { const int c = (tid >> 4) + 32 * i, c4 = tid & 15;
                *(LAS f32x4*)(Bt + c * 64 + 4 * c4) = *(const GAS f32x4*)(a.pool_w + (size_t)g * 65536 + (size_t)c * 256 + d0 + 4 * c4); }
            __syncthreads();
            float acc[8];
#pragma unroll
            for (int j = 0; j < 8; ++j) acc[j] = 0.f;
#pragma unroll 4
            for (int c = 0; c < 256; ++c) { const float av = At[lane * 257 + c]; const f32x4 b0 = *(const LAS f32x4*)(Bt + c * 64 + wave * 8), b1 = *(const LAS f32x4*)(Bt + c * 64 + wave * 8 + 4);
                acc[0] += av * b0.x; acc[1] += av * b0.y; acc[2] += av * b0.z; acc[3] += av * b0.w; acc[4] += av * b1.x; acc[5] += av * b1.y; acc[6] += av * b1.z; acc[7] += av * b1.w; }
#pragma unroll
            for (int j = 0; j < 8; ++j) WT[(size_t)(g * 256 + d0 + wave * 8 + j) * D + k0 + lane] = (bf16)(pk2(acc[j], 0.f) & 0xffffu);
            __syncthreads();
        }
    }
    constexpr int I_IN = (D / 64) * ((INW - 1024) / 32), I_SQ = (D / 64) * (D / 32), I_PLE = (PLE / 64) * (D / 32);
    constexpr int NITEMS = I_IN + 4 * I_SQ + I_PLE;
    for (int it = gw; it < NITEMS; it += NGW) {
        int r = it;
        if (r < I_IN) { const int kb = r / 176, nb = 32 + r % 176; const int n0 = 32 * nb; int roff = 0;
            if (n0 >= 4608) { const int c = (n0 - 4608) & 1023, isb = (n0 - 4608) >> 10; roff = 4608 + 256 * (c >> 7) + 128 * isb + (c & 127) - n0; }
            p0_transpose_item(a.w_in, D, INW, (bf16*)(ws + WS_WIN), roff, D, 0, scr, kb * (INW / 32) + nb, lane); continue; } r -= I_IN;
        if (r < I_SQ) { p0_transpose_item(a.w_a, D, D, (bf16*)(ws + WS_WAB), 0, 2048, 0, scr, r, lane); continue; } r -= I_SQ;
        if (r < I_SQ) { p0_transpose_item(a.w_b, D, D, (bf16*)(ws + WS_WAB), 0, 2048, 1024, scr, r, lane); continue; } r -= I_SQ;
        if (r < I_SQ) { p0_transpose_item(a.w_out, D, D, (bf16*)(ws + WS_WO), 0, D, 0, scr, r, lane); continue; } r -= I_SQ;
        if (r < I_SQ) { p0_transpose_item(a.w_gate, D, D, (bf16*)(ws + WS_WG), 0, D, 0, scr, r, lane, a.ple_norm); continue; } r -= I_SQ;
        p0_transpose_item(a.w_ple, PLE, D, (bf16*)(ws + WS_WPLE), 0, PLE, 0, scr, r, lane);
    }
    f32x4 gpre[4];
#pragma unroll
    for (int j = 0; j < 4; ++j) gpre[j] = ((const GAS f32x4*)a.norm_pre)[lane + 64 * j];
    bf16* H = (bf16*)(ws + WS_RA); bf16* PB = (bf16*)(ws + WS_PBF);
    for (int m = gw; m < M; m += NGW) {
        const GAS f32x4* xr = (const GAS f32x4*)xrow_ptr(a, m) + lane;
        f32x4 v[4]; float s = 0.f;
#pragma unroll
        for (int j = 0; j < 4; ++j) { v[j] = xr[64 * j]; s += (v[j].x * v[j].x + v[j].y * v[j].y) + (v[j].z * v[j].z + v[j].w * v[j].w); }
        const float rstd = 1.0f / sqrtf(wave_sum(s) * (1.f / D) + EPS);
        GAS v2u* o8 = (GAS v2u*)(H + (size_t)m * D) + lane;
#pragma unroll
        for (int j = 0; j < 4; ++j) { const f32x4 y = v[j] * rstd * gpre[j]; o8[64 * j] = (v2u){pk2(y.x, y.y), pk2(y.z, y.w)}; }
        const float* prow = m < MP ? a.p_p + (size_t)m * PLE : a.p_s + (size_t)(m - MP) * PLE;
        const f32x4 pv = ((const GAS f32x4*)prow)[lane];
        ((GAS v2u*)(PB + (size_t)m * PLE))[lane] = (v2u){pk2(pv.x, pv.y), pk2(pv.z, pv.w)};
    }
}

__device__ __forceinline__ void normrope16(bf16* ptr, int t, int qd, const float* gain, float scale) {
    const v4u w0 = ((const GAS v4u*)ptr)[0], w1 = ((const GAS v4u*)ptr)[1];
    float av[16];
    av[0] = blo(w0.x); av[1] = bhi(w0.x); av[2] = blo(w0.y); av[3] = bhi(w0.y); av[4] = blo(w0.z); av[5] = bhi(w0.z); av[6] = blo(w0.w); av[7] = bhi(w0.w);
    av[8] = blo(w1.x); av[9] = bhi(w1.x); av[10] = blo(w1.y); av[11] = bhi(w1.y); av[12] = blo(w1.z); av[13] = bhi(w1.z); av[14] = blo(w1.w); av[15] = bhi(w1.w);
    float ss = 0.f;
#pragma unroll
    for (int i = 0; i < 16; ++i) ss += av[i] * av[i];
    ss += __shfl_xor(ss, 1); ss += __shfl_xor(ss, 2);
    const float rstd = 1.0f / sqrtf(ss * (1.f / 64.f) + EPS);
    const float pos = (qd < 2) ? (float)(t >> 6) : (float)(t & 63);
    const float sgn = (qd & 1) ? 1.f : -1.f;
    float o[16];
#pragma unroll
    for (int i4 = 0; i4 < 4; ++i4) { const f32x4 g = ((const GAS f32x4*)(gain + qd * 16))[i4];
        av[4 * i4 + 0] *= rstd * g.x; av[4 * i4 + 1] *= rstd * g.y; av[4 * i4 + 2] *= rstd * g.z; av[4 * i4 + 3] *= rstd * g.w; }
#pragma unroll
    for (int i = 0; i < 16; ++i) {
        const float pr = __shfl_xor(av[i], 1);
        const float freq = __builtin_amdgcn_exp2f(-(float)i * 0.83048202372184058696f);
        float rev = pos * freq * 0.15915494309189533577f; rev = __builtin_amdgcn_fractf(rev);
        const float sn = __builtin_amdgcn_sinf(rev), cs = __builtin_amdgcn_cosf(rev);
        o[i] = (av[i] * cs + sgn * pr * sn) * scale;
    }
    v4u r0, r1;
    r0.x = pk2(o[0], o[1]); r0.y = pk2(o[2], o[3]); r0.z = pk2(o[4], o[5]); r0.w = pk2(o[6], o[7]);
    r1.x = pk2(o[8], o[9]); r1.y = pk2(o[10], o[11]); r1.z = pk2(o[12], o[13]); r1.w = pk2(o[14], o[15]);
    ((GAS v4u*)ptr)[0] = r0; ((GAS v4u*)ptr)[1] = r1;
}
__device__ __forceinline__ int tok_of_row(int m) { return m < MP ? (m & (TP - 1)) : (m & (TS - 1)); }
__device__ __forceinline__ void phase2(const Args& a, int vcu, int G) {
    int tid = threadIdx.x; asm volatile("" : "+v"(tid));
    const int lane = tid & 63, wave = __builtin_amdgcn_readfirstlane(tid >> 6);
    bf16* K = (bf16*)(a.ws + WS_RK);
    const int gw = vcu * NWAVES + wave, NGW = G * NWAVES;
    for (int m4 = gw; m4 < M / 4; m4 += NGW) { const int m = m4 * 4 + (lane >> 4); normrope16(K + (size_t)m * 256 + (lane & 15) * 16, tok_of_row(m), lane & 3, a.k_norm, 1.0f); }
}
template <int W> __device__ __forceinline__ void pool_item(const bf16* Z, const bf16* SZA, bf16* AO, const float* pscale, int g, int rb, int cc, int rsub) {
    const f32x4 ps0 = *(const GAS f32x4*)(pscale + g * 256 + cc * 8), ps1 = *(const GAS f32x4*)(pscale + g * 256 + cc * 8 + 4);
    constexpr int half = W / 2;
#pragma unroll 1
    for (int rr = 0; rr < 4; ++rr) {
        const int m = rb * 64 + rr * 16 + rsub;
        const int T = m < MP ? TP : TS, s0 = m < MP ? (m & ~(TP - 1)) : (m & ~(TS - 1)), t = m - s0;
        const bf16* colp = Z + (size_t)s0 * D + g * 256 + cc * 8;
        v4u wv[W];
#pragma unroll
        for (int i = 0; i < W; ++i) { const int sidx = t - half + i; const int sc = min(max(sidx, 0), T - 1); wv[i] = *(const GAS v4u*)(colp + (size_t)sc * D); }
        const v4u gz = *(const GAS v4u*)(SZA + (size_t)m * D + g * 256 + cc * 8);
        float acc[8];
#pragma unroll
        for (int e = 0; e < 8; ++e) acc[e] = 0.f;
#pragma unroll
        for (int i = 0; i < W; ++i) { const int sidx = t - half + i; const float wgt = (sidx >= 0 && sidx < T) ? 1.f : 0.f; const v4u w = wv[i];
            acc[0] += wgt * blo(w.x); acc[1] += wgt * bhi(w.x); acc[2] += wgt * blo(w.y); acc[3] += wgt * bhi(w.y); acc[4] += wgt * blo(w.z); acc[5] += wgt * bhi(w.z); acc[6] += wgt * blo(w.w); acc[7] += wgt * bhi(w.w); }
        const v4u own = wv[half];
        const int lo = max(t - half, 0), hi = min(t + half, T);
        const float inv = 1.0f / (float)(hi - lo);
        v4u o; o.x = pk2((acc[0] * inv - blo(own.x)) * ps0.x * blo(gz.x), (acc[1] * inv - bhi(own.x)) * ps0.y * bhi(gz.x));
        o.y = pk2((acc[2] * inv - blo(own.y)) * ps0.z * blo(gz.y), (acc[3] * inv - bhi(own.y)) * ps0.w * bhi(gz.y));
        o.z = pk2((acc[4] * inv - blo(own.z)) * ps1.x * blo(gz.z), (acc[5] * inv - bhi(own.z)) * ps1.y * bhi(gz.z));
        o.w = pk2((acc[6] * inv - blo(own.w)) * ps1.z * blo(gz.w), (acc[7] * inv - bhi(own.w)) * ps1.w * bhi(gz.w));
        *(GAS v4u*)(AO + (size_t)m * D + g * 256 + cc * 8) = o;
    }
}
__device__ __forceinline__ void pool_tail(const Args& a, int vcu, int G) {
    int tid = threadIdx.x; asm volatile("" : "+v"(tid));
    unsigned char* ws = a.ws;
    const bf16* Z = (const bf16*)(ws + WS_RB); const bf16* SZA = (const bf16*)(ws + WS_RC); bf16* AO = (bf16*)(ws + WS_RA);
    const int cc = tid & 31, rsub = tid >> 5;
    for (int it = vcu; it < (M / 64) * 4; it += G) {
        const int g = it & 3, rb = it >> 2;
        if (g == 0) pool_item<2>(Z, SZA, AO, a.pool_scale, g, rb, cc, rsub);
        else if (g == 1) pool_item<4>(Z, SZA, AO, a.pool_scale, g, rb, cc, rsub);
        else if (g == 2) pool_item<8>(Z, SZA, AO, a.pool_scale, g, rb, cc, rsub);
        else pool_item<16>(Z, SZA, AO, a.pool_scale, g, rb, cc, rsub);
    }
}

__device__ __forceinline__ void phase6(const Args& a, int vcu, int G) {
    int tid = threadIdx.x; asm volatile("" : "+v"(tid));
    const int lane = tid & 63, wave = __builtin_amdgcn_readfirstlane(tid >> 6);
    unsigned char* ws = a.ws;
    const bf16* Y = (const bf16*)(ws + WS_RA); bf16* X1 = (bf16*)(ws + WS_RB); float* R2 = (float*)(ws + WS_R2);
    const int gw = vcu * NWAVES + wave, NGW = G * NWAVES;
    f32x4 gpost[4];
#pragma unroll
    for (int j = 0; j < 4; ++j) gpost[j] = ((const GAS f32x4*)a.norm_post)[lane + 64 * j];
    for (int m = gw; m < M; m += NGW) {
        const GAS f32x4* xr = (const GAS f32x4*)xrow_ptr(a, m) + lane;
        const GAS v2u* yr = (const GAS v2u*)(Y + (size_t)m * D) + lane;
        f32x4 xv[4], yv[4]; float s = 0.f;
#pragma unroll
        for (int j = 0; j < 4; ++j) { xv[j] = xr[64 * j]; const v2u w = yr[64 * j]; yv[j] = (f32x4){blo(w.x), bhi(w.x), blo(w.y), bhi(w.y)};
            s += (yv[j].x * yv[j].x + yv[j].y * yv[j].y) + (yv[j].z * yv[j].z + yv[j].w * yv[j].w); }
        const float rstd = 1.0f / sqrtf(wave_sum(s) * (1.f / D) + EPS);
        float s2 = 0.f;
        GAS v2u* o8 = (GAS v2u*)(X1 + (size_t)m * D) + lane;
#pragma unroll
        for (int j = 0; j < 4; ++j) { xv[j] = xv[j] + yv[j] * rstd * gpost[j]; o8[64 * j] = (v2u){pk2(xv[j].x, xv[j].y), pk2(xv[j].z, xv[j].w)};
            s2 += (xv[j].x * xv[j].x + xv[j].y * xv[j].y) + (xv[j].z * xv[j].z + xv[j].w * xv[j].w); }
        const float rstd2 = 1.0f / sqrtf(wave_sum(s2) * (1.f / D) + EPS);
        if (lane == 0) R2[m] = rstd2;
    }
}

__device__ __forceinline__ bool attn_next(int i, int vcu, int G, long& qrow0, long& kvrow0, int& NT, int& h) {
    int samp, b, qb;
    if (G == 256) {
        if (i >= 20) return false;
        const int x = vcu >> 5, j = vcu & 31; b = x;
        if (i < 16) { samp = 0; h = (i >> 2) * 4 + (i & 3); qb = j; }
        else { samp = 1; h = (i - 16) * 4 + (j >> 3); qb = j & 7; }
    } else {
        const int uid = vcu + i * G; if (uid >= 5120) return false;
        if (uid < 4096) { samp = 0; b = uid >> 9; h = (uid >> 5) & 15; qb = uid & 31; }
        else { const int r = uid - 4096; samp = 1; b = r >> 7; h = (r >> 3) & 15; qb = r & 7; }
    }
    if (!samp) { kvrow0 = (long)b * TP; NT = TP / 64; } else { kvrow0 = (long)MP + (long)b * TS; NT = TS / 64; }
    qrow0 = kvrow0 + qb * 256;
    return true;
}

__global__ void __launch_bounds__(NWAVES * 64, 2) fwd_megakernel(Args args) {
    extern __shared__ __attribute__((aligned(16))) unsigned char lds_raw[];
    LAS unsigned char* lds = (LAS unsigned char*)lds_raw;
    const int G = gridDim.x; const int bx = blockIdx.x; const int vcu = (G % 8 == 0) ? (bx % 8) * (G / 8) + bx / 8 : bx;
    cg::grid_group grid = cg::this_grid();
    unsigned char* ws = args.ws;
    const int lo = args.ph_lo, hi = args.ph_hi;
#ifndef PH_MASK
#define PH_MASK 0xFF
#endif
#define IN(k) ((((PH_MASK) >> (k)) & 1) && lo <= (k) && (k) < hi)
#ifndef DUP_MASK
#define DUP_MASK 0
#endif
#define REPS(k) ((((DUP_MASK) >> (k)) & 1) ? 2 : 1)
#define SEAM(k) do { if (IN(k) && IN((k) + 1)) { if ((k) == 0) { VM_WAIT(); grid.sync(); VM_WAIT(); } else { xcd_barrier(bar); } } } while (0)
    volatile LAS unsigned* MISC = (volatile LAS unsigned*)(lds + MISC_OFF);
    if (threadIdx.x < 32) MISC[threadIdx.x] = 0u;
    __syncthreads();
    XcdBarrier bar = xcd_barrier_post((unsigned*)(ws + WS_CTL), MISC);
    bf16* RA = (bf16*)(ws + WS_RA); bf16* RB = (bf16*)(ws + WS_RB); bf16* RC = (bf16*)(ws + WS_RC); bf16* RD = (bf16*)(ws + WS_RD); bf16* RE = (bf16*)(ws + WS_RE);
    bf16* RK = (bf16*)(ws + WS_RK); bf16* RV = (bf16*)(ws + WS_RV);
    bf16* MA = (bf16*)args.out; bf16* MB = (bf16*)args.out + (size_t)M * D;

    if (IN(0)) { for (int rep = 0; rep < REPS(0); ++rep) phase0(args, lds, vcu, G); }
    SEAM(0);
    if (IN(1)) for (int rep = 0; rep < REPS(1); ++rep) {
        pg8::Gemm g{RA, RA, (const bf16*)(ws + WS_WIN), D, D, D, D, 0};
        pg8::StaticOrder S; S.init(M, INW, G, bx);
        pg8::EpiIn E{RB, RC, RD, RK, RV, RE, MA, MB};
        pg8::gemm_phase<pg8::EpiIn, pg8::StaticOrder, true, true>(lds, g, S, E);
    }
    SEAM(1);
    if (IN(2)) { phase2(args, vcu, G); }
    SEAM(2);
    if (IN(3)) {
        long qrow0, kvrow0; int NT, h;
        bool track;
        { const int ln = threadIdx.x & 63; float mq = fabsf(args.q_norm[ln]), mk = fabsf(args.k_norm[ln]);
#pragma unroll
          for (int o = 1; o < 64; o <<= 1) { mq = fmaxf(mq, __shfl_xor(mq, o)); mk = fmaxf(mk, __shfl_xor(mk, o)); }
          track = __builtin_amdgcn_readfirstlane((mq * mk <= 2.6f) ? 0 : 1) != 0; }
        for (int rep = 0; rep < REPS(3); ++rep)
        for (int i = 0; attn_next(i, vcu, G, qrow0, kvrow0, NT, h); ++i)
            { if (track) attn_body::attn_unit<8, true>(qrow0, kvrow0, NT, h, (const attn_body::bf16*)RD, (const attn_body::bf16*)RK, (const attn_body::bf16*)RV, (attn_body::bf16*)RD, (const attn_body::bf16*)RE, args.q_norm, (char*)lds_raw);
              else attn_body::attn_unit<8, false>(qrow0, kvrow0, NT, h, (const attn_body::bf16*)RD, (const attn_body::bf16*)RK, (const attn_body::bf16*)RV, (attn_body::bf16*)RD, (const attn_body::bf16*)RE, args.q_norm, (char*)lds_raw); }
        for (int rep = 0; rep < REPS(8); ++rep) pool_tail(args, vcu, G);
    }
    SEAM(3);
    if (IN(4)) {
        pg8::Gemm g{RA, RD, (const bf16*)(ws + WS_WAB), D, 2048, 2048, 1024, 0};
        pg8::DupOrder S; S.init(M, D, G, bx, REPS(4));
        pg8::EpiMerge E{RC, MA, MB};
        pg8::gemm_phase<pg8::EpiMerge, pg8::DupOrder, true, true>(lds, g, S, E);
    }
    SEAM(4);
    if (IN(5)) {
        { pg8::Gemm g{RC, RC, (const bf16*)(ws + WS_WO), D, D, D, D, 0};
          pg8::DupOrder S; S.init(M, D, G, bx, REPS(5));
          pg8::EpiPlain E{RA, D};
          pg8::gemm_phase<pg8::EpiPlain, pg8::DupOrder, true, true>(lds, g, S, E); }
        { pg8::Gemm g{(const bf16*)(ws + WS_PBF), (const bf16*)(ws + WS_PBF), (const bf16*)(ws + WS_WPLE), PLE, PLE, PLE, PLE, 0};
          pg8::DupOrder S; S.init(M, D, G, bx, REPS(9));
          pg8::EpiPlain E{RD, D};
          pg8::gemm_phase<pg8::EpiPlain, pg8::DupOrder, true, true>(lds, g, S, E); }
    }
    SEAM(5);
    if (IN(6)) { for (int rep = 0; rep < REPS(6); ++rep) phase6(args, vcu, G); }
    SEAM(6);
    if (IN(7)) {
        pg8::Gemm g{RB, RB, (const bf16*)(ws + WS_WG), D, D, D, D, 0};
        pg8::StaticOrder S; S.init(M, D, G, bx);
        pg8::EpiFinal E{args.out, RB, RD, (const float*)(ws + WS_R2)};
        pg8::gemm_phase<pg8::EpiFinal, pg8::StaticOrder, true, true>(lds, g, S, E);
    }
#undef IN
#undef SEAM
}

extern "C" void kernel_launch(void* const* d_in, const int* in_sizes, int n_in, void* d_out, int out_size, void* d_ws, size_t ws_size, hipStream_t stream) {
    static int grid = 0;
    if (grid == 0) {
        if (n_in != 17 || in_sizes[0] != MP * D || in_sizes[1] != MS * D || out_size != M * D || ws_size < WS_END) {
            fprintf(stderr, "kernel_launch: unexpected shapes (n_in %d, in0 %d, out %d, ws %zu); nothing launched\n", n_in, n_in > 0 ? in_sizes[0] : -1, out_size, ws_size); grid = -1; return; }
        int dev = 0, cus = 0, per_cu = 0;
        if (hipGetDevice(&dev) != hipSuccess || hipDeviceGetAttribute(&cus, hipDeviceAttributeMultiprocessorCount, dev) != hipSuccess) { fprintf(stderr, "kernel_launch: device query failed\n"); grid = -1; return; }
        if (hipFuncSetAttribute((const void*)fwd_megakernel, hipFuncAttributeMaxDynamicSharedMemorySize, LDS_BYTES) != hipSuccess) { fprintf(stderr, "kernel_launch: hipFuncSetAttribute failed\n"); grid = -1; return; }
        if (hipOccupancyMaxActiveBlocksPerMultiprocessor(&per_cu, (const void*)fwd_megakernel, NWAVES * 64, LDS_BYTES) != hipSuccess || per_cu < 1) { fprintf(stderr, "kernel_launch: occupancy query says %d\n", per_cu); per_cu = 1; }
        (void)hipGetLastError();
        grid = cus * 1;
        (void)per_cu;
    }
    if (grid < 0) return;
    if (hipMemsetAsync((char*)d_ws + WS_CTL, 0, CTL_ZERO_BYTES, stream) != hipSuccess) { fprintf(stderr, "kernel_launch: memset of control words failed\n"); return; }
    Args a{};
    a.x_p = (const float*)d_in[0]; a.x_s = (const float*)d_in[1]; a.p_p = (const float*)d_in[2]; a.p_s = (const float*)d_in[3]; a.norm_pre = (const float*)d_in[4];
    a.w_in = (const float*)d_in[5]; a.pool_w = (const float*)d_in[6]; a.pool_scale = (const float*)d_in[7]; a.w_a = (const float*)d_in[8]; a.q_norm = (const float*)d_in[9];
    a.k_norm = (const float*)d_in[10]; a.w_b = (const float*)d_in[11]; a.w_out = (const float*)d_in[12]; a.norm_post = (const float*)d_in[13]; a.ple_norm = (const float*)d_in[14];
    a.w_gate = (const float*)d_in[15]; a.w_ple = (const float*)d_in[16];
    a.out = (float*)d_out; a.ws = (unsigned char*)d_ws;
    if (N_LAUNCHES == 1) {
        a.ph_lo = 0; a.ph_hi = N_PHASES;
        void* kargs[] = {&a};
        hipError_t e = hipLaunchCooperativeKernel((const void*)fwd_megakernel, dim3(grid), dim3(NWAVES * 64), kargs, LDS_BYTES, stream);
        if (e != hipSuccess) fprintf(stderr, "kernel_launch: cooperative launch failed: %s (grid %d)\n", hipGetErrorString(e), grid);
    } else {
        for (int ph = 0; ph < N_PHASES; ++ph) {
            a.ph_lo = ph; a.ph_hi = ph + 1;
            hipLaunchKernelGGL(fwd_megakernel, dim3(grid), dim3(NWAVES * 64), LDS_BYTES, stream, a);
        }
    }
}
```
